# Optimizing an MI355X kernel written in HIP

```python
import math
import jax, jax.numpy as jnp
from jax import lax
import numpy as np


D_MODEL = 2048
BATCH = 8
SEQ = 2048
DEPTH = 1

N_MEM = 256
EPS = 1e-6
MIX_WIDTH = D_MODEL
ATTN_WIDTH = MIX_WIDTH // 2
SSM_WIDTH = MIX_WIDTH - ATTN_WIDTH
DIFF_HEADS = 8
DIFF_VDIM = ATTN_WIDTH // DIFF_HEADS
DIFF_QKDIM = DIFF_VDIM // 2
ROT_DIM = DIFF_QKDIM // 4
ROPE_THETA = 500000.0
Q_BLOCK = 128
IN_COLS = 3 * ATTN_WIDTH + SSM_WIDTH
SSM_GROUP = 16
SSM_GROUPS = SSM_WIDTH // SSM_GROUP
SSM_STATE = 64
DT_MIN = 0.001
DT_MAX = 0.1
XATTN_HEADS = 4
XATTN_HEAD_DIM = 128
XATTN_WIDTH = XATTN_HEADS * XATTN_HEAD_DIM
PEER_HEADS = 8
PEER_KEYS = 128
PEER_EXPERTS = PEER_KEYS * PEER_KEYS
PEER_QDIM = 256
PEER_TOPK = 16
PEER_CHUNK = 128

kernel_name = 'hymba_diffattn_s5_peer_block'


def rmsnorm(x, g):
    xf = x.astype(jnp.float32)
    y = xf * lax.rsqrt(jnp.mean(xf * xf, axis=-1, keepdims=True) + EPS)
    return (y * g.astype(jnp.float32)).astype(x.dtype)


def rope_tables(positions):
    freqs = ROPE_THETA ** (-jnp.arange(0, ROT_DIM, 2, dtype=jnp.float32) / ROT_DIM)
    ang = positions.astype(jnp.float32)[..., None] * freqs
    return jnp.cos(ang)[:, :, None, None, :], jnp.sin(ang)[:, :, None, None, :]


def partial_rope(t, cos, sin):
    half = ROT_DIM // 2
    r1, r2, rest = t[..., :half], t[..., half:ROT_DIM], t[..., ROT_DIM:]
    c, s = cos.astype(t.dtype), sin.astype(t.dtype)
    return jnp.concatenate([r1 * c - r2 * s, r1 * s + r2 * c, rest], axis=-1)


def diff_attention(q, k, v, lam):
    B, S, H, _, d = q.shape
    nblk = S // Q_BLOCK
    scale = DIFF_QKDIM ** -0.5
    qb = q.reshape(B, nblk, Q_BLOCK, H, 2, d).transpose(1, 0, 2, 3, 4, 5)
    k_idx = jnp.arange(S)

    def one_block(args):
        qblk, bi = args
        s = jnp.einsum('bqhcd,bkhcd->bhcqk', qblk, k).astype(jnp.float32) * scale
        q_idx = bi * Q_BLOCK + jnp.arange(Q_BLOCK)
        mask = k_idx[None, :] <= q_idx[:, None]
        p = jax.nn.softmax(jnp.where(mask, s, -jnp.inf), axis=-1)
        a = p[:, :, 0] - lam * p[:, :, 1]
        return jnp.einsum('bhqk,bkhe->bqhe', a.astype(v.dtype), v)

    out = lax.map(one_block, (qb, jnp.arange(nblk)))
    return out.transpose(1, 0, 2, 3, 4).reshape(B, S, H, v.shape[-1])


def s5_ssm(u, a_re, a_im, log_dt, b_re, b_im, c_re, c_im, d_skip):
    f32 = jnp.float32
    dt = jnp.exp(log_dt.astype(f32))[:, None]
    lre, lim = a_re.astype(f32), a_im.astype(f32)
    mag = jnp.exp(lre * dt)
    ang = lim * dt
    ab_re, ab_im = mag * jnp.cos(ang), mag * jnp.sin(ang)
    den = lre * lre + lim * lim
    f_re = ((ab_re - 1.0) * lre + ab_im * lim) / den
    f_im = (ab_im * lre - (ab_re - 1.0) * lim) / den
    br, bim = b_re.astype(f32), b_im.astype(f32)
    bb_re = f_re[..., None] * br - f_im[..., None] * bim
    bb_im = f_re[..., None] * bim + f_im[..., None] * br
    uf = u.astype(f32)
    bu_re = jnp.einsum('bsgh,gph->bsgp', uf, bb_re)
    bu_im = jnp.einsum('bsgh,gph->bsgp', uf, bb_im)
    S = u.shape[1]
    a_full_re = jnp.broadcast_to(ab_re, (1, S) + ab_re.shape)
    a_full_im = jnp.broadcast_to(ab_im, (1, S) + ab_im.shape)

    def combine(e1, e2):
        a1r, a1i, b1r, b1i = e1
        a2r, a2i, b2r, b2i = e2
        return (a2r * a1r - a2i * a1i,
                a2r * a1i + a2i * a1r,
                a2r * b1r - a2i * b1i + b2r,
                a2r * b1i + a2i * b1r + b2i)

    _, _, xr, xi = lax.associative_scan(combine, (a_full_re, a_full_im, bu_re, bu_im), axis=1)
    y = (jnp.einsum('bsgp,ghp->bsgh', xr, c_re.astype(f32))
         - jnp.einsum('bsgp,ghp->bsgh', xi, c_im.astype(f32))
         + d_skip.astype(f32) * uf)
    return y.astype(u.dtype)


def cross_attention(h, mem, wq, wkv, wo):
    B, S, _ = h.shape
    M = mem.shape[1]
    q = (h @ wq).reshape(B, S, XATTN_HEADS, XATTN_HEAD_DIM)
    kv = (mem @ wkv).reshape(M, B, 2, XATTN_HEADS, XATTN_HEAD_DIM) if False else (mem @ wkv).reshape(B, M, 2, XATTN_HEADS, XATTN_HEAD_DIM)
    k, v = kv[:, :, 0], kv[:, :, 1]
    s = jnp.einsum('bshd,bmhd->bhsm', q, k).astype(jnp.float32) * XATTN_HEAD_DIM ** -0.5
    p = jax.nn.softmax(s, axis=-1).astype(h.dtype)
    o = jnp.einsum('bhsm,bmhd->bshd', p, v).reshape(B, S, XATTN_WIDTH)
    return o @ wo


def peer(h, wq, sub_k1, sub_k2, u_tab, v_tab):
    B, S, D = h.shape
    half = PEER_QDIM // 2
    q = (h @ wq).reshape(B, S, PEER_HEADS, PEER_QDIM)
    s1 = jnp.einsum('bshd,hnd->bshn', q[..., :half], sub_k1).astype(jnp.float32)
    s2 = jnp.einsum('bshd,hnd->bshn', q[..., half:], sub_k2).astype(jnp.float32)
    t1, i1 = lax.top_k(s1, PEER_TOPK)
    t2, i2 = lax.top_k(s2, PEER_TOPK)
    cand = (t1[..., :, None] + t2[..., None, :]).reshape(B, S, PEER_HEADS, PEER_TOPK * PEER_TOPK)
    ts, ic = lax.top_k(cand, PEER_TOPK)
    e1 = jnp.take_along_axis(i1, ic // PEER_TOPK, axis=-1)
    e2 = jnp.take_along_axis(i2, ic % PEER_TOPK, axis=-1)
    experts = e1 * PEER_KEYS + e2
    gates = jax.nn.softmax(ts, axis=-1).astype(h.dtype)
    nc = (B * S) // PEER_CHUNK
    E = PEER_HEADS * PEER_TOPK
    hx = h.reshape(nc, PEER_CHUNK, D)
    ex = experts.reshape(nc, PEER_CHUNK, E)
    gt = gates.reshape(nc, PEER_CHUNK, E)

    def chunk(args):
        xc, ec, gc = args
        act = jnp.einsum('cd,ced->ce', xc, u_tab[ec])
        w = gc * jax.nn.gelu(act, approximate=False)
        return jnp.einsum('ce,ced->cd', w, v_tab[ec])

    return lax.map(chunk, (hx, ex, gt)).reshape(B, S, D)


def setup_inputs(seed: int = 0) -> dict:
    key = jax.random.key(seed)
    ks = iter(jax.random.split(key, 48))
    L, D, f32 = DEPTH, D_MODEL, jnp.float32

    def nrm(shape, scale):
        return jax.random.normal(next(ks), shape, f32) * scale

    def gain(shape):
        return 1.0 + 0.05 * jax.random.normal(next(ks), shape, f32)

    x = nrm((BATCH, SEQ, D), 1.0)
    mem = nrm((BATCH, N_MEM, D), 1.0)
    positions = (jax.random.randint(next(ks), (BATCH, 1), 0, 4096, dtype=jnp.int32)
                 + jnp.arange(SEQ, dtype=jnp.int32)[None, :])
    G, P, Hc = SSM_GROUPS, SSM_STATE, SSM_GROUP
    n = jnp.arange(P, dtype=f32)
    ssm_a_re = -0.5 * jnp.exp(0.02 * jax.random.normal(next(ks), (L, G, P), f32))
    ssm_a_im = math.pi * n + 0.02 * jax.random.normal(next(ks), (L, G, P), f32)
    ssm_log_dt = math.log(DT_MIN) + jax.random.uniform(next(ks), (L, G), f32) * (math.log(DT_MAX) - math.log(DT_MIN))
    return {
        'x': x,
        'mem': mem,
        'positions': positions,
        'mix_norm_g': gain((L, D)),
        'w_in': nrm((L, D, IN_COLS), D ** -0.5),
        'lam_q1': nrm((L, DIFF_QKDIM), 0.1),
        'lam_k1': nrm((L, DIFF_QKDIM), 0.1),
        'lam_q2': nrm((L, DIFF_QKDIM), 0.1),
        'lam_k2': nrm((L, DIFF_QKDIM), 0.1),
        'attn_head_g': gain((L, DIFF_VDIM)),
        'ssm_a_re': ssm_a_re,
        'ssm_a_im': ssm_a_im,
        'ssm_log_dt': ssm_log_dt,
        'ssm_b_re': nrm((L, G, P, Hc), (2 * Hc) ** -0.5),
        'ssm_b_im': nrm((L, G, P, Hc), (2 * Hc) ** -0.5),
        'ssm_c_re': nrm((L, G, Hc, P), (2 * P) ** -0.5),
        'ssm_c_im': nrm((L, G, Hc, P), (2 * P) ** -0.5),
        'ssm_d': nrm((L, G, Hc), 1.0),
        'glu_w': nrm((L, SSM_WIDTH, SSM_WIDTH), SSM_WIDTH ** -0.5),
        'glu_b': nrm((L, SSM_WIDTH), 0.01),
        'ssm_out_g': gain((L, SSM_WIDTH)),
        'w_out': nrm((L, MIX_WIDTH, D), MIX_WIDTH ** -0.5),
        'xattn_norm_g': gain((L, D)),
        'mem_norm_g': gain((L, D)),
        'xattn_wq': nrm((L, D, XATTN_WIDTH), D ** -0.5),
        'xattn_wkv': nrm((L, D, 2 * XATTN_WIDTH), D ** -0.5),
        'xattn_wo': nrm((L, XATTN_WIDTH, D), XATTN_WIDTH ** -0.5),
        'ffn_norm_g': gain((L, D)),
        'peer_wq': nrm((L, D, PEER_HEADS * PEER_QDIM), D ** -0.5),
        'peer_k1': nrm((L, PEER_HEADS, PEER_KEYS, PEER_QDIM // 2), (PEER_QDIM // 2) ** -0.5),
        'peer_k2': nrm((L, PEER_HEADS, PEER_KEYS, PEER_QDIM // 2), (PEER_QDIM // 2) ** -0.5),
        'peer_u': nrm((L, PEER_EXPERTS, D), D ** -0.5),
        'peer_v': nrm((L, PEER_EXPERTS, D), 0.5),
        'final_norm_g': gain((D,)),
    }


def reference(x, mem, positions, mix_norm_g, w_in, lam_q1, lam_k1, lam_q2, lam_k2,
              attn_head_g, ssm_a_re, ssm_a_im, ssm_log_dt, ssm_b_re, ssm_b_im,
              ssm_c_re, ssm_c_im, ssm_d, glu_w, glu_b, ssm_out_g, w_out,
              xattn_norm_g, mem_norm_g, xattn_wq, xattn_wkv, xattn_wo, ffn_norm_g,
              peer_wq, peer_k1, peer_k2, peer_u, peer_v, final_norm_g):
    B, S, D = x.shape
    cos, sin = rope_tables(positions)
    h = x
    for l in range(DEPTH):
        lam_init = 0.8 - 0.6 * math.exp(-0.3 * l)
        xn = rmsnorm(h, mix_norm_g[l])
        z = xn @ w_in[l]
        q = z[..., :ATTN_WIDTH].reshape(B, S, DIFF_HEADS, 2, DIFF_QKDIM)
        k = z[..., ATTN_WIDTH:2 * ATTN_WIDTH].reshape(B, S, DIFF_HEADS, 2, DIFF_QKDIM)
        v = z[..., 2 * ATTN_WIDTH:3 * ATTN_WIDTH].reshape(B, S, DIFF_HEADS, DIFF_VDIM)
        u = z[..., 3 * ATTN_WIDTH:].reshape(B, S, SSM_GROUPS, SSM_GROUP)
        q = partial_rope(q, cos, sin)
        k = partial_rope(k, cos, sin)
        lam = (jnp.exp(jnp.sum(lam_q1[l].astype(jnp.float32) * lam_k1[l].astype(jnp.float32)))
               - jnp.exp(jnp.sum(lam_q2[l].astype(jnp.float32) * lam_k2[l].astype(jnp.float32)))
               + lam_init)
        att = diff_attention(q, k, v, lam)
        att = (rmsnorm(att, attn_head_g[l]) * (1.0 - lam_init)).reshape(B, S, ATTN_WIDTH)
        y = s5_ssm(u, ssm_a_re[l], ssm_a_im[l], ssm_log_dt[l], ssm_b_re[l], ssm_b_im[l],
                   ssm_c_re[l], ssm_c_im[l], ssm_d[l]).reshape(B, S, SSM_WIDTH)
        g = jax.nn.gelu(y, approximate=False)
        g = g * jax.nn.sigmoid(g @ glu_w[l] + glu_b[l])
        ssm_out = rmsnorm(g, ssm_out_g[l])
        h = h + jnp.concatenate([att, ssm_out], axis=-1) @ w_out[l]
        hn = rmsnorm(h, xattn_norm_g[l])
        mn = rmsnorm(mem, mem_norm_g[l])
        h = h + cross_attention(hn, mn, xattn_wq[l], xattn_wkv[l], xattn_wo[l])
        h = h + peer(rmsnorm(h, ffn_norm_g[l]), peer_wq[l], peer_k1[l], peer_k2[l],
                     peer_u[l], peer_v[l])
    return rmsnorm(h, final_norm_g)
```

```cpp
#include <hip/hip_runtime.h>
#include <hip/hip_bf16.h>
#include <cstdio>
#include <cstdint>
#include <cmath>

constexpr int BATCH = 8, SEQ = 2048, DM = 2048, T = BATCH * SEQ;
constexpr int NMEM = 256;
constexpr float EPS = 1e-6f;
constexpr int ATTW = 1024, SSMW = 1024, INC = 4096;
constexpr int NH = 8;
constexpr int SG = 64, SP = 64;
constexpr int XH = 4, XD = 128, XW = 512;
constexpr int PH = 8, PK = 128, PQD = 256, PTOP = 16;
constexpr float LAM_INIT = 0.2f;

#ifndef MK_ONE_LAUNCH
#define MK_ONE_LAUNCH 1
#endif

constexpr int NWAVES = 8, NTHR = 512;
constexpr int LDS_BYTES = 147456;
constexpr int MISC_OFF = 147456 - 512;

constexpr size_t MiB = 1u << 20;
constexpr size_t WS_CTL = 0, CTL_ZERO_BYTES = 1 * MiB;
constexpr size_t WS_RSTD0 = 1 * MiB, WS_RSTDM = WS_RSTD0 + 65536, WS_RSTD1 = WS_RSTDM + 65536, WS_RSTD2 = WS_RSTD1 + 65536, WS_LAM = WS_RSTD2 + 65536;
constexpr size_t WS_ROPE = 2 * MiB;
constexpr size_t WS_WIN = 8 * MiB, WS_WGLU = 24 * MiB, WS_WOUT = 26 * MiB, WS_WXQ = 34 * MiB, WS_WXKV = 36 * MiB, WS_WXO = 40 * MiB, WS_WPQ = 42 * MiB, WS_KD = 50 * MiB;
constexpr size_t WS_UCAT = 56 * MiB, WS_BTC = 96 * MiB, WS_BTA = 136 * MiB, WS_QB = 152 * MiB, WS_KB = 184 * MiB, WS_VB = 216 * MiB, WS_O0 = 248 * MiB, WS_O1 = 280 * MiB;
constexpr size_t WS_UB = 56 * MiB, WS_VT = 120 * MiB, WS_XQ = 184 * MiB, WS_SC = 184 * MiB;
constexpr size_t WS_B = 312 * MiB;
constexpr size_t WS_SL = 376 * MiB, WS_IDX = 376 * MiB, WS_GATE = 384 * MiB;
constexpr size_t WS_GB = 392 * MiB, WS_XO = 392 * MiB;
constexpr size_t WS_PQ = 424 * MiB;
constexpr size_t WS_HB2 = 408 * MiB;
constexpr size_t WS_XKV = 472 * MiB;
constexpr size_t WS_MN = 480 * MiB;
constexpr size_t WS_END = 488 * MiB;
constexpr size_t WS_SSQ = 128 * 1024;
constexpr size_t WS_SSQ3 = 512 * 1024;
constexpr size_t WS_SSQP = 2 * MiB;
constexpr size_t WS_SSQ1 = 704 * 1024, WS_SSQ2 = 768 * 1024;
constexpr int CW_TICKET = 160 * 1024;
constexpr size_t WS_PACT = 184 * MiB, WS_PW = 248 * MiB;
constexpr size_t WS_ISCU = 4 * MiB, WS_ISCV = 4 * MiB + 65536;
constexpr int NSL = 16, SLW = 128;
constexpr size_t WS_LSUM = 256 * 1024;
constexpr size_t WS_KP = 472 * MiB, WS_VT2 = 476 * MiB;
constexpr size_t WS_XQB = 184 * MiB, WS_XP = 200 * MiB;
constexpr size_t WS_AL = WS_LAM + 4096;
constexpr int S5L = 32, NCH = T / S5L, UCK = 640;
constexpr int CW_BAR = 4096;

#define GAS __attribute__((address_space(1)))
#define LAS __attribute__((address_space(3)))
typedef GAS unsigned gu32;
#define RLX_AGENT __ATOMIC_RELAXED, __HIP_MEMORY_SCOPE_AGENT

#define XB_TMO      128
#define XB_XCNT(j)  (256  + 64 * (j))
#define XB_XSUB(j)  (1280 + 64 * (j))
#define XB_XGEN(j)  (2304 + 64 * (j))
#define XB_TOP      3328
#define XB_TOPGEN   3392
#define XCD_BAR_WORDS 3456
#define XB_SPIN_CAP (1u << 26)
__device__ __forceinline__ unsigned xb_ld(unsigned* p)              { return __hip_atomic_load(p, __ATOMIC_RELAXED, __HIP_MEMORY_SCOPE_AGENT); }
__device__ __forceinline__ unsigned xb_add(unsigned* p, unsigned v) { return __hip_atomic_fetch_add(p, v, __ATOMIC_RELAXED, __HIP_MEMORY_SCOPE_AGENT); }
__device__ __forceinline__ unsigned xb_xcc_id() { return (unsigned)__builtin_amdgcn_s_getreg((3 << 11) | 20) & 0xFu; }
#define XB_SPIN(cond, bar) do { unsigned _sp = 0; while (cond) { __builtin_amdgcn_s_sleep(1); \
    if ((++_sp & 255u) == 0u) { if (xb_ld(&(bar)[XB_TMO])) break; if (_sp > XB_SPIN_CAP) { atomicAdd(&(bar)[XB_TMO], 1u); break; } } } } while (0)
struct XcdBarrier { unsigned* bar; unsigned x; volatile LAS unsigned* st; };
__device__ __forceinline__ XcdBarrier xcd_barrier_post(unsigned* bar, volatile LAS unsigned* st) {
    XcdBarrier b; b.bar = bar; b.x = xb_xcc_id(); b.st = st;
    if (threadIdx.x == 0) (void)xb_add(&bar[XB_XCNT(b.x)], 1u);
    return b;
}
__device__ __forceinline__ void xcd_barrier_complete(unsigned* bar, unsigned x, unsigned& nloc, unsigned& nx) {
    const unsigned G = gridDim.x * gridDim.y * gridDim.z;
    unsigned sum, cnt, mine, sp = 0u;
    for (;;) {
        sum = 0u; cnt = 0u; mine = 0u;
#pragma unroll
        for (unsigned j = 0; j < 16; ++j) { const unsigned c = xb_ld(&bar[XB_XCNT(j)]); sum += c; cnt += (c > 0u) ? 1u : 0u; mine = (j == x) ? c : mine; }
        if (sum == G) break;
        __builtin_amdgcn_s_sleep(1);
        if ((++sp & 255u) == 0u) { if (xb_ld(&bar[XB_TMO])) break; if (sp > XB_SPIN_CAP) { atomicAdd(&bar[XB_TMO], 1u); break; } }
    }
    nloc = mine > 0u ? mine : 1u; nx = cnt > 0u ? cnt : 1u;
}
__device__ __forceinline__ void xcd_barrier(const XcdBarrier& b) {
    asm volatile("s_waitcnt vmcnt(0)" ::: "memory");
    __syncthreads();
    if (threadIdx.x == 0) {
        unsigned* bar = b.bar;
        __builtin_amdgcn_s_waitcnt(0);
        unsigned nloc = b.st[0], nx = b.st[1]; const unsigned bx = b.st[3];
        if (nloc == 0u) { xcd_barrier_complete(bar, bx, nloc, nx); b.st[0] = nloc; b.st[1] = nx; }
        const unsigned old = xb_add(&bar[XB_XSUB(bx)], 1u);
        const unsigned gen = old / nloc;
        if (old + 1u == (gen + 1u) * nloc) {
            __builtin_amdgcn_fence(__ATOMIC_RELEASE, "agent");
            asm volatile("s_waitcnt vmcnt(0)" ::: "memory");
            const unsigned og = xb_add(&bar[XB_TOP], 1u);
            const unsigned tg = og / nx;
            if (og + 1u == (tg + 1u) * nx) xb_add(&bar[XB_TOPGEN], 1u);
            else XB_SPIN(xb_ld(&bar[XB_TOPGEN]) == tg, bar);
            __builtin_amdgcn_fence(__ATOMIC_ACQUIRE, "agent");
            xb_add(&bar[XB_XGEN(bx)], 1u);
            asm volatile("s_waitcnt vmcnt(0)" ::: "memory");
        } else {
            XB_SPIN(xb_ld(&bar[XB_XGEN(bx)]) == gen, bar);
            __builtin_amdgcn_fence(__ATOMIC_ACQUIRE, "agent");
            asm volatile("s_waitcnt vmcnt(0)" ::: "memory");
        }
    }
    __syncthreads();
}

struct Args { const void* in[34]; float* out; unsigned char* ws; int ph_lo, ph_hi, li, pad; };
struct Frame {
    unsigned char* lds;
    LAS unsigned char* ldsl;
    int tid, lane, wave, G, bid;
    float* out;
    unsigned char* ws;
};
__device__ __forceinline__ float wave_sum(float v) {
#pragma unroll
    for (int o = 1; o < 64; o <<= 1) v += __shfl_xor(v, o);
    return v;
}
__device__ __forceinline__ float wave_max(float v) {
#pragma unroll
    for (int o = 1; o < 64; o <<= 1) v = fmaxf(v, __shfl_xor(v, o));
    return v;
}
__device__ __forceinline__ float gelu_exact(float x) { return 0.5f * x * (1.0f + erff(x * 0.70710678118654752f)); }

__device__ __forceinline__ const void* ldarg(int byte_off) {
    const void* p; auto k = __builtin_amdgcn_kernarg_segment_ptr();
    asm volatile("s_load_dwordx2 %0, %1, %2\n\ts_waitcnt lgkmcnt(0)" : "=s"(p) : "s"(k), "i"(byte_off) : "memory");
    return p;
}
#define IN_F(i) ((const float*)ldarg((i) * 8))
#define IN_I(i) ((const int*)ldarg((i) * 8))
#define WSF(off) ((float*)(F.ws + (off)))


typedef float nt_f4 __attribute__((ext_vector_type(4)));
__device__ __forceinline__ float4 ntld4(const float* p) { const nt_f4 v = __builtin_nontemporal_load((const GAS nt_f4*)p); return make_float4(v[0], v[1], v[2], v[3]); }
__device__ __forceinline__ void ntst4(float* p, float4 v) { const nt_f4 w = {v.x, v.y, v.z, v.w}; __builtin_nontemporal_store(w, (GAS nt_f4*)p); }
typedef unsigned short bf16;
typedef unsigned v4u __attribute__((ext_vector_type(4)));
__device__ __forceinline__ unsigned f2bf(float f) { unsigned u = __builtin_bit_cast(unsigned, f); return (u + 0x7fffu + ((u >> 16) & 1u)) >> 16; }
__device__ __forceinline__ unsigned pk2(float lo, float hi) { return f2bf(lo) | (f2bf(hi) << 16); }
__device__ __forceinline__ float bf2f(unsigned short b) { return __uint_as_float((unsigned)b << 16); }
#define WSB(off) ((bf16*)(F.ws + (off)))
#define LDS_WAIT() asm volatile("s_waitcnt lgkmcnt(0)" ::: "memory")

__device__ __forceinline__ void norm_2rows_to_bf16(const float* xrow, const float* g, bf16* orow, int lane) {
    float4 v[16]; float s0 = 0.f, s1 = 0.f;
#pragma unroll
    for (int j = 0; j < 16; ++j) v[j] = ntld4(xrow + (j >> 3) * DM + 256 * (j & 7) + 4 * lane);
#pragma unroll
    for (int j = 0; j < 8; ++j) { s0 += v[j].x * v[j].x + v[j].y * v[j].y + v[j].z * v[j].z + v[j].w * v[j].w; s1 += v[8 + j].x * v[8 + j].x + v[8 + j].y * v[8 + j].y + v[8 + j].z * v[8 + j].z + v[8 + j].w * v[8 + j].w; }
    s0 = wave_sum(s0); s1 = wave_sum(s1);
    const float r0 = 1.0f / sqrtf(s0 / (float)DM + EPS), r1 = 1.0f / sqrtf(s1 / (float)DM + EPS);
#pragma unroll
    for (int j = 0; j < 8; ++j) { const float4 g4 = *(const float4*)(g + 256 * j + 4 * lane);
        *(unsigned long long*)(orow + 256 * j + 4 * lane) = (unsigned long long)pk2(v[j].x * r0 * g4.x, v[j].y * r0 * g4.y) | ((unsigned long long)pk2(v[j].z * r0 * g4.z, v[j].w * r0 * g4.w) << 32);
        *(unsigned long long*)(orow + DM + 256 * j + 4 * lane) = (unsigned long long)pk2(v[8 + j].x * r1 * g4.x, v[8 + j].y * r1 * g4.y) | ((unsigned long long)pk2(v[8 + j].z * r1 * g4.z, v[8 + j].w * r1 * g4.w) << 32); }
}
__device__ __forceinline__ void norm4_load(const float* xrow, int lane, float4 (&v)[32]) {
#pragma unroll
    for (int j = 0; j < 32; ++j) v[j] = ntld4(xrow + (j >> 3) * DM + 256 * (j & 7) + 4 * lane);
}
__device__ __forceinline__ void norm4_finish(const float4 (&v)[32], const float* g, bf16* orow, int lane) {
    float s[4] = {0.f, 0.f, 0.f, 0.f};
#pragma unroll
    for (int j = 0; j < 32; ++j) s[j >> 3] += v[j].x * v[j].x + v[j].y * v[j].y + v[j].z * v[j].z + v[j].w * v[j].w;
    float r[4];
#pragma unroll
    for (int q = 0; q < 4; ++q) { s[q] = wave_sum(s[q]); r[q] = 1.0f / sqrtf(s[q] / (float)DM + EPS); }
#pragma unroll
    for (int j = 0; j < 8; ++j) { const float4 g4 = *(const float4*)(g + 256 * j + 4 * lane);
#pragma unroll
        for (int q = 0; q < 4; ++q) { const float4 w = v[8 * q + j]; const float rq = r[q];
            *(unsigned long long*)(orow + q * DM + 256 * j + 4 * lane) = (unsigned long long)pk2(w.x * rq * g4.x, w.y * rq * g4.y) | ((unsigned long long)pk2(w.z * rq * g4.z, w.w * rq * g4.w) << 32); } }
}
__device__ __forceinline__ void p0_transpose_item(const float* W, int K, int N, bf16* WT, int row_off, LAS float* scr, int item, int lane, const float* gain = nullptr, int goff = 0) {
    const int nblk = N / 32, kb = item / nblk, nb = item % nblk, k0 = 64 * kb, n0 = 32 * nb;
    float4 v[8];
#pragma unroll
    for (int i = 0; i < 8; ++i) v[i] = ntld4(W + (size_t)(k0 + 8 * i + (lane >> 3)) * N + n0 + 4 * (lane & 7));
#pragma unroll
    for (int i = 0; i < 8; ++i) { const int kk = 8 * i + (lane >> 3); const float gk = (gain && k0 + kk >= goff) ? gain[k0 + kk - goff] : 1.0f; LAS float* d = scr + kk * 33 + 4 * (lane & 7);
        d[0] = v[i].x * gk; d[1] = v[i].y * gk; d[2] = v[i].z * gk; d[3] = v[i].w * gk; }
    LDS_WAIT(); asm volatile("" ::: "memory");
    const int c = lane & 7;
#pragma unroll
    for (int j = 0; j < 4; ++j) { const int n = (lane >> 3) + 8 * j; const LAS float* s = scr + (8 * c) * 33 + n;
        v4u o; o.x = pk2(s[0 * 33], s[1 * 33]); o.y = pk2(s[2 * 33], s[3 * 33]); o.z = pk2(s[4 * 33], s[5 * 33]); o.w = pk2(s[6 * 33], s[7 * 33]);
        *(GAS v4u*)(WT + (size_t)(row_off + n0 + n) * K + k0 + 8 * c) = o; }
    LDS_WAIT(); asm volatile("" ::: "memory");
}
namespace pg8 {
#define PG8_LAS __attribute__((address_space(3)))
typedef unsigned short bf16_t;
typedef short bf16x8 __attribute__((ext_vector_type(8)));
typedef float f32x4 __attribute__((ext_vector_type(4)));
typedef unsigned u32x4 __attribute__((ext_vector_type(4)));
constexpr int BM = 256, BK = 64, HALF = 128, HTB = HALF * BK * 2  , STAGE_BYTES = 8 * HTB, NXCD = 8, WGM = 8;

__host__ __device__ __forceinline__ int lds_byte(int r, int c) { const int st = (r >> 4) * 2 + (c >> 5), rr = r & 15, cc = c & 31, ob = rr * 64 + cc * 2; return st * 1024 + (ob ^ (((ob >> 9) & 1) << 5)); }
__host__ __device__ __forceinline__ void stage_rc(int b, int& R, int& C) { const int st = b / 1024, sb = b % 1024, swz = sb ^ (((sb >> 9) & 1) << 5); R = (st >> 1) * 16 + swz / 64; C = (st & 1) * 32 + (swz % 64) / 2; }
__host__ __device__ __forceinline__ int perm32(int rho) { const int n = rho >> 4, i = rho & 15; return 8 * (i >> 2) + 4 * n + (i & 3); }

struct Unit { int pm, pn, bz; };
struct Gemm { const bf16_t* A; const bf16_t* Bt; int M, N, K; int lda, ldb; long sA, sB; int nb; };

struct StaticOrder {
    int nM, nN, nwg, G, c;
    int nb, per; __host__ __device__ void init(int M, int N, int G_, int c_, int nb_ = 1) { nM = M / BM; nN = N / BM; nb = nb_; per = nM * nN; nwg = per * nb; G = G_; c = c_; }
    __host__ __device__ bool next(int i, Unit& u) const {
        const long L = (long)i * G + c; if (L >= nwg) return false;
        int wgid = (int)L; { const int q = nwg / NXCD, r = nwg % NXCD, xcd = wgid % NXCD, off = wgid / NXCD; wgid = (xcd < r ? xcd * (q + 1) : r * (q + 1) + (xcd - r) * q) + off; }
        u.bz = wgid / per; wgid -= u.bz * per; const int nig = WGM * nN, gid = wgid / nig, fm = gid * WGM, gsz = (nM - fm) < WGM ? (nM - fm) : WGM;
        u.pm = fm + ((wgid % nig) % gsz); u.pn = (wgid % nig) / gsz; return true;
    }
    __device__ __forceinline__ void a_ready(const Unit&) const {}
    __device__ __forceinline__ void done(const Unit&) const {}
    template <class G_> __device__ __forceinline__ long offA(const Unit& u, const G_& g) const { return (long)u.bz * g.sA; }
    template <class G_> __device__ __forceinline__ long offB(const Unit& u, const G_& g) const { return (long)u.bz * g.sB; }
};

__device__ __forceinline__ unsigned cvt_pk_bf16(float lo, float hi) { unsigned r; asm volatile("v_cvt_pk_bf16_f32 %0, %1, %2" : "=v"(r) : "v"(lo), "v"(hi)); return r; }
typedef float f32x2 __attribute__((ext_vector_type(2)));
__device__ __forceinline__ f32x2 gelu_pk(f32x2 v) {
    const f32x2 av = __builtin_elementwise_abs(v), d = av * 0.2316418882f + 1.0f;
    f32x2 t; t.x = __builtin_amdgcn_rcpf(d.x); t.y = __builtin_amdgcn_rcpf(d.y);
    f32x2 q = t * 0.5307027145f + (-0.7265760135f); q = q * t + 0.7107068705f; q = q * t + (-0.142248368f); q = q * t + 0.127414796f; q = q * t;
    const f32x2 s = (v * v) * (-0.72134752044f);
    f32x2 e; e.x = __builtin_amdgcn_exp2f(s.x); e.y = __builtin_amdgcn_exp2f(s.y);
    const f32x2 m = v * (q * e), r = v - m;
    f32x2 o; o.x = v.x < 0.f ? m.x : r.x; o.y = v.y < 0.f ? m.y : r.y; return o;
}

template <int ACT  > struct EpiBf16 {
    static constexpr bool PERM = true, AFTER_DRAIN = false; static_assert(ACT == 0 || ACT == 1, "EpiBf16: ACT is 0 (none) or 1 (gelu_pk)");
    bf16_t* O; int ldc; const float* bias; int split_cols; size_t split_stride; float scale0;
    __device__ __forceinline__ void operator()(const f32x4 (&acc)[2][2][4][2], const Unit& u, int wr, int wc, int fr, int fq) const {
        const int row0 = u.pm * BM + wr * 64 + fr; int colt = u.pn * BM; bf16_t* base = O;
        float sc = 1.f; if (split_cols) { const int t = colt / split_cols; base += (size_t)t * split_stride; colt -= t * split_cols; if (t == 0) sc = scale0; }
        const int col0 = colt + wc * 32 + 8 * fq, bcol0 = u.pn * BM + wc * 32 + 8 * fq;
        f32x4 bv[2][2];
#pragma unroll
        for (int bj = 0; bj < 2; ++bj)
#pragma unroll
            for (int n = 0; n < 2; ++n) bv[bj][n] = bias ? *(const f32x4*)(bias + bcol0 + bj * HALF + 4 * n) : (f32x4){0.f, 0.f, 0.f, 0.f};
#pragma unroll
        for (int ai = 0; ai < 2; ++ai)
#pragma unroll
            for (int m = 0; m < 4; ++m) { bf16_t* rowp = base + (size_t)(row0 + ai * HALF + m * 16) * ldc + col0;
#pragma unroll
                for (int bj = 0; bj < 2; ++bj) { f32x4 v0 = acc[ai][bj][m][0] + bv[bj][0], v1 = acc[ai][bj][m][1] + bv[bj][1];
                    if (ACT == 1) { f32x2 a = gelu_pk((f32x2){v0[0], v0[1]}), b = gelu_pk((f32x2){v0[2], v0[3]}), c = gelu_pk((f32x2){v1[0], v1[1]}), d = gelu_pk((f32x2){v1[2], v1[3]});
                        v0 = (f32x4){a.x, a.y, b.x, b.y}; v1 = (f32x4){c.x, c.y, d.x, d.y}; }
                    v0 = v0 * sc; v1 = v1 * sc; u32x4 w; w.x = cvt_pk_bf16(v0[0], v0[1]); w.y = cvt_pk_bf16(v0[2], v0[3]); w.z = cvt_pk_bf16(v1[0], v1[1]); w.w = cvt_pk_bf16(v1[2], v1[3]);
                    *(u32x4*)(rowp + bj * HALF) = w; } }
    }
};
template <class T, class = void> struct MidK { static constexpr bool v = false; };
template <class T> struct MidK<T, decltype((void)T::MIDK)> { static constexpr bool v = T::MIDK; };
template <class Epi, class Sched, bool ALIGN_EPI = false, bool SP2 = false>
__device__ __forceinline__ void gemm_phase(PG8_LAS unsigned char* lds, const Gemm g, const Sched& S, const Epi& E) {
    const int tid = threadIdx.x, wid = __builtin_amdgcn_readfirstlane(tid >> 6), lane = tid & 63, wr = wid >> 2, wc = wid & 3, fr = lane & 15, fq = lane >> 4;
    const int K = g.K, nt = K / BK;
    unsigned voffA[2], voffB[2];
#pragma unroll
    for (int i = 0; i < 2; ++i) { int R, C; stage_rc(tid * 16 + i * 8192, R, C); const int Rb = Epi::PERM ? ((R & ~31) + perm32(R & 31)) : R;
        voffA[i] = (unsigned)(R * g.lda + C) * 2u; voffB[i] = (unsigned)(Rb * g.ldb + C) * 2u; }
    const size_t kstep = (size_t)(BK * 2);
    const size_t hstepA = (size_t)HALF * g.lda * 2, hstepB = (size_t)HALF * g.ldb * 2;
    const size_t tstepA = 2 * hstepA, tstepB = 2 * hstepB;
    const unsigned ldsw = (unsigned)wid * 1024u;
    const int aoff = lds_byte(wr * 64 + fr, fq * 8), boff = lds_byte(wc * 32 + fr, fq * 8);
#define PG8_SA(b, h) (((b) * 2 + (h)) * HTB)
#define PG8_SB(b, h) ((4 + (b) * 2 + (h)) * HTB)
#define PG8_STAGE(bufoff, gbase, voff) do { _Pragma("unroll") for (int _i = 0; _i < 2; ++_i) \
        __builtin_amdgcn_global_load_lds((const unsigned*)((const char*)(gbase) + (voff)[_i]), (PG8_LAS unsigned*)(lds + (bufoff) + ldsw + _i * 8192), 16, 0, 0); } while (0)
#define PG8_LDA(dst, b, h) do { _Pragma("unroll") for (int m = 0; m < 4; ++m) _Pragma("unroll") for (int k = 0; k < 2; ++k) dst[m][k] = *(const PG8_LAS bf16x8*)(lds + PG8_SA(b, h) + aoff + m * 2048 + k * 1024); } while (0)
#define PG8_LDB(dst, b, h) do { _Pragma("unroll") for (int n = 0; n < 2; ++n) _Pragma("unroll") for (int k = 0; k < 2; ++k) dst[n][k] = *(const PG8_LAS bf16x8*)(lds + PG8_SB(b, h) + boff + n * 2048 + k * 1024); } while (0)
#define PG8_MMA(ai, bj, At, Bt) do { __builtin_amdgcn_s_setprio(1); _Pragma("unroll") for (int m = 0; m < 4; ++m) _Pragma("unroll") for (int n = 0; n < 2; ++n) _Pragma("unroll") for (int k = 0; k < 2; ++k) \
        acc[ai][bj][m][n] = __builtin_amdgcn_mfma_f32_16x16x32_bf16(Bt[n][k], At[m][k], acc[ai][bj][m][n], 0, 0, 0); __builtin_amdgcn_s_setprio(0); } while (0)
#define PG8_WAIT_V(n) asm volatile("s_waitcnt vmcnt(" #n ")" ::: "memory")
#define PG8_WAIT_L(n) asm volatile("s_waitcnt lgkmcnt(" #n ")" ::: "memory")
#define PG8_BAR __builtin_amdgcn_s_barrier()
#define PG8_SCHED __builtin_amdgcn_sched_barrier(0)
    Unit cur, nxt; int ui = 0;
    if (!S.next(0, cur)) return;
    f32x4 acc[2][2][4][2];
#pragma unroll
    for (int a = 0; a < 2; ++a)
#pragma unroll
        for (int b = 0; b < 2; ++b)
#pragma unroll
            for (int m = 0; m < 4; ++m)
#pragma unroll
                for (int n = 0; n < 2; ++n) acc[a][b][m][n] = (f32x4){0.f, 0.f, 0.f, 0.f};
    bf16x8 At[4][2], B0[2][2], B1[2][2];
    const char* cA = (const char*)g.A + (size_t)S.offA(cur, g) * 2 + (size_t)cur.pm * tstepA; const char* cB = (const char*)g.Bt + (size_t)S.offB(cur, g) * 2 + (size_t)cur.pn * tstepB;
    S.a_ready(cur);
    if constexpr (SP2) {
        PG8_STAGE(PG8_SB(0, 0), cB, voffB); PG8_STAGE(PG8_SB(0, 1), cB + hstepB, voffB); PG8_STAGE(PG8_SA(0, 0), cA, voffA); PG8_STAGE(PG8_SA(0, 1), cA + hstepA, voffA);
        if (wr == 1) PG8_BAR;
        PG8_WAIT_V(2); PG8_BAR;
        PG8_STAGE(PG8_SB(1, 0), cB + kstep, voffB); PG8_STAGE(PG8_SA(1, 0), cA + kstep, voffA); PG8_STAGE(PG8_SB(1, 1), cB + hstepB + kstep, voffB);
        PG8_WAIT_V(6); PG8_BAR;
    } else {
        PG8_STAGE(PG8_SB(0, 0), cB, voffB); PG8_STAGE(PG8_SA(0, 0), cA, voffA); PG8_STAGE(PG8_SB(0, 1), cB + hstepB, voffB); PG8_STAGE(PG8_SA(0, 1), cA + hstepA, voffA);
        if (wr == 1) PG8_BAR;
        PG8_WAIT_V(4); PG8_BAR;
        PG8_STAGE(PG8_SB(1, 0), cB + kstep, voffB); PG8_STAGE(PG8_SA(1, 0), cA + kstep, voffA); PG8_STAGE(PG8_SB(1, 1), cB + hstepB + kstep, voffB);
        PG8_WAIT_V(6); PG8_BAR;
    }
    for (;;) {
        const bool has_next = S.next(ui + 1, nxt);
        const char* nA = has_next ? (const char*)g.A + (size_t)S.offA(nxt, g) * 2 + (size_t)nxt.pm * tstepA : cA; const char* nB = has_next ? (const char*)g.Bt + (size_t)S.offB(nxt, g) * 2 + (size_t)nxt.pn * tstepB : cB;
        for (int t = 0; t < nt; t += 2) {
            if constexpr (MidK<Epi>::v) { if (t == E.midk_t) E.midk(acc, cur, wr, wc, fr, fq); }
            const bool last = (t == nt - 2);
            const char* a1 = cA + (size_t)(t + 1) * kstep;
            const char* a2 = last ? nA : cA + (size_t)(t + 2) * kstep; const char* b2 = last ? nB : cB + (size_t)(t + 2) * kstep;
            const char* a3 = a2 + kstep; const char* b3 = b2 + kstep;
            if (last && has_next) S.a_ready(nxt);
            if constexpr (SP2) {
            PG8_LDB(B0, 0, 0); PG8_LDB(B1, 0, 1); PG8_SCHED; PG8_LDA(At, 0, 0); PG8_STAGE(PG8_SA(1, 1), a1 + hstepA, voffA);
            PG8_WAIT_V(8); PG8_WAIT_L(0); PG8_BAR; PG8_MMA(0, 0, At, B0); PG8_MMA(0, 1, At, B1); PG8_BAR; PG8_SCHED;
            PG8_LDA(At, 0, 1); PG8_STAGE(PG8_SB(0, 0), b2, voffB); PG8_STAGE(PG8_SB(0, 1), b2 + hstepB, voffB); PG8_STAGE(PG8_SA(0, 0), a2, voffA);
            PG8_WAIT_V(8); PG8_WAIT_L(0); PG8_BAR; PG8_MMA(1, 0, At, B0); PG8_MMA(1, 1, At, B1); PG8_BAR; PG8_SCHED;
            PG8_LDB(B0, 1, 0); PG8_LDB(B1, 1, 1); PG8_SCHED; PG8_LDA(At, 1, 0); PG8_STAGE(PG8_SA(0, 1), a2 + hstepA, voffA);
            PG8_WAIT_V(8); PG8_WAIT_L(0); PG8_BAR; PG8_MMA(0, 0, At, B0); PG8_MMA(0, 1, At, B1); PG8_BAR; PG8_SCHED;
            PG8_LDA(At, 1, 1); PG8_STAGE(PG8_SB(1, 0), b3, voffB); PG8_STAGE(PG8_SB(1, 1), b3 + hstepB, voffB); PG8_STAGE(PG8_SA(1, 0), a3, voffA);
            PG8_WAIT_V(8); PG8_WAIT_L(0); PG8_BAR; PG8_MMA(1, 0, At, B0); PG8_MMA(1, 1, At, B1); PG8_BAR; PG8_SCHED;
            } else {
            PG8_LDB(B0, 0, 0); PG8_SCHED; PG8_LDA(At, 0, 0); PG8_STAGE(PG8_SA(1, 1), a1 + hstepA, voffA);
            PG8_WAIT_L(8); PG8_BAR; PG8_WAIT_L(0); PG8_MMA(0, 0, At, B0); PG8_BAR; PG8_SCHED;
            PG8_LDB(B1, 0, 1); PG8_STAGE(PG8_SB(0, 0), b2, voffB);
            PG8_BAR; PG8_WAIT_L(0); PG8_MMA(0, 1, At, B1); PG8_BAR;
            PG8_LDA(At, 0, 1); PG8_STAGE(PG8_SA(0, 0), a2, voffA);
            PG8_BAR; PG8_WAIT_L(0); PG8_MMA(1, 0, At, B0); PG8_BAR; PG8_SCHED;
            PG8_STAGE(PG8_SB(0, 1), b2 + hstepB, voffB);
            PG8_WAIT_V(6); PG8_BAR; PG8_MMA(1, 1, At, B1); PG8_BAR;
            PG8_LDB(B0, 1, 0); PG8_SCHED; PG8_LDA(At, 1, 0); PG8_STAGE(PG8_SA(0, 1), a2 + hstepA, voffA);
            PG8_WAIT_L(8); PG8_BAR; PG8_WAIT_L(0); PG8_MMA(0, 0, At, B0); PG8_BAR; PG8_SCHED;
            PG8_LDB(B1, 1, 1); PG8_STAGE(PG8_SB(1, 0), b3, voffB);
            PG8_BAR; PG8_WAIT_L(0); PG8_MMA(0, 1, At, B1); PG8_BAR;
            PG8_LDA(At, 1, 1); PG8_STAGE(PG8_SA(1, 0), a3, voffA);
            PG8_BAR; PG8_WAIT_L(0); PG8_MMA(1, 0, At, B0); PG8_BAR; PG8_SCHED;
            PG8_STAGE(PG8_SB(1, 1), b3 + hstepB, voffB);
            PG8_WAIT_V(6); PG8_BAR; PG8_MMA(1, 1, At, B1); PG8_BAR;
            }
        }
        if constexpr (ALIGN_EPI) { if (wr == 0) PG8_BAR; }
        if constexpr (!Epi::AFTER_DRAIN) { E(acc, cur, wr, wc, fr, fq); S.done(cur); }
        if (!has_next) break;
#pragma unroll
        for (int a = 0; a < 2; ++a)
#pragma unroll
            for (int b = 0; b < 2; ++b)
#pragma unroll
                for (int m = 0; m < 4; ++m)
#pragma unroll
                    for (int n = 0; n < 2; ++n) acc[a][b][m][n] = (f32x4){0.f, 0.f, 0.f, 0.f};
        cur = nxt; cA = nA; cB = nB; ++ui;
        if constexpr (ALIGN_EPI) { if (wr == 1) PG8_BAR; }
    }
    PG8_WAIT_V(0);
    if constexpr (!ALIGN_EPI) { if (wr == 0) PG8_BAR; }
    PG8_BAR;
    if constexpr (Epi::AFTER_DRAIN) { E.fused(acc, cur, wr, wc, fr, fq, lds, wid, lane); S.done(cur); }
#undef PG8_SA
#undef PG8_SB
#undef PG8_STAGE
#undef PG8_LDA
#undef PG8_LDB
#undef PG8_MMA
#undef PG8_WAIT_V
#undef PG8_WAIT_L
#undef PG8_BAR
#undef PG8_SCHED
}
}

namespace pg8 {
struct EpiF32 {
    static constexpr bool PERM = false, AFTER_DRAIN = false;
    float* C; int ldc; const float* resid; long sC;
    __device__ __forceinline__ void operator()(const f32x4 (&acc)[2][2][4][2], const Unit& u, int wr, int wc, int fr, int fq) const {
        const int row0 = u.pm * BM + wr * 64 + fr, col0 = u.pn * BM + wc * 32 + 4 * fq;
        float* base = C + (size_t)u.bz * sC;
#pragma unroll
        for (int ai = 0; ai < 2; ++ai)
#pragma unroll
            for (int m = 0; m < 4; ++m) { const size_t ro = (size_t)(row0 + ai * HALF + m * 16) * ldc;
#pragma unroll
                for (int bj = 0; bj < 2; ++bj)
#pragma unroll
                    for (int n = 0; n < 2; ++n) { const size_t o = ro + col0 + bj * HALF + n * 16; f32x4 v = acc[ai][bj][m][n];
                        if (resid) v += *(const f32x4*)(resid + o);
                        *(f32x4*)(base + o) = v; } }
    }
};


template <bool RF32> struct EpiResidB {
    static constexpr bool PERM = true, AFTER_DRAIN = false;
    const void* resid; bf16_t* HB; float* ssq; int ldc;
    __device__ __forceinline__ void operator()(const f32x4 (&acc)[2][2][4][2], const Unit& u, int wr, int wc, int fr, int fq) const {
        const int row0 = u.pm * BM + wr * 64 + fr, col0 = u.pn * BM + wc * 32 + 8 * fq;
#pragma unroll
        for (int ai = 0; ai < 2; ++ai)
#pragma unroll
            for (int m = 0; m < 4; ++m) { const int r = row0 + ai * HALF + m * 16; const size_t ro = (size_t)r * ldc + col0; float ss = 0.f;
#pragma unroll
                for (int bj = 0; bj < 2; ++bj) { const size_t o = ro + bj * HALF; f32x4 v0 = acc[ai][bj][m][0], v1 = acc[ai][bj][m][1];
                    if (RF32) { v0 += *(const f32x4*)((const float*)resid + o); v1 += *(const f32x4*)((const float*)resid + o + 4); }
                    else { const u32x4 rb = *(const u32x4*)((const bf16_t*)resid + o);
                        v0[0] += __uint_as_float(rb.x << 16); v0[1] += __uint_as_float(rb.x & 0xffff0000u); v0[2] += __uint_as_float(rb.y << 16); v0[3] += __uint_as_float(rb.y & 0xffff0000u);
                        v1[0] += __uint_as_float(rb.z << 16); v1[1] += __uint_as_float(rb.z & 0xffff0000u); v1[2] += __uint_as_float(rb.w << 16); v1[3] += __uint_as_float(rb.w & 0xffff0000u); }
                    ss += (v0[0] * v0[0] + v0[1] * v0[1]) + (v0[2] * v0[2] + v0[3] * v0[3]) + (v1[0] * v1[0] + v1[1] * v1[1]) + (v1[2] * v1[2] + v1[3] * v1[3]);
                    u32x4 w; w.x = cvt_pk_bf16(v0[0], v0[1]); w.y = cvt_pk_bf16(v0[2], v0[3]); w.z = cvt_pk_bf16(v1[0], v1[1]); w.w = cvt_pk_bf16(v1[2], v1[3]);
                    *(u32x4*)(HB + o) = w; }
                ss += __shfl_xor(ss, 16); ss += __shfl_xor(ss, 32);
                if (fq == 0) atomicAdd(ssq + r, ss); }
    }
};

struct EpiWout {
    static constexpr bool PERM = true, AFTER_DRAIN = false, MIDK = true;
    const float* resid; bf16_t* HB; float* ssq; int ldc; const float* ssq_ssm; int midk_t;
    __device__ __forceinline__ void midk(f32x4 (&acc)[2][2][4][2], const Unit& u, int wr, int wc, int fr, int fq) const {
        const int row0 = u.pm * BM + wr * 64 + fr;
#pragma unroll
        for (int ai = 0; ai < 2; ++ai)
#pragma unroll
            for (int m = 0; m < 4; ++m) { const float ir = sqrtf(ssq_ssm[row0 + ai * HALF + m * 16] * (1.0f / 1024.0f) + 1e-6f);
#pragma unroll
                for (int bj = 0; bj < 2; ++bj) { acc[ai][bj][m][0] *= ir; acc[ai][bj][m][1] *= ir; } }
    }
    __device__ __forceinline__ void operator()(const f32x4 (&acc)[2][2][4][2], const Unit& u, int wr, int wc, int fr, int fq) const {
        const int row0 = u.pm * BM + wr * 64 + fr, col0 = u.pn * BM + wc * 32 + 8 * fq;
#pragma unroll
        for (int ai = 0; ai < 2; ++ai)
#pragma unroll
            for (int m = 0; m < 4; ++m) { const int r = row0 + ai * HALF + m * 16; const size_t ro = (size_t)r * ldc + col0; float ss = 0.f;
                const float rs = 1.0f / sqrtf(ssq_ssm[r] * (1.0f / 1024.0f) + 1e-6f);
#pragma unroll
                for (int bj = 0; bj < 2; ++bj) { const size_t o = ro + bj * HALF;
                    const f32x4 v0 = acc[ai][bj][m][0] * rs + *(const f32x4*)(resid + o), v1 = acc[ai][bj][m][1] * rs + *(const f32x4*)(resid + o + 4);
                    ss += (v0[0] * v0[0] + v0[1] * v0[1]) + (v0[2] * v0[2] + v0[3] * v0[3]) + (v1[0] * v1[0] + v1[1] * v1[1]) + (v1[2] * v1[2] + v1[3] * v1[3]);
                    u32x4 w; w.x = cvt_pk_bf16(v0[0], v0[1]); w.y = cvt_pk_bf16(v0[2], v0[3]); w.z = cvt_pk_bf16(v1[0], v1[1]); w.w = cvt_pk_bf16(v1[2], v1[3]);
                    *(u32x4*)(HB + o) = w; }
                ss += __shfl_xor(ss, 16); ss += __shfl_xor(ss, 32);
                if (fq == 0) atomicAdd(ssq + r, ss); }
    }
};
struct EpiRowBf16 {
    static constexpr bool PERM = true, AFTER_DRAIN = false;
    bf16_t* O; int ldc; const float* ssq; float scale;
    __device__ __forceinline__ void operator()(const f32x4 (&acc)[2][2][4][2], const Unit& u, int wr, int wc, int fr, int fq) const {
        const int row0 = u.pm * BM + wr * 64 + fr, col0 = u.pn * BM + wc * 32 + 8 * fq;
#pragma unroll
        for (int ai = 0; ai < 2; ++ai)
#pragma unroll
            for (int m = 0; m < 4; ++m) { const int r = row0 + ai * HALF + m * 16; const float sc = scale / sqrtf(ssq[r] * (1.0f / 2048.0f) + 1e-6f); bf16_t* rowp = O + (size_t)r * ldc + col0;
#pragma unroll
                for (int bj = 0; bj < 2; ++bj) { const f32x4 v0 = acc[ai][bj][m][0] * sc, v1 = acc[ai][bj][m][1] * sc;
                    u32x4 w; w.x = cvt_pk_bf16(v0[0], v0[1]); w.y = cvt_pk_bf16(v0[2], v0[3]); w.z = cvt_pk_bf16(v1[0], v1[1]); w.w = cvt_pk_bf16(v1[2], v1[3]);
                    *(u32x4*)(rowp + bj * HALF) = w; } }
    }
};
struct EpiSl {
    static constexpr bool PERM = false, AFTER_DRAIN = false;
    float* Sl;
    __device__ __forceinline__ void operator()(const f32x4 (&acc)[2][2][4][2], const Unit& u, int wr, int wc, int fr, int fq) const {
        const int row0 = u.pm * BM + wr * 64 + fr, col0 = wc * 32 + 4 * fq;
        float* base = Sl + (size_t)u.bz * 512 * 128;
#pragma unroll
        for (int ai = 0; ai < 2; ++ai)
#pragma unroll
            for (int m = 0; m < 4; ++m) { float* rowp = base + (size_t)(row0 + ai * HALF + m * 16) * 128 + col0;
#pragma unroll
                for (int n = 0; n < 2; ++n) *(f32x4*)(rowp + n * 16) = acc[ai][0][m][n]; }
    }
};
struct EpiS5 {
    static constexpr bool PERM = true, AFTER_DRAIN = false;
    bf16_t* Gb;
    __device__ __forceinline__ void operator()(const f32x4 (&acc)[2][2][4][2], const Unit& u, int wr, int wc, int fr, int fq) const {
        const int row0 = u.pm * BM + wr * 64 + fr, col0 = u.pn * BM + wc * 32 + 8 * fq;
#pragma unroll
        for (int ai = 0; ai < 2; ++ai)
#pragma unroll
            for (int m = 0; m < 4; ++m) { const int cb = row0 + ai * HALF + m * 16;
#pragma unroll
                for (int bj = 0; bj < 2; ++bj) { const int n0 = col0 + bj * HALF; const int tau = n0 >> 4, h0 = n0 & 15;
                    const f32x4 v0 = acc[ai][bj][m][0], v1 = acc[ai][bj][m][1];
                    const f32x2 a = gelu_pk((f32x2){v0[0], v0[1]}), b = gelu_pk((f32x2){v0[2], v0[3]}), c = gelu_pk((f32x2){v1[0], v1[1]}), d = gelu_pk((f32x2){v1[2], v1[3]});
                    u32x4 w; w.x = cvt_pk_bf16(a.x, a.y); w.y = cvt_pk_bf16(b.x, b.y); w.z = cvt_pk_bf16(c.x, c.y); w.w = cvt_pk_bf16(d.x, d.y);
                    *(u32x4*)(Gb + ((size_t)cb * 32 + tau) * 1024 + 16 * u.bz + h0) = w; } }
    }
};

struct EpiXkv {
    static constexpr bool PERM = false, AFTER_DRAIN = false;
    bf16_t* KP; bf16_t* VT2;
    __device__ __forceinline__ void operator()(const f32x4 (&acc)[2][2][4][2], const Unit& u, int wr, int wc, int fr, int fq) const {
        const int row0 = u.pm * BM + wr * 64 + fr, col0 = u.pn * BM + wc * 32 + 4 * fq;
#pragma unroll
        for (int ai = 0; ai < 2; ++ai)
#pragma unroll
            for (int m = 0; m < 4; ++m) { const int r = row0 + ai * HALF + m * 16; const int b = r >> 8, mm = r & 255;
#pragma unroll
                for (int bj = 0; bj < 2; ++bj)
#pragma unroll
                    for (int n = 0; n < 2; ++n) { const int c = col0 + bj * HALF + n * 16; const f32x4 v = acc[ai][bj][m][n];
                        if (c < 512) { const int hd = c >> 7, d = c & 127; bf16_t* p = KP + ((size_t)(b * 4 + hd) * 256 + mm) * 256;
                            *(unsigned long long*)(p + (hd & 1) * 128 + d) = (unsigned long long)cvt_pk_bf16(v[0], v[1]) | ((unsigned long long)cvt_pk_bf16(v[2], v[3]) << 32);
                            *(unsigned long long*)(p + ((hd & 1) ^ 1) * 128 + d) = 0ull; }
                        else { const int c2 = c - 512, hd = c2 >> 7, d = c2 & 127; bf16_t* p = VT2 + ((size_t)(b * 2 + (hd >> 1)) * 256 + (hd & 1) * 128 + d) * 512;
                            const unsigned w01 = cvt_pk_bf16(v[0], v[1]), w23 = cvt_pk_bf16(v[2], v[3]);
                            const int k1 = (hd & 1) * 256 + mm, k0 = ((hd & 1) ^ 1) * 256 + mm;
                            p[k1] = (bf16_t)(w01 & 0xffffu); p[512 + k1] = (bf16_t)(w01 >> 16); p[1024 + k1] = (bf16_t)(w23 & 0xffffu); p[1536 + k1] = (bf16_t)(w23 >> 16);
                            p[k0] = 0; p[512 + k0] = 0; p[1024 + k0] = 0; p[1536 + k0] = 0; } } }
    }
};
struct EpiXs {
    static constexpr bool PERM = true, AFTER_DRAIN = true;
    bf16_t* XP; float* Lsum;
    __device__ __forceinline__ void fused(f32x4 (&acc)[2][2][4][2], const Unit& u, int wr, int wc, int fr, int fq, PG8_LAS unsigned char* lds, int wid, int lane) const {
        PG8_LAS float* Mx = (PG8_LAS float*)lds;
        const int b = u.bz >> 2, hd = u.bz & 3;
#pragma unroll
        for (int ai = 0; ai < 2; ++ai)
#pragma unroll
            for (int m = 0; m < 4; ++m) { float mx = -INFINITY;
#pragma unroll
                for (int bj = 0; bj < 2; ++bj)
#pragma unroll
                    for (int n = 0; n < 2; ++n) { const f32x4 v = acc[ai][bj][m][n]; mx = fmaxf(mx, fmaxf(fmaxf(v[0], v[1]), fmaxf(v[2], v[3]))); }
                mx = fmaxf(mx, __shfl_xor(mx, 16)); mx = fmaxf(mx, __shfl_xor(mx, 32));
                if (fq == 0) Mx[(ai * HALF + wr * 64 + m * 16 + fr) * 4 + wc] = mx; }
        asm volatile("s_waitcnt lgkmcnt(0)" ::: "memory"); __builtin_amdgcn_s_barrier(); asm volatile("" ::: "memory");
#pragma unroll
        for (int ai = 0; ai < 2; ++ai)
#pragma unroll
            for (int m = 0; m < 4; ++m) { const int rl = ai * HALF + wr * 64 + m * 16 + fr; const f32x4 mv = *(const PG8_LAS f32x4*)(Mx + rl * 4);
                const float mx = fmaxf(fmaxf(mv[0], mv[1]), fmaxf(mv[2], mv[3])); float ss = 0.f;
                const size_t t = (size_t)b * 2048 + u.pm * BM + rl; bf16_t* rowp = XP + t * 1024 + hd * 256 + wc * 32 + 8 * fq;
#pragma unroll
                for (int bj = 0; bj < 2; ++bj) { f32x4 p0, p1;
#pragma unroll
                    for (int e = 0; e < 4; ++e) { p0[e] = __expf(acc[ai][bj][m][0][e] - mx); p1[e] = __expf(acc[ai][bj][m][1][e] - mx); }
                    ss += (p0[0] + p0[1]) + (p0[2] + p0[3]) + (p1[0] + p1[1]) + (p1[2] + p1[3]);
                    u32x4 w; w.x = cvt_pk_bf16(p0[0], p0[1]); w.y = cvt_pk_bf16(p0[2], p0[3]); w.z = cvt_pk_bf16(p1[0], p1[1]); w.w = cvt_pk_bf16(p1[2], p1[3]);
                    *(u32x4*)(rowp + bj * HALF) = w; }
                ss += __shfl_xor(ss, 16); ss += __shfl_xor(ss, 32);
                if (fq == 0) atomicAdd(Lsum + t * 4 + hd, ss); }
    }
};
struct EpiXo {
    static constexpr bool PERM = true, AFTER_DRAIN = false;
    bf16_t* XO; const float* Lsum;
    __device__ __forceinline__ void operator()(const f32x4 (&acc)[2][2][4][2], const Unit& u, int wr, int wc, int fr, int fq) const {
        const int b = u.bz >> 2, pair = (u.bz >> 1) & 1, kh = u.bz & 1;
#pragma unroll
        for (int ai = 0; ai < 2; ++ai)
#pragma unroll
            for (int m = 0; m < 4; ++m) { const size_t t = (size_t)b * 2048 + u.pm * BM + ai * HALF + wr * 64 + m * 16 + fr; bf16_t* rowp = XO + t * 512 + pair * 256 + wc * 32 + 8 * fq;
                { const float il = 1.0f / Lsum[t * 4 + pair * 2 + kh]; const f32x4 v0 = (kh ? acc[ai][1][m][0] : acc[ai][0][m][0]) * il, v1 = (kh ? acc[ai][1][m][1] : acc[ai][0][m][1]) * il;
                    u32x4 w; w.x = cvt_pk_bf16(v0[0], v0[1]); w.y = cvt_pk_bf16(v0[2], v0[3]); w.z = cvt_pk_bf16(v1[0], v1[1]); w.w = cvt_pk_bf16(v1[2], v1[3]);
                    *(u32x4*)(rowp + kh * HALF) = w; } }
    }
};
struct XsOrder {
    int G, c, sel;
    __device__ __forceinline__ bool next(int i, Unit& u) const { if (i > 0) return false; const int L = sel * G + c; if (L >= 256) return false; u.pm = L & 7; u.pn = 0; u.bz = L >> 3; return true; }
    __device__ __forceinline__ void a_ready(const Unit&) const {}
    __device__ __forceinline__ void done(const Unit&) const {}
    template <class G_> __device__ __forceinline__ long offA(const Unit& u, const G_&) const { return (long)(u.bz >> 2) * 2048 * 512 + ((u.bz & 3) >> 1) * 256; }
    template <class G_> __device__ __forceinline__ long offB(const Unit& u, const G_&) const { return (long)u.bz * 256 * 256; }
};
struct XoOrder {
    int G, c;
    __device__ __forceinline__ bool next(int i, Unit& u) const { const int L = i * G + c; if (L >= 256) return false; u.pm = L & 7; u.pn = 0; u.bz = L >> 3; return true; }
    __device__ __forceinline__ void a_ready(const Unit&) const {}
    __device__ __forceinline__ void done(const Unit&) const {}
    template <class G_> __device__ __forceinline__ long offA(const Unit& u, const G_&) const { return (long)(u.bz >> 2) * 2048 * 1024 + (u.bz & 3) * 256; }
    template <class G_> __device__ __forceinline__ long offB(const Unit& u, const G_&) const { return (long)(u.bz >> 1) * 256 * 512 + (u.bz & 1) * 256; }
};
struct EpiGlu {
    static constexpr bool PERM = false, AFTER_DRAIN = false;
    const bf16_t* G; const float* bias; bf16_t* CAT; float* ssq;
    __device__ __forceinline__ void operator()(const f32x4 (&acc)[2][2][4][2], const Unit& u, int wr, int wc, int fr, int fq) const {
        const int row0 = u.pm * BM + wr * 64 + fr, col0 = u.pn * BM + wc * 32 + 4 * fq;
#pragma unroll
        for (int ai = 0; ai < 2; ++ai)
#pragma unroll
            for (int m = 0; m < 4; ++m) { const int r = row0 + ai * HALF + m * 16; float ss = 0.f;
#pragma unroll
                for (int bj = 0; bj < 2; ++bj)
#pragma unroll
                    for (int n = 0; n < 2; ++n) { const int c = col0 + bj * HALF + n * 16; const f32x4 z = acc[ai][bj][m][n] + *(const f32x4*)(bias + c); const unsigned long long gb = *(const unsigned long long*)(G + (size_t)r * 1024 + c);
                        f32x4 gv; gv[0] = __uint_as_float((unsigned)gb << 16); gv[1] = __uint_as_float((unsigned)gb & 0xffff0000u); gv[2] = __uint_as_float((unsigned)(gb >> 32) << 16); gv[3] = __uint_as_float((unsigned)(gb >> 32) & 0xffff0000u);
                        f32x4 o; o[0] = gv[0] / (1.0f + __expf(-z[0])); o[1] = gv[1] / (1.0f + __expf(-z[1])); o[2] = gv[2] / (1.0f + __expf(-z[2])); o[3] = gv[3] / (1.0f + __expf(-z[3]));
                        ss += o[0] * o[0] + o[1] * o[1] + o[2] * o[2] + o[3] * o[3];
                        const unsigned long long w = (unsigned long long)cvt_pk_bf16(o[0], o[1]) | ((unsigned long long)cvt_pk_bf16(o[2], o[3]) << 32);
                        *(unsigned long long*)(CAT + (size_t)r * 2048 + 1024 + c) = w; }
                ss += __shfl_xor(ss, 16); ss += __shfl_xor(ss, 32);
                if (fq == 0) atomicAdd(ssq + r, ss); }
    }
};
struct EpiWin {
    static constexpr bool PERM = true, AFTER_DRAIN = false;
    bf16_t* QKV; size_t sec_stride; bf16_t* UC; const float* rope; float qscale;
    __device__ __forceinline__ void operator()(const f32x4 (&acc)[2][2][4][2], const Unit& u, int wr, int wc, int fr, int fq) const {
        const int row0 = u.pm * BM + wr * 64 + fr;
        const int sec = u.pn >> 2;
        const int col0 = (u.pn & 3) * BM + wc * 32 + 8 * fq;
        if (sec == 3) {
#pragma unroll
            for (int ai = 0; ai < 2; ++ai)
#pragma unroll
                for (int m = 0; m < 4; ++m) { const int r = row0 + ai * HALF + m * 16; const int cb = r >> 5, sg = r & 31;
#pragma unroll
                    for (int bj = 0; bj < 2; ++bj) { const int col = col0 + bj * HALF; const int g = col >> 4, h0 = col & 15;
                        const f32x4 v0 = acc[ai][bj][m][0], v1 = acc[ai][bj][m][1];
                        u32x4 w; w.x = cvt_pk_bf16(v0[0], v0[1]); w.y = cvt_pk_bf16(v0[2], v0[3]); w.z = cvt_pk_bf16(v1[0], v1[1]); w.w = cvt_pk_bf16(v1[2], v1[3]);
                        *(u32x4*)(UC + ((size_t)g * 512 + cb) * 640 + sg * 16 + h0) = w; } }
            return;
        }
        bf16_t* base = QKV + (size_t)sec * sec_stride;
        const float sc = sec == 0 ? qscale : 1.0f;
        const bool rot = (sec < 2) && ((wc & 1) == 0);
        const float sgn = (fq & 1) ? 1.0f : -1.0f;
        const bool mine = fq < 2;
#pragma unroll
        for (int ai = 0; ai < 2; ++ai)
#pragma unroll
            for (int m = 0; m < 4; ++m) { const int r = row0 + ai * HALF + m * 16; bf16_t* rowp = base + (size_t)r * 1024 + col0;
                f32x4 cs[4];
                if (rot) {
#pragma unroll
                    for (int q = 0; q < 4; ++q) cs[q] = *(const f32x4*)(rope + (size_t)r * 16 + 4 * q);
                }
#pragma unroll
                for (int bj = 0; bj < 2; ++bj) { f32x4 v0 = acc[ai][bj][m][0], v1 = acc[ai][bj][m][1];
                    if (rot) {
                        f32x4 p0, p1;
#pragma unroll
                        for (int e = 0; e < 4; ++e) { p0[e] = __shfl_xor(v0[e], 16); p1[e] = __shfl_xor(v1[e], 16); }
                        if (mine) {
#pragma unroll
                            for (int e = 0; e < 4; ++e) {
                                const float c0 = cs[e >> 1][(e & 1) * 2], s0 = cs[e >> 1][(e & 1) * 2 + 1];
                                const float c1 = cs[2 + (e >> 1)][(e & 1) * 2], s1 = cs[2 + (e >> 1)][(e & 1) * 2 + 1];
                                v0[e] = v0[e] * c0 + sgn * p0[e] * s0; v1[e] = v1[e] * c1 + sgn * p1[e] * s1; }
                        }
                    }
                    v0 = v0 * sc; v1 = v1 * sc; u32x4 w; w.x = cvt_pk_bf16(v0[0], v0[1]); w.y = cvt_pk_bf16(v0[2], v0[3]); w.z = cvt_pk_bf16(v1[0], v1[1]); w.w = cvt_pk_bf16(v1[2], v1[3]);
                    *(u32x4*)(rowp + bj * HALF) = w; } }
    }
};
}
#define GEMM_RUN(EPI, ALIGN, g, S, E) pg8::gemm_phase<EPI, pg8::StaticOrder, ALIGN, true>(F.ldsl, g, S, E)
namespace attn_body {
using bf16=__hip_bfloat16;
using bf16x8=__attribute__((ext_vector_type(8)))short;
using s16x4=__attribute__((ext_vector_type(4)))short;
using f32x16=__attribute__((ext_vector_type(16)))float;
using u32x4=__attribute__((ext_vector_type(4)))unsigned;
constexpr int BATCH=8,NHEAD=16,SEQ=2048,D=64,DM=NHEAD*D;
constexpr int NW=8,QBLK=32,QB=QBLK*NW,KVBLK=64,NQB=SEQ/QB;
constexpr int ATTN_PITCH=DM, ATTN_UNIT_ROWS=QB;
__device__ __forceinline__ int crow(int r,int hi){return (r&3)+8*(r>>2)+4*hi;}
#define SBAR() __builtin_amdgcn_sched_barrier(0)
__device__ __forceinline__ void cmask(f32x16&p0,f32x16&p1,int jb,int qrel,int hi){
  asm volatile("":"+v"(qrel),"+v"(hi));
  const float NEG=-INFINITY; int kb=64*jb+4*hi;
  #pragma unroll
  for(int r=0;r<16;++r){int kv=kb+(r&3)+8*(r>>2); if(kv>qrel)p0[r]=NEG; if(kv+32>qrel)p1[r]=NEG;}
}

constexpr int NSLOT=3, SLOTB=8192;
constexpr int LDS_K=0, LDS_V=NSLOT*SLOTB, LDS_WS=2*NSLOT*SLOTB, LDS_OST=LDS_WS+NW*64*4, LDS_BYTES=LDS_OST+NW*4096, LDS_X=LDS_BYTES, LDS_SSQ=LDS_X+NW*4096;
constexpr float C2=0.125f*1.4426950408889634f;
__device__ __forceinline__ void glds16(const void*gsrc,unsigned lds_dst){unsigned keep;
  asm volatile("s_mov_b32 %0, m0\n\ts_mov_b32 m0, %2\n\ts_nop 0\n\tglobal_load_lds_dwordx4 %1, off\n\ts_mov_b32 m0, %0":"=&s"(keep):"v"(gsrc),"s"(lds_dst):"memory");}
__device__ __forceinline__ float max3f(float a,float b,float c){float r;asm("v_max3_f32 %0, %1, %2, %3":"=v"(r):"v"(a),"v"(b),"v"(c));return r;}
__device__ __forceinline__ float max2f(float a,float b){float r;asm("v_max_f32_e32 %0, %1, %2":"=v"(r):"v"(a),"v"(b));return r;}
__device__ __forceinline__ float fadd_s(float a,float b){float r;asm("v_add_f32_e32 %0, %1, %2":"=v"(r):"v"(a),"v"(b));return r;}
__device__ __forceinline__ float fsub_s(float a,float b){float r;asm("v_sub_f32_e32 %0, %1, %2":"=v"(r):"v"(a),"v"(b));return r;}
typedef float f32x2_t __attribute__((ext_vector_type(2))); typedef __bf16 bf16x2_t __attribute__((ext_vector_type(2)));
__device__ __forceinline__ unsigned cvtpk_s(float lo,float hi){f32x2_t v={lo,hi};bf16x2_t b=__builtin_convertvector(v,bf16x2_t);return __builtin_bit_cast(unsigned,b);}
#define WAIT_BAR(N) asm volatile("s_waitcnt vmcnt(" #N ") lgkmcnt(0)\n\ts_barrier":::"memory")

__device__ __forceinline__ void qkt(f32x16&p0,f32x16&p1,const char*Kslot,const bf16x8*qr,int r32,int hi){ const f32x16 zc=f32x16{};
  const char*kb=Kslot+hi*1024+r32*16;
  #pragma unroll
  for(int d0=0;d0<4;++d0){
    const bf16x8 b0=*reinterpret_cast<const bf16x8*>(kb+d0*2048);
    const bf16x8 b1=*reinterpret_cast<const bf16x8*>(kb+d0*2048+512);
    if(d0==0){p0=__builtin_amdgcn_mfma_f32_32x32x16_bf16(b0,qr[0],zc,0,0,0);p1=__builtin_amdgcn_mfma_f32_32x32x16_bf16(b1,qr[0],zc,0,0,0);}
    else{p0=__builtin_amdgcn_mfma_f32_32x32x16_bf16(b0,qr[d0],p0,0,0,0);p1=__builtin_amdgcn_mfma_f32_32x32x16_bf16(b1,qr[d0],p1,0,0,0);}}
}
typedef __attribute__((address_space(3))) const char* lds_cptr;
typedef short v4i16_t __attribute__((ext_vector_type(4)));
__device__ __forceinline__ void kload8(bf16x8*kf,lds_cptr kp){
  kf[0]=*(const __attribute__((address_space(3))) bf16x8*)(kp);      kf[1]=*(const __attribute__((address_space(3))) bf16x8*)(kp+512);
  kf[2]=*(const __attribute__((address_space(3))) bf16x8*)(kp+2048); kf[3]=*(const __attribute__((address_space(3))) bf16x8*)(kp+2560);
  kf[4]=*(const __attribute__((address_space(3))) bf16x8*)(kp+4096); kf[5]=*(const __attribute__((address_space(3))) bf16x8*)(kp+4608);
  kf[6]=*(const __attribute__((address_space(3))) bf16x8*)(kp+6144); kf[7]=*(const __attribute__((address_space(3))) bf16x8*)(kp+6656);
}
__device__ __forceinline__ void kload2(bf16x8*kf,lds_cptr kp,int j){ kf[2*j]=*(const __attribute__((address_space(3))) bf16x8*)(kp+j*2048); kf[2*j+1]=*(const __attribute__((address_space(3))) bf16x8*)(kp+j*2048+512); }
__device__ __forceinline__ s16x4 vtr(lds_cptr p){ return __builtin_bit_cast(s16x4,__builtin_amdgcn_ds_read_tr16_b64_v4i16((__attribute__((address_space(3))) v4i16_t*)p)); }
__device__ __forceinline__ float rowmax(const f32x16&p0,const f32x16&p1){
  float a=max3f(p0[0],p0[1],p1[0]),b=max3f(p0[2],p0[3],p1[1]);a=max3f(a,p1[2],p1[3]);
  #pragma unroll
  for(int r=4;r<16;r+=4){a=max3f(a,p0[r],p0[r+1]);b=max3f(b,p0[r+2],p0[r+3]);a=max3f(a,p1[r],p1[r+1]);b=max3f(b,p1[r+2],p1[r+3]);}
  const float m=max2f(a,b);
  auto rr=__builtin_amdgcn_permlane32_swap(__float_as_uint(m),__float_as_uint(m),false,false);
  return max2f(__uint_as_float(rr[0]),__uint_as_float(rr[1]));
}
__device__ __forceinline__ void pv(f32x16*o,int vb,bf16x8 pa0,bf16x8 pa1,bf16x8 pa2,bf16x8 pa3){
  #pragma unroll
  for(int d0=0;d0<2;++d0){s16x4 lo[4],hi[4];
    #pragma unroll
    for(int ks=0;ks<4;++ks){
      asm volatile("ds_read_b64_tr_b16 %0,%1 offset:%c2":"=&v"(lo[ks]):"v"(vb),"i"(d0*4096+ks*1024):"memory");
      asm volatile("ds_read_b64_tr_b16 %0,%1 offset:%c2":"=&v"(hi[ks]):"v"(vb),"i"(d0*4096+ks*1024+512):"memory");}
    asm volatile("s_waitcnt lgkmcnt(0)":::"memory");SBAR();
    #define PK(k) (bf16x8){lo[k][0],lo[k][1],lo[k][2],lo[k][3],hi[k][0],hi[k][1],hi[k][2],hi[k][3]}
    o[d0]=__builtin_amdgcn_mfma_f32_32x32x16_bf16(pa0,PK(0),o[d0],0,0,0);
    o[d0]=__builtin_amdgcn_mfma_f32_32x32x16_bf16(pa1,PK(1),o[d0],0,0,0);
    o[d0]=__builtin_amdgcn_mfma_f32_32x32x16_bf16(pa2,PK(2),o[d0],0,0,0);
    o[d0]=__builtin_amdgcn_mfma_f32_32x32x16_bf16(pa3,PK(3),o[d0],0,0,0);
    #undef PK
  }
}

#ifndef ATTN_STORE16
#define ATTN_STORE16(p,v) (*(u32x4*)(p)=(v))
#endif
template<int THRL> __device__ __forceinline__ void attn_unit(int b,int h,int hv,int qb,const bf16*Q,const bf16*__restrict__ K,const bf16*__restrict__ V,bf16*CATp,const int mode,const float lam,const float*hgp,char*shm){
  const int tid=threadIdx.x,lane=tid&63,r32=lane&31,hi=lane>>5; const int wid=__builtin_amdgcn_readfirstlane(tid>>6);
  const long rowbase=(long)b*SEQ; const int q0=qb*QB;
  const bf16*Qw=Q+(rowbase+q0+wid*QBLK)*DM+h*D;
  const bf16*Kh=K+rowbase*DM+h*D,*Vh=V+rowbase*DM+hv*D;
  const unsigned lds0=(unsigned)(uintptr_t)shm;
  float*wsf=(float*)(shm+LDS_WS)+wid*64;
  const bf16*ksrc=Kh+(long)lane*DM+wid*8;
  const bf16*vsrc=Vh+(long)(16*(wid&3)+(lane>>2))*DM+(wid>>2)*32+(lane&3)*8;
  const unsigned kdst=lds0+LDS_K+wid*1024, vdst=lds0+LDS_V+wid*1024;
  #define DMA_K(t,slot) glds16(ksrc+(long)(t)*KVBLK*DM,(unsigned)__builtin_amdgcn_readfirstlane(kdst+(slot)))
  #define DMA_V(t,slot) glds16(vsrc+(long)(t)*KVBLK*DM,(unsigned)__builtin_amdgcn_readfirstlane(vdst+(slot)))
  const int vb0=(int)(lds0+LDS_V)+((lane>>4)&1)*32+(lane&3)*8+(4*hi+((lane&15)>>2))*64;
  const char*Kbase=shm+LDS_K; bf16x8 kf[8];
  const lds_cptr shm3=(lds_cptr)shm; const lds_cptr kp0=shm3+LDS_K+hi*1024+r32*16; const lds_cptr vp0=shm3+LDS_V+((lane>>4)&1)*32+(lane&3)*8+(4*hi+((lane&15)>>2))*64;
  const int NT=(q0+QB)/KVBLK;
  DMA_K(0,0);DMA_V(0,0);DMA_K(1,SLOTB);
  bf16x8 qr[4];
  #pragma unroll
  for(int d0=0;d0<4;++d0)qr[d0]=*reinterpret_cast<const bf16x8*>(&Qw[(long)r32*DM+d0*16+hi*8]);
  float mhat=0.f,l_reg=0.f;f32x16 o[2];o[0]=f32x16{};o[1]=f32x16{};
  const int qrel=wid*QBLK+r32;
  #define CMASK(P0,P1,t) do{int jb_=(t)-(NT-4); if(jb_>=0)cmask(P0,P1,jb_,qrel,hi);}while(0)
  bool resc=false;
  #define START(P0,P1) do{ const float rm=rowmax(P0,P1); resc=false; mhat=rm; \
    _Pragma("unroll") for(int r=0;r<16;++r)P0[r]=__builtin_amdgcn_exp2f(fsub_s(P0[r],mhat)); }while(0)
  #define RESC() do{ if(resc){ asm volatile("s_waitcnt lgkmcnt(0)":::"memory"); \
      _Pragma("unroll") for(int d_=0;d_<2;++d_) _Pragma("unroll") for(int r=0;r<16;++r)o[d_][r]*=wsf[crow(r,hi)]; } }while(0)
  f32x16 pA0,pA1,pB0,pB1;
  int sl_prev=0,sl_cur=0,sl_next=SLOTB;
  #define ROT() do{sl_prev=sl_cur;sl_cur=sl_next;sl_next=(sl_next==(NSLOT-1)*SLOTB)?0:sl_next+SLOTB;}while(0)
  DMA_K(2,2*SLOTB);
  WAIT_BAR(3);
  qkt(pA0,pA1,Kbase,qr,r32,hi);asm volatile("s_nop 15\n\ts_nop 7":"+v"(pA0),"+v"(pA1));CMASK(pA0,pA1,0);
  START(pA0,pA1);
  _Pragma("unroll") for(int r=0;r<16;++r)pA1[r]=__builtin_amdgcn_exp2f(fsub_s(pA1[r],mhat));
  WAIT_BAR(0);
  DMA_K(3,0);DMA_V(1,SLOTB);
  ROT();
  kload8(kf,kp0+sl_cur);
  WAIT_BAR(2);
  s16x4 vlo[8],vhi[8]; u32x4 pw0,pw1,pw2,pw3;
  #define PKW(P,B) cvtpk_s(P[B],P[B+1])
  #define PAF(k) __builtin_bit_cast(bf16x8,pw##k)
  #define VFR(i) (bf16x8){vlo[i][0],vlo[i][1],vlo[i][2],vlo[i][3],vhi[i][0],vhi[i][1],vhi[i][2],vhi[i][3]}
  #define PIN(x) asm volatile("":"+v"(x))
  #define MX3(a,b,c) __builtin_fmaxf(__builtin_fmaxf((a),(b)),(c))
  #define GAPA(MF,A0,A1,A2,A3,W0,W1,PW) do{ MF; sacc+=A0; sacc+=A1; sacc+=A2; sacc+=A3; PIN(sacc); W0; W1; PIN(PW); SBAR(); }while(0)
  #define EX(v) __builtin_amdgcn_exp2f((v)-mhat)
  #define GAPB(MF,X,B) do{ MF; X[B]=EX(X[B]); X[B+1]=EX(X[B+1]); X[B+2]=EX(X[B+2]); X[B+3]=EX(X[B+3]); PIN(X); SBAR(); }while(0)
  #define VRD(i) do{ vlo[i]=vtr(vp_+(((i)>>2)*4096+((i)&3)*1024)); vhi[i]=vtr(vp_+(((i)>>2)*4096+((i)&3)*1024+512)); }while(0)
  #define KRD(G,j) do{ if(G){ kload2(kf,kp0+sl_next,j); SBAR(); } }while(0)
  #define STEP(C0,C1,P0,P1,t,GK,GV,GL) do{ SBAR(); const f32x16 zc_=f32x16{}; \
    const lds_cptr vp_=vp0+sl_prev; \
    VRD(0); SBAR(); float sacc=(P0[0]+P0[1]); \
    GAPA(C0=__builtin_amdgcn_mfma_f32_32x32x16_bf16(kf[0],qr[0],zc_,0,0,0), P0[2],P0[3],P0[4],P0[5],     pw0[0]=PKW(P0,0), pw0[1]=PKW(P0,2), pw0); \
    VRD(4); SBAR(); GAPA(C1=__builtin_amdgcn_mfma_f32_32x32x16_bf16(kf[1],qr[0],zc_,0,0,0), P0[6],P0[7],P0[8],P0[9],     pw0[2]=PKW(P0,4), pw0[3]=PKW(P0,6), pw0); \
    VRD(1); SBAR(); GAPA(C0=__builtin_amdgcn_mfma_f32_32x32x16_bf16(kf[2],qr[1],C0,0,0,0),   P0[10],P0[11],P0[12],P0[13], pw1[0]=PKW(P0,8), pw1[1]=PKW(P0,10), pw1); \
    VRD(5); SBAR(); GAPA(C1=__builtin_amdgcn_mfma_f32_32x32x16_bf16(kf[3],qr[1],C1,0,0,0),   P0[14],P0[15],P1[0],P1[1],   pw1[2]=PKW(P0,12),pw1[3]=PKW(P0,14), pw1); \
    VRD(2); SBAR(); GAPA(C0=__builtin_amdgcn_mfma_f32_32x32x16_bf16(kf[4],qr[2],C0,0,0,0),   P1[2],P1[3],P1[4],P1[5],     pw2[0]=PKW(P1,0), pw2[1]=PKW(P1,2), pw2); \
    VRD(6); SBAR(); GAPA(C1=__builtin_amdgcn_mfma_f32_32x32x16_bf16(kf[5],qr[2],C1,0,0,0),   P1[6],P1[7],P1[8],P1[9],     pw2[2]=PKW(P1,4), pw2[3]=PKW(P1,6), pw2); \
    VRD(3); SBAR(); GAPA(C0=__builtin_amdgcn_mfma_f32_32x32x16_bf16(kf[6],qr[3],C0,0,0,0),   P1[10],P1[11],P1[12],P1[13], pw3[0]=PKW(P1,8), pw3[1]=PKW(P1,10), pw3); \
    VRD(7); SBAR(); GAPA(C1=__builtin_amdgcn_mfma_f32_32x32x16_bf16(kf[7],qr[3],C1,0,0,0),   P1[14],P1[15],0.f,0.f,       pw3[2]=PKW(P1,12),pw3[3]=PKW(P1,14), pw3); \
    l_reg+=sacc; \
    if(GK){DMA_K((t)+3,sl_cur);} if(GV){DMA_V((t)+1,sl_next);} \
    CMASK(C0,C1,t); \
    { float a=MX3(C0[0],C0[1],C1[0]),b=MX3(C0[2],C0[3],C1[1]); a=MX3(a,C1[2],C1[3]); \
      _Pragma("unroll") for(int r=4;r<16;r+=4){a=MX3(a,C0[r],C0[r+1]);b=MX3(b,C0[r+2],C0[r+3]);a=MX3(a,C1[r],C1[r+1]);b=MX3(b,C1[r+2],C1[r+3]);} \
      float rm=__builtin_fmaxf(a,b); { auto rr=__builtin_amdgcn_permlane32_swap(__float_as_uint(rm),__float_as_uint(rm),false,false); rm=__builtin_fmaxf(__uint_as_float(rr[0]),__uint_as_float(rr[1])); } \
      resc=false; \
      rm-=mhat; \
      if(__builtin_expect(__any(rm>(float)THRL),0)){ const float dl=__builtin_fmaxf(rm,0.f); mhat+=dl; \
        const float f=__builtin_amdgcn_exp2f(-dl); l_reg*=f; if(hi==0)wsf[r32]=f; resc=true; } } \
    SBAR(); \
    GAPB(o[0]=__builtin_amdgcn_mfma_f32_32x32x16_bf16(PAF(0),VFR(0),o[0],0,0,0), C0,0); \
    GAPB(o[1]=__builtin_amdgcn_mfma_f32_32x32x16_bf16(PAF(0),VFR(4),o[1],0,0,0), C0,4); \
    KRD(GL,0); GAPB(o[0]=__builtin_amdgcn_mfma_f32_32x32x16_bf16(PAF(1),VFR(1),o[0],0,0,0), C0,8); \
    KRD(GL,1); GAPB(o[1]=__builtin_amdgcn_mfma_f32_32x32x16_bf16(PAF(1),VFR(5),o[1],0,0,0), C0,12); \
    KRD(GL,2); GAPB(o[0]=__builtin_amdgcn_mfma_f32_32x32x16_bf16(PAF(2),VFR(2),o[0],0,0,0), C1,0); \
    KRD(GL,3); GAPB(o[1]=__builtin_amdgcn_mfma_f32_32x32x16_bf16(PAF(2),VFR(6),o[1],0,0,0), C1,4); \
    GAPB(o[0]=__builtin_amdgcn_mfma_f32_32x32x16_bf16(PAF(3),VFR(3),o[0],0,0,0), C1,8); \
    GAPB(o[1]=__builtin_amdgcn_mfma_f32_32x32x16_bf16(PAF(3),VFR(7),o[1],0,0,0), C1,12); \
    }while(0)
  int t=1;
  #undef CMASK
  #define CMASK(P0,P1,t) do{}while(0)
  for(;t+5<NT;t+=2){
    STEP(pB0,pB1,pA0,pA1,t,true,true,true);     WAIT_BAR(2); RESC(); ROT();
    STEP(pA0,pA1,pB0,pB1,t+1,true,true,true);   WAIT_BAR(2); RESC(); ROT();
  }
  #undef CMASK
  #define CMASK(P0,P1,t) do{int jb_=(t)-(NT-4); if(jb_>=0)cmask(P0,P1,jb_,qrel,hi);}while(0)
  #define ENDW(tt) do{ if((tt)+3<NT){WAIT_BAR(2);} else if((tt)+2<NT){WAIT_BAR(1);} else {WAIT_BAR(0);} }while(0)
  for(;t+1<NT;t+=2){
    STEP(pB0,pB1,pA0,pA1,t,(t+3<NT),(t+1<NT),(t+1<NT));       ENDW(t);   RESC(); ROT();
    STEP(pA0,pA1,pB0,pB1,t+1,(t+4<NT),(t+2<NT),(t+2<NT));     ENDW(t+1); RESC(); ROT();
  }
  STEP(pB0,pB1,pA0,pA1,NT-1,false,false,false); RESC();
  { float sacc=pB0[0]+pB0[1]; _Pragma("unroll") for(int r=2;r<16;++r)sacc+=pB0[r]; _Pragma("unroll") for(int r=0;r<16;++r)sacc+=pB1[r]; l_reg+=sacc;
    pw0=(u32x4){PKW(pB0,0),PKW(pB0,2),PKW(pB0,4),PKW(pB0,6)};pw1=(u32x4){PKW(pB0,8),PKW(pB0,10),PKW(pB0,12),PKW(pB0,14)};pw2=(u32x4){PKW(pB1,0),PKW(pB1,2),PKW(pB1,4),PKW(pB1,6)};pw3=(u32x4){PKW(pB1,8),PKW(pB1,10),PKW(pB1,12),PKW(pB1,14)};
    SBAR(); pv(o,vb0+sl_cur,PAF(0),PAF(1),PAF(2),PAF(3)); }
  #undef PKW
  #undef PAF
  #undef VFR
  #undef PIN
  #undef MX3
  #undef GAPA
  #undef GAPB
  #undef EX
  #undef VRD
  #undef KRD
  #undef STEP
  #undef ENDW
  {auto rr=__builtin_amdgcn_permlane32_swap(__float_as_uint(l_reg),__float_as_uint(l_reg),false,false);l_reg=__uint_as_float(rr[0])+__uint_as_float(rr[1]);}
  if(hi==0)wsf[32+r32]=l_reg;asm volatile("s_waitcnt lgkmcnt(0)":::"memory");
  float rli[16];
  #pragma unroll
  for(int r=0;r<16;++r)rli[r]=__builtin_amdgcn_rcpf(wsf[32+crow(r,hi)]);
  { bf16*stg=(bf16*)(shm+LDS_OST)+wid*2048;
    bf16*xst=(bf16*)(shm+LDS_X)+wid*2048; float*ssq=(float*)(shm+LDS_SSQ)+wid*32;
    bf16*cur=(mode&2)?stg:xst;
    if((mode&1)==0){
      #pragma unroll
      for(int r=0;r<16;++r){const int orow=crow(r,hi);
        #pragma unroll
        for(int d0=0;d0<2;++d0)cur[orow*64+d0*32+r32]=__float2bfloat16(o[d0][r]*rli[r]);}
    } else {
      #pragma unroll
      for(int r=0;r<16;++r){const int orow=crow(r,hi);
        #pragma unroll
        for(int d0=0;d0<2;++d0){const int pos=orow*64+d0*32+r32; const float dd=__bfloat162float(cur[pos])-lam*(o[d0][r]*rli[r]); cur[pos]=__float2bfloat16(dd);}}
      asm volatile("s_waitcnt lgkmcnt(0)":::"memory");
      const long trow=rowbase+q0+wid*QBLK;
      #pragma unroll
      for(int i=0;i<4;++i){const int row=i*8+(lane>>3),ch=lane&7; const u32x4 vb=*(const u32x4*)(cur+row*64+ch*8);
        float fb[8];
        #pragma unroll
        for(int e=0;e<4;++e){fb[2*e]=__uint_as_float(vb[e]<<16);fb[2*e+1]=__uint_as_float(vb[e]&0xffff0000u);}
        float ss=0.f;
        #pragma unroll
        for(int e=0;e<8;++e)ss+=fb[e]*fb[e];
        ss+=__shfl_xor(ss,1);ss+=__shfl_xor(ss,2);ss+=__shfl_xor(ss,4);
        if(mode==1){ if(ch==0)ssq[row]=ss; }
        else{
          const u32x4 va=*(const u32x4*)(xst+row*64+ch*8);
          const float rr=(1.0f-LAM_INIT)/sqrtf((ssq[row]+ss)/128.0f+EPS);
          const float4 ga0=*(const float4*)(hgp+ch*8),ga1=*(const float4*)(hgp+ch*8+4),gb0=*(const float4*)(hgp+64+ch*8),gb1=*(const float4*)(hgp+64+ch*8+4);
          const float ga[8]={ga0.x,ga0.y,ga0.z,ga0.w,ga1.x,ga1.y,ga1.z,ga1.w},gb[8]={gb0.x,gb0.y,gb0.z,gb0.w,gb1.x,gb1.y,gb1.z,gb1.w};
          u32x4 oa,ob;
          #pragma unroll
          for(int e=0;e<4;++e){
            oa[e]=cvtpk_s(__uint_as_float(va[e]<<16)*rr*ga[2*e],__uint_as_float(va[e]&0xffff0000u)*rr*ga[2*e+1]);
            ob[e]=cvtpk_s(fb[2*e]*rr*gb[2*e],fb[2*e+1]*rr*gb[2*e+1]);}
          bf16*cp=CATp+(trow+row)*2048+(hv>>1)*128+ch*8;
          ATTN_STORE16(cp,oa); ATTN_STORE16(cp+64,ob);
        }
      }
    }
  }
  asm volatile("s_waitcnt lgkmcnt(0)\n\ts_barrier":::"memory");
  #undef DMA_K
  #undef DMA_V
  #undef CMASK
  #undef START
  #undef RESC
  #undef ROT
}
constexpr int ATTN_LDS_BYTES=LDS_BYTES+NW*4096+NW*128;
struct AttnTensors { const bf16* Q; const bf16* K; const bf16* V; bf16* CAT; float lam; const float* hg; };
template<int THRL=8> __device__ __forceinline__ void attn_phase(char*lds,const AttnTensors&T,int vcu,int G){
  for(int item=vcu;item<BATCH*8*4;item+=G){
    const int b=item>>5,h=(item>>2)&7,j=item&3;
    for(int q2=0;q2<2;++q2){ const int qb=q2?j:NQB-1-j;
      for(int mode=0;mode<4;++mode) attn_unit<THRL>(b,2*h+(mode&1),2*h+(mode>>1),qb,T.Q,T.K,T.V,T.CAT,mode,T.lam,T.hg,lds); }
  }
}
#undef SBAR
#undef WAIT_BAR
}

__device__ __forceinline__ void p_s5_stepA(const Frame& F, const Args& A);
__device__ __forceinline__ void p3_attn(const Frame& F, const Args& A) {
    const attn_body::AttnTensors AT{(const attn_body::bf16*)WSB(WS_QB), (const attn_body::bf16*)WSB(WS_KB), (const attn_body::bf16*)WSB(WS_VB), (attn_body::bf16*)WSB(WS_B), *WSF(WS_LAM), IN_F(9)};
    const int vcu = (F.G % 8 == 0) ? (F.bid % 8) * (F.G / 8) + F.bid / 8 : F.bid;
    p_s5_stepA(F, A);
    attn_body::attn_phase<8>((char*)F.lds, AT, vcu, F.G);
}
__device__ __forceinline__ void p0_s5_setup(const Frame& F, const Args& A) {
    LAS float* Apr = (LAS float*)F.ldsl;
    LAS float* Api = Apr + 33 * 64;
    LAS float* Bbr = Api + 33 * 64;
    LAS float* Bbi = Bbr + 1024;
    LAS float* Cr = Bbi + 1024;
    LAS float* Ci = Cr + 1024;
    LAS float* Kk = Ci + 1024;
    const float* a_re = IN_F(10); const float* a_im = IN_F(11); const float* log_dt = IN_F(12);
    const float* b_re = IN_F(13); const float* b_im = IN_F(14); const float* c_re = IN_F(15); const float* c_im = IN_F(16); const float* dsk = IN_F(17);
    bf16* BtC = WSB(WS_BTC); bf16* BtA = WSB(WS_BTA); float* AL = WSF(WS_AL);
    const int tid = F.tid;
    const float* xin = IN_F(0); const float* g3 = IN_F(3); bf16* XN = WSB(WS_B);
    const int gw4 = 4 * (F.bid * NWAVES + F.wave), step4 = 4 * F.G * NWAVES; int nbat = 0;
#define S5_BAR() asm volatile("s_waitcnt lgkmcnt(0)\n\ts_barrier" ::: "memory")
    for (int item = F.bid; item < SG * 4; item += F.G) {
        const int g = item >> 2, hq = item & 3; const bool first = item == F.bid;
        S5_BAR();
        const float dtf = expf(log_dt[g]); const double dt = (double)dtf;
        for (int e = tid; e < 33 * 64; e += NTHR) {
            const int k = e >> 6, p = e & 63;
            const float lre = a_re[g * SP + p], lim = a_im[g * SP + p];
            const float mag = expf(lre * dtf * (float)k), af = lim * dtf * (float)k;
            Apr[e] = mag * cosf(af); Api[e] = mag * sinf(af);
        }
        for (int e = tid; e < 1024; e += NTHR) {
            const int p = e >> 4, h = e & 15;
            const double lre = a_re[g * SP + p], lim = a_im[g * SP + p];
            const double mag = exp(lre * dt), ang = lim * dt;
            const double rev = ang * 0.15915494309189533577, frr = rev - floor(rev);
            const float af = (float)(frr * 6.283185307179586477);
            const double ar = mag * (double)cosf(af), ai = mag * (double)sinf(af);
            const double den = lre * lre + lim * lim;
            const double fre = ((ar - 1.0) * lre + ai * lim) / den, fim = (ai * lre - (ar - 1.0) * lim) / den;
            const double br = b_re[(g * SP + p) * 16 + h], bi = b_im[(g * SP + p) * 16 + h];
            Bbr[e] = (float)(fre * br - fim * bi); Bbi[e] = (float)(fre * bi + fim * br);
            Cr[h * 64 + p] = c_re[(g * 16 + h) * SP + p]; Ci[h * 64 + p] = c_im[(g * 16 + h) * SP + p];
        }
        S5_BAR();
        float4 pv[32]; const int r0 = gw4 + nbat * step4; const bool has0 = first && r0 < T;
        if (has0) { norm4_load(xin + (size_t)r0 * DM, F.lane, pv); ++nbat; }
        if (hq == 0 && tid < 64) { AL[(g * 64 + tid) * 2] = Apr[32 * 64 + tid]; AL[(g * 64 + tid) * 2 + 1] = Api[32 * 64 + tid]; }
        if (tid < 128) {
            const int k = tid >> 2, hl = tid & 3, h = 4 * hq + hl;
            float acc[16];
#pragma unroll
            for (int q = 0; q < 16; ++q) acc[q] = 0.f;
            for (int p = 0; p < 64; ++p) {
                const float cr = Cr[h * 64 + p], ci = Ci[h * 64 + p], ar = Apr[k * 64 + p], ai = Api[k * 64 + p];
                const float gr = cr * ar - ci * ai, gi = cr * ai + ci * ar;
#pragma unroll
                for (int q = 0; q < 16; ++q) acc[q] += gr * Bbr[p * 16 + q] - gi * Bbi[p * 16 + q];
            }
#pragma unroll
            for (int q = 0; q < 16; ++q) Kk[tid * 16 + q] = acc[q];
        }
        S5_BAR();
        const float dk0 = dsk[g * 16 + 4 * hq], dk1 = dsk[g * 16 + 4 * hq + 1], dk2 = dsk[g * 16 + 4 * hq + 2], dk3 = dsk[g * 16 + 4 * hq + 3];
        if (has0) norm4_finish(pv, g3, XN + (size_t)r0 * DM, F.lane);
        const int r1 = gw4 + nbat * step4; const bool has1 = first && r1 < T;
        if (has1) { norm4_load(xin + (size_t)r1 * DM, F.lane, pv); ++nbat; }
        asm volatile("" ::: "memory");
        for (int e = tid; e < 128 * 80; e += NTHR) {
            const int rr = e / 80, k0 = (e - rr * 80) * 8; const int tau = rr >> 2, hl = rr & 3, h = 4 * hq + hl;
            float v[8];
            if (k0 < 512) { const int sg = k0 >> 4, hp0 = k0 & 15;
#pragma unroll
                for (int q = 0; q < 8; ++q) { float x = 0.f; if (sg <= tau) { x = Kk[(((tau - sg) << 2) + hl) * 16 + hp0 + q]; if (sg == tau && hp0 + q == h) x += (hl == 0 ? dk0 : hl == 1 ? dk1 : hl == 2 ? dk2 : dk3); } v[q] = x; } }
            else { const int kp = k0 - 512, ri = kp >> 6, p0 = kp & 63;
#pragma unroll
                for (int q = 0; q < 8; ++q) { const int p = p0 + q; const float ar = Apr[(tau + 1) * 64 + p], ai = Api[(tau + 1) * 64 + p];
                    const float gr = Cr[h * 64 + p] * ar - Ci[h * 64 + p] * ai, gi = Cr[h * 64 + p] * ai + Ci[h * 64 + p] * ar; v[q] = ri ? -gi : gr; } }
            v4u o; o.x = pk2(v[0], v[1]); o.y = pk2(v[2], v[3]); o.z = pk2(v[4], v[5]); o.w = pk2(v[6], v[7]);
            *(v4u*)(BtC + ((size_t)g * 512 + tau * 16 + h) * 640 + k0) = o;
        }
        for (int e = tid; e < 32 * 64; e += NTHR) {
            const int rr = e >> 6, k0 = (e & 63) * 8; const int ri = rr >> 4, p = 16 * hq + (rr & 15), sg = k0 >> 4, hp0 = k0 & 15;
            const float ar = Apr[(31 - sg) * 64 + p], ai = Api[(31 - sg) * 64 + p];
            float v[8];
#pragma unroll
            for (int q = 0; q < 8; ++q) { const float br = Bbr[p * 16 + hp0 + q], bi = Bbi[p * 16 + hp0 + q]; v[q] = ri ? (ar * bi + ai * br) : (ar * br - ai * bi); }
            v4u o; o.x = pk2(v[0], v[1]); o.y = pk2(v[2], v[3]); o.z = pk2(v[4], v[5]); o.w = pk2(v[6], v[7]);
            *(v4u*)(BtA + ((size_t)g * 256 + ri * 64 + p) * 512 + k0) = o;
        }
        if (has1) norm4_finish(pv, g3, XN + (size_t)r1 * DM, F.lane);
    }
    {
        float4 pv[32];
        for (int r = gw4 + nbat * step4; r < T; r += step4) { norm4_load(xin + (size_t)r * DM, F.lane, pv); norm4_finish(pv, g3, XN + (size_t)r * DM, F.lane); }
    }
#undef S5_BAR
    __syncthreads();
}
__device__ __forceinline__ void p_s5_stepA(const Frame& F, const Args& A) {
    pg8::Gemm g{WSB(WS_UCAT), WSB(WS_BTA), NCH, 256, 512, UCK, 512, (long)NCH * UCK, (long)256 * 512, SG}; pg8::StaticOrder S; S.init(NCH, 256, F.G, F.bid, SG);
    pg8::EpiSl E{WSF(WS_SL)}; GEMM_RUN(pg8::EpiSl, true, g, S, E);
}
__device__ __forceinline__ void p4_s5_scan(const Frame& F, const Args& A) {
    const float* Sl = WSF(WS_SL); const float* AL = WSF(WS_AL); bf16* UC = WSB(WS_UCAT);
    if (F.wave >= 4) return;
    pg8::StaticOrder S; S.init(NCH, 512, F.G, F.bid, SG); pg8::Unit u;
    for (int i = 0; S.next(i, u); ++i) {
        const int p = F.lane, b = u.pm * 4 + F.wave, g = u.bz;
        const float ar = AL[(g * 64 + p) * 2], ai = AL[(g * 64 + p) * 2 + 1];
        const size_t row0 = (size_t)g * NCH + b * 64;
        float lr[64], li[64];
#pragma unroll
        for (int c = 0; c < 64; ++c) { lr[c] = Sl[(row0 + c) * 128 + p]; li[c] = Sl[(row0 + c) * 128 + 64 + p]; }
        asm volatile("" ::: "memory");
        float sr = 0.f, si = 0.f;
#pragma unroll
        for (int c = 0; c < 64; ++c) {
            bf16* up = UC + (row0 + c) * UCK + 512;
            up[p] = (bf16)f2bf(sr); up[64 + p] = (bf16)f2bf(si);
            const float nr = ar * sr - ai * si + lr[c], ni = ar * si + ai * sr + li[c];
            sr = nr; si = ni;
        }
    }
}
__device__ __forceinline__ void p5_s5_out(const Frame& F, const Args& A) {
    pg8::Gemm g{WSB(WS_UCAT), WSB(WS_BTC), NCH, 512, UCK, UCK, UCK, (long)NCH * UCK, (long)512 * UCK, SG}; pg8::StaticOrder S; S.init(NCH, 512, F.G, F.bid, SG);
    pg8::EpiS5 E{WSB(WS_GB)}; GEMM_RUN(pg8::EpiS5, true, g, S, E);
}
__device__ __forceinline__ void p10_xscores(const Frame& F, const Args& A) {
    for (int sel = 0; sel * F.G + F.bid < 256; ++sel) {
        pg8::Gemm g{WSB(WS_XQB), WSB(WS_KP), 2048, 256, 256, XW, 256, 0, 0, 1}; pg8::XsOrder S{F.G, F.bid, sel};
        pg8::EpiXs E{WSB(WS_XP), WSF(WS_LSUM)};
        pg8::gemm_phase<pg8::EpiXs, pg8::XsOrder, false, true>(F.ldsl, g, S, E);
        __syncthreads();
    }
}
__device__ __forceinline__ void p10_xpv(const Frame& F, const Args& A) {
    pg8::Gemm g{WSB(WS_XP), WSB(WS_VT2), 2048, 256, 256, 1024, 512, 0, 0, 1}; pg8::XoOrder S{F.G, F.bid};
    pg8::EpiXo E{WSB(WS_XO), WSF(WS_LSUM)};
    pg8::gemm_phase<pg8::EpiXo, pg8::XoOrder, true, true>(F.ldsl, g, S, E);
}
__device__ __forceinline__ unsigned f2key(float f) { const unsigned u = __float_as_uint(f); return (u & 0x80000000u) ? ~u : (u | 0x80000000u); }
__device__ __forceinline__ float key2f(unsigned k) { const unsigned u = (k & 0x80000000u) ? (k ^ 0x80000000u) : ~k; return __uint_as_float(u); }
#define INS16(L, xk) do { unsigned x_ = (xk); _Pragma("unroll") for (int s_ = 0; s_ < 16; ++s_) { const unsigned hi_ = L[s_] > x_ ? L[s_] : x_; x_ = L[s_] > x_ ? x_ : L[s_]; L[s_] = hi_; } } while (0)
#define CE_DESC(a_, b_) do { const unsigned hi_ = (a_) > (b_) ? (a_) : (b_), lo_ = (a_) > (b_) ? (b_) : (a_); (a_) = hi_; (b_) = lo_; } while (0)
__device__ __forceinline__ void sort16_desc(unsigned (&v)[16]) {
#pragma unroll
    for (int k = 2; k <= 16; k <<= 1)
#pragma unroll
        for (int j = k >> 1; j > 0; j >>= 1)
#pragma unroll
            for (int i = 0; i < 16; ++i) { const int l = i ^ j; if (l > i) { if ((i & k) == 0) CE_DESC(v[i], v[l]); else CE_DESC(v[l], v[i]); } }
}
__device__ __forceinline__ void merge16_desc(unsigned (&a)[16], const unsigned (&b)[16]) {
#pragma unroll
    for (int i = 0; i < 16; ++i) a[i] = a[i] > b[15 - i] ? a[i] : b[15 - i];
#pragma unroll
    for (int j = 8; j > 0; j >>= 1)
#pragma unroll
        for (int i = 0; i < 16; ++i) { const int l = i ^ j; if (l > i) CE_DESC(a[i], a[l]); }
}
__device__ __forceinline__ void top16_of_128(const float* sp, unsigned (&L)[16]) {
#pragma unroll 1
    for (int c = 0; c < 8; ++c) {
        unsigned ch[16];
#pragma unroll
        for (int i = 0; i < 16; ++i) ch[i] = (f2key(sp[(size_t)(c * 16 + i) * T]) & ~127u) | (unsigned)(127 - (c * 16 + i));
        sort16_desc(ch);
        if (c == 0) {
#pragma unroll
            for (int i = 0; i < 16; ++i) L[i] = ch[i];
        } else merge16_desc(L, ch);
    }
}
namespace pg8 {
struct TkOrder {
    int G, c, sel;
    __device__ __forceinline__ bool next(int i, Unit& u) const { if (i > 0) return false; const int L = sel * G + c; if (L >= PH * (T / BM)) return false; u.pm = 0; u.pn = L & (T / BM - 1); u.bz = L / (T / BM); return true; }
    __device__ __forceinline__ void a_ready(const Unit&) const {}
    __device__ __forceinline__ void done(const Unit&) const {}
    template <class G_> __device__ __forceinline__ long offA(const Unit& u, const G_& g) const { return (long)u.bz * g.sA; }
    template <class G_> __device__ __forceinline__ long offB(const Unit& u, const G_& g) const { return (long)u.bz * g.sB; }
};
struct EpiTopk {
    static constexpr bool PERM = false, AFTER_DRAIN = true;
    static constexpr int PITCH = 260;
    unsigned short* IDX; float* GATE;
    __device__ __forceinline__ void stage(const f32x4 (&acc)[2][2][4][2], int ai, int wr, int wc, int fr, int fq, PG8_LAS float* SCL) const {
#pragma unroll
        for (int m = 0; m < 4; ++m)
#pragma unroll
            for (int bj = 0; bj < 2; ++bj)
#pragma unroll
                for (int n = 0; n < 2; ++n) *(PG8_LAS f32x4*)(SCL + (wr * 64 + m * 16 + fr) * PITCH + bj * HALF + wc * 32 + n * 16 + 4 * fq) = acc[ai][bj][m][n];
    }
    static __device__ __forceinline__ unsigned blend(unsigned m, unsigned a, unsigned b) { return (a & m) | (b & ~m); }
    static __device__ __forceinline__ unsigned swap1(unsigned v) { return (unsigned)__builtin_amdgcn_update_dpp(0, (int)v, 0xB1, 0xF, 0xF, true); }
    __device__ __forceinline__ void top16(const PG8_LAS float* sp, int nb, unsigned (&L)[16]) const {
#pragma unroll 1
        for (int c = 0; c < 4; ++c) {
            unsigned ch[16];
#pragma unroll
            for (int i = 0; i < 16; ++i) ch[i] = (f2key(sp[(c * 16 + i) * PITCH]) & ~127u) | (unsigned)(nb - (c * 16 + i));
            sort16_desc(ch);
            if (c == 0) {
#pragma unroll
                for (int i = 0; i < 16; ++i) L[i] = ch[i];
            } else merge16_desc(L, ch);
        }
        unsigned P[16];
#pragma unroll
        for (int i = 0; i < 16; ++i) P[i] = swap1(L[i]);
        merge16_desc(L, P);
    }
    __device__ __forceinline__ void fused(f32x4 (&acc)[2][2][4][2], const Unit& u, int wr, int wc, int fr, int fq, PG8_LAS unsigned char* lds, int wid, int lane) const {
        PG8_LAS float* SCL = (PG8_LAS float*)lds;
        int ln = lane; asm volatile("" : "+v"(ln));
        const int tl = wid * 32 + (ln >> 1), kh = ln & 1; const unsigned km = 0u - (unsigned)kh;
        PG8_LAS unsigned char* li = lds + PK * PITCH * 4 + tl * 32;
        const PG8_LAS float* col = SCL + tl;
        float t1[16], t2[16];
        stage(acc, 0, wr, wc, fr, fq, SCL);
        asm volatile("s_waitcnt lgkmcnt(0)" ::: "memory"); __builtin_amdgcn_s_barrier(); asm volatile("" ::: "memory");
        { unsigned L1[16]; top16(col + kh * 64 * PITCH, 127 - kh * 64, L1);
#pragma unroll
          for (int s = 0; s < 16; ++s) { const int i1 = 127 - (int)(L1[s] & 127u); if (kh == 0) li[s] = (unsigned char)i1; t1[s] = col[i1 * PITCH]; } }
        asm volatile("s_waitcnt lgkmcnt(0)" ::: "memory"); __builtin_amdgcn_s_barrier(); asm volatile("" ::: "memory");
        stage(acc, 1, wr, wc, fr, fq, SCL);
        asm volatile("s_waitcnt lgkmcnt(0)" ::: "memory"); __builtin_amdgcn_s_barrier(); asm volatile("" ::: "memory");
        { unsigned L2[16]; top16(col + kh * 64 * PITCH, 127 - kh * 64, L2);
#pragma unroll
          for (int s = 0; s < 16; ++s) { const int i2 = 127 - (int)(L2[s] & 127u); if (kh == 0) li[16 + s] = (unsigned char)i2; t2[s] = col[i2 * PITCH]; } }
        unsigned Lc[16], c1[16];
        {
            int n = 0;
#pragma unroll
            for (int a = 0; a < 16; ++a)
#pragma unroll
                for (int m = 0; m < 8; ++m)
                    if ((a + 1) * (2 * m + 1) <= 16) {
                        const bool odd_ok = (a + 1) * (2 * m + 2) <= 16;
                        const float tb = __uint_as_float(blend(km, __float_as_uint(t2[(2 * m + 1) & 15]), __float_as_uint(t2[2 * m])));
                        unsigned k = (f2key(t1[a] + tb) & ~255u) | (unsigned)((255 - (a * 16 + 2 * m)) - kh);
                        if (!odd_ok) k = kh ? 0u : k;
                        if (n < 16) Lc[n] = k; else c1[n - 16] = k; ++n; }
            c1[14] = 0u; c1[15] = 0u;
        }
        sort16_desc(Lc); sort16_desc(c1); merge16_desc(Lc, c1);
        {
            unsigned P[16];
#pragma unroll
            for (int i = 0; i < 16; ++i) P[i] = swap1(Lc[i]);
            merge16_desc(Lc, P);
        }
        float ts[16]; const float mx = key2f(Lc[0] & ~255u); float sum = 0.f;
#pragma unroll
        for (int s = 0; s < 16; ++s) { ts[s] = expf(key2f(Lc[s] & ~255u) - mx); sum += ts[s]; }
        const float inv = 1.0f / sum;
        const size_t ob = (size_t)(u.pn * BM + tl) * 128 + u.bz * 16 + kh * 8;
        asm volatile("s_waitcnt lgkmcnt(0)" ::: "memory");
#pragma unroll
        for (int s = 0; s < 8; ++s) {
            const unsigned key = blend(km, Lc[8 + s], Lc[s]); const float tv = __uint_as_float(blend(km, __float_as_uint(ts[8 + s]), __float_as_uint(ts[s])));
            const int flat = 255 - (int)(key & 255u); const int a = flat >> 4, b = flat & 15;
            const int e1 = li[a], e2 = li[16 + b];
            IDX[ob + s] = (unsigned short)(e1 * PK + e2);
            GATE[ob + s] = tv * inv;
        }
    }
};
}

struct PeerCtx { int xr, nx, nloc, rank; };
__device__ __forceinline__ PeerCtx peer_ctx(const Frame& F, volatile LAS unsigned* MISC) {
    if (F.tid == 0) {
        unsigned* barw = (unsigned*)(F.ws + WS_CTL) + CW_BAR; const unsigned x = MISC[11];
        unsigned nx = 0, xr = 0, nloc = 1;
        for (unsigned j = 0; j < 16; ++j) { const unsigned c = xb_ld(&barw[XB_XCNT(j)]); if (c) { ++nx; if (j < x) ++xr; } if (j == x) nloc = c ? c : 1u; }
        MISC[12] = xr; MISC[13] = nx ? nx : 1u; MISC[14] = nloc;
    }
    __syncthreads();
    PeerCtx c; c.xr = (int)MISC[12]; c.nx = (int)MISC[13]; c.nloc = (int)MISC[14]; c.rank = (int)MISC[10];
    return c;
}
typedef __bf16 bf16x2 __attribute__((ext_vector_type(2)));
__device__ __forceinline__ float dot2_bf16(unsigned w, unsigned x, float acc) { return __builtin_amdgcn_fdot2_f32_bf16(__builtin_bit_cast(bf16x2, w), __builtin_bit_cast(bf16x2, x), acc, false); }
__device__ __forceinline__ float dot8(const v4u& r, const v4u& x) { float a = dot2_bf16(r.x, x.x, 0.f); a = dot2_bf16(r.y, x.y, a); a = dot2_bf16(r.z, x.z, a); return dot2_bf16(r.w, x.w, a); }
__device__ __forceinline__ float xl1(float x) { return __uint_as_float((unsigned)__builtin_amdgcn_update_dpp(0, (int)__float_as_uint(x), 0xB1, 0xF, 0xF, true)); }
__device__ __forceinline__ float xl2(float x) { return __uint_as_float((unsigned)__builtin_amdgcn_update_dpp(0, (int)__float_as_uint(x), 0x4E, 0xF, 0xF, true)); }
__device__ __forceinline__ float xl4(float x) { const int v = (int)__float_as_uint(x); int r = __builtin_amdgcn_update_dpp(0, v, 0x104, 0xF, 0x5, false); r = __builtin_amdgcn_update_dpp(r, v, 0x114, 0xF, 0xA, false); return __uint_as_float((unsigned)r); }
__device__ __forceinline__ float xl8(float x) { return __uint_as_float((unsigned)__builtin_amdgcn_update_dpp(0, (int)__float_as_uint(x), 0x128, 0xF, 0xF, true)); }
__device__ __forceinline__ float sum16x(float a, float b) { const auto r = __builtin_amdgcn_permlane16_swap(__float_as_uint(a), __float_as_uint(b), false, false); return __uint_as_float(r[0]) + __uint_as_float(r[1]); }
__device__ __forceinline__ float sum32x(float a, float b) { const auto r = __builtin_amdgcn_permlane32_swap(__float_as_uint(a), __float_as_uint(b), false, false); return __uint_as_float(r[0]) + __uint_as_float(r[1]); }
__device__ __forceinline__ float wave_sum_valu(float x) {
    x += xl1(x); x += xl2(x);
    x += __uint_as_float((unsigned)__builtin_amdgcn_update_dpp(0, (int)__float_as_uint(x), 0x141, 0xF, 0xF, true));
    x += __uint_as_float((unsigned)__builtin_amdgcn_update_dpp(0, (int)__float_as_uint(x), 0x140, 0xF, 0xF, true));
    x = sum16x(x, x); return sum32x(x, x);
}
#define RED8J(v0, v1, v2, v3, v4, v5, v6, v7, B2, B1, B0, out) do { \
    const float a0_ = ((B2) ? v4 : v0) + xl4((B2) ? v0 : v4), a1_ = ((B2) ? v5 : v1) + xl4((B2) ? v1 : v5); \
    const float a2_ = ((B2) ? v6 : v2) + xl4((B2) ? v2 : v6), a3_ = ((B2) ? v7 : v3) + xl4((B2) ? v3 : v7); \
    const float c0_ = ((B1) ? a2_ : a0_) + xl2((B1) ? a0_ : a2_), c1_ = ((B1) ? a3_ : a1_) + xl2((B1) ? a1_ : a3_); \
    out = ((B0) ? c1_ : c0_) + xl1((B0) ? c0_ : c1_); } while (0)
#define RED8G(v0, v1, v2, v3, v4, v5, v6, v7, B0, out) do { \
    const float a0_ = sum32x(v0, v4), a1_ = sum32x(v1, v5), a2_ = sum32x(v2, v6), a3_ = sum32x(v3, v7); \
    const float c0_ = sum16x(a0_, a2_), c1_ = sum16x(a1_, a3_); \
    out = ((B0) ? c1_ : c0_) + xl8((B0) ? c0_ : c1_); } while (0)
#define RED8(v0, v1, v2, v3, v4, v5, v6, v7, B2, B1, B0, X2, X1, X0, out) do { \
    const float a0_ = ((B2) ? v4 : v0) + __shfl_xor((B2) ? v0 : v4, X2), a1_ = ((B2) ? v5 : v1) + __shfl_xor((B2) ? v1 : v5, X2); \
    const float a2_ = ((B2) ? v6 : v2) + __shfl_xor((B2) ? v2 : v6, X2), a3_ = ((B2) ? v7 : v3) + __shfl_xor((B2) ? v3 : v7, X2); \
    const float c0_ = ((B1) ? a2_ : a0_) + __shfl_xor((B1) ? a0_ : a2_, X1), c1_ = ((B1) ? a3_ : a1_) + __shfl_xor((B1) ? a1_ : a3_, X1); \
    out = ((B0) ? c1_ : c0_) + __shfl_xor((B0) ? c0_ : c1_, X0); } while (0)
typedef float f32x2 __attribute__((ext_vector_type(2)));
struct PTok { unsigned ix[8]; v4u xa, xb; float oa, ob; };
#define PK_IDX(TK, k) (((k) & 1) ? (TK.ix[(k) >> 1] >> 16) : (TK.ix[(k) >> 1] & 0xffffu))
#define LD_IDX16(TK, ip_) do { _Pragma("unroll") for (int q_ = 0; q_ < 2; ++q_) { const int4 v_ = (ip_)[q_]; TK.ix[4 * q_] = (unsigned)v_.x; TK.ix[4 * q_ + 1] = (unsigned)v_.y; TK.ix[4 * q_ + 2] = (unsigned)v_.z; TK.ix[4 * q_ + 3] = (unsigned)v_.w; } } while (0)
__device__ __forceinline__ float dot16_fp8(const v4u& r, const f32x2 (&X)[8]) {
    f32x2 a = {0.f, 0.f};
#pragma unroll
    for (int q = 0; q < 4; ++q) { const f32x2 lo = __builtin_amdgcn_cvt_pk_f32_fp8((int)r[q], false), hi = __builtin_amdgcn_cvt_pk_f32_fp8((int)r[q], true);
        a = lo * X[2 * q] + a; a = hi * X[2 * q + 1] + a; }
    return a.x + a.y;
}
__device__ __forceinline__ void p17_peer_u(const Frame& F, const Args& A, volatile LAS unsigned* MISC) {
    const PeerCtx cx = peer_ctx(F, MISC);
    const unsigned char* UB = F.ws + WS_UB; const bf16* HB = WSB(WS_B); const unsigned short* IDX = (const unsigned short*)(F.ws + WS_IDX); float* PACT = WSF(WS_PACT) + (size_t)cx.xr * T * 128;
    const int lane = F.lane, j = lane & 7, g = lane >> 3;
    const bool b2 = lane & 4, b1 = lane & 2, b0 = lane & 1;
    const int NI = (T / 8 - cx.rank + cx.nloc - 1) / cx.nloc;
#define U_TOK(i_) (((cx.rank + (i_) * cx.nloc) * 8) + F.wave)
    for (int p = 0; cx.xr + cx.nx * p < NSL; ++p) {
        const int s = cx.xr + cx.nx * p;
        const __amdgpu_buffer_rsrc_t rs = __builtin_amdgcn_make_buffer_rsrc((void*)(UB + (size_t)s * (PK * PK) * SLW), 0, PK * PK * SLW, 0x00020000);
#define U_LOAD(TK, t_) do { const int4* ip_ = (const int4*)(IDX + (size_t)(t_) * 128 + 16 * g); LD_IDX16(TK, ip_); \
        TK.xa = *(const v4u*)(HB + (size_t)(t_) * DM + s * SLW + j * 16); TK.xb = *(const v4u*)(HB + (size_t)(t_) * DM + s * SLW + j * 16 + 8); \
        TK.oa = 0.f; TK.ob = 0.f; if (p != 0) { const float2 pp_ = *(const float2*)(PACT + (size_t)(t_) * 128 + 16 * g + 2 * j); TK.oa = pp_.x; TK.ob = pp_.y; } } while (0)
#define U_GATHER(R, TK) do { _Pragma("unroll") for (int k = 0; k < 16; ++k) R[k] = __builtin_amdgcn_raw_buffer_load_b128(rs, ((unsigned)PK_IDX(TK, k) << 7) + (unsigned)(j * 16), 0, 0); } while (0)
#define U_COMPUTE(R, XA, XB, OA, OB, t_) do { f32x2 X[8]; \
        _Pragma("unroll") for (int q = 0; q < 4; ++q) { X[q] = (f32x2){__uint_as_float(XA[q] << 16), __uint_as_float(XA[q] & 0xffff0000u)}; X[4 + q] = (f32x2){__uint_as_float(XB[q] << 16), __uint_as_float(XB[q] & 0xffff0000u)}; } \
        float v[16]; float f_; _Pragma("unroll") for (int k = 0; k < 16; ++k) v[k] = dot16_fp8(R[k], X); \
        float fe_; \
        RED8J(v[0], v[2], v[4], v[6], v[8], v[10], v[12], v[14], b2, b1, b0, fe_); \
        RED8J(v[1], v[3], v[5], v[7], v[9], v[11], v[13], v[15], b2, b1, b0, f_); \
        *(float2*)(PACT + (size_t)(t_) * 128 + 16 * g + 2 * j) = make_float2(OA + fe_, OB + f_); } while (0)
        PTok TA, TB; v4u RA[16], RB[16];
        if (NI > 0) U_LOAD(TA, U_TOK(0));
        if (NI > 1) U_LOAD(TB, U_TOK(1));
        if (NI > 0) U_GATHER(RA, TA);
        for (int i = 0; i < NI; i += 2) {
            { const v4u xa = TA.xa, xb = TA.xb; const float oa = TA.oa, ob = TA.ob;
              if (i + 2 < NI) U_LOAD(TA, U_TOK(i + 2));
              if (i + 1 < NI) U_GATHER(RB, TB);
              U_COMPUTE(RA, xa, xb, oa, ob, U_TOK(i)); }
            if (i + 1 < NI) {
                const v4u xa = TB.xa, xb = TB.xb; const float oa = TB.oa, ob = TB.ob;
                if (i + 3 < NI) U_LOAD(TB, U_TOK(i + 3));
                if (i + 2 < NI) U_GATHER(RA, TA);
                U_COMPUTE(RB, xa, xb, oa, ob, U_TOK(i + 1));
            }
        }
    }
#undef U_LOAD
#undef U_GATHER
#undef U_COMPUTE
#undef U_TOK
}
__device__ __forceinline__ void p18_peer_w(const Frame& F, const Args& A, volatile LAS unsigned* MISC) {
    const PeerCtx cx = peer_ctx(F, MISC);
    const float* PACT = WSF(WS_PACT); const float* GATE = WSF(WS_GATE); float* W = WSF(WS_PW); const unsigned short* IDX = (const unsigned short*)(F.ws + WS_IDX);
    const float* iu = WSF(WS_ISCU); const float* iv = WSF(WS_ISCV); const float* ssq2 = WSF(WS_SSQ2);
    const size_t gt = (size_t)F.bid * NTHR + F.tid, NGT = (size_t)F.G * NTHR;
    for (size_t i = gt * 4; i < (size_t)T * 128; i += NGT * 4) {
        float4 a = make_float4(0.f, 0.f, 0.f, 0.f);
        for (int q0 = 0; q0 < cx.nx; q0 += 8) {
            float4 pa[8];
#pragma unroll
            for (int j = 0; j < 8; ++j) pa[j] = (q0 + j < cx.nx) ? *(const float4*)(PACT + (size_t)(q0 + j) * T * 128 + i) : make_float4(0.f, 0.f, 0.f, 0.f);
#pragma unroll
            for (int j = 0; j < 8; ++j) { a.x += pa[j].x; a.y += pa[j].y; a.z += pa[j].z; a.w += pa[j].w; }
        }
        const uint2 e2_ = *(const uint2*)(IDX + i); const int4 e = make_int4((int)(e2_.x & 0xffffu), (int)(e2_.x >> 16), (int)(e2_.y & 0xffffu), (int)(e2_.y >> 16)); const float4 gt4 = *(const float4*)(GATE + i);
        const float rs = 1.0f / sqrtf(ssq2[i >> 7] * (1.0f / 2048.0f) + EPS);
        float4 w;
        w.x = gt4.x * gelu_exact(a.x * iu[e.x] * rs) * iv[e.x]; w.y = gt4.y * gelu_exact(a.y * iu[e.y] * rs) * iv[e.y];
        w.z = gt4.z * gelu_exact(a.z * iu[e.z] * rs) * iv[e.z]; w.w = gt4.w * gelu_exact(a.w * iu[e.w] * rs) * iv[e.w];
        *(float4*)(W + i) = w;
    }
}
struct VTok { unsigned ix[8]; float h0, h1; };
__device__ __forceinline__ void p19_peer_v(const Frame& F, const Args& A, volatile LAS unsigned* MISC) {
    const PeerCtx cx = peer_ctx(F, MISC);
    const unsigned char* VT = F.ws + WS_VT; float* SSQP = WSF(WS_SSQP);
    const __amdgpu_buffer_rsrc_t rsI = __builtin_amdgcn_make_buffer_rsrc((void*)(F.ws + WS_IDX), 0, T * 128 * 2, 0x00020000);
    const __amdgpu_buffer_rsrc_t rsW = __builtin_amdgcn_make_buffer_rsrc((void*)(F.ws + WS_PW), 0, T * 128 * 4, 0x00020000);
    const __amdgpu_buffer_rsrc_t rsHB = __builtin_amdgcn_make_buffer_rsrc((void*)(F.ws + WS_B), 0, T * DM * 2, 0x00020000);
    const int lane = F.lane, j = lane & 7, g = lane >> 3;
    const bool b5 = lane & 32, b4 = lane & 16, b3 = lane & 8;
    const int NI = (T / 8 - cx.rank + cx.nloc - 1) / cx.nloc;
#define U_TOK(i_) (((cx.rank + (i_) * cx.nloc) * 8) + F.wave)
    for (int p = 0; cx.xr + cx.nx * p < NSL; ++p) {
        const int s = cx.xr + cx.nx * p;
        const __amdgpu_buffer_rsrc_t rs = __builtin_amdgcn_make_buffer_rsrc((void*)(VT + (size_t)s * (PK * PK) * SLW), 0, PK * PK * SLW, 0x00020000);
        const unsigned hoff = (unsigned)(s * SLW + 16 * j + 2 * g) * 2u;
#define V_LOAD(TK, t_) do { const unsigned io_ = ((unsigned)(t_) * 128u + 16u * g) * 2u; \
        _Pragma("unroll") for (int q_ = 0; q_ < 2; ++q_) { const v4u v_ = __builtin_amdgcn_raw_buffer_load_b128(rsI, io_ + 16u * q_, 0, 0); TK.ix[4 * q_] = v_[0]; TK.ix[4 * q_ + 1] = v_[1]; TK.ix[4 * q_ + 2] = v_[2]; TK.ix[4 * q_ + 3] = v_[3]; } \
        const unsigned hb_ = (unsigned)(t_) * (DM * 2u) + hoff; const unsigned hw_ = (unsigned)__builtin_amdgcn_raw_buffer_load_b32(rsHB, hb_, 0, 0); TK.h0 = __uint_as_float(hw_ << 16); TK.h1 = __uint_as_float(hw_ & 0xffff0000u); } while (0)
#define V_GATHER(R, WQ, TK, t_) do { _Pragma("unroll") for (int k = 0; k < 16; ++k) R[k] = __builtin_amdgcn_raw_buffer_load_b128(rs, ((unsigned)PK_IDX(TK, k) << 7) + (unsigned)(j * 16), 0, 0); \
        const unsigned wo_ = ((unsigned)(t_) * 128u + 16u * g) * 4u; _Pragma("unroll") for (int q_ = 0; q_ < 4; ++q_) WQ[q_] = __builtin_amdgcn_raw_buffer_load_b128(rsW, wo_ + 16u * q_, 0, 0); } while (0)
#define V_COMPUTE(R, WQ, H0, H1, t_) do { f32x2 acc[8]; _Pragma("unroll") for (int q = 0; q < 8; ++q) acc[q] = (f32x2){0.f, 0.f}; \
        _Pragma("unroll") for (int k = 0; k < 16; ++k) { const float wk_ = __uint_as_float(WQ[k >> 2][k & 3]); const f32x2 w2 = (f32x2){wk_, wk_}; \
            _Pragma("unroll") for (int q = 0; q < 4; ++q) { const f32x2 lo = __builtin_amdgcn_cvt_pk_f32_fp8((int)R[k][q], false), hi = __builtin_amdgcn_cvt_pk_f32_fp8((int)R[k][q], true); \
                acc[2 * q] = lo * w2 + acc[2 * q]; acc[2 * q + 1] = hi * w2 + acc[2 * q + 1]; } } \
        float f0_, f1_; \
        RED8G(acc[0].x, acc[1].x, acc[2].x, acc[3].x, acc[4].x, acc[5].x, acc[6].x, acc[7].x, b3, f0_); \
        RED8G(acc[0].y, acc[1].y, acc[2].y, acc[3].y, acc[4].y, acc[5].y, acc[6].y, acc[7].y, b3, f1_); \
        const unsigned hb2_ = (unsigned)(t_) * (DM * 2u) + hoff; const float n0_ = H0 + f0_, n1_ = H1 + f1_; \
        __builtin_amdgcn_raw_buffer_store_b32(pk2(n0_, n1_), rsHB, hb2_, 0, 0); \
        const float s0_ = wave_sum_valu(n0_ * n0_ + n1_ * n1_); if (lane == 0) SSQP[(size_t)s * T + (t_)] = s0_; } while (0)
        VTok TA, TB; v4u RA[16], RB[16], WA[4], WB[4];
        if (NI > 0) V_LOAD(TA, U_TOK(0));
        if (NI > 1) V_LOAD(TB, U_TOK(1));
        if (NI > 0) V_GATHER(RA, WA, TA, U_TOK(0));
        for (int i = 0; i < NI; i += 2) {
            { const float h0 = TA.h0, h1 = TA.h1;
              if (i + 2 < NI) V_LOAD(TA, U_TOK(i + 2));
              if (i + 1 < NI) V_GATHER(RB, WB, TB, U_TOK(i + 1));
              V_COMPUTE(RA, WA, h0, h1, U_TOK(i)); }
            if (i + 1 < NI) {
                const float h0 = TB.h0, h1 = TB.h1;
                if (i + 3 < NI) V_LOAD(TB, U_TOK(i + 3));
                if (i + 2 < NI) V_GATHER(RA, WA, TA, U_TOK(i + 2));
                V_COMPUTE(RB, WB, h0, h1, U_TOK(i + 1));
            }
        }
    }
#undef V_LOAD
#undef V_GATHER
#undef V_COMPUTE
#undef U_TOK
}
__device__ __forceinline__ void p20_final(const Frame& F, const Args& A) {
    float* O = F.out; const bf16* HB = WSB(WS_B); const float* fg = IN_F(33); const float* SSQP = WSF(WS_SSQP);
    const int gw = F.bid * NWAVES + F.wave, NGW = F.G * NWAVES, lane = F.lane;
    for (int t = gw; t < T; t += NGW) {
        float sq = 0.f;
#pragma unroll
        for (int sl = 0; sl < NSL; ++sl) sq += SSQP[(size_t)sl * T + t];
        const float r = 1.0f / sqrtf(sq / (float)DM + EPS);
#pragma unroll
        for (int q = 0; q < 4; ++q) { const int c = 512 * q + 8 * lane; const v4u h = *(const v4u*)(HB + (size_t)t * DM + c);
            const float4 g0 = *(const float4*)(fg + c), g1 = *(const float4*)(fg + c + 4);
            ntst4(O + (size_t)t * DM + c, make_float4(__uint_as_float(h.x << 16) * r * g0.x, __uint_as_float(h.x & 0xffff0000u) * r * g0.y, __uint_as_float(h.y << 16) * r * g0.z, __uint_as_float(h.y & 0xffff0000u) * r * g0.w));
            ntst4(O + (size_t)t * DM + c + 4, make_float4(__uint_as_float(h.z << 16) * r * g1.x, __uint_as_float(h.z & 0xffff0000u) * r * g1.y, __uint_as_float(h.w << 16) * r * g1.z, __uint_as_float(h.w & 0xffff0000u) * r * g1.w)); }
    }
}
__device__ __forceinline__ void p0_prep(const Frame& F, const Args& A) {
    const int gw = F.bid * NWAVES + F.wave, NGW = F.G * NWAVES, lane = F.lane;
    LAS float* scr = (LAS float*)(F.ldsl + F.wave * 16384);
    constexpr int I_IN = 32 * 128, I_GLU = 16 * 32, I_OUT = 32 * 64, I_XQ = 32 * 16, I_XKV = 32 * 32, I_XO = 8 * 64, I_PQ = 32 * 64;
    constexpr int NITEMS = I_IN + I_GLU + I_OUT + I_XQ + I_XKV + I_XO + I_PQ;
    for (int it = gw; it < NITEMS; it += NGW) {
        int r = it;
        if (r < I_IN) { p0_transpose_item(IN_F(4), DM, INC, WSB(WS_WIN), 0, scr, r, lane); continue; } r -= I_IN;
        if (r < I_GLU) { p0_transpose_item(IN_F(18), SSMW, SSMW, WSB(WS_WGLU), 0, scr, r, lane); continue; } r -= I_GLU;
        if (r < I_OUT) { p0_transpose_item(IN_F(21), DM, DM, WSB(WS_WOUT), 0, scr, r, lane, IN_F(20), 1024); continue; } r -= I_OUT;
        if (r < I_XQ) { p0_transpose_item(IN_F(24), DM, XW, WSB(WS_WXQ), 0, scr, r, lane, IN_F(22)); continue; } r -= I_XQ;
        if (r < I_XKV) { p0_transpose_item(IN_F(25), DM, 2 * XW, WSB(WS_WXKV), 0, scr, r, lane); continue; } r -= I_XKV;
        if (r < I_XO) { p0_transpose_item(IN_F(26), XW, DM, WSB(WS_WXO), 0, scr, r, lane); continue; } r -= I_XO;
        p0_transpose_item(IN_F(28), DM, PH * PQD, WSB(WS_WPQ), 0, scr, r, lane, IN_F(27));
    }
    const float* x = IN_F(0); const float* mem = IN_F(1);
    { const float* g3 = IN_F(3); bf16* XN = WSB(WS_B);
      (void)x; (void)g3; (void)XN; }
    { const float* g23 = IN_F(23); bf16* MN = WSB(WS_MN);
      for (int r = 2 * gw; r < BATCH * NMEM; r += 2 * NGW) { norm_2rows_to_bf16(mem + (size_t)r * DM, g23, MN + (size_t)r * DM, lane); } }
    const int* pos = IN_I(2); float* rope = WSF(WS_ROPE);
    const int gt = F.bid * NTHR + F.tid, NGT = F.G * NTHR;
    for (int e = gt; e < T * 8; e += NGT) {
        const int t = e >> 3, i = e & 7;
        const float freq = expf(-(float)i * (13.122363377404328f / 8.0f));
        const float a = (float)pos[t] * freq;
        rope[e * 2 + 0] = cosf(a); rope[e * 2 + 1] = sinf(a);
    }
    if (gt == 0) {
        const float* q1 = IN_F(5); const float* k1 = IN_F(6); const float* q2 = IN_F(7); const float* k2 = IN_F(8);
        float s1 = 0.f, s2 = 0.f;
        for (int i = 0; i < 64; ++i) { s1 += q1[i] * k1[i]; s2 += q2[i] * k2[i]; }
        *WSF(WS_LAM) = expf(s1) - expf(s2) + LAM_INIT;
    }
    bf16* KD = WSB(WS_KD); const float* k1 = IN_F(29); const float* k2 = IN_F(30);
    for (int e = gt; e < PH * 256 * 256; e += NGT) {
        const int kk = e & 255, nn = (e >> 8) & 255, h = e >> 16;
        float v = 0.f;
        if ((kk >> 7) == (nn >> 7)) { const float* ks = (nn >> 7) ? k2 : k1; v = ks[((size_t)h * PK + (nn & 127)) * 128 + (kk & 127)]; }
        KD[e] = (bf16)f2bf(v);
    }
}
__device__ __forceinline__ void p1_win(const Frame& F, const Args& A) {
    { pg8::Gemm g{WSB(WS_B), WSB(WS_WIN), T, INC, DM, DM, DM, 0, 0, 1}; pg8::StaticOrder S; S.init(T, INC, F.G, F.bid); pg8::EpiWin E{WSB(WS_QB), (size_t)(WS_KB - WS_QB) / 2, WSB(WS_UCAT), WSF(WS_ROPE), attn_body::C2}; GEMM_RUN(pg8::EpiWin, true, g, S, E); }
}
__device__ __forceinline__ void p5_glu(const Frame& F, const Args& A) {
    pg8::Gemm g{WSB(WS_GB), WSB(WS_WGLU), T, SSMW, SSMW, SSMW, SSMW, 0, 0, 1}; pg8::StaticOrder S; S.init(T, SSMW, F.G, F.bid);
    pg8::EpiGlu E{WSB(WS_GB), IN_F(19), WSB(WS_B), WSF(WS_SSQ)}; GEMM_RUN(pg8::EpiGlu, true, g, S, E);
}

__device__ __forceinline__ void p5_tables(const Frame& F, const Args& A) {
    unsigned char* UB = F.ws + WS_UB; unsigned char* VT = F.ws + WS_VT;
    const float* Uin = IN_F(31); const float* Vin = IN_F(32); const float* gfn = IN_F(27); float* iscu = WSF(WS_ISCU); float* iscv = WSF(WS_ISCV);
    const int gw = F.bid * NWAVES + F.wave, NGW = F.G * NWAVES, lane = F.lane;
    for (int it = 2 * gw; it < 2 * PK * PK; it += 2 * NGW) {
        const int tb = it >= PK * PK, e = tb ? it - PK * PK : it;
        const float* src = (tb ? Vin : Uin) + (size_t)e * DM; unsigned char* dst = tb ? VT : UB; float* isc = tb ? iscv : iscu;
        float4 v[16]; float am0 = 0.f, am1 = 0.f;
#pragma unroll
        for (int q = 0; q < 16; ++q) v[q] = ntld4(src + (q >> 3) * DM + 256 * (q & 7) + 4 * lane);
        if (!tb) {
#pragma unroll
            for (int q = 0; q < 8; ++q) { const float4 g4 = *(const float4*)(gfn + 256 * q + 4 * lane);
                v[q].x *= g4.x; v[q].y *= g4.y; v[q].z *= g4.z; v[q].w *= g4.w; v[8 + q].x *= g4.x; v[8 + q].y *= g4.y; v[8 + q].z *= g4.z; v[8 + q].w *= g4.w; }
        }
#pragma unroll
        for (int q = 0; q < 8; ++q) { am0 = fmaxf(am0, fmaxf(fmaxf(fabsf(v[q].x), fabsf(v[q].y)), fmaxf(fabsf(v[q].z), fabsf(v[q].w))));
                                      am1 = fmaxf(am1, fmaxf(fmaxf(fabsf(v[8 + q].x), fabsf(v[8 + q].y)), fmaxf(fabsf(v[8 + q].z), fabsf(v[8 + q].w)))); }
        am0 = wave_max(am0); am1 = wave_max(am1);
        float sc0 = 1.0f, sc1 = 1.0f;
        if (am0 > 1e-30f) sc0 = __uint_as_float(__float_as_uint(448.0f / am0) & 0x7f800000u);
        if (am1 > 1e-30f) sc1 = __uint_as_float(__float_as_uint(448.0f / am1) & 0x7f800000u);
        if (lane == 0) { isc[e] = 1.0f / sc0; isc[e + 1] = 1.0f / sc1; }
#pragma unroll
        for (int q = 0; q < 16; ++q) {
            const float sc = q < 8 ? sc0 : sc1; int w = 0;
            w = __builtin_amdgcn_cvt_pk_fp8_f32(v[q].x * sc, v[q].y * sc, w, false);
            w = __builtin_amdgcn_cvt_pk_fp8_f32(v[q].z * sc, v[q].w * sc, w, true);
            const int c = 256 * (q & 7) + 4 * lane;
            *(int*)(dst + ((size_t)(c >> 7) * (PK * PK) + e + (q >> 3)) * SLW + (c & 127)) = w;
        }
    }
}
__device__ __forceinline__ void p7_wout(const Frame& F, const Args& A) {
    pg8::Gemm g{WSB(WS_B), WSB(WS_WOUT), T, DM, DM, DM, DM, 0, 0, 1}; pg8::StaticOrder S; S.init(T, DM, F.G, F.bid);
    pg8::EpiWout E{IN_F(0), WSB(WS_HB2), WSF(WS_SSQ1), DM, WSF(WS_SSQ), 16}; GEMM_RUN(pg8::EpiWout, true, g, S, E);
}
__device__ __forceinline__ void p9_xq(const Frame& F, const Args& A) {
    pg8::Gemm g{WSB(WS_HB2), WSB(WS_WXQ), T, XW, DM, DM, DM, 0, 0, 1}; pg8::StaticOrder S; S.init(T, XW, F.G, F.bid);
    pg8::EpiRowBf16 E{WSB(WS_XQB), XW, WSF(WS_SSQ1), 0.08838834764831845f}; GEMM_RUN(pg8::EpiRowBf16, true, g, S, E);
    { pg8::Gemm g2{WSB(WS_MN), WSB(WS_WXKV), BATCH * NMEM, 2 * XW, DM, DM, DM, 0, 0, 1}; pg8::StaticOrder S2; S2.init(BATCH * NMEM, 2 * XW, F.G, F.G - 1 - F.bid); pg8::EpiXkv E2{WSB(WS_KP), WSB(WS_VT2)}; GEMM_RUN(pg8::EpiXkv, true, g2, S2, E2); }
}
__device__ __forceinline__ void p11_xo(const Frame& F, const Args& A) {
    pg8::Gemm g{WSB(WS_XO), WSB(WS_WXO), T, DM, XW, XW, XW, 0, 0, 1}; pg8::StaticOrder S; S.init(T, DM, F.G, F.bid);
    pg8::EpiResidB<false> E{WSB(WS_HB2), WSB(WS_B), WSF(WS_SSQ2), DM}; GEMM_RUN(pg8::EpiResidB<false>, true, g, S, E);
}
__device__ __forceinline__ void p13_pq(const Frame& F, const Args& A) {
    pg8::Gemm g{WSB(WS_B), WSB(WS_WPQ), T, PH * PQD, DM, DM, DM, 0, 0, 1}; pg8::StaticOrder S; S.init(T, PH * PQD, F.G, F.bid);
    pg8::EpiRowBf16 E{WSB(WS_PQ), PH * PQD, WSF(WS_SSQ2), 1.0f}; GEMM_RUN(pg8::EpiRowBf16, true, g, S, E);
}
__device__ __forceinline__ void p14_scores(const Frame& F, const Args& A) {
    for (int sel = 0; sel * F.G + F.bid < PH * (T / 256); ++sel) {
        pg8::Gemm g{WSB(WS_KD), WSB(WS_PQ), 256, T, 256, 256, PH * PQD, 65536, 256, PH}; pg8::TkOrder S{F.G, F.bid, sel};
        pg8::EpiTopk E{(unsigned short*)(F.ws + WS_IDX), WSF(WS_GATE)};
        pg8::gemm_phase<pg8::EpiTopk, pg8::TkOrder, false, true>(F.ldsl, g, S, E);
        __syncthreads();
    }
}

constexpr int NPHASE = 15;
__global__ void __launch_bounds__(NTHR, 2) mk_fwd(Args args) {
    extern __shared__ __attribute__((aligned(16))) unsigned char lds[];
#define MKFRAME() Frame F; { int t_ = threadIdx.x; asm volatile("" : "+v"(t_)); F.lds = lds; F.ldsl = (LAS unsigned char*)lds; F.tid = t_; F.lane = t_ & 63; F.wave = __builtin_amdgcn_readfirstlane(t_ >> 6); \
    F.G = gridDim.x; F.bid = blockIdx.x; F.ws = args.ws; F.out = args.out; }
    volatile LAS unsigned* MISC = (volatile LAS unsigned*)((LAS unsigned char*)lds + MISC_OFF);
    if (threadIdx.x < 32) MISC[threadIdx.x] = 0u;
    __syncthreads();
    (void)xcd_barrier_post((unsigned*)(args.ws + WS_CTL) + CW_BAR, MISC + 8);
    if (threadIdx.x == 0) { const unsigned x = xb_xcc_id(); MISC[11] = x; MISC[10] = xb_add((unsigned*)(args.ws + WS_CTL) + CW_TICKET + 64 * x, 1u); }
    const int lo = args.ph_lo, hi = args.ph_hi;
#define IN(k) (lo <= (k) && (k) < hi)
#define SEAM(k) do { if (IN(k) && IN((k) + 1)) { XcdBarrier b_; b_.bar = (unsigned*)(args.ws + WS_CTL) + CW_BAR; b_.x = 0; b_.st = MISC + 8; xcd_barrier(b_); } } while (0)
    if (IN(0)) { MKFRAME(); p0_prep(F, args); __syncthreads(); p0_s5_setup(F, args); }  SEAM(0);
    if (IN(1)) { MKFRAME(); p1_win(F, args); }             SEAM(1);
    if (IN(2)) { MKFRAME(); p3_attn(F, args); }            SEAM(2);
    if (IN(3)) { MKFRAME(); p4_s5_scan(F, args); }
    { int g3_ = __builtin_amdgcn_readfirstlane(IN(3) ? 1 : 0); asm volatile("s_waitcnt vmcnt(0)" : "+s"(g3_) :: "memory"); __syncthreads(); if (g3_) { MKFRAME(); p5_s5_out(F, args); } }   SEAM(3);
    if (IN(4)) { MKFRAME(); p5_glu(F, args); p5_tables(F, args); }  SEAM(4);
    if (IN(5)) { MKFRAME(); p7_wout(F, args); }            SEAM(5);
    if (IN(6)) { MKFRAME(); p9_xq(F, args); }              SEAM(6);
    if (IN(7)) { MKFRAME(); p10_xscores(F, args); }
    { int g8_ = __builtin_amdgcn_readfirstlane(IN(7) ? 1 : 0); asm volatile("s_waitcnt vmcnt(0)" : "+s"(g8_) :: "memory"); __syncthreads(); if (g8_) { MKFRAME(); p10_xpv(F, args); } }   SEAM(7);
    if (IN(8)) { MKFRAME(); p11_xo(F, args); }            SEAM(8);
    if (IN(9)) { MKFRAME(); p13_pq(F, args); }            SEAM(9);
    if (IN(10)) { MKFRAME(); p14_scores(F, args); }        SEAM(10);
    if (IN(11)) { MKFRAME(); p17_peer_u(F, args, MISC); }  SEAM(11);
    if (IN(12)) { MKFRAME(); p18_peer_w(F, args, MISC); }  SEAM(12);
    if (IN(13)) { MKFRAME(); p19_peer_v(F, args, MISC); }  SEAM(13);
    if (IN(14)) { MKFRAME(); p20_final(F, args); }
#undef IN
#undef SEAM
}
extern "C" void kernel_launch(void* const* d_in, const int* in_sizes, int n_in, void* d_out, int out_size, void* d_ws, size_t ws_size, hipStream_t stream) {
    static int grid = 0;
    if (grid == 0) {
        if (n_in != 34 || out_size != T * DM || ws_size < WS_END) { fprintf(stderr, "kernel_launch: unexpected shapes n_in %d out %d ws %zu\n", n_in, out_size, ws_size); grid = -1; return; }
        int dev = 0, cus = 0;
        if (hipGetDevice(&dev) != hipSuccess || hipDeviceGetAttribute(&cus, hipDeviceAttributeMultiprocessorCount, dev) != hipSuccess) { grid = -1; return; }
        if (hipFuncSetAttribute((const void*)mk_fwd, hipFuncAttributeMaxDynamicSharedMemorySize, LDS_BYTES) != hipSuccess) { fprintf(stderr, "kernel_launch: hipFuncSetAttribute failed\n"); grid = -1; return; }
        int per_cu = 0;
        (void)hipOccupancyMaxActiveBlocksPerMultiprocessor(&per_cu, (const void*)mk_fwd, NTHR, LDS_BYTES);
        (void)hipGetLastError();
        grid = cus;
    }
    if (grid < 0) return;
    (void)hipMemsetAsync((char*)d_ws + WS_CTL, 0, CTL_ZERO_BYTES, stream);
    Args a{};
    for (int i = 0; i < 34; ++i) a.in[i] = d_in[i];
    a.out = (float*)d_out; a.ws = (unsigned char*)d_ws;
    a.ph_lo = 0; a.ph_hi = NPHASE; a.li = 0;
    hipLaunchKernelGGL(mk_fwd, dim3(grid), dim3(NTHR), LDS_BYTES, stream, a);
}
```

```cpp
#include <hip/hip_runtime.h>
#include <hip/hip_bf16.h>
#include <cstdio>
#include <cstdint>
#include <cmath>

constexpr int BATCH = 8, SEQ = 2048, DM = 2048, T = BATCH * SEQ;
constexpr int NMEM = 256;
constexpr float EPS = 1e-6f;
constexpr int ATTW = 1024, SSMW = 1024, INC = 4096;
constexpr int NH = 8;
constexpr int SG = 64, SP = 64;
constexpr int XH = 4, XD = 128, XW = 512;
constexpr int PH = 8, PK = 128, PQD = 256, PTOP = 16;
constexpr float LAM_INIT = 0.2f;

#ifndef MK_ONE_LAUNCH
#define MK_ONE_LAUNCH 1
#endif

constexpr int NWAVES = 8, NTHR = 512;
constexpr int LDS_BYTES = 147456;
constexpr int MISC_OFF = 147456 - 512;

constexpr size_t MiB = 1u << 20;
constexpr size_t WS_CTL = 0, CTL_ZERO_BYTES = 1 * MiB;
constexpr size_t WS_RSTD0 = 1 * MiB, WS_RSTDM = WS_RSTD0 + 65536, WS_RSTD1 = WS_RSTDM + 65536, WS_RSTD2 = WS_RSTD1 + 65536, WS_LAM = WS_RSTD2 + 65536;
constexpr size_t WS_ROPE = 2 * MiB;
constexpr size_t WS_WIN = 8 * MiB, WS_WGLU = 24 * MiB, WS_WOUT = 26 * MiB, WS_WXQ = 34 * MiB, WS_WXKV = 36 * MiB, WS_WXO = 40 * MiB, WS_WPQ = 42 * MiB, WS_KD = 50 * MiB;
constexpr size_t WS_UCAT = 56 * MiB, WS_BTC = 96 * MiB, WS_BTA = 136 * MiB, WS_QB = 152 * MiB, WS_KB = 184 * MiB, WS_VB = 216 * MiB, WS_O0 = 248 * MiB, WS_O1 = 280 * MiB;
constexpr size_t WS_UB = 56 * MiB, WS_VT = 120 * MiB, WS_XQ = 184 * MiB, WS_SC = 184 * MiB;
constexpr size_t WS_B = 312 * MiB;
constexpr size_t WS_SL = 376 * MiB, WS_IDX = 376 * MiB, WS_GATE = 384 * MiB;
constexpr size_t WS_GB = 392 * MiB, WS_XO = 392 * MiB;
constexpr size_t WS_PQ = 424 * MiB;
constexpr size_t WS_HB2 = 408 * MiB;
constexpr size_t WS_XKV = 472 * MiB;
constexpr size_t WS_MN = 480 * MiB;
constexpr size_t WS_END = 488 * MiB;
constexpr size_t WS_SSQ = 128 * 1024;
constexpr size_t WS_SSQ3 = 512 * 1024;
constexpr size_t WS_SSQP = 2 * MiB;
constexpr size_t WS_SSQ1 = 704 * 1024, WS_SSQ2 = 768 * 1024;
constexpr int CW_TICKET = 160 * 1024;
constexpr size_t WS_PACT = 184 * MiB, WS_PW = 248 * MiB;
constexpr size_t WS_ISCU = 4 * MiB, WS_ISCV = 4 * MiB + 65536;
constexpr int NSL = 16, SLW = 128;
constexpr size_t WS_LSUM = 256 * 1024;
constexpr size_t WS_KP = 472 * MiB, WS_VT2 = 476 * MiB;
constexpr size_t WS_XQB = 184 * MiB, WS_XP = 200 * MiB;
constexpr size_t WS_AL = WS_LAM + 4096;
constexpr int S5L = 32, NCH = T / S5L, UCK = 640;
constexpr int CW_BAR = 4096;

#define GAS __attribute__((address_space(1)))
#define LAS __attribute__((address_space(3)))
typedef GAS unsigned gu32;
#define RLX_AGENT __ATOMIC_RELAXED, __HIP_MEMORY_SCOPE_AGENT

#define XB_TMO      128
#define XB_XCNT(j)  (256  + 64 * (j))
#define XB_XSUB(j)  (1280 + 64 * (j))
#define XB_XGEN(j)  (2304 + 64 * (j))
#define XB_TOP      3328
#define XB_TOPGEN   3392
#define XCD_BAR_WORDS 3456
#define XB_SPIN_CAP (1u << 26)
__device__ __forceinline__ unsigned xb_ld(unsigned* p)              { return __hip_atomic_load(p, __ATOMIC_RELAXED, __HIP_MEMORY_SCOPE_AGENT); }
__device__ __forceinline__ unsigned xb_add(unsigned* p, unsigned v) { return __hip_atomic_fetch_add(p, v, __ATOMIC_RELAXED, __HIP_MEMORY_SCOPE_AGENT); }
__device__ __forceinline__ unsigned xb_xcc_id() { return (unsigned)__builtin_amdgcn_s_getreg((3 << 11) | 20) & 0xFu; }
#define XB_SPIN(cond, bar) do { unsigned _sp = 0; while (cond) { __builtin_amdgcn_s_sleep(1); \
    if ((++_sp & 255u) == 0u) { if (xb_ld(&(bar)[XB_TMO])) break; if (_sp > XB_SPIN_CAP) { atomicAdd(&(bar)[XB_TMO], 1u); break; } } } } while (0)
struct XcdBarrier { unsigned* bar; unsigned x; volatile LAS unsigned* st; };
__device__ __forceinline__ XcdBarrier xcd_barrier_post(unsigned* bar, volatile LAS unsigned* st) {
    XcdBarrier b; b.bar = bar; b.x = xb_xcc_id(); b.st = st;
    if (threadIdx.x == 0) (void)xb_add(&bar[XB_XCNT(b.x)], 1u);
    return b;
}
__device__ __forceinline__ void xcd_barrier_complete(unsigned* bar, unsigned x, unsigned& nloc, unsigned& nx) {
    const unsigned G = gridDim.x * gridDim.y * gridDim.z;
    unsigned sum, cnt, mine, sp = 0u;
    for (;;) {
        sum = 0u; cnt = 0u; mine = 0u;
#pragma unroll
        for (unsigned j = 0; j < 16; ++j) { const unsigned c = xb_ld(&bar[XB_XCNT(j)]); sum += c; cnt += (c > 0u) ? 1u : 0u; mine = (j == x) ? c : mine; }
        if (sum == G) break;
        __builtin_amdgcn_s_sleep(1);
        if ((++sp & 255u) == 0u) { if (xb_ld(&bar[XB_TMO])) break; if (sp > XB_SPIN_CAP) { atomicAdd(&bar[XB_TMO], 1u); break; } }
    }
    nloc = mine > 0u ? mine : 1u; nx = cnt > 0u ? cnt : 1u;
}
__device__ __forceinline__ void xcd_barrier(const XcdBarrier& b) {
    asm volatile("s_waitcnt vmcnt(0)" ::: "memory");
    __syncthreads();
    if (threadIdx.x == 0) {
        unsigned* bar = b.bar;
        __builtin_amdgcn_s_waitcnt(0);
        unsigned nloc = b.st[0], nx = b.st[1]; const unsigned bx = b.st[3];
        if (nloc == 0u) { xcd_barrier_complete(bar, bx, nloc, nx); b.st[0] = nloc; b.st[1] = nx; }
        const unsigned old = xb_add(&bar[XB_XSUB(bx)], 1u);
        const unsigned gen = old / nloc;
        if (old + 1u == (gen + 1u) * nloc) {
            __builtin_amdgcn_fence(__ATOMIC_RELEASE, "agent");
            asm volatile("s_waitcnt vmcnt(0)" ::: "memory");
            const unsigned og = xb_add(&bar[XB_TOP], 1u);
            const unsigned tg = og / nx;
            if (og + 1u == (tg + 1u) * nx) xb_add(&bar[XB_TOPGEN], 1u);
            else XB_SPIN(xb_ld(&bar[XB_TOPGEN]) == tg, bar);
            __builtin_amdgcn_fence(__ATOMIC_ACQUIRE, "agent");
            xb_add(&bar[XB_XGEN(bx)], 1u);
            asm volatile("s_waitcnt vmcnt(0)" ::: "memory");
        } else {
            XB_SPIN(xb_ld(&bar[XB_XGEN(bx)]) == gen, bar);
            __builtin_amdgcn_fence(__ATOMIC_ACQUIRE, "agent");
            asm volatile("s_waitcnt vmcnt(0)" ::: "memory");
        }
    }
    __syncthreads();
}

struct Args { const void* in[34]; float* out; unsigned char* ws; int ph_lo, ph_hi, li, pad; };
struct Frame {
    unsigned char* lds;
    LAS unsigned char* ldsl;
    int tid, lane, wave, G, bid;
    float* out;
    unsigned char* ws;
};
__device__ __forceinline__ float wave_sum(float v) {
#pragma unroll
    for (int o = 1; o < 64; o <<= 1) v += __shfl_xor(v, o);
    return v;
}
__device__ __forceinline__ float wave_max(float v) {
#pragma unroll
    for (int o = 1; o < 64; o <<= 1) v = fmaxf(v, __shfl_xor(v, o));
    return v;
}
__device__ __forceinline__ float gelu_exact(float x) { return 0.5f * x * (1.0f + erff(x * 0.70710678118654752f)); }

__device__ __forceinline__ const void* ldarg(int byte_off) {
    const void* p; auto k = __builtin_amdgcn_kernarg_segment_ptr();
    asm volatile("s_load_dwordx2 %0, %1, %2\n\ts_waitcnt lgkmcnt(0)" : "=s"(p) : "s"(k), "i"(byte_off) : "memory");
    return p;
}
#define IN_F(i) ((const float*)ldarg((i) * 8))
#define IN_I(i) ((const int*)ldarg((i) * 8))
#define WSF(off) ((float*)(F.ws + (off)))


typedef float nt_f4 __attribute__((ext_vector_type(4)));
__device__ __forceinline__ float4 ntld4(const float* p) { const nt_f4 v = __builtin_nontemporal_load((const GAS nt_f4*)p); return make_float4(v[0], v[1], v[2], v[3]); }
__device__ __forceinline__ void ntst4(float* p, float4 v) { const nt_f4 w = {v.x, v.y, v.z, v.w}; __builtin_nontemporal_store(w, (GAS nt_f4*)p); }
typedef unsigned short bf16;
typedef unsigned v4u __attribute__((ext_vector_type(4)));
__device__ __forceinline__ unsigned f2bf(float f) { unsigned u = __builtin_bit_cast(unsigned, f); return (u + 0x7fffu + ((u >> 16) & 1u)) >> 16; }
__device__ __forceinline__ unsigned pk2(float lo, float hi) { return f2bf(lo) | (f2bf(hi) << 16); }
__device__ __forceinline__ float bf2f(unsigned short b) { return __uint_as_float((unsigned)b << 16); }
#define WSB(off) ((bf16*)(F.ws + (off)))
#define LDS_WAIT() asm volatile("s_waitcnt lgkmcnt(0)" ::: "memory")

__device__ __forceinline__ void norm_2rows_to_bf16(const float* xrow, const float* g, bf16* orow, int lane) {
    float4 v[16]; float s0 = 0.f, s1 = 0.f;
#pragma unroll
    for (int j = 0; j < 16; ++j) v[j] = ntld4(xrow + (j >> 3) * DM + 256 * (j & 7) + 4 * lane);
#pragma unroll
    for (int j = 0; j < 8; ++j) { s0 += v[j].x * v[j].x + v[j].y * v[j].y + v[j].z * v[j].z + v[j].w * v[j].w; s1 += v[8 + j].x * v[8 + j].x + v[8 + j].y * v[8 + j].y + v[8 + j].z * v[8 + j].z + v[8 + j].w * v[8 + j].w; }
    s0 = wave_sum(s0); s1 = wave_sum(s1);
    const float r0 = 1.0f / sqrtf(s0 / (float)DM + EPS), r1 = 1.0f / sqrtf(s1 / (float)DM + EPS);
#pragma unroll
    for (int j = 0; j < 8; ++j) { const float4 g4 = *(const float4*)(g + 256 * j + 4 * lane);
        *(unsigned long long*)(orow + 256 * j + 4 * lane) = (unsigned long long)pk2(v[j].x * r0 * g4.x, v[j].y * r0 * g4.y) | ((unsigned long long)pk2(v[j].z * r0 * g4.z, v[j].w * r0 * g4.w) << 32);
        *(unsigned long long*)(orow + DM + 256 * j + 4 * lane) = (unsigned long long)pk2(v[8 + j].x * r1 * g4.x, v[8 + j].y * r1 * g4.y) | ((unsigned long long)pk2(v[8 + j].z * r1 * g4.z, v[8 + j].w * r1 * g4.w) << 32); }
}
__device__ __forceinline__ void norm4_load(const float* xrow, int lane, float4 (&v)[32]) {
#pragma unroll
    for (int j = 0; j < 32; ++j) v[j] = ntld4(xrow + (j >> 3) * DM + 256 * (j & 7) + 4 * lane);
}
__device__ __forceinline__ void norm4_finish(const float4 (&v)[32], const float* g, bf16* orow, int lane) {
    float s[4] = {0.f, 0.f, 0.f, 0.f};
#pragma unroll
    for (int j = 0; j < 32; ++j) s[j >> 3] += v[j].x * v[j].x + v[j].y * v[j].y + v[j].z * v[j].z + v[j].w * v[j].w;
    float r[4];
#pragma unroll
    for (int q = 0; q < 4; ++q) { s[q] = wave_sum(s[q]); r[q] = 1.0f / sqrtf(s[q] / (float)DM + EPS); }
#pragma unroll
    for (int j = 0; j < 8; ++j) { const float4 g4 = *(const float4*)(g + 256 * j + 4 * lane);
#pragma unroll
        for (int q = 0; q < 4; ++q) { const float4 w = v[8 * q + j]; const float rq = r[q];
            *(unsigned long long*)(orow + q * DM + 256 * j + 4 * lane) = (unsigned long long)pk2(w.x * rq * g4.x, w.y * rq * g4.y) | ((unsigned long long)pk2(w.z * rq * g4.z, w.w * rq * g4.w) << 32); } }
}
__device__ __forceinline__ void p0_transpose_item(const float* W, int K, int N, bf16* WT, int row_off, LAS float* scr, int item, int lane, const float* gain = nullptr, int goff = 0) {
    const int nblk = N / 32, kb = item / nblk, nb = item % nblk, k0 = 64 * kb, n0 = 32 * nb;
    float4 v[8];
#pragma unroll
    for (int i = 0; i < 8; ++i) v[i] = ntld4(W + (size_t)(k0 + 8 * i + (lane >> 3)) * N + n0 + 4 * (lane & 7));
#pragma unroll
    for (int i = 0; i < 8; ++i) { const int kk = 8 * i + (lane >> 3); const float gk = (gain && k0 + kk >= goff) ? gain[k0 + kk - goff] : 1.0f; LAS float* d = scr + kk * 33 + 4 * (lane & 7);
        d[0] = v[i].x * gk; d[1] = v[i].y * gk; d[2] = v[i].z * gk; d[3] = v[i].w * gk; }
    LDS_WAIT(); asm volatile("" ::: "memory");
    const int c = lane & 7;
#pragma unroll
    for (int j = 0; j < 4; ++j) { const int n = (lane >> 3) + 8 * j; const LAS float* s = scr + (8 * c) * 33 + n;
        v4u o; o.x = pk2(s[0 * 33], s[1 * 33]); o.y = pk2(s[2 * 33], s[3 * 33]); o.z = pk2(s[4 * 33], s[5 * 33]); o.w = pk2(s[6 * 33], s[7 * 33]);
        *(GAS v4u*)(WT + (size_t)(row_off + n0 + n) * K + k0 + 8 * c) = o; }
    LDS_WAIT(); asm volatile("" ::: "memory");
}
namespace pg8 {
#define PG8_LAS __attribute__((address_space(3)))
typedef unsigned short bf16_t;
typedef short bf16x8 __attribute__((ext_vector_type(8)));
typedef float f32x4 __attribute__((ext_vector_type(4)));
typedef unsigned u32x4 __attribute__((ext_vector_type(4)));
constexpr int BM = 256, BK = 64, HALF = 128, HTB = HALF * BK * 2  , STAGE_BYTES = 8 * HTB, NXCD = 8, WGM = 8;

__host__ __device__ __forceinline__ int lds_byte(int r, int c) { const int st = (r >> 4) * 2 + (c >> 5), rr = r & 15, cc = c & 31, ob = rr * 64 + cc * 2; return st * 1024 + (ob ^ (((ob >> 9) & 1) << 5)); }
__host__ __device__ __forceinline__ void stage_rc(int b, int& R, int& C) { const int st = b / 1024, sb = b % 1024, swz = sb ^ (((sb >> 9) & 1) << 5); R = (st >> 1) * 16 + swz / 64; C = (st & 1) * 32 + (swz % 64) / 2; }
__host__ __device__ __forceinline__ int perm32(int rho) { const int n = rho >> 4, i = rho & 15; return 8 * (i >> 2) + 4 * n + (i & 3); }

struct Unit { int pm, pn, bz; };
struct Gemm { const bf16_t* A; const bf16_t* Bt; int M, N, K; int lda, ldb; long sA, sB; int nb; };

struct StaticOrder {
    int nM, nN, nwg, G, c;
    int nb, per; __host__ __device__ void init(int M, int N, int G_, int c_, int nb_ = 1) { nM = M / BM; nN = N / BM; nb = nb_; per = nM * nN; nwg = per * nb; G = G_; c = c_; }
    __host__ __device__ bool next(int i, Unit& u) const {
        const long L = (long)i * G + c; if (L >= nwg) return false;
        int wgid = (int)L; { const int q = nwg / NXCD, r = nwg % NXCD, xcd = wgid % NXCD, off = wgid / NXCD; wgid = (xcd < r ? xcd * (q + 1) : r * (q + 1) + (xcd - r) * q) + off; }
        u.bz = wgid / per; wgid -= u.bz * per; const int nig = WGM * nN, gid = wgid / nig, fm = gid * WGM, gsz = (nM - fm) < WGM ? (nM - fm) : WGM;
        u.pm = fm + ((wgid % nig) % gsz); u.pn = (wgid % nig) / gsz; return true;
    }
    __device__ __forceinline__ void a_ready(const Unit&) const {}
    __device__ __forceinline__ void done(const Unit&) const {}
    template <class G_> __device__ __forceinline__ long offA(const Unit& u, const G_& g) const { return (long)u.bz * g.sA; }
    template <class G_> __device__ __forceinline__ long offB(const Unit& u, const G_& g) const { return (long)u.bz * g.sB; }
};

__device__ __forceinline__ unsigned cvt_pk_bf16(float lo, float hi) { unsigned r; asm volatile("v_cvt_pk_bf16_f32 %0, %1, %2" : "=v"(r) : "v"(lo), "v"(hi)); return r; }
typedef float f32x2 __attribute__((ext_vector_type(2)));
__device__ __forceinline__ f32x2 gelu_pk(f32x2 v) {
    const f32x2 av = __builtin_elementwise_abs(v), d = av * 0.2316418882f + 1.0f;
    f32x2 t; t.x = __builtin_amdgcn_rcpf(d.x); t.y = __builtin_amdgcn_rcpf(d.y);
    f32x2 q = t * 0.5307027145f + (-0.7265760135f); q = q * t + 0.7107068705f; q = q * t + (-0.142248368f); q = q * t + 0.127414796f; q = q * t;
    const f32x2 s = (v * v) * (-0.72134752044f);
    f32x2 e; e.x = __builtin_amdgcn_exp2f(s.x); e.y = __builtin_amdgcn_exp2f(s.y);
    const f32x2 m = v * (q * e), r = v - m;
    f32x2 o; o.x = v.x < 0.f ? m.x : r.x; o.y = v.y < 0.f ? m.y : r.y; return o;
}

template <int ACT  > struct EpiBf16 {
    static constexpr bool PERM = true, AFTER_DRAIN = false; static_assert(ACT == 0 || ACT == 1, "EpiBf16: ACT is 0 (none) or 1 (gelu_pk)");
    bf16_t* O; int ldc; const float* bias; int split_cols; size_t split_stride; float scale0;
    __device__ __forceinline__ void operator()(const f32x4 (&acc)[2][2][4][2], const Unit& u, int wr, int wc, int fr, int fq) const {
        const int row0 = u.pm * BM + wr * 64 + fr; int colt = u.pn * BM; bf16_t* base = O;
        float sc = 1.f; if (split_cols) { const int t = colt / split_cols; base += (size_t)t * split_stride; colt -= t * split_cols; if (t == 0) sc = scale0; }
        const int col0 = colt + wc * 32 + 8 * fq, bcol0 = u.pn * BM + wc * 32 + 8 * fq;
        f32x4 bv[2][2];
#pragma unroll
        for (int bj = 0; bj < 2; ++bj)
#pragma unroll
            for (int n = 0; n < 2; ++n) bv[bj][n] = bias ? *(const f32x4*)(bias + bcol0 + bj * HALF + 4 * n) : (f32x4){0.f, 0.f, 0.f, 0.f};
#pragma unroll
        for (int ai = 0; ai < 2; ++ai)
#pragma unroll
            for (int m = 0; m < 4; ++m) { bf16_t* rowp = base + (size_t)(row0 + ai * HALF + m * 16) * ldc + col0;
#pragma unroll
                for (int bj = 0; bj < 2; ++bj) { f32x4 v0 = acc[ai][bj][m][0] + bv[bj][0], v1 = acc[ai][bj][m][1] + bv[bj][1];
                    if (ACT == 1) { f32x2 a = gelu_pk((f32x2){v0[0], v0[1]}), b = gelu_pk((f32x2){v0[2], v0[3]}), c = gelu_pk((f32x2){v1[0], v1[1]}), d = gelu_pk((f32x2){v1[2], v1[3]});
                        v0 = (f32x4){a.x, a.y, b.x, b.y}; v1 = (f32x4){c.x, c.y, d.x, d.y}; }
                    v0 = v0 * sc; v1 = v1 * sc; u32x4 w; w.x = cvt_pk_bf16(v0[0], v0[1]); w.y = cvt_pk_bf16(v0[2], v0[3]); w.z = cvt_pk_bf16(v1[0], v1[1]); w.w = cvt_pk_bf16(v1[2], v1[3]);
                    *(u32x4*)(rowp + bj * HALF) = w; } }
    }
};
template <class T, class = void> struct MidK { static constexpr bool v = false; };
template <class T> struct MidK<T, decltype((void)T::MIDK)> { static constexpr bool v = T::MIDK; };
template <class Epi, class Sched, bool ALIGN_EPI = false, bool SP2 = false>
__device__ __forceinline__ void gemm_phase(PG8_LAS unsigned char* lds, const Gemm g, const Sched& S, const Epi& E) {
    const int tid = threadIdx.x, wid = __builtin_amdgcn_readfirstlane(tid >> 6), lane = tid & 63, wr = wid >> 2, wc = wid & 3, fr = lane & 15, fq = lane >> 4;
    const int K = g.K, nt = K / BK;
    unsigned voffA[2], voffB[2];
#pragma unroll
    for (int i = 0; i < 2; ++i) { int R, C; stage_rc(tid * 16 + i * 8192, R, C); const int Rb = Epi::PERM ? ((R & ~31) + perm32(R & 31)) : R;
        voffA[i] = (unsigned)(R * g.lda + C) * 2u; voffB[i] = (unsigned)(Rb * g.ldb + C) * 2u; }
    const size_t kstep = (size_t)(BK * 2);
    const size_t hstepA = (size_t)HALF * g.lda * 2, hstepB = (size_t)HALF * g.ldb * 2;
    const size_t tstepA = 2 * hstepA, tstepB = 2 * hstepB;
    const unsigned ldsw = (unsigned)wid * 1024u;
    const int aoff = lds_byte(wr * 64 + fr, fq * 8), boff = lds_byte(wc * 32 + fr, fq * 8);
#define PG8_SA(b, h) (((b) * 2 + (h)) * HTB)
#define PG8_SB(b, h) ((4 + (b) * 2 + (h)) * HTB)
#define PG8_STAGE(bufoff, gbase, voff) do { _Pragma("unroll") for (int _i = 0; _i < 2; ++_i) \
        __builtin_amdgcn_global_load_lds((const unsigned*)((const char*)(gbase) + (voff)[_i]), (PG8_LAS unsigned*)(lds + (bufoff) + ldsw + _i * 8192), 16, 0, 0); } while (0)
#define PG8_LDA(dst, b, h) do { _Pragma("unroll") for (int m = 0; m < 4; ++m) _Pragma("unroll") for (int k = 0; k < 2; ++k) dst[m][k] = *(const PG8_LAS bf16x8*)(lds + PG8_SA(b, h) + aoff + m * 2048 + k * 1024); } while (0)
#define PG8_LDB(dst, b, h) do { _Pragma("unroll") for (int n = 0; n < 2; ++n) _Pragma("unroll") for (int k = 0; k < 2; ++k) dst[n][k] = *(const PG8_LAS bf16x8*)(lds + PG8_SB(b, h) + boff + n * 2048 + k * 1024); } while (0)
#define PG8_MMA(ai, bj, At, Bt) do { __builtin_amdgcn_s_setprio(1); _Pragma("unroll") for (int m = 0; m < 4; ++m) _Pragma("unroll") for (int n = 0; n < 2; ++n) _Pragma("unroll") for (int k = 0; k < 2; ++k) \
        acc[ai][bj][m][n] = __builtin_amdgcn_mfma_f32_16x16x32_bf16(Bt[n][k], At[m][k], acc[ai][bj][m][n], 0, 0, 0); __builtin_amdgcn_s_setprio(0); } while (0)
#define PG8_WAIT_V(n) asm volatile("s_waitcnt vmcnt(" #n ")" ::: "memory")
#define PG8_WAIT_L(n) asm volatile("s_waitcnt lgkmcnt(" #n ")" ::: "memory")
#define PG8_BAR __builtin_amdgcn_s_barrier()
#define PG8_SCHED __builtin_amdgcn_sched_barrier(0)
    Unit cur, nxt; int ui = 0;
    if (!S.next(0, cur)) return;
    f32x4 acc[2][2][4][2];
#pragma unroll
    for (int a = 0; a < 2; ++a)
#pragma unroll
        for (int b = 0; b < 2; ++b)
#pragma unroll
            for (int m = 0; m < 4; ++m)
#pragma unroll
                for (int n = 0; n < 2; ++n) acc[a][b][m][n] = (f32x4){0.f, 0.f, 0.f, 0.f};
    bf16x8 At[4][2], B0[2][2], B1[2][2];
    const char* cA = (const char*)g.A + (size_t)S.offA(cur, g) * 2 + (size_t)cur.pm * tstepA; const char* cB = (const char*)g.Bt + (size_t)S.offB(cur, g) * 2 + (size_t)cur.pn * tstepB;
    S.a_ready(cur);
    if constexpr (SP2) {
        PG8_STAGE(PG8_SB(0, 0), cB, voffB); PG8_STAGE(PG8_SB(0, 1), cB + hstepB, voffB); PG8_STAGE(PG8_SA(0, 0), cA, voffA); PG8_STAGE(PG8_SA(0, 1), cA + hstepA, voffA);
        if (wr == 1) PG8_BAR;
        PG8_WAIT_V(2); PG8_BAR;
        PG8_STAGE(PG8_SB(1, 0), cB + kstep, voffB); PG8_STAGE(PG8_SA(1, 0), cA + kstep, voffA); PG8_STAGE(PG8_SB(1, 1), cB + hstepB + kstep, voffB);
        PG8_WAIT_V(6); PG8_BAR;
    } else {
        PG8_STAGE(PG8_SB(0, 0), cB, voffB); PG8_STAGE(PG8_SA(0, 0), cA, voffA); PG8_STAGE(PG8_SB(0, 1), cB + hstepB, voffB); PG8_STAGE(PG8_SA(0, 1), cA + hstepA, voffA);
        if (wr == 1) PG8_BAR;
        PG8_WAIT_V(4); PG8_BAR;
        PG8_STAGE(PG8_SB(1, 0), cB + kstep, voffB); PG8_STAGE(PG8_SA(1, 0), cA + kstep, voffA); PG8_STAGE(PG8_SB(1, 1), cB + hstepB + kstep, voffB);
        PG8_WAIT_V(6); PG8_BAR;
    }
    for (;;) {
        const bool has_next = S.next(ui + 1, nxt);
        const char* nA = has_next ? (const char*)g.A + (size_t)S.offA(nxt, g) * 2 + (size_t)nxt.pm * tstepA : cA; const char* nB = has_next ? (const char*)g.Bt + (size_t)S.offB(nxt, g) * 2 + (size_t)nxt.pn * tstepB : cB;
        for (int t = 0; t < nt; t += 2) {
            if constexpr (MidK<Epi>::v) { if (t == E.midk_t) E.midk(acc, cur, wr, wc, fr, fq); }
            const bool last = (t == nt - 2);
            const char* a1 = cA + (size_t)(t + 1) * kstep;
            const char* a2 = last ? nA : cA + (size_t)(t + 2) * kstep; const char* b2 = last ? nB : cB + (size_t)(t + 2) * kstep;
            const char* a3 = a2 + kstep; const char* b3 = b2 + kstep;
            if (last && has_next) S.a_ready(nxt);
            if constexpr (SP2) {
            PG8_LDB(B0, 0, 0); PG8_LDB(B1, 0, 1); PG8_SCHED; PG8_LDA(At, 0, 0); PG8_STAGE(PG8_SA(1, 1), a1 + hstepA, voffA);
            PG8_WAIT_V(8); PG8_WAIT_L(0); PG8_BAR; PG8_MMA(0, 0, At, B0); PG8_MMA(0, 1, At, B1); PG8_BAR; PG8_SCHED;
            PG8_LDA(At, 0, 1); PG8_STAGE(PG8_SB(0, 0), b2, voffB); PG8_STAGE(PG8_SB(0, 1), b2 + hstepB, voffB); PG8_STAGE(PG8_SA(0, 0), a2, voffA);
            PG8_WAIT_V(8); PG8_WAIT_L(0); PG8_BAR; PG8_MMA(1, 0, At, B0); PG8_MMA(1, 1, At, B1); PG8_BAR; PG8_SCHED;
            PG8_LDB(B0, 1, 0); PG8_LDB(B1, 1, 1); PG8_SCHED; PG8_LDA(At, 1, 0); PG8_STAGE(PG8_SA(0, 1), a2 + hstepA, voffA);
            PG8_WAIT_V(8); PG8_WAIT_L(0); PG8_BAR; PG8_MMA(0, 0, At, B0); PG8_MMA(0, 1, At, B1); PG8_BAR; PG8_SCHED;
            PG8_LDA(At, 1, 1); PG8_STAGE(PG8_SB(1, 0), b3, voffB); PG8_STAGE(PG8_SB(1, 1), b3 + hstepB, voffB); PG8_STAGE(PG8_SA(1, 0), a3, voffA);
            PG8_WAIT_V(8); PG8_WAIT_L(0); PG8_BAR; PG8_MMA(1, 0, At, B0); PG8_MMA(1, 1, At, B1); PG8_BAR; PG8_SCHED;
            } else {
            PG8_LDB(B0, 0, 0); PG8_SCHED; PG8_LDA(At, 0, 0); PG8_STAGE(PG8_SA(1, 1), a1 + hstepA, voffA);
            PG8_WAIT_L(8); PG8_BAR; PG8_WAIT_L(0); PG8_MMA(0, 0, At, B0); PG8_BAR; PG8_SCHED;
            PG8_LDB(B1, 0, 1); PG8_STAGE(PG8_SB(0, 0), b2, voffB);
            PG8_BAR; PG8_WAIT_L(0); PG8_MMA(0, 1, At, B1); PG8_BAR;
            PG8_LDA(At, 0, 1); PG8_STAGE(PG8_SA(0, 0), a2, voffA);
            PG8_BAR; PG8_WAIT_L(0); PG8_MMA(1, 0, At, B0); PG8_BAR; PG8_SCHED;
            PG8_STAGE(PG8_SB(0, 1), b2 + hstepB, voffB);
            PG8_WAIT_V(6); PG8_BAR; PG8_MMA(1, 1, At, B1); PG8_BAR;
            PG8_LDB(B0, 1, 0); PG8_SCHED; PG8_LDA(At, 1, 0); PG8_STAGE(PG8_SA(0, 1), a2 + hstepA, voffA);
            PG8_WAIT_L(8); PG8_BAR; PG8_WAIT_L(0); PG8_MMA(0, 0, At, B0); PG8_BAR; PG8_SCHED;
            PG8_LDB(B1, 1, 1); PG8_STAGE(PG8_SB(1, 0), b3, voffB);
            PG8_BAR; PG8_WAIT_L(0); PG8_MMA(0, 1, At, B1); PG8_BAR;
            PG8_LDA(At, 1, 1); PG8_STAGE(PG8_SA(1, 0), a3, voffA);
            PG8_BAR; PG8_WAIT_L(0); PG8_MMA(1, 0, At, B0); PG8_BAR; PG8_SCHED;
            PG8_STAGE(PG8_SB(1, 1), b3 + hstepB, voffB);
            PG8_WAIT_V(6); PG8_BAR; PG8_MMA(1, 1, At, B1); PG8_BAR;
            }
        }
        if constexpr (ALIGN_EPI) { if (wr == 0) PG8_BAR; }
        if constexpr (!Epi::AFTER_DRAIN) { E(acc, cur, wr, wc, fr, fq); S.done(cur); }
        if (!has_next) break;
#pragma unroll
        for (int a = 0; a < 2; ++a)
#pragma unroll
            for (int b = 0; b < 2; ++b)
#pragma unroll
                for (int m = 0; m < 4; ++m)
#pragma unroll
                    for (int n = 0; n < 2; ++n) acc[a][b][m][n] = (f32x4){0.f, 0.f, 0.f, 0.f};
        cur = nxt; cA = nA; cB = nB; ++ui;
        if constexpr (ALIGN_EPI) { if (wr == 1) PG8_BAR; }
    }
    PG8_WAIT_V(0);
    if constexpr (!ALIGN_EPI) { if (wr == 0) PG8_BAR; }
    PG8_BAR;
    if constexpr (Epi::AFTER_DRAIN) { E.fused(acc, cur, wr, wc, fr, fq, lds, wid, lane); S.done(cur); }
#undef PG8_SA
#undef PG8_SB
#undef PG8_STAGE
#undef PG8_LDA
#undef PG8_LDB
#undef PG8_MMA
#undef PG8_WAIT_V
#undef PG8_WAIT_L
#undef PG8_BAR
#undef PG8_SCHED
}
}

namespace pg8 {
struct EpiF32 {
    static constexpr bool PERM = false, AFTER_DRAIN = false;
    float* C; int ldc; const float* resid; long sC;
    __device__ __forceinline__ void operator()(const f32x4 (&acc)[2][2][4][2], const Unit& u, int wr, int wc, int fr, int fq) const {
        const int row0 = u.pm * BM + wr * 64 + fr, col0 = u.pn * BM + wc * 32 + 4 * fq;
        float* base = C + (size_t)u.bz * sC;
#pragma unroll
        for (int ai = 0; ai < 2; ++ai)
#pragma unroll
            for (int m = 0; m < 4; ++m) { const size_t ro = (size_t)(row0 + ai * HALF + m * 16) * ldc;
#pragma unroll
                for (int bj = 0; bj < 2; ++bj)
#pragma unroll
                    for (int n = 0; n < 2; ++n) { const size_t o = ro + col0 + bj * HALF + n * 16; f32x4 v = acc[ai][bj][m][n];
                        if (resid) v += *(const f32x4*)(resid + o);
                        *(f32x4*)(base + o) = v; } }
    }
};


template <bool RF32> struct EpiResidB {
    static constexpr bool PERM = true, AFTER_DRAIN = false;
    const void* resid; bf16_t* HB; float* ssq; int ldc;
    __device__ __forceinline__ void operator()(const f32x4 (&acc)[2][2][4][2], const Unit& u, int wr, int wc, int fr, int fq) const {
        const int row0 = u.pm * BM + wr * 64 + fr, col0 = u.pn * BM + wc * 32 + 8 * fq;
#pragma unroll
        for (int ai = 0; ai < 2; ++ai)
#pragma unroll
            for (int m = 0; m < 4; ++m) { const int r = row0 + ai * HALF + m * 16; const size_t ro = (size_t)r * ldc + col0; float ss = 0.f;
#pragma unroll
                for (int bj = 0; bj < 2; ++bj) { const size_t o = ro + bj * HALF; f32x4 v0 = acc[ai][bj][m][0], v1 = acc[ai][bj][m][1];
                    if (RF32) { v0 += *(const f32x4*)((const float*)resid + o); v1 += *(const f32x4*)((const float*)resid + o + 4); }
                    else { const u32x4 rb = *(const u32x4*)((const bf16_t*)resid + o);
                        v0[0] += __uint_as_float(rb.x << 16); v0[1] += __uint_as_float(rb.x & 0xffff0000u); v0[2] += __uint_as_float(rb.y << 16); v0[3] += __uint_as_float(rb.y & 0xffff0000u);
                        v1[0] += __uint_as_float(rb.z << 16); v1[1] += __uint_as_float(rb.z & 0xffff0000u); v1[2] += __uint_as_float(rb.w << 16); v1[3] += __uint_as_float(rb.w & 0xffff0000u); }
                    ss += (v0[0] * v0[0] + v0[1] * v0[1]) + (v0[2] * v0[2] + v0[3] * v0[3]) + (v1[0] * v1[0] + v1[1] * v1[1]) + (v1[2] * v1[2] + v1[3] * v1[3]);
                    u32x4 w; w.x = cvt_pk_bf16(v0[0], v0[1]); w.y = cvt_pk_bf16(v0[2], v0[3]); w.z = cvt_pk_bf16(v1[0], v1[1]); w.w = cvt_pk_bf16(v1[2], v1[3]);
                    *(u32x4*)(HB + o) = w; }
                ss += __shfl_xor(ss, 16); ss += __shfl_xor(ss, 32);
                if (fq == 0) atomicAdd(ssq + r, ss); }
    }
};

struct EpiWout {
    static constexpr bool PERM = true, AFTER_DRAIN = false, MIDK = true;
    const float* resid; bf16_t* HB; float* ssq; int ldc; const float* ssq_ssm; int midk_t;
    __device__ __forceinline__ void midk(f32x4 (&acc)[2][2][4][2], const Unit& u, int wr, int wc, int fr, int fq) const {
        const int row0 = u.pm * BM + wr * 64 + fr;
#pragma unroll
        for (int ai = 0; ai < 2; ++ai)
#pragma unroll
            for (int m = 0; m < 4; ++m) { const float ir = sqrtf(ssq_ssm[row0 + ai * HALF + m * 16] * (1.0f / 1024.0f) + 1e-6f);
#pragma unroll
                for (int bj = 0; bj < 2; ++bj) { acc[ai][bj][m][0] *= ir; acc[ai][bj][m][1] *= ir; } }
    }
    __device__ __forceinline__ void operator()(const f32x4 (&acc)[2][2][4][2], const Unit& u, int wr, int wc, int fr, int fq) const {
        const int row0 = u.pm * BM + wr * 64 + fr, col0 = u.pn * BM + wc * 32 + 8 * fq;
#pragma unroll
        for (int ai = 0; ai < 2; ++ai)
#pragma unroll
            for (int m = 0; m < 4; ++m) { const int r = row0 + ai * HALF + m * 16; const size_t ro = (size_t)r * ldc + col0; float ss = 0.f;
                const float rs = 1.0f / sqrtf(ssq_ssm[r] * (1.0f / 1024.0f) + 1e-6f);
#pragma unroll
                for (int bj = 0; bj < 2; ++bj) { const size_t o = ro + bj * HALF;
                    const f32x4 v0 = acc[ai][bj][m][0] * rs + *(const f32x4*)(resid + o), v1 = acc[ai][bj][m][1] * rs + *(const f32x4*)(resid + o + 4);
                    ss += (v0[0] * v0[0] + v0[1] * v0[1]) + (v0[2] * v0[2] + v0[3] * v0[3]) + (v1[0] * v1[0] + v1[1] * v1[1]) + (v1[2] * v1[2] + v1[3] * v1[3]);
                    u32x4 w; w.x = cvt_pk_bf16(v0[0], v0[1]); w.y = cvt_pk_bf16(v0[2], v0[3]); w.z = cvt_pk_bf16(v1[0], v1[1]); w.w = cvt_pk_bf16(v1[2], v1[3]);
                    *(u32x4*)(HB + o) = w; }
                ss += __shfl_xor(ss, 16); ss += __shfl_xor(ss, 32);
                if (fq == 0) atomicAdd(ssq + r, ss); }
    }
};
struct EpiRowBf16 {
    static constexpr bool PERM = true, AFTER_DRAIN = false;
    bf16_t* O; int ldc; const float* ssq; float scale;
    __device__ __forceinline__ void operator()(const f32x4 (&acc)[2][2][4][2], const Unit& u, int wr, int wc, int fr, int fq) const {
        const int row0 = u.pm * BM + wr * 64 + fr, col0 = u.pn * BM + wc * 32 + 8 * fq;
#pragma unroll
        for (int ai = 0; ai < 2; ++ai)
#pragma unroll
            for (int m = 0; m < 4; ++m) { const int r = row0 + ai * HALF + m * 16; const float sc = scale / sqrtf(ssq[r] * (1.0f / 2048.0f) + 1e-6f); bf16_t* rowp = O + (size_t)r * ldc + col0;
#pragma unroll
                for (int bj = 0; bj < 2; ++bj) { const f32x4 v0 = acc[ai][bj][m][0] * sc, v1 = acc[ai][bj][m][1] * sc;
                    u32x4 w; w.x = cvt_pk_bf16(v0[0], v0[1]); w.y = cvt_pk_bf16(v0[2], v0[3]); w.z = cvt_pk_bf16(v1[0], v1[1]); w.w = cvt_pk_bf16(v1[2], v1[3]);
                    *(u32x4*)(rowp + bj * HALF) = w; } }
    }
};
struct EpiSl {
    static constexpr bool PERM = false, AFTER_DRAIN = false;
    float* Sl;
    __device__ __forceinline__ void operator()(const f32x4 (&acc)[2][2][4][2], const Unit& u, int wr, int wc, int fr, int fq) const {
        const int row0 = u.pm * BM + wr * 64 + fr, col0 = wc * 32 + 4 * fq;
        float* base = Sl + (size_t)u.bz * 512 * 128;
#pragma unroll
        for (int ai = 0; ai < 2; ++ai)
#pragma unroll
            for (int m = 0; m < 4; ++m) { float* rowp = base + (size_t)(row0 + ai * HALF + m * 16) * 128 + col0;
#pragma unroll
                for (int n = 0; n < 2; ++n) *(f32x4*)(rowp + n * 16) = acc[ai][0][m][n]; }
    }
};
struct EpiS5 {
    static constexpr bool PERM = true, AFTER_DRAIN = false;
    bf16_t* Gb;
    __device__ __forceinline__ void operator()(const f32x4 (&acc)[2][2][4][2], const Unit& u, int wr, int wc, int fr, int fq) const {
        const int row0 = u.pm * BM + wr * 64 + fr, col0 = u.pn * BM + wc * 32 + 8 * fq;
#pragma unroll
        for (int ai = 0; ai < 2; ++ai)
#pragma unroll
            for (int m = 0; m < 4; ++m) { const int cb = row0 + ai * HALF + m * 16;
#pragma unroll
                for (int bj = 0; bj < 2; ++bj) { const int n0 = col0 + bj * HALF; const int tau = n0 >> 4, h0 = n0 & 15;
                    const f32x4 v0 = acc[ai][bj][m][0], v1 = acc[ai][bj][m][1];
                    const f32x2 a = gelu_pk((f32x2){v0[0], v0[1]}), b = gelu_pk((f32x2){v0[2], v0[3]}), c = gelu_pk((f32x2){v1[0], v1[1]}), d = gelu_pk((f32x2){v1[2], v1[3]});
                    u32x4 w; w.x = cvt_pk_bf16(a.x, a.y); w.y = cvt_pk_bf16(b.x, b.y); w.z = cvt_pk_bf16(c.x, c.y); w.w = cvt_pk_bf16(d.x, d.y);
                    *(u32x4*)(Gb + ((size_t)cb * 32 + tau) * 1024 + 16 * u.bz + h0) = w; } }
    }
};

struct EpiXkv {
    static constexpr bool PERM = false, AFTER_DRAIN = false;
    bf16_t* KP; bf16_t* VT2;
    __device__ __forceinline__ void operator()(const f32x4 (&acc)[2][2][4][2], const Unit& u, int wr, int wc, int fr, int fq) const {
        const int row0 = u.pm * BM + wr * 64 + fr, col0 = u.pn * BM + wc * 32 + 4 * fq;
#pragma unroll
        for (int ai = 0; ai < 2; ++ai)
#pragma unroll
            for (int m = 0; m < 4; ++m) { const int r = row0 + ai * HALF + m * 16; const int b = r >> 8, mm = r & 255;
#pragma unroll
                for (int bj = 0; bj < 2; ++bj)
#pragma unroll
                    for (int n = 0; n < 2; ++n) { const int c = col0 + bj * HALF + n * 16; const f32x4 v = acc[ai][bj][m][n];
                        if (c < 512) { const int hd = c >> 7, d = c & 127; bf16_t* p = KP + ((size_t)(b * 4 + hd) * 256 + mm) * 256;
                            *(unsigned long long*)(p + (hd & 1) * 128 + d) = (unsigned long long)cvt_pk_bf16(v[0], v[1]) | ((unsigned long long)cvt_pk_bf16(v[2], v[3]) << 32);
                            *(unsigned long long*)(p + ((hd & 1) ^ 1) * 128 + d) = 0ull; }
                        else { const int c2 = c - 512, hd = c2 >> 7, d = c2 & 127; bf16_t* p = VT2 + ((size_t)(b * 2 + (hd >> 1)) * 256 + (hd & 1) * 128 + d) * 512;
                            const unsigned w01 = cvt_pk_bf16(v[0], v[1]), w23 = cvt_pk_bf16(v[2], v[3]);
                            const int k1 = (hd & 1) * 256 + mm, k0 = ((hd & 1) ^ 1) * 256 + mm;
                            p[k1] = (bf16_t)(w01 & 0xffffu); p[512 + k1] = (bf16_t)(w01 >> 16); p[1024 + k1] = (bf16_t)(w23 & 0xffffu); p[1536 + k1] = (bf16_t)(w23 >> 16);
                            p[k0] = 0; p[512 + k0] = 0; p[1024 + k0] = 0; p[1536 + k0] = 0; } } }
    }
};
struct EpiXs {
    static constexpr bool PERM = true, AFTER_DRAIN = true;
    bf16_t* XP; float* Lsum;
    __device__ __forceinline__ void fused(f32x4 (&acc)[2][2][4][2], const Unit& u, int wr, int wc, int fr, int fq, PG8_LAS unsigned char* lds, int wid, int lane) const {
        PG8_LAS float* Mx = (PG8_LAS float*)lds;
        const int b = u.bz >> 2, hd = u.bz & 3;
#pragma unroll
        for (int ai = 0; ai < 2; ++ai)
#pragma unroll
            for (int m = 0; m < 4; ++m) { float mx = -INFINITY;
#pragma unroll
                for (int bj = 0; bj < 2; ++bj)
#pragma unroll
                    for (int n = 0; n < 2; ++n) { const f32x4 v = acc[ai][bj][m][n]; mx = fmaxf(mx, fmaxf(fmaxf(v[0], v[1]), fmaxf(v[2], v[3]))); }
                mx = fmaxf(mx, __shfl_xor(mx, 16)); mx = fmaxf(mx, __shfl_xor(mx, 32));
                if (fq == 0) Mx[(ai * HALF + wr * 64 + m * 16 + fr) * 4 + wc] = mx; }
        asm volatile("s_waitcnt lgkmcnt(0)" ::: "memory"); __builtin_amdgcn_s_barrier(); asm volatile("" ::: "memory");
#pragma unroll
        for (int ai = 0; ai < 2; ++ai)
#pragma unroll
            for (int m = 0; m < 4; ++m) { const int rl = ai * HALF + wr * 64 + m * 16 + fr; const f32x4 mv = *(const PG8_LAS f32x4*)(Mx + rl * 4);
                const float mx = fmaxf(fmaxf(mv[0], mv[1]), fmaxf(mv[2], mv[3])); float ss = 0.f;
                const size_t t = (size_t)b * 2048 + u.pm * BM + rl; bf16_t* rowp = XP + t * 1024 + hd * 256 + wc * 32 + 8 * fq;
#pragma unroll
                for (int bj = 0; bj < 2; ++bj) { f32x4 p0, p1;
#pragma unroll
                    for (int e = 0; e < 4; ++e) { p0[e] = __expf(acc[ai][bj][m][0][e] - mx); p1[e] = __expf(acc[ai][bj][m][1][e] - mx); }
                    ss += (p0[0] + p0[1]) + (p0[2] + p0[3]) + (p1[0] + p1[1]) + (p1[2] + p1[3]);
                    u32x4 w; w.x = cvt_pk_bf16(p0[0], p0[1]); w.y = cvt_pk_bf16(p0[2], p0[3]); w.z = cvt_pk_bf16(p1[0], p1[1]); w.w = cvt_pk_bf16(p1[2], p1[3]);
                    *(u32x4*)(rowp + bj * HALF) = w; }
                ss += __shfl_xor(ss, 16); ss += __shfl_xor(ss, 32);
                if (fq == 0) atomicAdd(Lsum + t * 4 + hd, ss); }
    }
};
struct EpiXo {
    static constexpr bool PERM = true, AFTER_DRAIN = false;
    bf16_t* XO; const float* Lsum;
    __device__ __forceinline__ void operator()(const f32x4 (&acc)[2][2][4][2], const Unit& u, int wr, int wc, int fr, int fq) const {
        const int b = u.bz >> 2, pair = (u.bz >> 1) & 1, kh = u.bz & 1;
#pragma unroll
        for (int ai = 0; ai < 2; ++ai)
#pragma unroll
            for (int m = 0; m < 4; ++m) { const size_t t = (size_t)b * 2048 + u.pm * BM + ai * HALF + wr * 64 + m * 16 + fr; bf16_t* rowp = XO + t * 512 + pair * 256 + wc * 32 + 8 * fq;
                { const float il = 1.0f / Lsum[t * 4 + pair * 2 + kh]; const f32x4 v0 = (kh ? acc[ai][1][m][0] : acc[ai][0][m][0]) * il, v1 = (kh ? acc[ai][1][m][1] : acc[ai][0][m][1]) * il;
                    u32x4 w; w.x = cvt_pk_bf16(v0[0], v0[1]); w.y = cvt_pk_bf16(v0[2], v0[3]); w.z = cvt_pk_bf16(v1[0], v1[1]); w.w = cvt_pk_bf16(v1[2], v1[3]);
                    *(u32x4*)(rowp + kh * HALF) = w; } }
    }
};
struct XsOrder {
    int G, c, sel;
    __device__ __forceinline__ bool next(int i, Unit& u) const { if (i > 0) return false; const int L = sel * G + c; if (L >= 256) return false; u.pm = L & 7; u.pn = 0; u.bz = L >> 3; return true; }
    __device__ __forceinline__ void a_ready(const Unit&) const {}
    __device__ __forceinline__ void done(const Unit&) const {}
    template <class G_> __device__ __forceinline__ long offA(const Unit& u, const G_&) const { return (long)(u.bz >> 2) * 2048 * 512 + ((u.bz & 3) >> 1) * 256; }
    template <class G_> __device__ __forceinline__ long offB(const Unit& u, const G_&) const { return (long)u.bz * 256 * 256; }
};
struct XoOrder {
    int G, c;
    __device__ __forceinline__ bool next(int i, Unit& u) const { const int L = i * G + c; if (L >= 256) return false; u.pm = L & 7; u.pn = 0; u.bz = L >> 3; return true; }
    __device__ __forceinline__ void a_ready(const Unit&) const {}
    __device__ __forceinline__ void done(const Unit&) const {}
    template <class G_> __device__ __forceinline__ long offA(const Unit& u, const G_&) const { return (long)(u.bz >> 2) * 2048 * 1024 + (u.bz & 3) * 256; }
    template <class G_> __device__ __forceinline__ long offB(const Unit& u, const G_&) const { return (long)(u.bz >> 1) * 256 * 512 + (u.bz & 1) * 256; }
};
struct EpiGlu {
    static constexpr bool PERM = false, AFTER_DRAIN = false;
    const bf16_t* G; const float* bias; bf16_t* CAT; float* ssq;
    __device__ __forceinline__ void operator()(const f32x4 (&acc)[2][2][4][2], const Unit& u, int wr, int wc, int fr, int fq) const {
        const int row0 = u.pm * BM + wr * 64 + fr, col0 = u.pn * BM + wc * 32 + 4 * fq;
#pragma unroll
        for (int ai = 0; ai < 2; ++ai)
#pragma unroll
            for (int m = 0; m < 4; ++m) { const int r = row0 + ai * HALF + m * 16; float ss = 0.f;
#pragma unroll
                for (int bj = 0; bj < 2; ++bj)
#pragma unroll
                    for (int n = 0; n < 2; ++n) { const int c = col0 + bj * HALF + n * 16; const f32x4 z = acc[ai][bj][m][n] + *(const f32x4*)(bias + c); const unsigned long long gb = *(const unsigned long long*)(G + (size_t)r * 1024 + c);
                        f32x4 gv; gv[0] = __uint_as_float((unsigned)gb << 16); gv[1] = __uint_as_float((unsigned)gb & 0xffff0000u); gv[2] = __uint_as_float((unsigned)(gb >> 32) << 16); gv[3] = __uint_as_float((unsigned)(gb >> 32) & 0xffff0000u);
                        f32x4 o; o[0] = gv[0] / (1.0f + __expf(-z[0])); o[1] = gv[1] / (1.0f + __expf(-z[1])); o[2] = gv[2] / (1.0f + __expf(-z[2])); o[3] = gv[3] / (1.0f + __expf(-z[3]));
                        ss += o[0] * o[0] + o[1] * o[1] + o[2] * o[2] + o[3] * o[3];
                        const unsigned long long w = (unsigned long long)cvt_pk_bf16(o[0], o[1]) | ((unsigned long long)cvt_pk_bf16(o[2], o[3]) << 32);
                        *(unsigned long long*)(CAT + (size_t)r * 2048 + 1024 + c) = w; }
                ss += __shfl_xor(ss, 16); ss += __shfl_xor(ss, 32);
                if (fq == 0) atomicAdd(ssq + r, ss); }
    }
};
struct EpiWin {
    static constexpr bool PERM = true, AFTER_DRAIN = false;
    bf16_t* QKV; size_t sec_stride; bf16_t* UC; const float* rope; float qscale;
    __device__ __forceinline__ void operator()(const f32x4 (&acc)[2][2][4][2], const Unit& u, int wr, int wc, int fr, int fq) const {
        const int row0 = u.pm * BM + wr * 64 + fr;
        const int sec = u.pn >> 2;
        const int col0 = (u.pn & 3) * BM + wc * 32 + 8 * fq;
        if (sec == 3) {
#pragma unroll
            for (int ai = 0; ai < 2; ++ai)
#pragma unroll
                for (int m = 0; m < 4; ++m) { const int r = row0 + ai * HALF + m * 16; const int cb = r >> 5, sg = r & 31;
#pragma unroll
                    for (int bj = 0; bj < 2; ++bj) { const int col = col0 + bj * HALF; const int g = col >> 4, h0 = col & 15;
                        const f32x4 v0 = acc[ai][bj][m][0], v1 = acc[ai][bj][m][1];
                        u32x4 w; w.x = cvt_pk_bf16(v0[0], v0[1]); w.y = cvt_pk_bf16(v0[2], v0[3]); w.z = cvt_pk_bf16(v1[0], v1[1]); w.w = cvt_pk_bf16(v1[2], v1[3]);
                        *(u32x4*)(UC + ((size_t)g * 512 + cb) * 640 + sg * 16 + h0) = w; } }
            return;
        }
        bf16_t* base = QKV + (size_t)sec * sec_stride;
        const float sc = sec == 0 ? qscale : 1.0f;
        const bool rot = (sec < 2) && ((wc & 1) == 0);
        const float sgn = (fq & 1) ? 1.0f : -1.0f;
        const bool mine = fq < 2;
#pragma unroll
        for (int ai = 0; ai < 2; ++ai)
#pragma unroll
            for (int m = 0; m < 4; ++m) { const int r = row0 + ai * HALF + m * 16; bf16_t* rowp = base + (size_t)r * 1024 + col0;
                f32x4 cs[4];
                if (rot) {
#pragma unroll
                    for (int q = 0; q < 4; ++q) cs[q] = *(const f32x4*)(rope + (size_t)r * 16 + 4 * q);
                }
#pragma unroll
                for (int bj = 0; bj < 2; ++bj) { f32x4 v0 = acc[ai][bj][m][0], v1 = acc[ai][bj][m][1];
                    if (rot) {
                        f32x4 p0, p1;
#pragma unroll
                        for (int e = 0; e < 4; ++e) { p0[e] = __shfl_xor(v0[e], 16); p1[e] = __shfl_xor(v1[e], 16); }
                        if (mine) {
#pragma unroll
                            for (int e = 0; e < 4; ++e) {
                                const float c0 = cs[e >> 1][(e & 1) * 2], s0 = cs[e >> 1][(e & 1) * 2 + 1];
                                const float c1 = cs[2 + (e >> 1)][(e & 1) * 2], s1 = cs[2 + (e >> 1)][(e & 1) * 2 + 1];
                                v0[e] = v0[e] * c0 + sgn * p0[e] * s0; v1[e] = v1[e] * c1 + sgn * p1[e] * s1; }
                        }
                    }
                    v0 = v0 * sc; v1 = v1 * sc; u32x4 w; w.x = cvt_pk_bf16(v0[0], v0[1]); w.y = cvt_pk_bf16(v0[2], v0[3]); w.z = cvt_pk_bf16(v1[0], v1[1]); w.w = cvt_pk_bf16(v1[2], v1[3]);
                    *(u32x4*)(rowp + bj * HALF) = w; } }
    }
};
}
#define GEMM_RUN(EPI, ALIGN, g, S, E) pg8::gemm_phase<EPI, pg8::StaticOrder, ALIGN, true>(F.ldsl, g, S, E)
namespace attn_body {
using bf16=__hip_bfloat16;
using bf16x8=__attribute__((ext_vector_type(8)))short;
using s16x4=__attribute__((ext_vector_type(4)))short;
using f32x16=__attribute__((ext_vector_type(16)))float;
using u32x4=__attribute__((ext_vector_type(4)))unsigned;
constexpr int BATCH=8,NHEAD=16,SEQ=2048,D=64,DM=NHEAD*D;
constexpr int NW=8,QBLK=32,QB=QBLK*NW,KVBLK=64,NQB=SEQ/QB;
constexpr int ATTN_PITCH=DM, ATTN_UNIT_ROWS=QB;
__device__ __forceinline__ int crow(int r,int hi){return (r&3)+8*(r>>2)+4*hi;}
#define SBAR() __builtin_amdgcn_sched_barrier(0)
__device__ __forceinline__ void cmask(f32x16&p0,f32x16&p1,int jb,int qrel,int hi){
  asm volatile("":"+v"(qrel),"+v"(hi));
  const float NEG=-INFINITY; int kb=64*jb+4*hi;
  #pragma unroll
  for(int r=0;r<16;++r){int kv=kb+(r&3)+8*(r>>2); if(kv>qrel)p0[r]=NEG; if(kv+32>qrel)p1[r]=NEG;}
}

constexpr int NSLOT=3, SLOTB=8192;
constexpr int LDS_K=0, LDS_V=NSLOT*SLOTB, LDS_WS=2*NSLOT*SLOTB, LDS_OST=LDS_WS+NW*64*4, LDS_BYTES=LDS_OST+NW*4096, LDS_X=LDS_BYTES, LDS_SSQ=LDS_X+NW*4096;
constexpr float C2=0.125f*1.4426950408889634f;
__device__ __forceinline__ void glds16(const void*gsrc,unsigned lds_dst){unsigned keep;
  asm volatile("s_mov_b32 %0, m0\n\ts_mov_b32 m0, %2\n\ts_nop 0\n\tglobal_load_lds_dwordx4 %1, off\n\ts_mov_b32 m0, %0":"=&s"(keep):"v"(gsrc),"s"(lds_dst):"memory");}
__device__ __forceinline__ float max3f(float a,float b,float c){float r;asm("v_max3_f32 %0, %1, %2, %3":"=v"(r):"v"(a),"v"(b),"v"(c));return r;}
__device__ __forceinline__ float max2f(float a,float b){float r;asm("v_max_f32_e32 %0, %1, %2":"=v"(r):"v"(a),"v"(b));return r;}
__device__ __forceinline__ float fadd_s(float a,float b){float r;asm("v_add_f32_e32 %0, %1, %2":"=v"(r):"v"(a),"v"(b));return r;}
__device__ __forceinline__ float fsub_s(float a,float b){float r;asm("v_sub_f32_e32 %0, %1, %2":"=v"(r):"v"(a),"v"(b));return r;}
typedef float f32x2_t __attribute__((ext_vector_type(2))); typedef __bf16 bf16x2_t __attribute__((ext_vector_type(2)));
__device__ __forceinline__ unsigned cvtpk_s(float lo,float hi){f32x2_t v={lo,hi};bf16x2_t b=__builtin_convertvector(v,bf16x2_t);return __builtin_bit_cast(unsigned,b);}
#define WAIT_BAR(N) asm volatile("s_waitcnt vmcnt(" #N ") lgkmcnt(0)\n\ts_barrier":::"memory")

__device__ __forceinline__ void qkt(f32x16&p0,f32x16&p1,const char*Kslot,const bf16x8*qr,int r32,int hi){ const f32x16 zc=f32x16{};
  const char*kb=Kslot+hi*1024+r32*16;
  #pragma unroll
  for(int d0=0;d0<4;++d0){
    const bf16x8 b0=*reinterpret_cast<const bf16x8*>(kb+d0*2048);
    const bf16x8 b1=*reinterpret_cast<const bf16x8*>(kb+d0*2048+512);
    if(d0==0){p0=__builtin_amdgcn_mfma_f32_32x32x16_bf16(b0,qr[0],zc,0,0,0);p1=__builtin_amdgcn_mfma_f32_32x32x16_bf16(b1,qr[0],zc,0,0,0);}
    else{p0=__builtin_amdgcn_mfma_f32_32x32x16_bf16(b0,qr[d0],p0,0,0,0);p1=__builtin_amdgcn_mfma_f32_32x32x16_bf16(b1,qr[d0],p1,0,0,0);}}
}
typedef __attribute__((address_space(3))) const char* lds_cptr;
typedef short v4i16_t __attribute__((ext_vector_type(4)));
__device__ __forceinline__ void kload8(bf16x8*kf,lds_cptr kp){
  kf[0]=*(const __attribute__((address_space(3))) bf16x8*)(kp);      kf[1]=*(const __attribute__((address_space(3))) bf16x8*)(kp+512);
  kf[2]=*(const __attribute__((address_space(3))) bf16x8*)(kp+2048); kf[3]=*(const __attribute__((address_space(3))) bf16x8*)(kp+2560);
  kf[4]=*(const __attribute__((address_space(3))) bf16x8*)(kp+4096); kf[5]=*(const __attribute__((address_space(3))) bf16x8*)(kp+4608);
  kf[6]=*(const __attribute__((address_space(3))) bf16x8*)(kp+6144); kf[7]=*(const __attribute__((address_space(3))) bf16x8*)(kp+6656);
}
__device__ __forceinline__ void kload2(bf16x8*kf,lds_cptr kp,int j){ kf[2*j]=*(const __attribute__((address_space(3))) bf16x8*)(kp+j*2048); kf[2*j+1]=*(const __attribute__((address_space(3))) bf16x8*)(kp+j*2048+512); }
__device__ __forceinline__ s16x4 vtr(lds_cptr p){ return __builtin_bit_cast(s16x4,__builtin_amdgcn_ds_read_tr16_b64_v4i16((__attribute__((address_space(3))) v4i16_t*)p)); }
__device__ __forceinline__ float rowmax(const f32x16&p0,const f32x16&p1){
  float a=max3f(p0[0],p0[1],p1[0]),b=max3f(p0[2],p0[3],p1[1]);a=max3f(a,p1[2],p1[3]);
  #pragma unroll
  for(int r=4;r<16;r+=4){a=max3f(a,p0[r],p0[r+1]);b=max3f(b,p0[r+2],p0[r+3]);a=max3f(a,p1[r],p1[r+1]);b=max3f(b,p1[r+2],p1[r+3]);}
  const float m=max2f(a,b);
  auto rr=__builtin_amdgcn_permlane32_swap(__float_as_uint(m),__float_as_uint(m),false,false);
  return max2f(__uint_as_float(rr[0]),__uint_as_float(rr[1]));
}
__device__ __forceinline__ void pv(f32x16*o,int vb,bf16x8 pa0,bf16x8 pa1,bf16x8 pa2,bf16x8 pa3){
  #pragma unroll
  for(int d0=0;d0<2;++d0){s16x4 lo[4],hi[4];
    #pragma unroll
    for(int ks=0;ks<4;++ks){
      asm volatile("ds_read_b64_tr_b16 %0,%1 offset:%c2":"=&v"(lo[ks]):"v"(vb),"i"(d0*4096+ks*1024):"memory");
      asm volatile("ds_read_b64_tr_b16 %0,%1 offset:%c2":"=&v"(hi[ks]):"v"(vb),"i"(d0*4096+ks*1024+512):"memory");}
    asm volatile("s_waitcnt lgkmcnt(0)":::"memory");SBAR();
    #define PK(k) (bf16x8){lo[k][0],lo[k][1],lo[k][2],lo[k][3],hi[k][0],hi[k][1],hi[k][2],hi[k][3]}
    o[d0]=__builtin_amdgcn_mfma_f32_32x32x16_bf16(pa0,PK(0),o[d0],0,0,0);
    o[d0]=__builtin_amdgcn_mfma_f32_32x32x16_bf16(pa1,PK(1),o[d0],0,0,0);
    o[d0]=__builtin_amdgcn_mfma_f32_32x32x16_bf16(pa2,PK(2),o[d0],0,0,0);
    o[d0]=__builtin_amdgcn_mfma_f32_32x32x16_bf16(pa3,PK(3),o[d0],0,0,0);
    #undef PK
  }
}

#ifndef ATTN_STORE16
#define ATTN_STORE16(p,v) (*(u32x4*)(p)=(v))
#endif
template<int THRL> __device__ __forceinline__ void attn_unit(int b,int h,int hv,int qb,const bf16*Q,const bf16*__restrict__ K,const bf16*__restrict__ V,bf16*CATp,const int mode,const float lam,const float*hgp,char*shm){
  const int tid=threadIdx.x,lane=tid&63,r32=lane&31,hi=lane>>5; const int wid=__builtin_amdgcn_readfirstlane(tid>>6);
  const long rowbase=(long)b*SEQ; const int q0=qb*QB;
  const bf16*Qw=Q+(rowbase+q0+wid*QBLK)*DM+h*D;
  const bf16*Kh=K+rowbase*DM+h*D,*Vh=V+rowbase*DM+hv*D;
  const unsigned lds0=(unsigned)(uintptr_t)shm;
  float*wsf=(float*)(shm+LDS_WS)+wid*64;
  const bf16*ksrc=Kh+(long)lane*DM+wid*8;
  const bf16*vsrc=Vh+(long)(16*(wid&3)+(lane>>2))*DM+(wid>>2)*32+(lane&3)*8;
  const unsigned kdst=lds0+LDS_K+wid*1024, vdst=lds0+LDS_V+wid*1024;
  #define DMA_K(t,slot) glds16(ksrc+(long)(t)*KVBLK*DM,(unsigned)__builtin_amdgcn_readfirstlane(kdst+(slot)))
  #define DMA_V(t,slot) glds16(vsrc+(long)(t)*KVBLK*DM,(unsigned)__builtin_amdgcn_readfirstlane(vdst+(slot)))
  const int vb0=(int)(lds0+LDS_V)+((lane>>4)&1)*32+(lane&3)*8+(4*hi+((lane&15)>>2))*64;
  const char*Kbase=shm+LDS_K; bf16x8 kf[8];
  const lds_cptr shm3=(lds_cptr)shm; const lds_cptr kp0=shm3+LDS_K+hi*1024+r32*16; const lds_cptr vp0=shm3+LDS_V+((lane>>4)&1)*32+(lane&3)*8+(4*hi+((lane&15)>>2))*64;
  const int NT=(q0+QB)/KVBLK;
  DMA_K(0,0);DMA_V(0,0);DMA_K(1,SLOTB);
  bf16x8 qr[4];
  #pragma unroll
  for(int d0=0;d0<4;++d0)qr[d0]=*reinterpret_cast<const bf16x8*>(&Qw[(long)r32*DM+d0*16+hi*8]);
  float mhat=0.f,l_reg=0.f;f32x16 o[2];o[0]=f32x16{};o[1]=f32x16{};
  const int qrel=wid*QBLK+r32;
  #define CMASK(P0,P1,t) do{int jb_=(t)-(NT-4); if(jb_>=0)cmask(P0,P1,jb_,qrel,hi);}while(0)
  bool resc=false;
  #define START(P0,P1) do{ const float rm=rowmax(P0,P1); resc=false; mhat=rm; \
    _Pragma("unroll") for(int r=0;r<16;++r)P0[r]=__builtin_amdgcn_exp2f(fsub_s(P0[r],mhat)); }while(0)
  #define RESC() do{ if(resc){ asm volatile("s_waitcnt lgkmcnt(0)":::"memory"); \
      _Pragma("unroll") for(int d_=0;d_<2;++d_) _Pragma("unroll") for(int r=0;r<16;++r)o[d_][r]*=wsf[crow(r,hi)]; } }while(0)
  f32x16 pA0,pA1,pB0,pB1;
  int sl_prev=0,sl_cur=0,sl_next=SLOTB;
  #define ROT() do{sl_prev=sl_cur;sl_cur=sl_next;sl_next=(sl_next==(NSLOT-1)*SLOTB)?0:sl_next+SLOTB;}while(0)
  DMA_K(2,2*SLOTB);
  WAIT_BAR(3);
  qkt(pA0,pA1,Kbase,qr,r32,hi);asm volatile("s_nop 15\n\ts_nop 7":"+v"(pA0),"+v"(pA1));CMASK(pA0,pA1,0);
  START(pA0,pA1);
  _Pragma("unroll") for(int r=0;r<16;++r)pA1[r]=__builtin_amdgcn_exp2f(fsub_s(pA1[r],mhat));
  WAIT_BAR(0);
  DMA_K(3,0);DMA_V(1,SLOTB);
  ROT();
  kload8(kf,kp0+sl_cur);
  WAIT_BAR(2);
  s16x4 vlo[8],vhi[8]; u32x4 pw0,pw1,pw2,pw3;
  #define PKW(P,B) cvtpk_s(P[B],P[B+1])
  #define PAF(k) __builtin_bit_cast(bf16x8,pw##k)
  #define VFR(i) (bf16x8){vlo[i][0],vlo[i][1],vlo[i][2],vlo[i][3],vhi[i][0],vhi[i][1],vhi[i][2],vhi[i][3]}
  #define PIN(x) asm volatile("":"+v"(x))
  #define MX3(a,b,c) __builtin_fmaxf(__builtin_fmaxf((a),(b)),(c))
  #define GAPA(MF,A0,A1,A2,A3,W0,W1,PW) do{ MF; sacc+=A0; sacc+=A1; sacc+=A2; sacc+=A3; PIN(sacc); W0; W1; PIN(PW); SBAR(); }while(0)
  #define EX(v) __builtin_amdgcn_exp2f((v)-mhat)
  #define GAPB(MF,X,B) do{ MF; X[B]=EX(X[B]); X[B+1]=EX(X[B+1]); X[B+2]=EX(X[B+2]); X[B+3]=EX(X[B+3]); PIN(X); SBAR(); }while(0)
  #define VRD(i) do{ vlo[i]=vtr(vp_+(((i)>>2)*4096+((i)&3)*1024)); vhi[i]=vtr(vp_+(((i)>>2)*4096+((i)&3)*1024+512)); }while(0)
  #define KRD(G,j) do{ if(G){ kload2(kf,kp0+sl_next,j); SBAR(); } }while(0)
  #define STEP(C0,C1,P0,P1,t,GK,GV,GL) do{ SBAR(); const f32x16 zc_=f32x16{}; \
    const lds_cptr vp_=vp0+sl_prev; \
    VRD(0); SBAR(); float sacc=(P0[0]+P0[1]); \
    GAPA(C0=__builtin_amdgcn_mfma_f32_32x32x16_bf16(kf[0],qr[0],zc_,0,0,0), P0[2],P0[3],P0[4],P0[5],     pw0[0]=PKW(P0,0), pw0[1]=PKW(P0,2), pw0); \
    VRD(4); SBAR(); GAPA(C1=__builtin_amdgcn_mfma_f32_32x32x16_bf16(kf[1],qr[0],zc_,0,0,0), P0[6],P0[7],P0[8],P0[9],     pw0[2]=PKW(P0,4), pw0[3]=PKW(P0,6), pw0); \
    VRD(1); SBAR(); GAPA(C0=__builtin_amdgcn_mfma_f32_32x32x16_bf16(kf[2],qr[1],C0,0,0,0),   P0[10],P0[11],P0[12],P0[13], pw1[0]=PKW(P0,8), pw1[1]=PKW(P0,10), pw1); \
    VRD(5); SBAR(); GAPA(C1=__builtin_amdgcn_mfma_f32_32x32x16_bf16(kf[3],qr[1],C1,0,0,0),   P0[14],P0[15],P1[0],P1[1],   pw1[2]=PKW(P0,12),pw1[3]=PKW(P0,14), pw1); \
    VRD(2); SBAR(); GAPA(C0=__builtin_amdgcn_mfma_f32_32x32x16_bf16(kf[4],qr[2],C0,0,0,0),   P1[2],P1[3],P1[4],P1[5],     pw2[0]=PKW(P1,0), pw2[1]=PKW(P1,2), pw2); \
    VRD(6); SBAR(); GAPA(C1=__builtin_amdgcn_mfma_f32_32x32x16_bf16(kf[5],qr[2],C1,0,0,0),   P1[6],P1[7],P1[8],P1[9],     pw2[2]=PKW(P1,4), pw2[3]=PKW(P1,6), pw2); \
    VRD(3); SBAR(); GAPA(C0=__builtin_amdgcn_mfma_f32_32x32x16_bf16(kf[6],qr[3],C0,0,0,0),   P1[10],P1[11],P1[12],P1[13], pw3[0]=PKW(P1,8), pw3[1]=PKW(P1,10), pw3); \
    VRD(7); SBAR(); GAPA(C1=__builtin_amdgcn_mfma_f32_32x32x16_bf16(kf[7],qr[3],C1,0,0,0),   P1[14],P1[15],0.f,0.f,       pw3[2]=PKW(P1,12),pw3[3]=PKW(P1,14), pw3); \
    l_reg+=sacc; \
    if(GK){DMA_K((t)+3,sl_cur);} if(GV){DMA_V((t)+1,sl_next);} \
    CMASK(C0,C1,t); \
    { float a=MX3(C0[0],C0[1],C1[0]),b=MX3(C0[2],C0[3],C1[1]); a=MX3(a,C1[2],C1[3]); \
      _Pragma("unroll") for(int r=4;r<16;r+=4){a=MX3(a,C0[r],C0[r+1]);b=MX3(b,C0[r+2],C0[r+3]);a=MX3(a,C1[r],C1[r+1]);b=MX3(b,C1[r+2],C1[r+3]);} \
      float rm=__builtin_fmaxf(a,b); { auto rr=__builtin_amdgcn_permlane32_swap(__float_as_uint(rm),__float_as_uint(rm),false,false); rm=__builtin_fmaxf(__uint_as_float(rr[0]),__uint_as_float(rr[1])); } \
      resc=false; \
      rm-=mhat; \
      if(__builtin_expect(__any(rm>(float)THRL),0)){ const float dl=__builtin_fmaxf(rm,0.f); mhat+=dl; \
        const float f=__builtin_amdgcn_exp2f(-dl); l_reg*=f; if(hi==0)wsf[r32]=f; resc=true; } } \
    SBAR(); \
    GAPB(o[0]=__builtin_amdgcn_mfma_f32_32x32x16_bf16(PAF(0),VFR(0),o[0],0,0,0), C0,0); \
    GAPB(o[1]=__builtin_amdgcn_mfma_f32_32x32x16_bf16(PAF(0),VFR(4),o[1],0,0,0), C0,4); \
    KRD(GL,0); GAPB(o[0]=__builtin_amdgcn_mfma_f32_32x32x16_bf16(PAF(1),VFR(1),o[0],0,0,0), C0,8); \
    KRD(GL,1); GAPB(o[1]=__builtin_amdgcn_mfma_f32_32x32x16_bf16(PAF(1),VFR(5),o[1],0,0,0), C0,12); \
    KRD(GL,2); GAPB(o[0]=__builtin_amdgcn_mfma_f32_32x32x16_bf16(PAF(2),VFR(2),o[0],0,0,0), C1,0); \
    KRD(GL,3); GAPB(o[1]=__builtin_amdgcn_mfma_f32_32x32x16_bf16(PAF(2),VFR(6),o[1],0,0,0), C1,4); \
    GAPB(o[0]=__builtin_amdgcn_mfma_f32_32x32x16_bf16(PAF(3),VFR(3),o[0],0,0,0), C1,8); \
    GAPB(o[1]=__builtin_amdgcn_mfma_f32_32x32x16_bf16(PAF(3),VFR(7),o[1],0,0,0), C1,12); \
    }while(0)
  int t=1;
  #undef CMASK
  #define CMASK(P0,P1,t) do{}while(0)
  for(;t+5<NT;t+=2){
    STEP(pB0,pB1,pA0,pA1,t,true,true,true);     WAIT_BAR(2); RESC(); ROT();
    STEP(pA0,pA1,pB0,pB1,t+1,true,true,true);   WAIT_BAR(2); RESC(); ROT();
  }
  #undef CMASK
  #define CMASK(P0,P1,t) do{int jb_=(t)-(NT-4); if(jb_>=0)cmask(P0,P1,jb_,qrel,hi);}while(0)
  #define ENDW(tt) do{ if((tt)+3<NT){WAIT_BAR(2);} else if((tt)+2<NT){WAIT_BAR(1);} else {WAIT_BAR(0);} }while(0)
  for(;t+1<NT;t+=2){
    STEP(pB0,pB1,pA0,pA1,t,(t+3<NT),(t+1<NT),(t+1<NT));       ENDW(t);   RESC(); ROT();
    STEP(pA0,pA1,pB0,pB1,t+1,(t+4<NT),(t+2<NT),(t+2<NT));     ENDW(t+1); RESC(); ROT();
  }
  STEP(pB0,pB1,pA0,pA1,NT-1,false,false,false); RESC();
  { float sacc=pB0[0]+pB0[1]; _Pragma("unroll") for(int r=2;r<16;++r)sacc+=pB0[r]; _Pragma("unroll") for(int r=0;r<16;++r)sacc+=pB1[r]; l_reg+=sacc;
    pw0=(u32x4){PKW(pB0,0),PKW(pB0,2),PKW(pB0,4),PKW(pB0,6)};pw1=(u32x4){PKW(pB0,8),PKW(pB0,10),PKW(pB0,12),PKW(pB0,14)};pw2=(u32x4){PKW(pB1,0),PKW(pB1,2),PKW(pB1,4),PKW(pB1,6)};pw3=(u32x4){PKW(pB1,8),PKW(pB1,10),PKW(pB1,12),PKW(pB1,14)};
    SBAR(); pv(o,vb0+sl_cur,PAF(0),PAF(1),PAF(2),PAF(3)); }
  #undef PKW
  #undef PAF
  #undef VFR
  #undef PIN
  #undef MX3
  #undef GAPA
  #undef GAPB
  #undef EX
  #undef VRD
  #undef KRD
  #undef STEP
  #undef ENDW
  {auto rr=__builtin_amdgcn_permlane32_swap(__float_as_uint(l_reg),__float_as_uint(l_reg),false,false);l_reg=__uint_as_float(rr[0])+__uint_as_float(rr[1]);}
  if(hi==0)wsf[32+r32]=l_reg;asm volatile("s_waitcnt lgkmcnt(0)":::"memory");
  float rli[16];
  #pragma unroll
  for(int r=0;r<16;++r)rli[r]=__builtin_amdgcn_rcpf(wsf[32+crow(r,hi)]);
  { bf16*stg=(bf16*)(shm+LDS_OST)+wid*2048;
    bf16*xst=(bf16*)(shm+LDS_X)+wid*2048; float*ssq=(float*)(shm+LDS_SSQ)+wid*32;
    bf16*cur=(mode&2)?stg:xst;
    if((mode&1)==0){
      #pragma unroll
      for(int r=0;r<16;++r){const int orow=crow(r,hi);
        #pragma unroll
        for(int d0=0;d0<2;++d0)cur[orow*64+d0*32+r32]=__float2bfloat16(o[d0][r]*rli[r]);}
    } else {
      #pragma unroll
      for(int r=0;r<16;++r){const int orow=crow(r,hi);
        #pragma unroll
        for(int d0=0;d0<2;++d0){const int pos=orow*64+d0*32+r32; const float dd=__bfloat162float(cur[pos])-lam*(o[d0][r]*rli[r]); cur[pos]=__float2bfloat16(dd);}}
      asm volatile("s_waitcnt lgkmcnt(0)":::"memory");
      const long trow=rowbase+q0+wid*QBLK;
      #pragma unroll
      for(int i=0;i<4;++i){const int row=i*8+(lane>>3),ch=lane&7; const u32x4 vb=*(const u32x4*)(cur+row*64+ch*8);
        float fb[8];
        #pragma unroll
        for(int e=0;e<4;++e){fb[2*e]=__uint_as_float(vb[e]<<16);fb[2*e+1]=__uint_as_float(vb[e]&0xffff0000u);}
        float ss=0.f;
        #pragma unroll
        for(int e=0;e<8;++e)ss+=fb[e]*fb[e];
        ss+=__shfl_xor(ss,1);ss+=__shfl_xor(ss,2);ss+=__shfl_xor(ss,4);
        if(mode==1){ if(ch==0)ssq[row]=ss; }
        else{
          const u32x4 va=*(const u32x4*)(xst+row*64+ch*8);
          const float rr=(1.0f-LAM_INIT)/sqrtf((ssq[row]+ss)/128.0f+EPS);
          const float4 ga0=*(const float4*)(hgp+ch*8),ga1=*(const float4*)(hgp+ch*8+4),gb0=*(const float4*)(hgp+64+ch*8),gb1=*(const float4*)(hgp+64+ch*8+4);
          const float ga[8]={ga0.x,ga0.y,ga0.z,ga0.w,ga1.x,ga1.y,ga1.z,ga1.w},gb[8]={gb0.x,gb0.y,gb0.z,gb0.w,gb1.x,gb1.y,gb1.z,gb1.w};
          u32x4 oa,ob;
          #pragma unroll
          for(int e=0;e<4;++e){
            oa[e]=cvtpk_s(__uint_as_float(va[e]<<16)*rr*ga[2*e],__uint_as_float(va[e]&0xffff0000u)*rr*ga[2*e+1]);
            ob[e]=cvtpk_s(fb[2*e]*rr*gb[2*e],fb[2*e+1]*rr*gb[2*e+1]);}
          bf16*cp=CATp+(trow+row)*2048+(hv>>1)*128+ch*8;
          ATTN_STORE16(cp,oa); ATTN_STORE16(cp+64,ob);
        }
      }
    }
  }
  asm volatile("s_waitcnt lgkmcnt(0)\n\ts_barrier":::"memory");
  #undef DMA_K
  #undef DMA_V
  #undef CMASK
  #undef START
  #undef RESC
  #undef ROT
}
constexpr int ATTN_LDS_BYTES=LDS_BYTES+NW*4096+NW*128;
struct AttnTensors { const bf16* Q; const bf16* K; const bf16* V; bf16* CAT; float lam; const float* hg; };
template<int THRL=8> __device__ __forceinline__ void attn_phase(char*lds,const AttnTensors&T,int vcu,int G){
  for(int item=vcu;item<BATCH*8*4;item+=G){
    const int b=item>>5,h=(item>>2)&7,j=item&3;
    for(int q2=0;q2<2;++q2){ const int qb=q2?j:NQB-1-j;
      for(int mode=0;mode<4;++mode) attn_unit<THRL>(b,2*h+(mode&1),2*h+(mode>>1),qb,T.Q,T.K,T.V,T.CAT,mode,T.lam,T.hg,lds); }
  }
}
#undef SBAR
#undef WAIT_BAR
}

__device__ __forceinline__ void p_s5_stepA(const Frame& F, const Args& A);
__device__ __forceinline__ void p3_attn(const Frame& F, const Args& A) {
    const attn_body::AttnTensors AT{(const attn_body::bf16*)WSB(WS_QB), (const attn_body::bf16*)WSB(WS_KB), (const attn_body::bf16*)WSB(WS_VB), (attn_body::bf16*)WSB(WS_B), *WSF(WS_LAM), IN_F(9)};
    const int vcu = (F.G % 8 == 0) ? (F.bid % 8) * (F.G / 8) + F.bid / 8 : F.bid;
    p_s5_stepA(F, A);
    attn_body::attn_phase<8>((char*)F.lds, AT, vcu, F.G);
}
__device__ __forceinline__ void p0_s5_setup(const Frame& F, const Args& A) {
    LAS float* Apr = (LAS float*)F.ldsl;
    LAS float* Api = Apr + 33 * 64;
    LAS float* Bbr = Api + 33 * 64;
    LAS float* Bbi = Bbr + 1024;
    LAS float* Cr = Bbi + 1024;
    LAS float* Ci = Cr + 1024;
    LAS float* Kk = Ci + 1024;
    const float* a_re = IN_F(10); const float* a_im = IN_F(11); const float* log_dt = IN_F(12);
    const float* b_re = IN_F(13); const float* b_im = IN_F(14); const float* c_re = IN_F(15); const float* c_im = IN_F(16); const float* dsk = IN_F(17);
    bf16* BtC = WSB(WS_BTC); bf16* BtA = WSB(WS_BTA); float* AL = WSF(WS_AL);
    const int tid = F.tid;
    const float* xin = IN_F(0); const float* g3 = IN_F(3); bf16* XN = WSB(WS_B);
    const int gw4 = 4 * (F.bid * NWAVES + F.wave), step4 = 4 * F.G * NWAVES; int nbat = 0;
#define S5_BAR() asm volatile("s_waitcnt lgkmcnt(0)\n\ts_barrier" ::: "memory")
    for (int item = F.bid; item < SG * 4; item += F.G) {
        const int g = item >> 2, hq = item & 3; const bool first = item == F.bid;
        S5_BAR();
        const float dtf = expf(log_dt[g]); const double dt = (double)dtf;
        for (int e = tid; e < 33 * 64; e += NTHR) {
            const int k = e >> 6, p = e & 63;
            const float lre = a_re[g * SP + p], lim = a_im[g * SP + p];
            const float mag = expf(lre * dtf * (float)k), af = lim * dtf * (float)k;
            Apr[e] = mag * cosf(af); Api[e] = mag * sinf(af);
        }
        for (int e = tid; e < 1024; e += NTHR) {
            const int p = e >> 4, h = e & 15;
            const double lre = a_re[g * SP + p], lim = a_im[g * SP + p];
            const double mag = exp(lre * dt), ang = lim * dt;
            const double rev = ang * 0.15915494309189533577, frr = rev - floor(rev);
            const float af = (float)(frr * 6.283185307179586477);
            const double ar = mag * (double)cosf(af), ai = mag * (double)sinf(af);
            const double den = lre * lre + lim * lim;
            const double fre = ((ar - 1.0) * lre + ai * lim) / den, fim = (ai * lre - (ar - 1.0) * lim) / den;
            const double br = b_re[(g * SP + p) * 16 + h], bi = b_im[(g * SP + p) * 16 + h];
            Bbr[e] = (float)(fre * br - fim * bi); Bbi[e] = (float)(fre * bi + fim * br);
            Cr[h * 64 + p] = c_re[(g * 16 + h) * SP + p]; Ci[h * 64 + p] = c_im[(g * 16 + h) * SP + p];
        }
        S5_BAR();
        float4 pv[32]; const int r0 = gw4 + nbat * step4; const bool has0 = first && r0 < T;
        if (has0) { norm4_load(xin + (size_t)r0 * DM, F.lane, pv); ++nbat; }
        if (hq == 0 && tid < 64) { AL[(g * 64 + tid) * 2] = Apr[32 * 64 + tid]; AL[(g * 64 + tid) * 2 + 1] = Api[32 * 64 + tid]; }
        if (tid < 128) {
            const int k = tid >> 2, hl = tid & 3, h = 4 * hq + hl;
            float acc[16];
#pragma unroll
            for (int q = 0; q < 16; ++q) acc[q] = 0.f;
            for (int p = 0; p < 64; ++p) {
                const float cr = Cr[h * 64 + p], ci = Ci[h * 64 + p], ar = Apr[k * 64 + p], ai = Api[k * 64 + p];
                const float gr = cr * ar - ci * ai, gi = cr * ai + ci * ar;
#pragma unroll
                for (int q = 0; q < 16; ++q) acc[q] += gr * Bbr[p * 16 + q] - gi * Bbi[p * 16 + q];
            }
#pragma unroll
            for (int q = 0; q < 16; ++q) Kk[tid * 16 + q] = acc[q];
        }
        S5_BAR();
        const float dk0 = dsk[g * 16 + 4 * hq], dk1 = dsk[g * 16 + 4 * hq + 1], dk2 = dsk[g * 16 + 4 * hq + 2], dk3 = dsk[g * 16 + 4 * hq + 3];
        if (has0) norm4_finish(pv, g3, XN + (size_t)r0 * DM, F.lane);
        const int r1 = gw4 + nbat * step4; const bool has1 = first && r1 < T;
        if (has1) { norm4_load(xin + (size_t)r1 * DM, F.lane, pv); ++nbat; }
        asm volatile("" ::: "memory");
        for (int e = tid; e < 128 * 80; e += NTHR) {
            const int rr = e / 80, k0 = (e - rr * 80) * 8; const int tau = rr >> 2, hl = rr & 3, h = 4 * hq + hl;
            float v[8];
            if (k0 < 512) { const int sg = k0 >> 4, hp0 = k0 & 15;
#pragma unroll
                for (int q = 0; q < 8; ++q) { float x = 0.f; if (sg <= tau) { x = Kk[(((tau - sg) << 2) + hl) * 16 + hp0 + q]; if (sg == tau && hp0 + q == h) x += (hl == 0 ? dk0 : hl == 1 ? dk1 : hl == 2 ? dk2 : dk3); } v[q] = x; } }
            else { const int kp = k0 - 512, ri = kp >> 6, p0 = kp & 63;
#pragma unroll
                for (int q = 0; q < 8; ++q) { const int p = p0 + q; const float ar = Apr[(tau + 1) * 64 + p], ai = Api[(tau + 1) * 64 + p];
                    const float gr = Cr[h * 64 + p] * ar - Ci[h * 64 + p] * ai, gi = Cr[h * 64 + p] * ai + Ci[h * 64 + p] * ar; v[q] = ri ? -gi : gr; } }
            v4u o; o.x = pk2(v[0], v[1]); o.y = pk2(v[2], v[3]); o.z = pk2(v[4], v[5]); o.w = pk2(v[6], v[7]);
            *(v4u*)(BtC + ((size_t)g * 512 + tau * 16 + h) * 640 + k0) = o;
        }
        for (int e = tid; e < 32 * 64; e += NTHR) {
            const int rr = e >> 6, k0 = (e & 63) * 8; const int ri = rr >> 4, p = 16 * hq + (rr & 15), sg = k0 >> 4, hp0 = k0 & 15;
            const float ar = Apr[(31 - sg) * 64 + p], ai = Api[(31 - sg) * 64 + p];
            float v[8];
#pragma unroll
            for (int q = 0; q < 8; ++q) { const float br = Bbr[p * 16 + hp0 + q], bi = Bbi[p * 16 + hp0 + q]; v[q] = ri ? (ar * bi + ai * br) : (ar * br - ai * bi); }
            v4u o; o.x = pk2(v[0], v[1]); o.y = pk2(v[2], v[3]); o.z = pk2(v[4], v[5]); o.w = pk2(v[6], v[7]);
            *(v4u*)(BtA + ((size_t)g * 256 + ri * 64 + p) * 512 + k0) = o;
        }
        if (has1) norm4_finish(pv, g3, XN + (size_t)r1 * DM, F.lane);
    }
    {
        float4 pv[32];
        for (int r = gw4 + nbat * step4; r < T; r += step4) { norm4_load(xin + (size_t)r * DM, F.lane, pv); norm4_finish(pv, g3, XN + (size_t)r * DM, F.lane); }
    }
#undef S5_BAR
    __syncthreads();
}
__device__ __forceinline__ void p_s5_stepA(const Frame& F, const Args& A) {
    pg8::Gemm g{WSB(WS_UCAT), WSB(WS_BTA), NCH, 256, 512, UCK, 512, (long)NCH * UCK, (long)256 * 512, SG}; pg8::StaticOrder S; S.init(NCH, 256, F.G, F.bid, SG);
    pg8::EpiSl E{WSF(WS_SL)}; GEMM_RUN(pg8::EpiSl, true, g, S, E);
}
__device__ __forceinline__ void p4_s5_scan(const Frame& F, const Args& A) {
    const float* Sl = WSF(WS_SL); const float* AL = WSF(WS_AL); bf16* UC = WSB(WS_UCAT);
    if (F.wave >= 4) return;
    pg8::StaticOrder S; S.init(NCH, 512, F.G, F.bid, SG); pg8::Unit u;
    for (int i = 0; S.next(i, u); ++i) {
        const int p = F.lane, b = u.pm * 4 + F.wave, g = u.bz;
        const float ar = AL[(g * 64 + p) * 2], ai = AL[(g * 64 + p) * 2 + 1];
        const size_t row0 = (size_t)g * NCH + b * 64;
        float lr[64], li[64];
#pragma unroll
        for (int c = 0; c < 64; ++c) { lr[c] = Sl[(row0 + c) * 128 + p]; li[c] = Sl[(row0 + c) * 128 + 64 + p]; }
        asm volatile("" ::: "memory");
        float sr = 0.f, si = 0.f;
#pragma unroll
        for (int c = 0; c < 64; ++c) {
            bf16* up = UC + (row0 + c) * UCK + 512;
            up[p] = (bf16)f2bf(sr); up[64 + p] = (bf16)f2bf(si);
            const float nr = ar * sr - ai * si + lr[c], ni = ar * si + ai * sr + li[c];
            sr = nr; si = ni;
        }
    }
}
__device__ __forceinline__ void p5_s5_out(const Frame& F, const Args& A) {
    pg8::Gemm g{WSB(WS_UCAT), WSB(WS_BTC), NCH, 512, UCK, UCK, UCK, (long)NCH * UCK, (long)512 * UCK, SG}; pg8::StaticOrder S; S.init(NCH, 512, F.G, F.bid, SG);
    pg8::EpiS5 E{WSB(WS_GB)}; GEMM_RUN(pg8::EpiS5, true, g, S, E);
}
__device__ __forceinline__ void p10_xscores(const Frame& F, const Args& A) {
    for (int sel = 0; sel * F.G + F.bid < 256; ++sel) {
        pg8::Gemm g{WSB(WS_XQB), WSB(WS_KP), 2048, 256, 256, XW, 256, 0, 0, 1}; pg8::XsOrder S{F.G, F.bid, sel};
        pg8::EpiXs E{WSB(WS_XP), WSF(WS_LSUM)};
        pg8::gemm_phase<pg8::EpiXs, pg8::XsOrder, false, true>(F.ldsl, g, S, E);
        __syncthreads();
    }
}
__device__ __forceinline__ void p10_xpv(const Frame& F, const Args& A) {
    pg8::Gemm g{WSB(WS_XP), WSB(WS_VT2), 2048, 256, 256, 1024, 512, 0, 0, 1}; pg8::XoOrder S{F.G, F.bid};
    pg8::EpiXo E{WSB(WS_XO), WSF(WS_LSUM)};
    pg8::gemm_phase<pg8::EpiXo, pg8::XoOrder, true, true>(F.ldsl, g, S, E);
}
__device__ __forceinline__ unsigned f2key(float f) { const unsigned u = __float_as_uint(f); return (u & 0x80000000u) ? ~u : (u | 0x80000000u); }
__device__ __forceinline__ float key2f(unsigned k) { const unsigned u = (k & 0x80000000u) ? (k ^ 0x80000000u) : ~k; return __uint_as_float(u); }
#define INS16(L, xk) do { unsigned x_ = (xk); _Pragma("unroll") for (int s_ = 0; s_ < 16; ++s_) { const unsigned hi_ = L[s_] > x_ ? L[s_] : x_; x_ = L[s_] > x_ ? x_ : L[s_]; L[s_] = hi_; } } while (0)
#define CE_DESC(a_, b_) do { const unsigned hi_ = (a_) > (b_) ? (a_) : (b_), lo_ = (a_) > (b_) ? (b_) : (a_); (a_) = hi_; (b_) = lo_; } while (0)
__device__ __forceinline__ void sort16_desc(unsigned (&v)[16]) {
#pragma unroll
    for (int k = 2; k <= 16; k <<= 1)
#pragma unroll
        for (int j = k >> 1; j > 0; j >>= 1)
#pragma unroll
            for (int i = 0; i < 16; ++i) { const int l = i ^ j; if (l > i) { if ((i & k) == 0) CE_DESC(v[i], v[l]); else CE_DESC(v[l], v[i]); } }
}
__device__ __forceinline__ void merge16_desc(unsigned (&a)[16], const unsigned (&b)[16]) {
#pragma unroll
    for (int i = 0; i < 16; ++i) a[i] = a[i] > b[15 - i] ? a[i] : b[15 - i];
#pragma unroll
    for (int j = 8; j > 0; j >>= 1)
#pragma unroll
        for (int i = 0; i < 16; ++i) { const int l = i ^ j; if (l > i) CE_DESC(a[i], a[l]); }
}
__device__ __forceinline__ void top16_of_128(const float* sp, unsigned (&L)[16]) {
#pragma unroll 1
    for (int c = 0; c < 8; ++c) {
        unsigned ch[16];
#pragma unroll
        for (int i = 0; i < 16; ++i) ch[i] = (f2key(sp[(size_t)(c * 16 + i) * T]) & ~127u) | (unsigned)(127 - (c * 16 + i));
        sort16_desc(ch);
        if (c == 0) {
#pragma unroll
            for (int i = 0; i < 16; ++i) L[i] = ch[i];
        } else merge16_desc(L, ch);
    }
}
namespace pg8 {
struct TkOrder {
    int G, c, sel;
    __device__ __forceinline__ bool next(int i, Unit& u) const { if (i > 0) return false; const int L = sel * G + c; if (L >= PH * (T / BM)) return false; u.pm = 0; u.pn = L & (T / BM - 1); u.bz = L / (T / BM); return true; }
    __device__ __forceinline__ void a_ready(const Unit&) const {}
    __device__ __forceinline__ void done(const Unit&) const {}
    template <class G_> __device__ __forceinline__ long offA(const Unit& u, const G_& g) const { return (long)u.bz * g.sA; }
    template <class G_> __device__ __forceinline__ long offB(const Unit& u, const G_& g) const { return (long)u.bz * g.sB; }
};
struct EpiTopk {
    static constexpr bool PERM = false, AFTER_DRAIN = true;
    static constexpr int PITCH = 260;
    unsigned short* IDX; float* GATE;
    __device__ __forceinline__ void stage(const f32x4 (&acc)[2][2][4][2], int ai, int wr, int wc, int fr, int fq, PG8_LAS float* SCL) const {
#pragma unroll
        for (int m = 0; m < 4; ++m)
#pragma unroll
            for (int bj = 0; bj < 2; ++bj)
#pragma unroll
                for (int n = 0; n < 2; ++n) *(PG8_LAS f32x4*)(SCL + (wr * 64 + m * 16 + fr) * PITCH + bj * HALF + wc * 32 + n * 16 + 4 * fq) = acc[ai][bj][m][n];
    }
    static __device__ __forceinline__ unsigned blend(unsigned m, unsigned a, unsigned b) { return (a & m) | (b & ~m); }
    static __device__ __forceinline__ unsigned swap1(unsigned v) { return (unsigned)__builtin_amdgcn_update_dpp(0, (int)v, 0xB1, 0xF, 0xF, true); }
    __device__ __forceinline__ void top16(const PG8_LAS float* sp, int nb, unsigned (&L)[16]) const {
#pragma unroll 1
        for (int c = 0; c < 4; ++c) {
            unsigned ch[16];
#pragma unroll
            for (int i = 0; i < 16; ++i) ch[i] = (f2key(sp[(c * 16 + i) * PITCH]) & ~127u) | (unsigned)(nb - (c * 16 + i));
            sort16_desc(ch);
            if (c == 0) {
#pragma unroll
                for (int i = 0; i < 16; ++i) L[i] = ch[i];
            } else merge16_desc(L, ch);
        }
        unsigned P[16];
#pragma unroll
        for (int i = 0; i < 16; ++i) P[i] = swap1(L[i]);
        merge16_desc(L, P);
    }
    __device__ __forceinline__ void fused(f32x4 (&acc)[2][2][4][2], const Unit& u, int wr, int wc, int fr, int fq, PG8_LAS unsigned char* lds, int wid, int lane) const {
        PG8_LAS float* SCL = (PG8_LAS float*)lds;
        int ln = lane; asm volatile("" : "+v"(ln));
        const int tl = wid * 32 + (ln >> 1), kh = ln & 1; const unsigned km = 0u - (unsigned)kh;
        PG8_LAS unsigned char* li = lds + PK * PITCH * 4 + tl * 32;
        const PG8_LAS float* col = SCL + tl;
        float t1[16], t2[16];
        stage(acc, 0, wr, wc, fr, fq, SCL);
        asm volatile("s_waitcnt lgkmcnt(0)" ::: "memory"); __builtin_amdgcn_s_barrier(); asm volatile("" ::: "memory");
        { unsigned L1[16]; top16(col + kh * 64 * PITCH, 127 - kh * 64, L1);
#pragma unroll
          for (int s = 0; s < 16; ++s) { const int i1 = 127 - (int)(L1[s] & 127u); if (kh == 0) li[s] = (unsigned char)i1; t1[s] = col[i1 * PITCH]; } }
        asm volatile("s_waitcnt lgkmcnt(0)" ::: "memory"); __builtin_amdgcn_s_barrier(); asm volatile("" ::: "memory");
        stage(acc, 1, wr, wc, fr, fq, SCL);
        asm volatile("s_waitcnt lgkmcnt(0)" ::: "memory"); __builtin_amdgcn_s_barrier(); asm volatile("" ::: "memory");
        { unsigned L2[16]; top16(col + kh * 64 * PITCH, 127 - kh * 64, L2);
#pragma unroll
          for (int s = 0; s < 16; ++s) { const int i2 = 127 - (int)(L2[s] & 127u); if (kh == 0) li[16 + s] = (unsigned char)i2; t2[s] = col[i2 * PITCH]; } }
        unsigned Lc[16], c1[16];
        {
            int n = 0;
#pragma unroll
            for (int a = 0; a < 16; ++a)
#pragma unroll
                for (int m = 0; m < 8; ++m)
                    if ((a + 1) * (2 * m + 1) <= 16) {
                        const bool odd_ok = (a + 1) * (2 * m + 2) <= 16;
                        const float tb = __uint_as_float(blend(km, __float_as_uint(t2[(2 * m + 1) & 15]), __float_as_uint(t2[2 * m])));
                        unsigned k = (f2key(t1[a] + tb) & ~255u) | (unsigned)((255 - (a * 16 + 2 * m)) - kh);
                        if (!odd_ok) k = kh ? 0u : k;
                        if (n < 16) Lc[n] = k; else c1[n - 16] = k; ++n; }
            c1[14] = 0u; c1[15] = 0u;
        }
        sort16_desc(Lc); sort16_desc(c1); merge16_desc(Lc, c1);
        {
            unsigned P[16];
#pragma unroll
            for (int i = 0; i < 16; ++i) P[i] = swap1(Lc[i]);
            merge16_desc(Lc, P);
        }
        float ts[16]; const float mx = key2f(Lc[0] & ~255u); float sum = 0.f;
#pragma unroll
        for (int s = 0; s < 16; ++s) { ts[s] = expf(key2f(Lc[s] & ~255u) - mx); sum += ts[s]; }
        const float inv = 1.0f / sum;
        const size_t ob = (size_t)(u.pn * BM + tl) * 128 + u.bz * 16 + kh * 8;
        asm volatile("s_waitcnt lgkmcnt(0)" ::: "memory");
#pragma unroll
        for (int s = 0; s < 8; ++s) {
            const unsigned key = blend(km, Lc[8 + s], Lc[s]); const float tv = __uint_as_float(blend(km, __float_as_uint(ts[8 + s]), __float_as_uint(ts[s])));
            const int flat = 255 - (int)(key & 255u); const int a = flat >> 4, b = flat & 15;
            const int e1 = li[a], e2 = li[16 + b];
            IDX[ob + s] = (unsigned short)(e1 * PK + e2);
            GATE[ob + s] = tv * inv;
        }
    }
};
}

struct PeerCtx { int xr, nx, nloc, rank; };
__device__ __forceinline__ PeerCtx peer_ctx(const Frame& F, volatile LAS unsigned* MISC) {
    if (F.tid == 0) {
        unsigned* barw = (unsigned*)(F.ws + WS_CTL) + CW_BAR; const unsigned x = MISC[11];
        unsigned nx = 0, xr = 0, nloc = 1;
        for (unsigned j = 0; j < 16; ++j) { const unsigned c = xb_ld(&barw[XB_XCNT(j)]); if (c) { ++nx; if (j < x) ++xr; } if (j == x) nloc = c ? c : 1u; }
        MISC[12] = xr; MISC[13] = nx ? nx : 1u; MISC[14] = nloc;
    }
    __syncthreads();
    PeerCtx c; c.xr = (int)MISC[12]; c.nx = (int)MISC[13]; c.nloc = (int)MISC[14]; c.rank = (int)MISC[10];
    return c;
}
typedef __bf16 bf16x2 __attribute__((ext_vector_type(2)));
__device__ __forceinline__ float dot2_bf16(unsigned w, unsigned x, float acc) { return __builtin_amdgcn_fdot2_f32_bf16(__builtin_bit_cast(bf16x2, w), __builtin_bit_cast(bf16x2, x), acc, false); }
__device__ __forceinline__ float dot8(const v4u& r, const v4u& x) { float a = dot2_bf16(r.x, x.x, 0.f); a = dot2_bf16(r.y, x.y, a); a = dot2_bf16(r.z, x.z, a); return dot2_bf16(r.w, x.w, a); }
__device__ __forceinline__ float xl1(float x) { return __uint_as_float((unsigned)__builtin_amdgcn_update_dpp(0, (int)__float_as_uint(x), 0xB1, 0xF, 0xF, true)); }
__device__ __forceinline__ float xl2(float x) { return __uint_as_float((unsigned)__builtin_amdgcn_update_dpp(0, (int)__float_as_uint(x), 0x4E, 0xF, 0xF, true)); }
__device__ __forceinline__ float xl4(float x) { const int v = (int)__float_as_uint(x); int r = __builtin_amdgcn_update_dpp(0, v, 0x104, 0xF, 0x5, false); r = __builtin_amdgcn_update_dpp(r, v, 0x114, 0xF, 0xA, false); return __uint_as_float((unsigned)r); }
__device__ __forceinline__ float xl8(float x) { return __uint_as_float((unsigned)__builtin_amdgcn_update_dpp(0, (int)__float_as_uint(x), 0x128, 0xF, 0xF, true)); }
__device__ __forceinline__ float sum16x(float a, float b) { const auto r = __builtin_amdgcn_permlane16_swap(__float_as_uint(a), __float_as_uint(b), false, false); return __uint_as_float(r[0]) + __uint_as_float(r[1]); }
__device__ __forceinline__ float sum32x(float a, float b) { const auto r = __builtin_amdgcn_permlane32_swap(__float_as_uint(a), __float_as_uint(b), false, false); return __uint_as_float(r[0]) + __uint_as_float(r[1]); }
__device__ __forceinline__ float wave_sum_valu(float x) {
    x += xl1(x); x += xl2(x);
    x += __uint_as_float((unsigned)__builtin_amdgcn_update_dpp(0, (int)__float_as_uint(x), 0x141, 0xF, 0xF, true));
    x += __uint_as_float((unsigned)__builtin_amdgcn_update_dpp(0, (int)__float_as_uint(x), 0x140, 0xF, 0xF, true));
    x = sum16x(x, x); return sum32x(x, x);
}
#define RED8J(v0, v1, v2, v3, v4, v5, v6, v7, B2, B1, B0, out) do { \
    const float a0_ = ((B2) ? v4 : v0) + xl4((B2) ? v0 : v4), a1_ = ((B2) ? v5 : v1) + xl4((B2) ? v1 : v5); \
    const float a2_ = ((B2) ? v6 : v2) + xl4((B2) ? v2 : v6), a3_ = ((B2) ? v7 : v3) + xl4((B2) ? v3 : v7); \
    const float c0_ = ((B1) ? a2_ : a0_) + xl2((B1) ? a0_ : a2_), c1_ = ((B1) ? a3_ : a1_) + xl2((B1) ? a1_ : a3_); \
    out = ((B0) ? c1_ : c0_) + xl1((B0) ? c0_ : c1_); } while (0)
#define RED8G(v0, v1, v2, v3, v4, v5, v6, v7, B0, out) do { \
    const float a0_ = sum32x(v0, v4), a1_ = sum32x(v1, v5), a2_ = sum32x(v2, v6), a3_ = sum32x(v3, v7); \
    const float c0_ = sum16x(a0_, a2_), c1_ = sum16x(a1_, a3_); \
    out = ((B0) ? c1_ : c0_) + xl8((B0) ? c0_ : c1_); } while (0)
#define RED8(v0, v1, v2, v3, v4, v5, v6, v7, B2, B1, B0, X2, X1, X0, out) do { \
    const float a0_ = ((B2) ? v4 : v0) + __shfl_xor((B2) ? v0 : v4, X2), a1_ = ((B2) ? v5 : v1) + __shfl_xor((B2) ? v1 : v5, X2); \
    const float a2_ = ((B2) ? v6 : v2) + __shfl_xor((B2) ? v2 : v6, X2), a3_ = ((B2) ? v7 : v3) + __shfl_xor((B2) ? v3 : v7, X2); \
    const float c0_ = ((B1) ? a2_ : a0_) + __shfl_xor((B1) ? a0_ : a2_, X1), c1_ = ((B1) ? a3_ : a1_) + __shfl_xor((B1) ? a1_ : a3_, X1); \
    out = ((B0) ? c1_ : c0_) + __shfl_xor((B0) ? c0_ : c1_, X0); } while (0)
typedef float f32x2 __attribute__((ext_vector_type(2)));
struct PTok { unsigned ix[8]; v4u xa, xb; float oa, ob; };
#define PK_IDX(TK, k) (((k) & 1) ? (TK.ix[(k) >> 1] >> 16) : (TK.ix[(k) >> 1] & 0xffffu))
#define LD_IDX16(TK, ip_) do { _Pragma("unroll") for (int q_ = 0; q_ < 2; ++q_) { const int4 v_ = (ip_)[q_]; TK.ix[4 * q_] = (unsigned)v_.x; TK.ix[4 * q_ + 1] = (unsigned)v_.y; TK.ix[4 * q_ + 2] = (unsigned)v_.z; TK.ix[4 * q_ + 3] = (unsigned)v_.w; } } while (0)
__device__ __forceinline__ float dot16_fp8(const v4u& r, const f32x2 (&X)[8]) {
    f32x2 a = {0.f, 0.f};
#pragma unroll
    for (int q = 0; q < 4; ++q) { const f32x2 lo = __builtin_amdgcn_cvt_pk_f32_fp8((int)r[q], false), hi = __builtin_amdgcn_cvt_pk_f32_fp8((int)r[q], true);
        a = lo * X[2 * q] + a; a = hi * X[2 * q + 1] + a; }
    return a.x + a.y;
}
__device__ __forceinline__ void p17_peer_u(const Frame& F, const Args& A, volatile LAS unsigned* MISC) {
    const PeerCtx cx = peer_ctx(F, MISC);
    const unsigned char* UB = F.ws + WS_UB; const bf16* HB = WSB(WS_B); const unsigned short* IDX = (const unsigned short*)(F.ws + WS_IDX); float* PACT = WSF(WS_PACT) + (size_t)cx.xr * T * 128;
    const int lane = F.lane, j = lane & 7, g = lane >> 3;
    const bool b2 = lane & 4, b1 = lane & 2, b0 = lane & 1;
    const int NI = (T / 8 - cx.rank + cx.nloc - 1) / cx.nloc;
#define U_TOK(i_) (((cx.rank + (i_) * cx.nloc) * 8) + F.wave)
    for (int p = 0; cx.xr + cx.nx * p < NSL; ++p) {
        const int s = cx.xr + cx.nx * p;
        const __amdgpu_buffer_rsrc_t rs = __builtin_amdgcn_make_buffer_rsrc((void*)(UB + (size_t)s * (PK * PK) * SLW), 0, PK * PK * SLW, 0x00020000);
#define U_LOAD(TK, t_) do { const int4* ip_ = (const int4*)(IDX + (size_t)(t_) * 128 + 16 * g); LD_IDX16(TK, ip_); \
        TK.xa = *(const v4u*)(HB + (size_t)(t_) * DM + s * SLW + j * 16); TK.xb = *(const v4u*)(HB + (size_t)(t_) * DM + s * SLW + j * 16 + 8); \
        TK.oa = 0.f; TK.ob = 0.f; if (p != 0) { const float2 pp_ = *(const float2*)(PACT + (size_t)(t_) * 128 + 16 * g + 2 * j); TK.oa = pp_.x; TK.ob = pp_.y; } } while (0)
#define U_GATHER(R, TK) do { _Pragma("unroll") for (int k = 0; k < 16; ++k) R[k] = __builtin_amdgcn_raw_buffer_load_b128(rs, ((unsigned)PK_IDX(TK, k) << 7) + (unsigned)(j * 16), 0, 0); } while (0)
#define U_COMPUTE(R, XA, XB, OA, OB, t_) do { f32x2 X[8]; \
        _Pragma("unroll") for (int q = 0; q < 4; ++q) { X[q] = (f32x2){__uint_as_float(XA[q] << 16), __uint_as_float(XA[q] & 0xffff0000u)}; X[4 + q] = (f32x2){__uint_as_float(XB[q] << 16), __uint_as_float(XB[q] & 0xffff0000u)}; } \
        float v[16]; float f_; _Pragma("unroll") for (int k = 0; k < 16; ++k) v[k] = dot16_fp8(R[k], X); \
        float fe_; \
        RED8J(v[0], v[2], v[4], v[6], v[8], v[10], v[12], v[14], b2, b1, b0, fe_); \
        RED8J(v[1], v[3], v[5], v[7], v[9], v[11], v[13], v[15], b2, b1, b0, f_); \
        *(float2*)(PACT + (size_t)(t_) * 128 + 16 * g + 2 * j) = make_float2(OA + fe_, OB + f_); } while (0)
        PTok TA, TB; v4u RA[16], RB[16];
        if (NI > 0) U_LOAD(TA, U_TOK(0));
        if (NI > 1) U_LOAD(TB, U_TOK(1));
        if (NI > 0) U_GATHER(RA, TA);
        for (int i = 0; i < NI; i += 2) {
            { const v4u xa = TA.xa, xb = TA.xb; const float oa = TA.oa, ob = TA.ob;
              if (i + 2 < NI) U_LOAD(TA, U_TOK(i + 2));
              if (i + 1 < NI) U_GATHER(RB, TB);
              U_COMPUTE(RA, xa, xb, oa, ob, U_TOK(i)); }
            if (i + 1 < NI) {
                const v4u xa = TB.xa, xb = TB.xb; const float oa = TB.oa, ob = TB.ob;
                if (i + 3 < NI) U_LOAD(TB, U_TOK(i + 3));
                if (i + 2 < NI) U_GATHER(RA, TA);
                U_COMPUTE(RB, xa, xb, oa, ob, U_TOK(i + 1));
            }
        }
    }
#undef U_LOAD
#undef U_GATHER
#undef U_COMPUTE
#undef U_TOK
}
__device__ __forceinline__ void p18_peer_w(const Frame& F, const Args& A, volatile LAS unsigned* MISC) {
    const PeerCtx cx = peer_ctx(F, MISC);
    const float* PACT = WSF(WS_PACT); const float* GATE = WSF(WS_GATE); unsigned short* W = (unsigned short*)(F.ws + WS_PW);            const unsigned short* IDX = (const unsigned short*)(F.ws + WS_IDX);
    const float* iu = WSF(WS_ISCU); const float* iv = WSF(WS_ISCV); const float* ssq2 = WSF(WS_SSQ2);
    const size_t gt = (size_t)F.bid * NTHR + F.tid, NGT = (size_t)F.G * NTHR;
    for (size_t i = gt * 4; i < (size_t)T * 128; i += NGT * 4) {
        float4 a = make_float4(0.f, 0.f, 0.f, 0.f);
        for (int q0 = 0; q0 < cx.nx; q0 += 8) {
            float4 pa[8];
#pragma unroll
            for (int j = 0; j < 8; ++j) pa[j] = (q0 + j < cx.nx) ? *(const float4*)(PACT + (size_t)(q0 + j) * T * 128 + i) : make_float4(0.f, 0.f, 0.f, 0.f);
#pragma unroll
            for (int j = 0; j < 8; ++j) { a.x += pa[j].x; a.y += pa[j].y; a.z += pa[j].z; a.w += pa[j].w; }
        }
        const uint2 e2_ = *(const uint2*)(IDX + i); const int4 e = make_int4((int)(e2_.x & 0xffffu), (int)(e2_.x >> 16), (int)(e2_.y & 0xffffu), (int)(e2_.y >> 16)); const float4 gt4 = *(const float4*)(GATE + i);
        const float rs = 1.0f / sqrtf(ssq2[i >> 7] * (1.0f / 2048.0f) + EPS);
        float4 w;
        w.x = gt4.x * gelu_exact(a.x * iu[e.x] * rs) * iv[e.x]; w.y = gt4.y * gelu_exact(a.y * iu[e.y] * rs) * iv[e.y];
        w.z = gt4.z * gelu_exact(a.z * iu[e.z] * rs) * iv[e.z]; w.w = gt4.w * gelu_exact(a.w * iu[e.w] * rs) * iv[e.w];
        *(uint2*)(W + i) = make_uint2(pk2(w.x, w.y), pk2(w.z, w.w));
    }
}
struct VTok { unsigned ix[8]; unsigned w[8]; float h0, h1; };
__device__ __forceinline__ void p19_peer_v(const Frame& F, const Args& A, volatile LAS unsigned* MISC) {
    const PeerCtx cx = peer_ctx(F, MISC);
    const unsigned char* VT = F.ws + WS_VT; float* SSQP = WSF(WS_SSQP);
    const __amdgpu_buffer_rsrc_t rsI = __builtin_amdgcn_make_buffer_rsrc((void*)(F.ws + WS_IDX), 0, T * 128 * 2, 0x00020000);
    const __amdgpu_buffer_rsrc_t rsW = __builtin_amdgcn_make_buffer_rsrc((void*)(F.ws + WS_PW), 0, T * 128 * 2, 0x00020000);
    const __amdgpu_buffer_rsrc_t rsHB = __builtin_amdgcn_make_buffer_rsrc((void*)(F.ws + WS_B), 0, T * DM * 2, 0x00020000);
    const int lane = F.lane, j = lane & 7, g = lane >> 3;
    const bool b5 = lane & 32, b4 = lane & 16, b3 = lane & 8;
    const int NI = (T / 8 - cx.rank + cx.nloc - 1) / cx.nloc;
#define U_TOK(i_) (((cx.rank + (i_) * cx.nloc) * 8) + F.wave)
    for (int p = 0; cx.xr + cx.nx * p < NSL; ++p) {
        const int s = cx.xr + cx.nx * p;
        const __amdgpu_buffer_rsrc_t rs = __builtin_amdgcn_make_buffer_rsrc((void*)(VT + (size_t)s * (PK * PK) * SLW), 0, PK * PK * SLW, 0x00020000);
        const unsigned hoff = (unsigned)(s * SLW + 16 * j + 2 * g) * 2u;
#define V_LOAD(TK, t_) do { const unsigned io_ = ((unsigned)(t_) * 128u + 16u * g) * 2u; \
        _Pragma("unroll") for (int q_ = 0; q_ < 2; ++q_) { const v4u v_ = __builtin_amdgcn_raw_buffer_load_b128(rsI, io_ + 16u * q_, 0, 0); TK.ix[4 * q_] = v_[0]; TK.ix[4 * q_ + 1] = v_[1]; TK.ix[4 * q_ + 2] = v_[2]; TK.ix[4 * q_ + 3] = v_[3]; } \
        _Pragma("unroll") for (int q_ = 0; q_ < 2; ++q_) { const v4u v_ = __builtin_amdgcn_raw_buffer_load_b128(rsW, io_ + 16u * q_, 0, 0); TK.w[4 * q_] = v_[0]; TK.w[4 * q_ + 1] = v_[1]; TK.w[4 * q_ + 2] = v_[2]; TK.w[4 * q_ + 3] = v_[3]; } \
        const unsigned hb_ = (unsigned)(t_) * (DM * 2u) + hoff; const unsigned hw_ = (unsigned)__builtin_amdgcn_raw_buffer_load_b32(rsHB, hb_, 0, 0); TK.h0 = __uint_as_float(hw_ << 16); TK.h1 = __uint_as_float(hw_ & 0xffff0000u); } while (0)
#define V_GATHER(R, TK) do { _Pragma("unroll") for (int k = 0; k < 16; ++k) R[k] = __builtin_amdgcn_raw_buffer_load_b128(rs, ((unsigned)PK_IDX(TK, k) << 7) + (unsigned)(j * 16), 0, 0); } while (0)
#define V_COMPUTE(R, WQ, H0, H1, t_) do { f32x2 acc[8]; _Pragma("unroll") for (int q = 0; q < 8; ++q) acc[q] = (f32x2){0.f, 0.f}; \
        _Pragma("unroll") for (int k = 0; k < 16; ++k) { const unsigned wd_ = WQ[k >> 1]; const float wk_ = __uint_as_float((k & 1) ? (wd_ & 0xffff0000u) : (wd_ << 16)); const f32x2 w2 = (f32x2){wk_, wk_}; \
            _Pragma("unroll") for (int q = 0; q < 4; ++q) { const f32x2 lo = __builtin_amdgcn_cvt_pk_f32_fp8((int)R[k][q], false), hi = __builtin_amdgcn_cvt_pk_f32_fp8((int)R[k][q], true); \
                acc[2 * q] = lo * w2 + acc[2 * q]; acc[2 * q + 1] = hi * w2 + acc[2 * q + 1]; } } \
        float f0_, f1_; \
        RED8G(acc[0].x, acc[1].x, acc[2].x, acc[3].x, acc[4].x, acc[5].x, acc[6].x, acc[7].x, b3, f0_); \
        RED8G(acc[0].y, acc[1].y, acc[2].y, acc[3].y, acc[4].y, acc[5].y, acc[6].y, acc[7].y, b3, f1_); \
        const unsigned hb2_ = (unsigned)(t_) * (DM * 2u) + hoff; const float n0_ = H0 + f0_, n1_ = H1 + f1_; \
        __builtin_amdgcn_raw_buffer_store_b32(pk2(n0_, n1_), rsHB, hb2_, 0, 0); \
        const float s0_ = wave_sum_valu(n0_ * n0_ + n1_ * n1_); if (lane == 0) SSQP[(size_t)s * T + (t_)] = s0_; } while (0)
        VTok TA, TB; v4u RA[16], RB[16];
        if (NI > 0) V_LOAD(TA, U_TOK(0));
        if (NI > 1) V_LOAD(TB, U_TOK(1));
        if (NI > 0) V_GATHER(RA, TA);
        for (int i = 0; i < NI; i += 2) {
            { const float h0 = TA.h0, h1 = TA.h1; unsigned wv[8];
              _Pragma("unroll") for (int q = 0; q < 8; ++q) wv[q] = TA.w[q];
              if (i + 2 < NI) V_LOAD(TA, U_TOK(i + 2));
              if (i + 1 < NI) V_GATHER(RB, TB);
              V_COMPUTE(RA, wv, h0, h1, U_TOK(i)); }
            if (i + 1 < NI) {
                const float h0 = TB.h0, h1 = TB.h1; unsigned wv[8];
                _Pragma("unroll") for (int q = 0; q < 8; ++q) wv[q] = TB.w[q];
                if (i + 3 < NI) V_LOAD(TB, U_TOK(i + 3));
                if (i + 2 < NI) V_GATHER(RA, TA);
                V_COMPUTE(RB, wv, h0, h1, U_TOK(i + 1));
            }
        }
    }
#undef V_LOAD
#undef V_GATHER
#undef V_COMPUTE
#undef U_TOK
}
__device__ __forceinline__ void p20_final(const Frame& F, const Args& A) {
    float* O = F.out; const bf16* HB = WSB(WS_B); const float* fg = IN_F(33); const float* SSQP = WSF(WS_SSQP);
    const int gw = F.bid * NWAVES + F.wave, NGW = F.G * NWAVES, lane = F.lane;
    for (int t = gw; t < T; t += NGW) {
        float sq = 0.f;
#pragma unroll
        for (int sl = 0; sl < NSL; ++sl) sq += SSQP[(size_t)sl * T + t];
        const float r = 1.0f / sqrtf(sq / (float)DM + EPS);
#pragma unroll
        for (int q = 0; q < 4; ++q) { const int c = 512 * q + 8 * lane; const v4u h = *(const v4u*)(HB + (size_t)t * DM + c);
            const float4 g0 = *(const float4*)(fg + c), g1 = *(const float4*)(fg + c + 4);
            ntst4(O + (size_t)t * DM + c, make_float4(__uint_as_float(h.x << 16) * r * g0.x, __uint_as_float(h.x & 0xffff0000u) * r * g0.y, __uint_as_float(h.y << 16) * r * g0.z, __uint_as_float(h.y & 0xffff0000u) * r * g0.w));
            ntst4(O + (size_t)t * DM + c + 4, make_float4(__uint_as_float(h.z << 16) * r * g1.x, __uint_as_float(h.z & 0xffff0000u) * r * g1.y, __uint_as_float(h.w << 16) * r * g1.z, __uint_as_float(h.w & 0xffff0000u) * r * g1.w)); }
    }
}
__device__ __forceinline__ void p0_prep(const Frame& F, const Args& A) {
    const int gw = F.bid * NWAVES + F.wave, NGW = F.G * NWAVES, lane = F.lane;
    LAS float* scr = (LAS float*)(F.ldsl + F.wave * 16384);
    constexpr int I_IN = 32 * 128, I_GLU = 16 * 32, I_OUT = 32 * 64, I_XQ = 32 * 16, I_XKV = 32 * 32, I_XO = 8 * 64, I_PQ = 32 * 64;
    constexpr int NITEMS = I_IN + I_GLU + I_OUT + I_XQ + I_XKV + I_XO + I_PQ;
    for (int it = gw; it < NITEMS; it += NGW) {
        int r = it;
        if (r < I_IN) { p0_transpose_item(IN_F(4), DM, INC, WSB(WS_WIN), 0, scr, r, lane); continue; } r -= I_IN;
        if (r < I_GLU) { p0_transpose_item(IN_F(18), SSMW, SSMW, WSB(WS_WGLU), 0, scr, r, lane); continue; } r -= I_GLU;
        if (r < I_OUT) { p0_transpose_item(IN_F(21), DM, DM, WSB(WS_WOUT), 0, scr, r, lane, IN_F(20), 1024); continue; } r -= I_OUT;
        if (r < I_XQ) { p0_transpose_item(IN_F(24), DM, XW, WSB(WS_WXQ), 0, scr, r, lane, IN_F(22)); continue; } r -= I_XQ;
        if (r < I_XKV) { p0_transpose_item(IN_F(25), DM, 2 * XW, WSB(WS_WXKV), 0, scr, r, lane); continue; } r -= I_XKV;
        if (r < I_XO) { p0_transpose_item(IN_F(26), XW, DM, WSB(WS_WXO), 0, scr, r, lane); continue; } r -= I_XO;
        p0_transpose_item(IN_F(28), DM, PH * PQD, WSB(WS_WPQ), 0, scr, r, lane, IN_F(27));
    }
    const float* x = IN_F(0); const float* mem = IN_F(1);
    { const float* g3 = IN_F(3); bf16* XN = WSB(WS_B);
      (void)x; (void)g3; (void)XN; }
    { const float* g23 = IN_F(23); bf16* MN = WSB(WS_MN);
      for (int r = 2 * gw; r < BATCH * NMEM; r += 2 * NGW) { norm_2rows_to_bf16(mem + (size_t)r * DM, g23, MN + (size_t)r * DM, lane); } }
    const int* pos = IN_I(2); float* rope = WSF(WS_ROPE);
    const int gt = F.bid * NTHR + F.tid, NGT = F.G * NTHR;
    for (int e = gt; e < T * 8; e += NGT) {
        const int t = e >> 3, i = e & 7;
        const float freq = expf(-(float)i * (13.122363377404328f / 8.0f));
        const float a = (float)pos[t] * freq;
        rope[e * 2 + 0] = cosf(a); rope[e * 2 + 1] = sinf(a);
    }
    if (gt == 0) {
        const float* q1 = IN_F(5); const float* k1 = IN_F(6); const float* q2 = IN_F(7); const float* k2 = IN_F(8);
        float s1 = 0.f, s2 = 0.f;
        for (int i = 0; i < 64; ++i) { s1 += q1[i] * k1[i]; s2 += q2[i] * k2[i]; }
        *WSF(WS_LAM) = expf(s1) - expf(s2) + LAM_INIT;
    }
    bf16* KD = WSB(WS_KD); const float* k1 = IN_F(29); const float* k2 = IN_F(30);
    for (int e = gt; e < PH * 256 * 256; e += NGT) {
        const int kk = e & 255, nn = (e >> 8) & 255, h = e >> 16;
        float v = 0.f;
        if ((kk >> 7) == (nn >> 7)) { const float* ks = (nn >> 7) ? k2 : k1; v = ks[((size_t)h * PK + (nn & 127)) * 128 + (kk & 127)]; }
        KD[e] = (bf16)f2bf(v);
    }
}
__device__ __forceinline__ void p1_win(const Frame& F, const Args& A) {
    { pg8::Gemm g{WSB(WS_B), WSB(WS_WIN), T, INC, DM, DM, DM, 0, 0, 1}; pg8::StaticOrder S; S.init(T, INC, F.G, F.bid); pg8::EpiWin E{WSB(WS_QB), (size_t)(WS_KB - WS_QB) / 2, WSB(WS_UCAT), WSF(WS_ROPE), attn_body::C2}; GEMM_RUN(pg8::EpiWin, true, g, S, E); }
}
__device__ __forceinline__ void p5_glu(const Frame& F, const Args& A) {
    pg8::Gemm g{WSB(WS_GB), WSB(WS_WGLU), T, SSMW, SSMW, SSMW, SSMW, 0, 0, 1}; pg8::StaticOrder S; S.init(T, SSMW, F.G, F.bid);
    pg8::EpiGlu E{WSB(WS_GB), IN_F(19), WSB(WS_B), WSF(WS_SSQ)}; GEMM_RUN(pg8::EpiGlu, true, g, S, E);
}

__device__ __forceinline__ void p5_tables(const Frame& F, const Args& A) {
    unsigned char* UB = F.ws + WS_UB; unsigned char* VT = F.ws + WS_VT;
    const float* Uin = IN_F(31); const float* Vin = IN_F(32); const float* gfn = IN_F(27); float* iscu = WSF(WS_ISCU); float* iscv = WSF(WS_ISCV);
    const int gw = F.bid * NWAVES + F.wave, NGW = F.G * NWAVES, lane = F.lane;
    for (int it = 2 * gw; it < 2 * PK * PK; it += 2 * NGW) {
        const int tb = it >= PK * PK, e = tb ? it - PK * PK : it;
        const float* src = (tb ? Vin : Uin) + (size_t)e * DM; unsigned char* dst = tb ? VT : UB; float* isc = tb ? iscv : iscu;
        float4 v[16]; float am0 = 0.f, am1 = 0.f;
#pragma unroll
        for (int q = 0; q < 16; ++q) v[q] = ntld4(src + (q >> 3) * DM + 256 * (q & 7) + 4 * lane);
        if (!tb) {
#pragma unroll
            for (int q = 0; q < 8; ++q) { const float4 g4 = *(const float4*)(gfn + 256 * q + 4 * lane);
                v[q].x *= g4.x; v[q].y *= g4.y; v[q].z *= g4.z; v[q].w *= g4.w; v[8 + q].x *= g4.x; v[8 + q].y *= g4.y; v[8 + q].z *= g4.z; v[8 + q].w *= g4.w; }
        }
#pragma unroll
        for (int q = 0; q < 8; ++q) { am0 = fmaxf(am0, fmaxf(fmaxf(fabsf(v[q].x), fabsf(v[q].y)), fmaxf(fabsf(v[q].z), fabsf(v[q].w))));
                                      am1 = fmaxf(am1, fmaxf(fmaxf(fabsf(v[8 + q].x), fabsf(v[8 + q].y)), fmaxf(fabsf(v[8 + q].z), fabsf(v[8 + q].w)))); }
        am0 = wave_max(am0); am1 = wave_max(am1);
        float sc0 = 1.0f, sc1 = 1.0f;
        if (am0 > 1e-30f) sc0 = __uint_as_float(__float_as_uint(448.0f / am0) & 0x7f800000u);
        if (am1 > 1e-30f) sc1 = __uint_as_float(__float_as_uint(448.0f / am1) & 0x7f800000u);
        if (lane == 0) { isc[e] = 1.0f / sc0; isc[e + 1] = 1.0f / sc1; }
#pragma unroll
        for (int q = 0; q < 16; ++q) {
            const float sc = q < 8 ? sc0 : sc1; int w = 0;
            w = __builtin_amdgcn_cvt_pk_fp8_f32(v[q].x * sc, v[q].y * sc, w, false);
            w = __builtin_amdgcn_cvt_pk_fp8_f32(v[q].z * sc, v[q].w * sc, w, true);
            const int c = 256 * (q & 7) + 4 * lane;
            *(int*)(dst + ((size_t)(c >> 7) * (PK * PK) + e + (q >> 3)) * SLW + (c & 127)) = w;
        }
    }
}
__device__ __forceinline__ void p7_wout(const Frame& F, const Args& A) {
    pg8::Gemm g{WSB(WS_B), WSB(WS_WOUT), T, DM, DM, DM, DM, 0, 0, 1}; pg8::StaticOrder S; S.init(T, DM, F.G, F.bid);
    pg8::EpiWout E{IN_F(0), WSB(WS_HB2), WSF(WS_SSQ1), DM, WSF(WS_SSQ), 16}; GEMM_RUN(pg8::EpiWout, true, g, S, E);
}
__device__ __forceinline__ void p9_xq(const Frame& F, const Args& A) {
    pg8::Gemm g{WSB(WS_HB2), WSB(WS_WXQ), T, XW, DM, DM, DM, 0, 0, 1}; pg8::StaticOrder S; S.init(T, XW, F.G, F.bid);
    pg8::EpiRowBf16 E{WSB(WS_XQB), XW, WSF(WS_SSQ1), 0.08838834764831845f}; GEMM_RUN(pg8::EpiRowBf16, true, g, S, E);
    { pg8::Gemm g2{WSB(WS_MN), WSB(WS_WXKV), BATCH * NMEM, 2 * XW, DM, DM, DM, 0, 0, 1}; pg8::StaticOrder S2; S2.init(BATCH * NMEM, 2 * XW, F.G, F.G - 1 - F.bid); pg8::EpiXkv E2{WSB(WS_KP), WSB(WS_VT2)}; GEMM_RUN(pg8::EpiXkv, true, g2, S2, E2); }
}
__device__ __forceinline__ void p11_xo(const Frame& F, const Args& A) {
    pg8::Gemm g{WSB(WS_XO), WSB(WS_WXO), T, DM, XW, XW, XW, 0, 0, 1}; pg8::StaticOrder S; S.init(T, DM, F.G, F.bid);
    pg8::EpiResidB<false> E{WSB(WS_HB2), WSB(WS_B), WSF(WS_SSQ2), DM}; GEMM_RUN(pg8::EpiResidB<false>, true, g, S, E);
}
__device__ __forceinline__ void p13_pq(const Frame& F, const Args& A) {
    pg8::Gemm g{WSB(WS_B), WSB(WS_WPQ), T, PH * PQD, DM, DM, DM, 0, 0, 1}; pg8::StaticOrder S; S.init(T, PH * PQD, F.G, F.bid);
    pg8::EpiRowBf16 E{WSB(WS_PQ), PH * PQD, WSF(WS_SSQ2), 1.0f}; GEMM_RUN(pg8::EpiRowBf16, true, g, S, E);
}
__device__ __forceinline__ void p14_scores(const Frame& F, const Args& A) {
    for (int sel = 0; sel * F.G + F.bid < PH * (T / 256); ++sel) {
        pg8::Gemm g{WSB(WS_KD), WSB(WS_PQ), 256, T, 256, 256, PH * PQD, 65536, 256, PH}; pg8::TkOrder S{F.G, F.bid, sel};
        pg8::EpiTopk E{(unsigned short*)(F.ws + WS_IDX), WSF(WS_GATE)};
        pg8::gemm_phase<pg8::EpiTopk, pg8::TkOrder, false, true>(F.ldsl, g, S, E);
        __syncthreads();
    }
}

constexpr int NPHASE = 15;
__global__ void __launch_bounds__(NTHR, 2) mk_fwd(Args args) {
    extern __shared__ __attribute__((aligned(16))) unsigned char lds[];
#define MKFRAME() Frame F; { int t_ = threadIdx.x; asm volatile("" : "+v"(t_)); F.lds = lds; F.ldsl = (LAS unsigned char*)lds; F.tid = t_; F.lane = t_ & 63; F.wave = __builtin_amdgcn_readfirstlane(t_ >> 6); \
    F.G = gridDim.x; F.bid = blockIdx.x; F.ws = args.ws; F.out = args.out; }
    volatile LAS unsigned* MISC = (volatile LAS unsigned*)((LAS unsigned char*)lds + MISC_OFF);
    if (threadIdx.x < 32) MISC[threadIdx.x] = 0u;
    __syncthreads();
    (void)xcd_barrier_post((unsigned*)(args.ws + WS_CTL) + CW_BAR, MISC + 8);
    if (threadIdx.x == 0) { const unsigned x = xb_xcc_id(); MISC[11] = x; MISC[10] = xb_add((unsigned*)(args.ws + WS_CTL) + CW_TICKET + 64 * x, 1u); }
    const int lo = args.ph_lo, hi = args.ph_hi;
#define IN(k) (lo <= (k) && (k) < hi)
#define SEAM(k) do { if (IN(k) && IN((k) + 1)) { XcdBarrier b_; b_.bar = (unsigned*)(args.ws + WS_CTL) + CW_BAR; b_.x = 0; b_.st = MISC + 8; xcd_barrier(b_); } } while (0)
    if (IN(0)) { MKFRAME(); p0_prep(F, args); __syncthreads(); p0_s5_setup(F, args); }  SEAM(0);
    if (IN(1)) { MKFRAME(); p1_win(F, args); }             SEAM(1);
    if (IN(2)) { MKFRAME(); p3_attn(F, args); }            SEAM(2);
    if (IN(3)) { MKFRAME(); p4_s5_scan(F, args); }
    { int g3_ = __builtin_amdgcn_readfirstlane(IN(3) ? 1 : 0); asm volatile("s_waitcnt vmcnt(0)" : "+s"(g3_) :: "memory"); __syncthreads(); if (g3_) { MKFRAME(); p5_s5_out(F, args); } }   SEAM(3);
    if (IN(4)) { MKFRAME(); p5_glu(F, args); p5_tables(F, args); }  SEAM(4);
    if (IN(5)) { MKFRAME(); p7_wout(F, args); }            SEAM(5);
    if (IN(6)) { MKFRAME(); p9_xq(F, args); }              SEAM(6);
    if (IN(7)) { MKFRAME(); p10_xscores(F, args); }
    { int g8_ = __builtin_amdgcn_readfirstlane(IN(7) ? 1 : 0); asm volatile("s_waitcnt vmcnt(0)" : "+s"(g8_) :: "memory"); __syncthreads(); if (g8_) { MKFRAME(); p10_xpv(F, args); } }   SEAM(7);
    if (IN(8)) { MKFRAME(); p11_xo(F, args); }            SEAM(8);
    if (IN(9)) { MKFRAME(); p13_pq(F, args); }            SEAM(9);
    if (IN(10)) { MKFRAME(); p14_scores(F, args); }        SEAM(10);
    if (IN(11)) { MKFRAME(); p17_peer_u(F, args, MISC); }  SEAM(11);
    if (IN(12)) { MKFRAME(); p18_peer_w(F, args, MISC); }  SEAM(12);
    if (IN(13)) { MKFRAME(); p19_peer_v(F, args, MISC); }  SEAM(13);
    if (IN(14)) { MKFRAME(); p20_final(F, args); }
#undef IN
#undef SEAM
}
extern "C" void kernel_launch(void* const* d_in, const int* in_sizes, int n_in, void* d_out, int out_size, void* d_ws, size_t ws_size, hipStream_t stream) {
    static int grid = 0;
    if (grid == 0) {
        if (n_in != 34 || out_size != T * DM || ws_size < WS_END) { fprintf(stderr, "kernel_launch: unexpected shapes n_in %d out %d ws %zu\n", n_in, out_size, ws_size); grid = -1; return; }
        int dev = 0, cus = 0;
        if (hipGetDevice(&dev) != hipSuccess || hipDeviceGetAttribute(&cus, hipDeviceAttributeMultiprocessorCount, dev) != hipSuccess) { grid = -1; return; }
        if (hipFuncSetAttribute((const void*)mk_fwd, hipFuncAttributeMaxDynamicSharedMemorySize, LDS_BYTES) != hipSuccess) { fprintf(stderr, "kernel_launch: hipFuncSetAttribute failed\n"); grid = -1; return; }
        int per_cu = 0;
        (void)hipOccupancyMaxActiveBlocksPerMultiprocessor(&per_cu, (const void*)mk_fwd, NTHR, LDS_BYTES);
        (void)hipGetLastError();
        grid = cus;
    }
    if (grid < 0) return;
    (void)hipMemsetAsync((char*)d_ws + WS_CTL, 0, CTL_ZERO_BYTES, stream);
    Args a{};
    for (int i = 0; i < 34; ++i) a.in[i] = d_in[i];
    a.out = (float*)d_out; a.ws = (unsigned char*)d_ws;
    a.ph_lo = 0; a.ph_hi = NPHASE; a.li = 0;
    hipLaunchKernelGGL(mk_fwd, dim3(grid), dim3(NTHR), LDS_BYTES, stream, a);
}
```

```cpp
#include <hip/hip_runtime.h>
#include <hip/hip_bf16.h>
#include <cstdio>
#include <cstdint>
#include <cmath>

constexpr int BATCH = 8, SEQ = 2048, DM = 2048, T = BATCH * SEQ;
constexpr int NMEM = 256;
constexpr float EPS = 1e-6f;
constexpr int ATTW = 1024, SSMW = 1024, INC = 4096;
constexpr int NH = 8;
constexpr int SG = 64, SP = 64;
constexpr int XH = 4, XD = 128, XW = 512;
constexpr int PH = 8, PK = 128, PQD = 256, PTOP = 16;
constexpr float LAM_INIT = 0.2f;

#ifndef MK_ONE_LAUNCH
#define MK_ONE_LAUNCH 1
#endif

constexpr int NWAVES = 8, NTHR = 512;
constexpr int LDS_BYTES = 147456;
constexpr int MISC_OFF = 147456 - 512;

constexpr size_t MiB = 1u << 20;
constexpr size_t WS_CTL = 0, CTL_ZERO_BYTES = 1 * MiB;
constexpr size_t WS_RSTD0 = 1 * MiB, WS_RSTDM = WS_RSTD0 + 65536, WS_RSTD1 = WS_RSTDM + 65536, WS_RSTD2 = WS_RSTD1 + 65536, WS_LAM = WS_RSTD2 + 65536;
constexpr size_t WS_ROPE = 2 * MiB;
constexpr size_t WS_WIN = 8 * MiB, WS_WGLU = 24 * MiB, WS_WOUT = 26 * MiB, WS_WXQ = 34 * MiB, WS_WXKV = 36 * MiB, WS_WXO = 40 * MiB, WS_WPQ = 42 * MiB, WS_KD = 50 * MiB;
constexpr size_t WS_UCAT = 56 * MiB, WS_BTC = 96 * MiB, WS_BTA = 136 * MiB, WS_QB = 152 * MiB, WS_KB = 184 * MiB, WS_VB = 216 * MiB, WS_O0 = 248 * MiB, WS_O1 = 280 * MiB;
constexpr size_t WS_UB = 56 * MiB, WS_VT = 120 * MiB, WS_XQ = 184 * MiB, WS_SC = 184 * MiB;
constexpr size_t WS_B = 312 * MiB;
constexpr size_t WS_SL = 376 * MiB, WS_IDX = 376 * MiB, WS_GATE = 384 * MiB;
constexpr size_t WS_GB = 392 * MiB, WS_XO = 392 * MiB;
constexpr size_t WS_PQ = 424 * MiB;
constexpr size_t WS_HB2 = 408 * MiB;
constexpr size_t WS_XKV = 472 * MiB;
constexpr size_t WS_MN = 480 * MiB;
constexpr size_t WS_END = 488 * MiB;
constexpr size_t WS_SSQ = 128 * 1024;
constexpr size_t WS_SSQ3 = 512 * 1024;
constexpr size_t WS_X8 = 152 * MiB;
constexpr size_t WS_XS = 3 * MiB;
constexpr size_t WS_SSQP = 2 * MiB;
constexpr size_t WS_SSQ1 = 704 * 1024, WS_SSQ2 = 768 * 1024;
constexpr int CW_TICKET = 160 * 1024;
constexpr size_t WS_PACT = 184 * MiB, WS_PW = 248 * MiB;
constexpr size_t WS_ISCU = 4 * MiB, WS_ISCV = 4 * MiB + 65536;
constexpr int NSL = 16, SLW = 128;
constexpr size_t WS_LSUM = 256 * 1024;
constexpr size_t WS_KP = 472 * MiB, WS_VT2 = 476 * MiB;
constexpr size_t WS_XQB = 184 * MiB, WS_XP = 200 * MiB;
constexpr size_t WS_AL = WS_LAM + 4096;
constexpr int S5L = 32, NCH = T / S5L, UCK = 640;
constexpr int CW_BAR = 4096;

#define GAS __attribute__((address_space(1)))
#define LAS __attribute__((address_space(3)))
typedef GAS unsigned gu32;
#define RLX_AGENT __ATOMIC_RELAXED, __HIP_MEMORY_SCOPE_AGENT

#define XB_TMO      128
#define XB_XCNT(j)  (256  + 64 * (j))
#define XB_XSUB(j)  (1280 + 64 * (j))
#define XB_XGEN(j)  (2304 + 64 * (j))
#define XB_TOP      3328
#define XB_TOPGEN   3392
#define XCD_BAR_WORDS 3456
#define XB_SPIN_CAP (1u << 26)
__device__ __forceinline__ unsigned xb_ld(unsigned* p)              { return __hip_atomic_load(p, __ATOMIC_RELAXED, __HIP_MEMORY_SCOPE_AGENT); }
__device__ __forceinline__ unsigned xb_add(unsigned* p, unsigned v) { return __hip_atomic_fetch_add(p, v, __ATOMIC_RELAXED, __HIP_MEMORY_SCOPE_AGENT); }
__device__ __forceinline__ unsigned xb_xcc_id() { return (unsigned)__builtin_amdgcn_s_getreg((3 << 11) | 20) & 0xFu; }
#define XB_SPIN(cond, bar) do { unsigned _sp = 0; while (cond) { __builtin_amdgcn_s_sleep(1); \
    if ((++_sp & 255u) == 0u) { if (xb_ld(&(bar)[XB_TMO])) break; if (_sp > XB_SPIN_CAP) { atomicAdd(&(bar)[XB_TMO], 1u); break; } } } } while (0)
struct XcdBarrier { unsigned* bar; unsigned x; volatile LAS unsigned* st; };
__device__ __forceinline__ XcdBarrier xcd_barrier_post(unsigned* bar, volatile LAS unsigned* st) {
    XcdBarrier b; b.bar = bar; b.x = xb_xcc_id(); b.st = st;
    if (threadIdx.x == 0) (void)xb_add(&bar[XB_XCNT(b.x)], 1u);
    return b;
}
__device__ __forceinline__ void xcd_barrier_complete(unsigned* bar, unsigned x, unsigned& nloc, unsigned& nx) {
    const unsigned G = gridDim.x * gridDim.y * gridDim.z;
    unsigned sum, cnt, mine, sp = 0u;
    for (;;) {
        sum = 0u; cnt = 0u; mine = 0u;
#pragma unroll
        for (unsigned j = 0; j < 16; ++j) { const unsigned c = xb_ld(&bar[XB_XCNT(j)]); sum += c; cnt += (c > 0u) ? 1u : 0u; mine = (j == x) ? c : mine; }
        if (sum == G) break;
        __builtin_amdgcn_s_sleep(1);
        if ((++sp & 255u) == 0u) { if (xb_ld(&bar[XB_TMO])) break; if (sp > XB_SPIN_CAP) { atomicAdd(&bar[XB_TMO], 1u); break; } }
    }
    nloc = mine > 0u ? mine : 1u; nx = cnt > 0u ? cnt : 1u;
}
__device__ __forceinline__ void xcd_barrier(const XcdBarrier& b) {
    asm volatile("s_waitcnt vmcnt(0)" ::: "memory");
    __syncthreads();
    if (threadIdx.x == 0) {
        unsigned* bar = b.bar;
        __builtin_amdgcn_s_waitcnt(0);
        unsigned nloc = b.st[0], nx = b.st[1]; const unsigned bx = b.st[3];
        if (nloc == 0u) { xcd_barrier_complete(bar, bx, nloc, nx); b.st[0] = nloc; b.st[1] = nx; }
        const unsigned old = xb_add(&bar[XB_XSUB(bx)], 1u);
        const unsigned gen = old / nloc;
        if (old + 1u == (gen + 1u) * nloc) {
            __builtin_amdgcn_fence(__ATOMIC_RELEASE, "agent");
            asm volatile("s_waitcnt vmcnt(0)" ::: "memory");
            const unsigned og = xb_add(&bar[XB_TOP], 1u);
            const unsigned tg = og / nx;
            if (og + 1u == (tg + 1u) * nx) xb_add(&bar[XB_TOPGEN], 1u);
            else XB_SPIN(xb_ld(&bar[XB_TOPGEN]) == tg, bar);
            __builtin_amdgcn_fence(__ATOMIC_ACQUIRE, "agent");
            xb_add(&bar[XB_XGEN(bx)], 1u);
            asm volatile("s_waitcnt vmcnt(0)" ::: "memory");
        } else {
            XB_SPIN(xb_ld(&bar[XB_XGEN(bx)]) == gen, bar);
            __builtin_amdgcn_fence(__ATOMIC_ACQUIRE, "agent");
            asm volatile("s_waitcnt vmcnt(0)" ::: "memory");
        }
    }
    __syncthreads();
}

struct Args { const void* in[34]; float* out; unsigned char* ws; int ph_lo, ph_hi, li, pad; };
struct Frame {
    unsigned char* lds;
    LAS unsigned char* ldsl;
    int tid, lane, wave, G, bid;
    float* out;
    unsigned char* ws;
};
__device__ __forceinline__ float wave_sum(float v) {
#pragma unroll
    for (int o = 1; o < 64; o <<= 1) v += __shfl_xor(v, o);
    return v;
}
__device__ __forceinline__ float wave_max(float v) {
#pragma unroll
    for (int o = 1; o < 64; o <<= 1) v = fmaxf(v, __shfl_xor(v, o));
    return v;
}
__device__ __forceinline__ float gelu_exact(float x) { return 0.5f * x * (1.0f + erff(x * 0.70710678118654752f)); }

__device__ __forceinline__ const void* ldarg(int byte_off) {
    const void* p; auto k = __builtin_amdgcn_kernarg_segment_ptr();
    asm volatile("s_load_dwordx2 %0, %1, %2\n\ts_waitcnt lgkmcnt(0)" : "=s"(p) : "s"(k), "i"(byte_off) : "memory");
    return p;
}
#define IN_F(i) ((const float*)ldarg((i) * 8))
#define IN_I(i) ((const int*)ldarg((i) * 8))
#define WSF(off) ((float*)(F.ws + (off)))


typedef float nt_f4 __attribute__((ext_vector_type(4)));
__device__ __forceinline__ float4 ntld4(const float* p) { const nt_f4 v = __builtin_nontemporal_load((const GAS nt_f4*)p); return make_float4(v[0], v[1], v[2], v[3]); }
__device__ __forceinline__ void ntst4(float* p, float4 v) { const nt_f4 w = {v.x, v.y, v.z, v.w}; __builtin_nontemporal_store(w, (GAS nt_f4*)p); }
typedef unsigned short bf16;
typedef unsigned v4u __attribute__((ext_vector_type(4)));
__device__ __forceinline__ unsigned f2bf(float f) { unsigned u = __builtin_bit_cast(unsigned, f); return (u + 0x7fffu + ((u >> 16) & 1u)) >> 16; }
__device__ __forceinline__ unsigned pk2(float lo, float hi) { return f2bf(lo) | (f2bf(hi) << 16); }
__device__ __forceinline__ float bf2f(unsigned short b) { return __uint_as_float((unsigned)b << 16); }
#define WSB(off) ((bf16*)(F.ws + (off)))
#define LDS_WAIT() asm volatile("s_waitcnt lgkmcnt(0)" ::: "memory")

__device__ __forceinline__ void norm_2rows_to_bf16(const float* xrow, const float* g, bf16* orow, int lane) {
    float4 v[16]; float s0 = 0.f, s1 = 0.f;
#pragma unroll
    for (int j = 0; j < 16; ++j) v[j] = ntld4(xrow + (j >> 3) * DM + 256 * (j & 7) + 4 * lane);
#pragma unroll
    for (int j = 0; j < 8; ++j) { s0 += v[j].x * v[j].x + v[j].y * v[j].y + v[j].z * v[j].z + v[j].w * v[j].w; s1 += v[8 + j].x * v[8 + j].x + v[8 + j].y * v[8 + j].y + v[8 + j].z * v[8 + j].z + v[8 + j].w * v[8 + j].w; }
    s0 = wave_sum(s0); s1 = wave_sum(s1);
    const float r0 = 1.0f / sqrtf(s0 / (float)DM + EPS), r1 = 1.0f / sqrtf(s1 / (float)DM + EPS);
#pragma unroll
    for (int j = 0; j < 8; ++j) { const float4 g4 = *(const float4*)(g + 256 * j + 4 * lane);
        *(unsigned long long*)(orow + 256 * j + 4 * lane) = (unsigned long long)pk2(v[j].x * r0 * g4.x, v[j].y * r0 * g4.y) | ((unsigned long long)pk2(v[j].z * r0 * g4.z, v[j].w * r0 * g4.w) << 32);
        *(unsigned long long*)(orow + DM + 256 * j + 4 * lane) = (unsigned long long)pk2(v[8 + j].x * r1 * g4.x, v[8 + j].y * r1 * g4.y) | ((unsigned long long)pk2(v[8 + j].z * r1 * g4.z, v[8 + j].w * r1 * g4.w) << 32); }
}
__device__ __forceinline__ void norm4_load(const float* xrow, int lane, float4 (&v)[32]) {
#pragma unroll
    for (int j = 0; j < 32; ++j) v[j] = ntld4(xrow + (j >> 3) * DM + 256 * (j & 7) + 4 * lane);
}
__device__ __forceinline__ void norm4_finish(const float4 (&v)[32], const float* g, bf16* orow, int lane) {
    float s[4] = {0.f, 0.f, 0.f, 0.f};
#pragma unroll
    for (int j = 0; j < 32; ++j) s[j >> 3] += v[j].x * v[j].x + v[j].y * v[j].y + v[j].z * v[j].z + v[j].w * v[j].w;
    float r[4];
#pragma unroll
    for (int q = 0; q < 4; ++q) { s[q] = wave_sum(s[q]); r[q] = 1.0f / sqrtf(s[q] / (float)DM + EPS); }
#pragma unroll
    for (int j = 0; j < 8; ++j) { const float4 g4 = *(const float4*)(g + 256 * j + 4 * lane);
#pragma unroll
        for (int q = 0; q < 4; ++q) { const float4 w = v[8 * q + j]; const float rq = r[q];
            *(unsigned long long*)(orow + q * DM + 256 * j + 4 * lane) = (unsigned long long)pk2(w.x * rq * g4.x, w.y * rq * g4.y) | ((unsigned long long)pk2(w.z * rq * g4.z, w.w * rq * g4.w) << 32); } }
}
__device__ __forceinline__ void p0_transpose_item(const float* W, int K, int N, bf16* WT, int row_off, LAS float* scr, int item, int lane, const float* gain = nullptr, int goff = 0) {
    const int nblk = N / 32, kb = item / nblk, nb = item % nblk, k0 = 64 * kb, n0 = 32 * nb;
    float4 v[8];
#pragma unroll
    for (int i = 0; i < 8; ++i) v[i] = ntld4(W + (size_t)(k0 + 8 * i + (lane >> 3)) * N + n0 + 4 * (lane & 7));
#pragma unroll
    for (int i = 0; i < 8; ++i) { const int kk = 8 * i + (lane >> 3); const float gk = (gain && k0 + kk >= goff) ? gain[k0 + kk - goff] : 1.0f; LAS float* d = scr + kk * 33 + 4 * (lane & 7);
        d[0] = v[i].x * gk; d[1] = v[i].y * gk; d[2] = v[i].z * gk; d[3] = v[i].w * gk; }
    LDS_WAIT(); asm volatile("" ::: "memory");
    const int c = lane & 7;
#pragma unroll
    for (int j = 0; j < 4; ++j) { const int n = (lane >> 3) + 8 * j; const LAS float* s = scr + (8 * c) * 33 + n;
        v4u o; o.x = pk2(s[0 * 33], s[1 * 33]); o.y = pk2(s[2 * 33], s[3 * 33]); o.z = pk2(s[4 * 33], s[5 * 33]); o.w = pk2(s[6 * 33], s[7 * 33]);
        *(GAS v4u*)(WT + (size_t)(row_off + n0 + n) * K + k0 + 8 * c) = o; }
    LDS_WAIT(); asm volatile("" ::: "memory");
}
namespace pg8 {
#define PG8_LAS __attribute__((address_space(3)))
typedef unsigned short bf16_t;
typedef short bf16x8 __attribute__((ext_vector_type(8)));
typedef float f32x4 __attribute__((ext_vector_type(4)));
typedef unsigned u32x4 __attribute__((ext_vector_type(4)));
constexpr int BM = 256, BK = 64, HALF = 128, HTB = HALF * BK * 2  , STAGE_BYTES = 8 * HTB, NXCD = 8, WGM = 8;

__host__ __device__ __forceinline__ int lds_byte(int r, int c) { const int st = (r >> 4) * 2 + (c >> 5), rr = r & 15, cc = c & 31, ob = rr * 64 + cc * 2; return st * 1024 + (ob ^ (((ob >> 9) & 1) << 5)); }
__host__ __device__ __forceinline__ void stage_rc(int b, int& R, int& C) { const int st = b / 1024, sb = b % 1024, swz = sb ^ (((sb >> 9) & 1) << 5); R = (st >> 1) * 16 + swz / 64; C = (st & 1) * 32 + (swz % 64) / 2; }
__host__ __device__ __forceinline__ int perm32(int rho) { const int n = rho >> 4, i = rho & 15; return 8 * (i >> 2) + 4 * n + (i & 3); }

struct Unit { int pm, pn, bz; };
struct Gemm { const bf16_t* A; const bf16_t* Bt; int M, N, K; int lda, ldb; long sA, sB; int nb; };

struct StaticOrder {
    int nM, nN, nwg, G, c;
    int nb, per; __host__ __device__ void init(int M, int N, int G_, int c_, int nb_ = 1) { nM = M / BM; nN = N / BM; nb = nb_; per = nM * nN; nwg = per * nb; G = G_; c = c_; }
    __host__ __device__ bool next(int i, Unit& u) const {
        const long L = (long)i * G + c; if (L >= nwg) return false;
        int wgid = (int)L; { const int q = nwg / NXCD, r = nwg % NXCD, xcd = wgid % NXCD, off = wgid / NXCD; wgid = (xcd < r ? xcd * (q + 1) : r * (q + 1) + (xcd - r) * q) + off; }
        u.bz = wgid / per; wgid -= u.bz * per; const int nig = WGM * nN, gid = wgid / nig, fm = gid * WGM, gsz = (nM - fm) < WGM ? (nM - fm) : WGM;
        u.pm = fm + ((wgid % nig) % gsz); u.pn = (wgid % nig) / gsz; return true;
    }
    __device__ __forceinline__ void a_ready(const Unit&) const {}
    __device__ __forceinline__ void done(const Unit&) const {}
    template <class G_> __device__ __forceinline__ long offA(const Unit& u, const G_& g) const { return (long)u.bz * g.sA; }
    template <class G_> __device__ __forceinline__ long offB(const Unit& u, const G_& g) const { return (long)u.bz * g.sB; }
};

__device__ __forceinline__ unsigned cvt_pk_bf16(float lo, float hi) { unsigned r; asm volatile("v_cvt_pk_bf16_f32 %0, %1, %2" : "=v"(r) : "v"(lo), "v"(hi)); return r; }
typedef float f32x2 __attribute__((ext_vector_type(2)));
__device__ __forceinline__ f32x2 gelu_pk(f32x2 v) {
    const f32x2 av = __builtin_elementwise_abs(v), d = av * 0.2316418882f + 1.0f;
    f32x2 t; t.x = __builtin_amdgcn_rcpf(d.x); t.y = __builtin_amdgcn_rcpf(d.y);
    f32x2 q = t * 0.5307027145f + (-0.7265760135f); q = q * t + 0.7107068705f; q = q * t + (-0.142248368f); q = q * t + 0.127414796f; q = q * t;
    const f32x2 s = (v * v) * (-0.72134752044f);
    f32x2 e; e.x = __builtin_amdgcn_exp2f(s.x); e.y = __builtin_amdgcn_exp2f(s.y);
    const f32x2 m = v * (q * e), r = v - m;
    f32x2 o; o.x = v.x < 0.f ? m.x : r.x; o.y = v.y < 0.f ? m.y : r.y; return o;
}

template <int ACT  > struct EpiBf16 {
    static constexpr bool PERM = true, AFTER_DRAIN = false; static_assert(ACT == 0 || ACT == 1, "EpiBf16: ACT is 0 (none) or 1 (gelu_pk)");
    bf16_t* O; int ldc; const float* bias; int split_cols; size_t split_stride; float scale0;
    __device__ __forceinline__ void operator()(const f32x4 (&acc)[2][2][4][2], const Unit& u, int wr, int wc, int fr, int fq) const {
        const int row0 = u.pm * BM + wr * 64 + fr; int colt = u.pn * BM; bf16_t* base = O;
        float sc = 1.f; if (split_cols) { const int t = colt / split_cols; base += (size_t)t * split_stride; colt -= t * split_cols; if (t == 0) sc = scale0; }
        const int col0 = colt + wc * 32 + 8 * fq, bcol0 = u.pn * BM + wc * 32 + 8 * fq;
        f32x4 bv[2][2];
#pragma unroll
        for (int bj = 0; bj < 2; ++bj)
#pragma unroll
            for (int n = 0; n < 2; ++n) bv[bj][n] = bias ? *(const f32x4*)(bias + bcol0 + bj * HALF + 4 * n) : (f32x4){0.f, 0.f, 0.f, 0.f};
#pragma unroll
        for (int ai = 0; ai < 2; ++ai)
#pragma unroll
            for (int m = 0; m < 4; ++m) { bf16_t* rowp = base + (size_t)(row0 + ai * HALF + m * 16) * ldc + col0;
#pragma unroll
                for (int bj = 0; bj < 2; ++bj) { f32x4 v0 = acc[ai][bj][m][0] + bv[bj][0], v1 = acc[ai][bj][m][1] + bv[bj][1];
                    if (ACT == 1) { f32x2 a = gelu_pk((f32x2){v0[0], v0[1]}), b = gelu_pk((f32x2){v0[2], v0[3]}), c = gelu_pk((f32x2){v1[0], v1[1]}), d = gelu_pk((f32x2){v1[2], v1[3]});
                        v0 = (f32x4){a.x, a.y, b.x, b.y}; v1 = (f32x4){c.x, c.y, d.x, d.y}; }
                    v0 = v0 * sc; v1 = v1 * sc; u32x4 w; w.x = cvt_pk_bf16(v0[0], v0[1]); w.y = cvt_pk_bf16(v0[2], v0[3]); w.z = cvt_pk_bf16(v1[0], v1[1]); w.w = cvt_pk_bf16(v1[2], v1[3]);
                    *(u32x4*)(rowp + bj * HALF) = w; } }
    }
};
template <class T, class = void> struct MidK { static constexpr bool v = false; };
template <class T> struct MidK<T, decltype((void)T::MIDK)> { static constexpr bool v = T::MIDK; };
template <class Epi, class Sched, bool ALIGN_EPI = false, bool SP2 = false>
__device__ __forceinline__ void gemm_phase(PG8_LAS unsigned char* lds, const Gemm g, const Sched& S, const Epi& E) {
    const int tid = threadIdx.x, wid = __builtin_amdgcn_readfirstlane(tid >> 6), lane = tid & 63, wr = wid >> 2, wc = wid & 3, fr = lane & 15, fq = lane >> 4;
    const int K = g.K, nt = K / BK;
    unsigned voffA[2], voffB[2];
#pragma unroll
    for (int i = 0; i < 2; ++i) { int R, C; stage_rc(tid * 16 + i * 8192, R, C); const int Rb = Epi::PERM ? ((R & ~31) + perm32(R & 31)) : R;
        voffA[i] = (unsigned)(R * g.lda + C) * 2u; voffB[i] = (unsigned)(Rb * g.ldb + C) * 2u; }
    const size_t kstep = (size_t)(BK * 2);
    const size_t hstepA = (size_t)HALF * g.lda * 2, hstepB = (size_t)HALF * g.ldb * 2;
    const size_t tstepA = 2 * hstepA, tstepB = 2 * hstepB;
    const unsigned ldsw = (unsigned)wid * 1024u;
    const int aoff = lds_byte(wr * 64 + fr, fq * 8), boff = lds_byte(wc * 32 + fr, fq * 8);
#define PG8_SA(b, h) (((b) * 2 + (h)) * HTB)
#define PG8_SB(b, h) ((4 + (b) * 2 + (h)) * HTB)
#define PG8_STAGE(bufoff, gbase, voff) do { _Pragma("unroll") for (int _i = 0; _i < 2; ++_i) \
        __builtin_amdgcn_global_load_lds((const unsigned*)((const char*)(gbase) + (voff)[_i]), (PG8_LAS unsigned*)(lds + (bufoff) + ldsw + _i * 8192), 16, 0, 0); } while (0)
#define PG8_LDA(dst, b, h) do { _Pragma("unroll") for (int m = 0; m < 4; ++m) _Pragma("unroll") for (int k = 0; k < 2; ++k) dst[m][k] = *(const PG8_LAS bf16x8*)(lds + PG8_SA(b, h) + aoff + m * 2048 + k * 1024); } while (0)
#define PG8_LDB(dst, b, h) do { _Pragma("unroll") for (int n = 0; n < 2; ++n) _Pragma("unroll") for (int k = 0; k < 2; ++k) dst[n][k] = *(const PG8_LAS bf16x8*)(lds + PG8_SB(b, h) + boff + n * 2048 + k * 1024); } while (0)
#define PG8_MMA(ai, bj, At, Bt) do { __builtin_amdgcn_s_setprio(1); _Pragma("unroll") for (int m = 0; m < 4; ++m) _Pragma("unroll") for (int n = 0; n < 2; ++n) _Pragma("unroll") for (int k = 0; k < 2; ++k) \
        acc[ai][bj][m][n] = __builtin_amdgcn_mfma_f32_16x16x32_bf16(Bt[n][k], At[m][k], acc[ai][bj][m][n], 0, 0, 0); __builtin_amdgcn_s_setprio(0); } while (0)
#define PG8_WAIT_V(n) asm volatile("s_waitcnt vmcnt(" #n ")" ::: "memory")
#define PG8_WAIT_L(n) asm volatile("s_waitcnt lgkmcnt(" #n ")" ::: "memory")
#define PG8_BAR __builtin_amdgcn_s_barrier()
#define PG8_SCHED __builtin_amdgcn_sched_barrier(0)
    Unit cur, nxt; int ui = 0;
    if (!S.next(0, cur)) return;
    f32x4 acc[2][2][4][2];
#pragma unroll
    for (int a = 0; a < 2; ++a)
#pragma unroll
        for (int b = 0; b < 2; ++b)
#pragma unroll
            for (int m = 0; m < 4; ++m)
#pragma unroll
                for (int n = 0; n < 2; ++n) acc[a][b][m][n] = (f32x4){0.f, 0.f, 0.f, 0.f};
    bf16x8 At[4][2], B0[2][2], B1[2][2];
    const char* cA = (const char*)g.A + (size_t)S.offA(cur, g) * 2 + (size_t)cur.pm * tstepA; const char* cB = (const char*)g.Bt + (size_t)S.offB(cur, g) * 2 + (size_t)cur.pn * tstepB;
    S.a_ready(cur);
    if constexpr (SP2) {
        PG8_STAGE(PG8_SB(0, 0), cB, voffB); PG8_STAGE(PG8_SB(0, 1), cB + hstepB, voffB); PG8_STAGE(PG8_SA(0, 0), cA, voffA); PG8_STAGE(PG8_SA(0, 1), cA + hstepA, voffA);
        if (wr == 1) PG8_BAR;
        PG8_WAIT_V(2); PG8_BAR;
        PG8_STAGE(PG8_SB(1, 0), cB + kstep, voffB); PG8_STAGE(PG8_SA(1, 0), cA + kstep, voffA); PG8_STAGE(PG8_SB(1, 1), cB + hstepB + kstep, voffB);
        PG8_WAIT_V(6); PG8_BAR;
    } else {
        PG8_STAGE(PG8_SB(0, 0), cB, voffB); PG8_STAGE(PG8_SA(0, 0), cA, voffA); PG8_STAGE(PG8_SB(0, 1), cB + hstepB, voffB); PG8_STAGE(PG8_SA(0, 1), cA + hstepA, voffA);
        if (wr == 1) PG8_BAR;
        PG8_WAIT_V(4); PG8_BAR;
        PG8_STAGE(PG8_SB(1, 0), cB + kstep, voffB); PG8_STAGE(PG8_SA(1, 0), cA + kstep, voffA); PG8_STAGE(PG8_SB(1, 1), cB + hstepB + kstep, voffB);
        PG8_WAIT_V(6); PG8_BAR;
    }
    for (;;) {
        const bool has_next = S.next(ui + 1, nxt);
        const char* nA = has_next ? (const char*)g.A + (size_t)S.offA(nxt, g) * 2 + (size_t)nxt.pm * tstepA : cA; const char* nB = has_next ? (const char*)g.Bt + (size_t)S.offB(nxt, g) * 2 + (size_t)nxt.pn * tstepB : cB;
        for (int t = 0; t < nt; t += 2) {
            if constexpr (MidK<Epi>::v) { if (t == E.midk_t) E.midk(acc, cur, wr, wc, fr, fq); }
            const bool last = (t == nt - 2);
            const char* a1 = cA + (size_t)(t + 1) * kstep;
            const char* a2 = last ? nA : cA + (size_t)(t + 2) * kstep; const char* b2 = last ? nB : cB + (size_t)(t + 2) * kstep;
            const char* a3 = a2 + kstep; const char* b3 = b2 + kstep;
            if (last && has_next) S.a_ready(nxt);
            if constexpr (SP2) {
            PG8_LDB(B0, 0, 0); PG8_LDB(B1, 0, 1); PG8_SCHED; PG8_LDA(At, 0, 0); PG8_STAGE(PG8_SA(1, 1), a1 + hstepA, voffA);
            PG8_WAIT_V(8); PG8_WAIT_L(0); PG8_BAR; PG8_MMA(0, 0, At, B0); PG8_MMA(0, 1, At, B1); PG8_BAR; PG8_SCHED;
            PG8_LDA(At, 0, 1); PG8_STAGE(PG8_SB(0, 0), b2, voffB); PG8_STAGE(PG8_SB(0, 1), b2 + hstepB, voffB); PG8_STAGE(PG8_SA(0, 0), a2, voffA);
            PG8_WAIT_V(8); PG8_WAIT_L(0); PG8_BAR; PG8_MMA(1, 0, At, B0); PG8_MMA(1, 1, At, B1); PG8_BAR; PG8_SCHED;
            PG8_LDB(B0, 1, 0); PG8_LDB(B1, 1, 1); PG8_SCHED; PG8_LDA(At, 1, 0); PG8_STAGE(PG8_SA(0, 1), a2 + hstepA, voffA);
            PG8_WAIT_V(8); PG8_WAIT_L(0); PG8_BAR; PG8_MMA(0, 0, At, B0); PG8_MMA(0, 1, At, B1); PG8_BAR; PG8_SCHED;
            PG8_LDA(At, 1, 1); PG8_STAGE(PG8_SB(1, 0), b3, voffB); PG8_STAGE(PG8_SB(1, 1), b3 + hstepB, voffB); PG8_STAGE(PG8_SA(1, 0), a3, voffA);
            PG8_WAIT_V(8); PG8_WAIT_L(0); PG8_BAR; PG8_MMA(1, 0, At, B0); PG8_MMA(1, 1, At, B1); PG8_BAR; PG8_SCHED;
            } else {
            PG8_LDB(B0, 0, 0); PG8_SCHED; PG8_LDA(At, 0, 0); PG8_STAGE(PG8_SA(1, 1), a1 + hstepA, voffA);
            PG8_WAIT_L(8); PG8_BAR; PG8_WAIT_L(0); PG8_MMA(0, 0, At, B0); PG8_BAR; PG8_SCHED;
            PG8_LDB(B1, 0, 1); PG8_STAGE(PG8_SB(0, 0), b2, voffB);
            PG8_BAR; PG8_WAIT_L(0); PG8_MMA(0, 1, At, B1); PG8_BAR;
            PG8_LDA(At, 0, 1); PG8_STAGE(PG8_SA(0, 0), a2, voffA);
            PG8_BAR; PG8_WAIT_L(0); PG8_MMA(1, 0, At, B0); PG8_BAR; PG8_SCHED;
            PG8_STAGE(PG8_SB(0, 1), b2 + hstepB, voffB);
            PG8_WAIT_V(6); PG8_BAR; PG8_MMA(1, 1, At, B1); PG8_BAR;
            PG8_LDB(B0, 1, 0); PG8_SCHED; PG8_LDA(At, 1, 0); PG8_STAGE(PG8_SA(0, 1), a2 + hstepA, voffA);
            PG8_WAIT_L(8); PG8_BAR; PG8_WAIT_L(0); PG8_MMA(0, 0, At, B0); PG8_BAR; PG8_SCHED;
            PG8_LDB(B1, 1, 1); PG8_STAGE(PG8_SB(1, 0), b3, voffB);
            PG8_BAR; PG8_WAIT_L(0); PG8_MMA(0, 1, At, B1); PG8_BAR;
            PG8_LDA(At, 1, 1); PG8_STAGE(PG8_SA(1, 0), a3, voffA);
            PG8_BAR; PG8_WAIT_L(0); PG8_MMA(1, 0, At, B0); PG8_BAR; PG8_SCHED;
            PG8_STAGE(PG8_SB(1, 1), b3 + hstepB, voffB);
            PG8_WAIT_V(6); PG8_BAR; PG8_MMA(1, 1, At, B1); PG8_BAR;
            }
        }
        if constexpr (ALIGN_EPI) { if (wr == 0) PG8_BAR; }
        if constexpr (!Epi::AFTER_DRAIN) { E(acc, cur, wr, wc, fr, fq); S.done(cur); }
        if (!has_next) break;
#pragma unroll
        for (int a = 0; a < 2; ++a)
#pragma unroll
            for (int b = 0; b < 2; ++b)
#pragma unroll
                for (int m = 0; m < 4; ++m)
#pragma unroll
                    for (int n = 0; n < 2; ++n) acc[a][b][m][n] = (f32x4){0.f, 0.f, 0.f, 0.f};
        cur = nxt; cA = nA; cB = nB; ++ui;
        if constexpr (ALIGN_EPI) { if (wr == 1) PG8_BAR; }
    }
    PG8_WAIT_V(0);
    if constexpr (!ALIGN_EPI) { if (wr == 0) PG8_BAR; }
    PG8_BAR;
    if constexpr (Epi::AFTER_DRAIN) { E.fused(acc, cur, wr, wc, fr, fq, lds, wid, lane); S.done(cur); }
#undef PG8_SA
#undef PG8_SB
#undef PG8_STAGE
#undef PG8_LDA
#undef PG8_LDB
#undef PG8_MMA
#undef PG8_WAIT_V
#undef PG8_WAIT_L
#undef PG8_BAR
#undef PG8_SCHED
}
}

namespace pg8 {
struct EpiF32 {
    static constexpr bool PERM = false, AFTER_DRAIN = false;
    float* C; int ldc; const float* resid; long sC;
    __device__ __forceinline__ void operator()(const f32x4 (&acc)[2][2][4][2], const Unit& u, int wr, int wc, int fr, int fq) const {
        const int row0 = u.pm * BM + wr * 64 + fr, col0 = u.pn * BM + wc * 32 + 4 * fq;
        float* base = C + (size_t)u.bz * sC;
#pragma unroll
        for (int ai = 0; ai < 2; ++ai)
#pragma unroll
            for (int m = 0; m < 4; ++m) { const size_t ro = (size_t)(row0 + ai * HALF + m * 16) * ldc;
#pragma unroll
                for (int bj = 0; bj < 2; ++bj)
#pragma unroll
                    for (int n = 0; n < 2; ++n) { const size_t o = ro + col0 + bj * HALF + n * 16; f32x4 v = acc[ai][bj][m][n];
                        if (resid) v += *(const f32x4*)(resid + o);
                        *(f32x4*)(base + o) = v; } }
    }
};


template <bool RF32> struct EpiResidB {
    static constexpr bool PERM = true, AFTER_DRAIN = false;
    const void* resid; bf16_t* HB; float* ssq; int ldc;
    __device__ __forceinline__ void operator()(const f32x4 (&acc)[2][2][4][2], const Unit& u, int wr, int wc, int fr, int fq) const {
        const int row0 = u.pm * BM + wr * 64 + fr, col0 = u.pn * BM + wc * 32 + 8 * fq;
#pragma unroll
        for (int ai = 0; ai < 2; ++ai)
#pragma unroll
            for (int m = 0; m < 4; ++m) { const int r = row0 + ai * HALF + m * 16; const size_t ro = (size_t)r * ldc + col0; float ss = 0.f;
#pragma unroll
                for (int bj = 0; bj < 2; ++bj) { const size_t o = ro + bj * HALF; f32x4 v0 = acc[ai][bj][m][0], v1 = acc[ai][bj][m][1];
                    if (RF32) { v0 += *(const f32x4*)((const float*)resid + o); v1 += *(const f32x4*)((const float*)resid + o + 4); }
                    else { const u32x4 rb = *(const u32x4*)((const bf16_t*)resid + o);
                        v0[0] += __uint_as_float(rb.x << 16); v0[1] += __uint_as_float(rb.x & 0xffff0000u); v0[2] += __uint_as_float(rb.y << 16); v0[3] += __uint_as_float(rb.y & 0xffff0000u);
                        v1[0] += __uint_as_float(rb.z << 16); v1[1] += __uint_as_float(rb.z & 0xffff0000u); v1[2] += __uint_as_float(rb.w << 16); v1[3] += __uint_as_float(rb.w & 0xffff0000u); }
                    ss += (v0[0] * v0[0] + v0[1] * v0[1]) + (v0[2] * v0[2] + v0[3] * v0[3]) + (v1[0] * v1[0] + v1[1] * v1[1]) + (v1[2] * v1[2] + v1[3] * v1[3]);
                    u32x4 w; w.x = cvt_pk_bf16(v0[0], v0[1]); w.y = cvt_pk_bf16(v0[2], v0[3]); w.z = cvt_pk_bf16(v1[0], v1[1]); w.w = cvt_pk_bf16(v1[2], v1[3]);
                    *(u32x4*)(HB + o) = w; }
                ss += __shfl_xor(ss, 16); ss += __shfl_xor(ss, 32);
                if (fq == 0) atomicAdd(ssq + r, ss); }
    }
};

struct EpiWout {
    static constexpr bool PERM = true, AFTER_DRAIN = false, MIDK = true;
    const float* resid; bf16_t* HB; float* ssq; int ldc; const float* ssq_ssm; int midk_t;
    __device__ __forceinline__ void midk(f32x4 (&acc)[2][2][4][2], const Unit& u, int wr, int wc, int fr, int fq) const {
        const int row0 = u.pm * BM + wr * 64 + fr;
#pragma unroll
        for (int ai = 0; ai < 2; ++ai)
#pragma unroll
            for (int m = 0; m < 4; ++m) { const float ir = sqrtf(ssq_ssm[row0 + ai * HALF + m * 16] * (1.0f / 1024.0f) + 1e-6f);
#pragma unroll
                for (int bj = 0; bj < 2; ++bj) { acc[ai][bj][m][0] *= ir; acc[ai][bj][m][1] *= ir; } }
    }
    __device__ __forceinline__ void operator()(const f32x4 (&acc)[2][2][4][2], const Unit& u, int wr, int wc, int fr, int fq) const {
        const int row0 = u.pm * BM + wr * 64 + fr, col0 = u.pn * BM + wc * 32 + 8 * fq;
#pragma unroll
        for (int ai = 0; ai < 2; ++ai)
#pragma unroll
            for (int m = 0; m < 4; ++m) { const int r = row0 + ai * HALF + m * 16; const size_t ro = (size_t)r * ldc + col0; float ss = 0.f;
                const float rs = 1.0f / sqrtf(ssq_ssm[r] * (1.0f / 1024.0f) + 1e-6f);
#pragma unroll
                for (int bj = 0; bj < 2; ++bj) { const size_t o = ro + bj * HALF;
                    const f32x4 v0 = acc[ai][bj][m][0] * rs + *(const f32x4*)(resid + o), v1 = acc[ai][bj][m][1] * rs + *(const f32x4*)(resid + o + 4);
                    ss += (v0[0] * v0[0] + v0[1] * v0[1]) + (v0[2] * v0[2] + v0[3] * v0[3]) + (v1[0] * v1[0] + v1[1] * v1[1]) + (v1[2] * v1[2] + v1[3] * v1[3]);
                    u32x4 w; w.x = cvt_pk_bf16(v0[0], v0[1]); w.y = cvt_pk_bf16(v0[2], v0[3]); w.z = cvt_pk_bf16(v1[0], v1[1]); w.w = cvt_pk_bf16(v1[2], v1[3]);
                    *(u32x4*)(HB + o) = w; }
                ss += __shfl_xor(ss, 16); ss += __shfl_xor(ss, 32);
                if (fq == 0) atomicAdd(ssq + r, ss); }
    }
};
struct EpiRowBf16 {
    static constexpr bool PERM = true, AFTER_DRAIN = false;
    bf16_t* O; int ldc; const float* ssq; float scale;
    __device__ __forceinline__ void operator()(const f32x4 (&acc)[2][2][4][2], const Unit& u, int wr, int wc, int fr, int fq) const {
        const int row0 = u.pm * BM + wr * 64 + fr, col0 = u.pn * BM + wc * 32 + 8 * fq;
#pragma unroll
        for (int ai = 0; ai < 2; ++ai)
#pragma unroll
            for (int m = 0; m < 4; ++m) { const int r = row0 + ai * HALF + m * 16; const float sc = scale / sqrtf(ssq[r] * (1.0f / 2048.0f) + 1e-6f); bf16_t* rowp = O + (size_t)r * ldc + col0;
#pragma unroll
                for (int bj = 0; bj < 2; ++bj) { const f32x4 v0 = acc[ai][bj][m][0] * sc, v1 = acc[ai][bj][m][1] * sc;
                    u32x4 w; w.x = cvt_pk_bf16(v0[0], v0[1]); w.y = cvt_pk_bf16(v0[2], v0[3]); w.z = cvt_pk_bf16(v1[0], v1[1]); w.w = cvt_pk_bf16(v1[2], v1[3]);
                    *(u32x4*)(rowp + bj * HALF) = w; } }
    }
};
struct EpiSl {
    static constexpr bool PERM = false, AFTER_DRAIN = false;
    float* Sl;
    __device__ __forceinline__ void operator()(const f32x4 (&acc)[2][2][4][2], const Unit& u, int wr, int wc, int fr, int fq) const {
        const int row0 = u.pm * BM + wr * 64 + fr, col0 = wc * 32 + 4 * fq;
        float* base = Sl + (size_t)u.bz * 512 * 128;
#pragma unroll
        for (int ai = 0; ai < 2; ++ai)
#pragma unroll
            for (int m = 0; m < 4; ++m) { float* rowp = base + (size_t)(row0 + ai * HALF + m * 16) * 128 + col0;
#pragma unroll
                for (int n = 0; n < 2; ++n) *(f32x4*)(rowp + n * 16) = acc[ai][0][m][n]; }
    }
};
struct EpiS5 {
    static constexpr bool PERM = true, AFTER_DRAIN = false;
    bf16_t* Gb;
    __device__ __forceinline__ void operator()(const f32x4 (&acc)[2][2][4][2], const Unit& u, int wr, int wc, int fr, int fq) const {
        const int row0 = u.pm * BM + wr * 64 + fr, col0 = u.pn * BM + wc * 32 + 8 * fq;
#pragma unroll
        for (int ai = 0; ai < 2; ++ai)
#pragma unroll
            for (int m = 0; m < 4; ++m) { const int cb = row0 + ai * HALF + m * 16;
#pragma unroll
                for (int bj = 0; bj < 2; ++bj) { const int n0 = col0 + bj * HALF; const int tau = n0 >> 4, h0 = n0 & 15;
                    const f32x4 v0 = acc[ai][bj][m][0], v1 = acc[ai][bj][m][1];
                    const f32x2 a = gelu_pk((f32x2){v0[0], v0[1]}), b = gelu_pk((f32x2){v0[2], v0[3]}), c = gelu_pk((f32x2){v1[0], v1[1]}), d = gelu_pk((f32x2){v1[2], v1[3]});
                    u32x4 w; w.x = cvt_pk_bf16(a.x, a.y); w.y = cvt_pk_bf16(b.x, b.y); w.z = cvt_pk_bf16(c.x, c.y); w.w = cvt_pk_bf16(d.x, d.y);
                    *(u32x4*)(Gb + ((size_t)cb * 32 + tau) * 1024 + 16 * u.bz + h0) = w; } }
    }
};

struct EpiXkv {
    static constexpr bool PERM = false, AFTER_DRAIN = false;
    bf16_t* KP; bf16_t* VT2;
    __device__ __forceinline__ void operator()(const f32x4 (&acc)[2][2][4][2], const Unit& u, int wr, int wc, int fr, int fq) const {
        const int row0 = u.pm * BM + wr * 64 + fr, col0 = u.pn * BM + wc * 32 + 4 * fq;
#pragma unroll
        for (int ai = 0; ai < 2; ++ai)
#pragma unroll
            for (int m = 0; m < 4; ++m) { const int r = row0 + ai * HALF + m * 16; const int b = r >> 8, mm = r & 255;
#pragma unroll
                for (int bj = 0; bj < 2; ++bj)
#pragma unroll
                    for (int n = 0; n < 2; ++n) { const int c = col0 + bj * HALF + n * 16; const f32x4 v = acc[ai][bj][m][n];
                        if (c < 512) { const int hd = c >> 7, d = c & 127; bf16_t* p = KP + ((size_t)(b * 4 + hd) * 256 + mm) * 256;
                            *(unsigned long long*)(p + (hd & 1) * 128 + d) = (unsigned long long)cvt_pk_bf16(v[0], v[1]) | ((unsigned long long)cvt_pk_bf16(v[2], v[3]) << 32);
                            *(unsigned long long*)(p + ((hd & 1) ^ 1) * 128 + d) = 0ull; }
                        else { const int c2 = c - 512, hd = c2 >> 7, d = c2 & 127; bf16_t* p = VT2 + ((size_t)(b * 2 + (hd >> 1)) * 256 + (hd & 1) * 128 + d) * 512;
                            const unsigned w01 = cvt_pk_bf16(v[0], v[1]), w23 = cvt_pk_bf16(v[2], v[3]);
                            const int k1 = (hd & 1) * 256 + mm, k0 = ((hd & 1) ^ 1) * 256 + mm;
                            p[k1] = (bf16_t)(w01 & 0xffffu); p[512 + k1] = (bf16_t)(w01 >> 16); p[1024 + k1] = (bf16_t)(w23 & 0xffffu); p[1536 + k1] = (bf16_t)(w23 >> 16);
                            p[k0] = 0; p[512 + k0] = 0; p[1024 + k0] = 0; p[1536 + k0] = 0; } } }
    }
};
struct EpiXs {
    static constexpr bool PERM = true, AFTER_DRAIN = true;
    bf16_t* XP; float* Lsum;
    __device__ __forceinline__ void fused(f32x4 (&acc)[2][2][4][2], const Unit& u, int wr, int wc, int fr, int fq, PG8_LAS unsigned char* lds, int wid, int lane) const {
        PG8_LAS float* Mx = (PG8_LAS float*)lds;
        const int b = u.bz >> 2, hd = u.bz & 3;
#pragma unroll
        for (int ai = 0; ai < 2; ++ai)
#pragma unroll
            for (int m = 0; m < 4; ++m) { float mx = -INFINITY;
#pragma unroll
                for (int bj = 0; bj < 2; ++bj)
#pragma unroll
                    for (int n = 0; n < 2; ++n) { const f32x4 v = acc[ai][bj][m][n]; mx = fmaxf(mx, fmaxf(fmaxf(v[0], v[1]), fmaxf(v[2], v[3]))); }
                mx = fmaxf(mx, __shfl_xor(mx, 16)); mx = fmaxf(mx, __shfl_xor(mx, 32));
                if (fq == 0) Mx[(ai * HALF + wr * 64 + m * 16 + fr) * 4 + wc] = mx; }
        asm volatile("s_waitcnt lgkmcnt(0)" ::: "memory"); __builtin_amdgcn_s_barrier(); asm volatile("" ::: "memory");
#pragma unroll
        for (int ai = 0; ai < 2; ++ai)
#pragma unroll
            for (int m = 0; m < 4; ++m) { const int rl = ai * HALF + wr * 64 + m * 16 + fr; const f32x4 mv = *(const PG8_LAS f32x4*)(Mx + rl * 4);
                const float mx = fmaxf(fmaxf(mv[0], mv[1]), fmaxf(mv[2], mv[3])); float ss = 0.f;
                const size_t t = (size_t)b * 2048 + u.pm * BM + rl; bf16_t* rowp = XP + t * 1024 + hd * 256 + wc * 32 + 8 * fq;
#pragma unroll
                for (int bj = 0; bj < 2; ++bj) { f32x4 p0, p1;
#pragma unroll
                    for (int e = 0; e < 4; ++e) { p0[e] = __expf(acc[ai][bj][m][0][e] - mx); p1[e] = __expf(acc[ai][bj][m][1][e] - mx); }
                    ss += (p0[0] + p0[1]) + (p0[2] + p0[3]) + (p1[0] + p1[1]) + (p1[2] + p1[3]);
                    u32x4 w; w.x = cvt_pk_bf16(p0[0], p0[1]); w.y = cvt_pk_bf16(p0[2], p0[3]); w.z = cvt_pk_bf16(p1[0], p1[1]); w.w = cvt_pk_bf16(p1[2], p1[3]);
                    *(u32x4*)(rowp + bj * HALF) = w; }
                ss += __shfl_xor(ss, 16); ss += __shfl_xor(ss, 32);
                if (fq == 0) atomicAdd(Lsum + t * 4 + hd, ss); }
    }
};
struct EpiXo {
    static constexpr bool PERM = true, AFTER_DRAIN = false;
    bf16_t* XO; const float* Lsum;
    __device__ __forceinline__ void operator()(const f32x4 (&acc)[2][2][4][2], const Unit& u, int wr, int wc, int fr, int fq) const {
        const int b = u.bz >> 2, pair = (u.bz >> 1) & 1, kh = u.bz & 1;
#pragma unroll
        for (int ai = 0; ai < 2; ++ai)
#pragma unroll
            for (int m = 0; m < 4; ++m) { const size_t t = (size_t)b * 2048 + u.pm * BM + ai * HALF + wr * 64 + m * 16 + fr; bf16_t* rowp = XO + t * 512 + pair * 256 + wc * 32 + 8 * fq;
                { const float il = 1.0f / Lsum[t * 4 + pair * 2 + kh]; const f32x4 v0 = (kh ? acc[ai][1][m][0] : acc[ai][0][m][0]) * il, v1 = (kh ? acc[ai][1][m][1] : acc[ai][0][m][1]) * il;
                    u32x4 w; w.x = cvt_pk_bf16(v0[0], v0[1]); w.y = cvt_pk_bf16(v0[2], v0[3]); w.z = cvt_pk_bf16(v1[0], v1[1]); w.w = cvt_pk_bf16(v1[2], v1[3]);
                    *(u32x4*)(rowp + kh * HALF) = w; } }
    }
};
struct XsOrder {
    int G, c, sel;
    __device__ __forceinline__ bool next(int i, Unit& u) const { if (i > 0) return false; const int L = sel * G + c; if (L >= 256) return false; u.pm = L & 7; u.pn = 0; u.bz = L >> 3; return true; }
    __device__ __forceinline__ void a_ready(const Unit&) const {}
    __device__ __forceinline__ void done(const Unit&) const {}
    template <class G_> __device__ __forceinline__ long offA(const Unit& u, const G_&) const { return (long)(u.bz >> 2) * 2048 * 512 + ((u.bz & 3) >> 1) * 256; }
    template <class G_> __device__ __forceinline__ long offB(const Unit& u, const G_&) const { return (long)u.bz * 256 * 256; }
};
struct XoOrder {
    int G, c;
    __device__ __forceinline__ bool next(int i, Unit& u) const { const int L = i * G + c; if (L >= 256) return false; u.pm = L & 7; u.pn = 0; u.bz = L >> 3; return true; }
    __device__ __forceinline__ void a_ready(const Unit&) const {}
    __device__ __forceinline__ void done(const Unit&) const {}
    template <class G_> __device__ __forceinline__ long offA(const Unit& u, const G_&) const { return (long)(u.bz >> 2) * 2048 * 1024 + (u.bz & 3) * 256; }
    template <class G_> __device__ __forceinline__ long offB(const Unit& u, const G_&) const { return (long)(u.bz >> 1) * 256 * 512 + (u.bz & 1) * 256; }
};
struct EpiGlu {
    static constexpr bool PERM = false, AFTER_DRAIN = false;
    const bf16_t* G; const float* bias; bf16_t* CAT; float* ssq;
    __device__ __forceinline__ void operator()(const f32x4 (&acc)[2][2][4][2], const Unit& u, int wr, int wc, int fr, int fq) const {
        const int row0 = u.pm * BM + wr * 64 + fr, col0 = u.pn * BM + wc * 32 + 4 * fq;
#pragma unroll
        for (int ai = 0; ai < 2; ++ai)
#pragma unroll
            for (int m = 0; m < 4; ++m) { const int r = row0 + ai * HALF + m * 16; float ss = 0.f;
#pragma unroll
                for (int bj = 0; bj < 2; ++bj)
#pragma unroll
                    for (int n = 0; n < 2; ++n) { const int c = col0 + bj * HALF + n * 16; const f32x4 z = acc[ai][bj][m][n] + *(const f32x4*)(bias + c); const unsigned long long gb = *(const unsigned long long*)(G + (size_t)r * 1024 + c);
                        f32x4 gv; gv[0] = __uint_as_float((unsigned)gb << 16); gv[1] = __uint_as_float((unsigned)gb & 0xffff0000u); gv[2] = __uint_as_float((unsigned)(gb >> 32) << 16); gv[3] = __uint_as_float((unsigned)(gb >> 32) & 0xffff0000u);
                        f32x4 o; o[0] = gv[0] / (1.0f + __expf(-z[0])); o[1] = gv[1] / (1.0f + __expf(-z[1])); o[2] = gv[2] / (1.0f + __expf(-z[2])); o[3] = gv[3] / (1.0f + __expf(-z[3]));
                        ss += o[0] * o[0] + o[1] * o[1] + o[2] * o[2] + o[3] * o[3];
                        const unsigned long long w = (unsigned long long)cvt_pk_bf16(o[0], o[1]) | ((unsigned long long)cvt_pk_bf16(o[2], o[3]) << 32);
                        *(unsigned long long*)(CAT + (size_t)r * 2048 + 1024 + c) = w; }
                ss += __shfl_xor(ss, 16); ss += __shfl_xor(ss, 32);
                if (fq == 0) atomicAdd(ssq + r, ss); }
    }
};
struct EpiWin {
    static constexpr bool PERM = true, AFTER_DRAIN = false;
    bf16_t* QKV; size_t sec_stride; bf16_t* UC; const float* rope; float qscale;
    __device__ __forceinline__ void operator()(const f32x4 (&acc)[2][2][4][2], const Unit& u, int wr, int wc, int fr, int fq) const {
        const int row0 = u.pm * BM + wr * 64 + fr;
        const int sec = u.pn >> 2;
        const int col0 = (u.pn & 3) * BM + wc * 32 + 8 * fq;
        if (sec == 3) {
#pragma unroll
            for (int ai = 0; ai < 2; ++ai)
#pragma unroll
                for (int m = 0; m < 4; ++m) { const int r = row0 + ai * HALF + m * 16; const int cb = r >> 5, sg = r & 31;
#pragma unroll
                    for (int bj = 0; bj < 2; ++bj) { const int col = col0 + bj * HALF; const int g = col >> 4, h0 = col & 15;
                        const f32x4 v0 = acc[ai][bj][m][0], v1 = acc[ai][bj][m][1];
                        u32x4 w; w.x = cvt_pk_bf16(v0[0], v0[1]); w.y = cvt_pk_bf16(v0[2], v0[3]); w.z = cvt_pk_bf16(v1[0], v1[1]); w.w = cvt_pk_bf16(v1[2], v1[3]);
                        *(u32x4*)(UC + ((size_t)g * 512 + cb) * 640 + sg * 16 + h0) = w; } }
            return;
        }
        bf16_t* base = QKV + (size_t)sec * sec_stride;
        const float sc = sec == 0 ? qscale : 1.0f;
        const bool rot = (sec < 2) && ((wc & 1) == 0);
        const float sgn = (fq & 1) ? 1.0f : -1.0f;
        const bool mine = fq < 2;
#pragma unroll
        for (int ai = 0; ai < 2; ++ai)
#pragma unroll
            for (int m = 0; m < 4; ++m) { const int r = row0 + ai * HALF + m * 16; bf16_t* rowp = base + (size_t)r * 1024 + col0;
                f32x4 cs[4];
                if (rot) {
#pragma unroll
                    for (int q = 0; q < 4; ++q) cs[q] = *(const f32x4*)(rope + (size_t)r * 16 + 4 * q);
                }
#pragma unroll
                for (int bj = 0; bj < 2; ++bj) { f32x4 v0 = acc[ai][bj][m][0], v1 = acc[ai][bj][m][1];
                    if (rot) {
                        f32x4 p0, p1;
#pragma unroll
                        for (int e = 0; e < 4; ++e) { p0[e] = __shfl_xor(v0[e], 16); p1[e] = __shfl_xor(v1[e], 16); }
                        if (mine) {
#pragma unroll
                            for (int e = 0; e < 4; ++e) {
                                const float c0 = cs[e >> 1][(e & 1) * 2], s0 = cs[e >> 1][(e & 1) * 2 + 1];
                                const float c1 = cs[2 + (e >> 1)][(e & 1) * 2], s1 = cs[2 + (e >> 1)][(e & 1) * 2 + 1];
                                v0[e] = v0[e] * c0 + sgn * p0[e] * s0; v1[e] = v1[e] * c1 + sgn * p1[e] * s1; }
                        }
                    }
                    v0 = v0 * sc; v1 = v1 * sc; u32x4 w; w.x = cvt_pk_bf16(v0[0], v0[1]); w.y = cvt_pk_bf16(v0[2], v0[3]); w.z = cvt_pk_bf16(v1[0], v1[1]); w.w = cvt_pk_bf16(v1[2], v1[3]);
                    *(u32x4*)(rowp + bj * HALF) = w; } }
    }
};
}
#define GEMM_RUN(EPI, ALIGN, g, S, E) pg8::gemm_phase<EPI, pg8::StaticOrder, ALIGN, true>(F.ldsl, g, S, E)
namespace attn_body {
using bf16=__hip_bfloat16;
using bf16x8=__attribute__((ext_vector_type(8)))short;
using s16x4=__attribute__((ext_vector_type(4)))short;
using f32x16=__attribute__((ext_vector_type(16)))float;
using u32x4=__attribute__((ext_vector_type(4)))unsigned;
constexpr int BATCH=8,NHEAD=16,SEQ=2048,D=64,DM=NHEAD*D;
constexpr int NW=8,QBLK=32,QB=QBLK*NW,KVBLK=64,NQB=SEQ/QB;
constexpr int ATTN_PITCH=DM, ATTN_UNIT_ROWS=QB;
__device__ __forceinline__ int crow(int r,int hi){return (r&3)+8*(r>>2)+4*hi;}
#define SBAR() __builtin_amdgcn_sched_barrier(0)
__device__ __forceinline__ void cmask(f32x16&p0,f32x16&p1,int jb,int qrel,int hi){
  asm volatile("":"+v"(qrel),"+v"(hi));
  const float NEG=-INFINITY; int kb=64*jb+4*hi;
  #pragma unroll
  for(int r=0;r<16;++r){int kv=kb+(r&3)+8*(r>>2); if(kv>qrel)p0[r]=NEG; if(kv+32>qrel)p1[r]=NEG;}
}

constexpr int NSLOT=3, SLOTB=8192;
constexpr int LDS_K=0, LDS_V=NSLOT*SLOTB, LDS_WS=2*NSLOT*SLOTB, LDS_OST=LDS_WS+NW*64*4, LDS_BYTES=LDS_OST+NW*4096, LDS_X=LDS_BYTES, LDS_SSQ=LDS_X+NW*4096;
constexpr float C2=0.125f*1.4426950408889634f;
__device__ __forceinline__ void glds16(const void*gsrc,unsigned lds_dst){unsigned keep;
  asm volatile("s_mov_b32 %0, m0\n\ts_mov_b32 m0, %2\n\ts_nop 0\n\tglobal_load_lds_dwordx4 %1, off\n\ts_mov_b32 m0, %0":"=&s"(keep):"v"(gsrc),"s"(lds_dst):"memory");}
__device__ __forceinline__ float max3f(float a,float b,float c){float r;asm("v_max3_f32 %0, %1, %2, %3":"=v"(r):"v"(a),"v"(b),"v"(c));return r;}
__device__ __forceinline__ float max2f(float a,float b){float r;asm("v_max_f32_e32 %0, %1, %2":"=v"(r):"v"(a),"v"(b));return r;}
__device__ __forceinline__ float fadd_s(float a,float b){float r;asm("v_add_f32_e32 %0, %1, %2":"=v"(r):"v"(a),"v"(b));return r;}
__device__ __forceinline__ float fsub_s(float a,float b){float r;asm("v_sub_f32_e32 %0, %1, %2":"=v"(r):"v"(a),"v"(b));return r;}
typedef float f32x2_t __attribute__((ext_vector_type(2))); typedef __bf16 bf16x2_t __attribute__((ext_vector_type(2)));
__device__ __forceinline__ unsigned cvtpk_s(float lo,float hi){f32x2_t v={lo,hi};bf16x2_t b=__builtin_convertvector(v,bf16x2_t);return __builtin_bit_cast(unsigned,b);}
#define WAIT_BAR(N) asm volatile("s_waitcnt vmcnt(" #N ") lgkmcnt(0)\n\ts_barrier":::"memory")

__device__ __forceinline__ void qkt(f32x16&p0,f32x16&p1,const char*Kslot,const bf16x8*qr,int r32,int hi){ const f32x16 zc=f32x16{};
  const char*kb=Kslot+hi*1024+r32*16;
  #pragma unroll
  for(int d0=0;d0<4;++d0){
    const bf16x8 b0=*reinterpret_cast<const bf16x8*>(kb+d0*2048);
    const bf16x8 b1=*reinterpret_cast<const bf16x8*>(kb+d0*2048+512);
    if(d0==0){p0=__builtin_amdgcn_mfma_f32_32x32x16_bf16(b0,qr[0],zc,0,0,0);p1=__builtin_amdgcn_mfma_f32_32x32x16_bf16(b1,qr[0],zc,0,0,0);}
    else{p0=__builtin_amdgcn_mfma_f32_32x32x16_bf16(b0,qr[d0],p0,0,0,0);p1=__builtin_amdgcn_mfma_f32_32x32x16_bf16(b1,qr[d0],p1,0,0,0);}}
}
typedef __attribute__((address_space(3))) const char* lds_cptr;
typedef short v4i16_t __attribute__((ext_vector_type(4)));
__device__ __forceinline__ void kload8(bf16x8*kf,lds_cptr kp){
  kf[0]=*(const __attribute__((address_space(3))) bf16x8*)(kp);      kf[1]=*(const __attribute__((address_space(3))) bf16x8*)(kp+512);
  kf[2]=*(const __attribute__((address_space(3))) bf16x8*)(kp+2048); kf[3]=*(const __attribute__((address_space(3))) bf16x8*)(kp+2560);
  kf[4]=*(const __attribute__((address_space(3))) bf16x8*)(kp+4096); kf[5]=*(const __attribute__((address_space(3))) bf16x8*)(kp+4608);
  kf[6]=*(const __attribute__((address_space(3))) bf16x8*)(kp+6144); kf[7]=*(const __attribute__((address_space(3))) bf16x8*)(kp+6656);
}
__device__ __forceinline__ void kload2(bf16x8*kf,lds_cptr kp,int j){ kf[2*j]=*(const __attribute__((address_space(3))) bf16x8*)(kp+j*2048); kf[2*j+1]=*(const __attribute__((address_space(3))) bf16x8*)(kp+j*2048+512); }
__device__ __forceinline__ s16x4 vtr(lds_cptr p){ return __builtin_bit_cast(s16x4,__builtin_amdgcn_ds_read_tr16_b64_v4i16((__attribute__((address_space(3))) v4i16_t*)p)); }
__device__ __forceinline__ float rowmax(const f32x16&p0,const f32x16&p1){
  float a=max3f(p0[0],p0[1],p1[0]),b=max3f(p0[2],p0[3],p1[1]);a=max3f(a,p1[2],p1[3]);
  #pragma unroll
  for(int r=4;r<16;r+=4){a=max3f(a,p0[r],p0[r+1]);b=max3f(b,p0[r+2],p0[r+3]);a=max3f(a,p1[r],p1[r+1]);b=max3f(b,p1[r+2],p1[r+3]);}
  const float m=max2f(a,b);
  auto rr=__builtin_amdgcn_permlane32_swap(__float_as_uint(m),__float_as_uint(m),false,false);
  return max2f(__uint_as_float(rr[0]),__uint_as_float(rr[1]));
}
__device__ __forceinline__ void pv(f32x16*o,int vb,bf16x8 pa0,bf16x8 pa1,bf16x8 pa2,bf16x8 pa3){
  #pragma unroll
  for(int d0=0;d0<2;++d0){s16x4 lo[4],hi[4];
    #pragma unroll
    for(int ks=0;ks<4;++ks){
      asm volatile("ds_read_b64_tr_b16 %0,%1 offset:%c2":"=&v"(lo[ks]):"v"(vb),"i"(d0*4096+ks*1024):"memory");
      asm volatile("ds_read_b64_tr_b16 %0,%1 offset:%c2":"=&v"(hi[ks]):"v"(vb),"i"(d0*4096+ks*1024+512):"memory");}
    asm volatile("s_waitcnt lgkmcnt(0)":::"memory");SBAR();
    #define PK(k) (bf16x8){lo[k][0],lo[k][1],lo[k][2],lo[k][3],hi[k][0],hi[k][1],hi[k][2],hi[k][3]}
    o[d0]=__builtin_amdgcn_mfma_f32_32x32x16_bf16(pa0,PK(0),o[d0],0,0,0);
    o[d0]=__builtin_amdgcn_mfma_f32_32x32x16_bf16(pa1,PK(1),o[d0],0,0,0);
    o[d0]=__builtin_amdgcn_mfma_f32_32x32x16_bf16(pa2,PK(2),o[d0],0,0,0);
    o[d0]=__builtin_amdgcn_mfma_f32_32x32x16_bf16(pa3,PK(3),o[d0],0,0,0);
    #undef PK
  }
}

#ifndef ATTN_STORE16
#define ATTN_STORE16(p,v) (*(u32x4*)(p)=(v))
#endif
template<int THRL> __device__ __forceinline__ void attn_unit(int b,int h,int hv,int qb,const bf16*Q,const bf16*__restrict__ K,const bf16*__restrict__ V,bf16*CATp,const int mode,const float lam,const float*hgp,char*shm){
  const int tid=threadIdx.x,lane=tid&63,r32=lane&31,hi=lane>>5; const int wid=__builtin_amdgcn_readfirstlane(tid>>6);
  const long rowbase=(long)b*SEQ; const int q0=qb*QB;
  const bf16*Qw=Q+(rowbase+q0+wid*QBLK)*DM+h*D;
  const bf16*Kh=K+rowbase*DM+h*D,*Vh=V+rowbase*DM+hv*D;
  const unsigned lds0=(unsigned)(uintptr_t)shm;
  float*wsf=(float*)(shm+LDS_WS)+wid*64;
  const bf16*ksrc=Kh+(long)lane*DM+wid*8;
  const bf16*vsrc=Vh+(long)(16*(wid&3)+(lane>>2))*DM+(wid>>2)*32+(lane&3)*8;
  const unsigned kdst=lds0+LDS_K+wid*1024, vdst=lds0+LDS_V+wid*1024;
  #define DMA_K(t,slot) glds16(ksrc+(long)(t)*KVBLK*DM,(unsigned)__builtin_amdgcn_readfirstlane(kdst+(slot)))
  #define DMA_V(t,slot) glds16(vsrc+(long)(t)*KVBLK*DM,(unsigned)__builtin_amdgcn_readfirstlane(vdst+(slot)))
  const int vb0=(int)(lds0+LDS_V)+((lane>>4)&1)*32+(lane&3)*8+(4*hi+((lane&15)>>2))*64;
  const char*Kbase=shm+LDS_K; bf16x8 kf[8];
  const lds_cptr shm3=(lds_cptr)shm; const lds_cptr kp0=shm3+LDS_K+hi*1024+r32*16; const lds_cptr vp0=shm3+LDS_V+((lane>>4)&1)*32+(lane&3)*8+(4*hi+((lane&15)>>2))*64;
  const int NT=(q0+QB)/KVBLK;
  DMA_K(0,0);DMA_V(0,0);DMA_K(1,SLOTB);
  bf16x8 qr[4];
  #pragma unroll
  for(int d0=0;d0<4;++d0)qr[d0]=*reinterpret_cast<const bf16x8*>(&Qw[(long)r32*DM+d0*16+hi*8]);
  float mhat=0.f,l_reg=0.f;f32x16 o[2];o[0]=f32x16{};o[1]=f32x16{};
  const int qrel=wid*QBLK+r32;
  #define CMASK(P0,P1,t) do{int jb_=(t)-(NT-4); if(jb_>=0)cmask(P0,P1,jb_,qrel,hi);}while(0)
  bool resc=false;
  #define START(P0,P1) do{ const float rm=rowmax(P0,P1); resc=false; mhat=rm; \
    _Pragma("unroll") for(int r=0;r<16;++r)P0[r]=__builtin_amdgcn_exp2f(fsub_s(P0[r],mhat)); }while(0)
  #define RESC() do{ if(resc){ asm volatile("s_waitcnt lgkmcnt(0)":::"memory"); \
      _Pragma("unroll") for(int d_=0;d_<2;++d_) _Pragma("unroll") for(int r=0;r<16;++r)o[d_][r]*=wsf[crow(r,hi)]; } }while(0)
  f32x16 pA0,pA1,pB0,pB1;
  int sl_prev=0,sl_cur=0,sl_next=SLOTB;
  #define ROT() do{sl_prev=sl_cur;sl_cur=sl_next;sl_next=(sl_next==(NSLOT-1)*SLOTB)?0:sl_next+SLOTB;}while(0)
  DMA_K(2,2*SLOTB);
  WAIT_BAR(3);
  qkt(pA0,pA1,Kbase,qr,r32,hi);asm volatile("s_nop 15\n\ts_nop 7":"+v"(pA0),"+v"(pA1));CMASK(pA0,pA1,0);
  START(pA0,pA1);
  _Pragma("unroll") for(int r=0;r<16;++r)pA1[r]=__builtin_amdgcn_exp2f(fsub_s(pA1[r],mhat));
  WAIT_BAR(0);
  DMA_K(3,0);DMA_V(1,SLOTB);
  ROT();
  kload8(kf,kp0+sl_cur);
  WAIT_BAR(2);
  s16x4 vlo[8],vhi[8]; u32x4 pw0,pw1,pw2,pw3;
  #define PKW(P,B) cvtpk_s(P[B],P[B+1])
  #define PAF(k) __builtin_bit_cast(bf16x8,pw##k)
  #define VFR(i) (bf16x8){vlo[i][0],vlo[i][1],vlo[i][2],vlo[i][3],vhi[i][0],vhi[i][1],vhi[i][2],vhi[i][3]}
  #define PIN(x) asm volatile("":"+v"(x))
  #define MX3(a,b,c) __builtin_fmaxf(__builtin_fmaxf((a),(b)),(c))
  #define GAPA(MF,A0,A1,A2,A3,W0,W1,PW) do{ MF; sacc+=A0; sacc+=A1; sacc+=A2; sacc+=A3; PIN(sacc); W0; W1; PIN(PW); SBAR(); }while(0)
  #define EX(v) __builtin_amdgcn_exp2f((v)-mhat)
  #define GAPB(MF,X,B) do{ MF; X[B]=EX(X[B]); X[B+1]=EX(X[B+1]); X[B+2]=EX(X[B+2]); X[B+3]=EX(X[B+3]); PIN(X); SBAR(); }while(0)
  #define VRD(i) do{ vlo[i]=vtr(vp_+(((i)>>2)*4096+((i)&3)*1024)); vhi[i]=vtr(vp_+(((i)>>2)*4096+((i)&3)*1024+512)); }while(0)
  #define KRD(G,j) do{ if(G){ kload2(kf,kp0+sl_next,j); SBAR(); } }while(0)
  #define STEP(C0,C1,P0,P1,t,GK,GV,GL) do{ SBAR(); const f32x16 zc_=f32x16{}; \
    const lds_cptr vp_=vp0+sl_prev; \
    VRD(0); SBAR(); float sacc=(P0[0]+P0[1]); \
    GAPA(C0=__builtin_amdgcn_mfma_f32_32x32x16_bf16(kf[0],qr[0],zc_,0,0,0), P0[2],P0[3],P0[4],P0[5],     pw0[0]=PKW(P0,0), pw0[1]=PKW(P0,2), pw0); \
    VRD(4); SBAR(); GAPA(C1=__builtin_amdgcn_mfma_f32_32x32x16_bf16(kf[1],qr[0],zc_,0,0,0), P0[6],P0[7],P0[8],P0[9],     pw0[2]=PKW(P0,4), pw0[3]=PKW(P0,6), pw0); \
    VRD(1); SBAR(); GAPA(C0=__builtin_amdgcn_mfma_f32_32x32x16_bf16(kf[2],qr[1],C0,0,0,0),   P0[10],P0[11],P0[12],P0[13], pw1[0]=PKW(P0,8), pw1[1]=PKW(P0,10), pw1); \
    VRD(5); SBAR(); GAPA(C1=__builtin_amdgcn_mfma_f32_32x32x16_bf16(kf[3],qr[1],C1,0,0,0),   P0[14],P0[15],P1[0],P1[1],   pw1[2]=PKW(P0,12),pw1[3]=PKW(P0,14), pw1); \
    VRD(2); SBAR(); GAPA(C0=__builtin_amdgcn_mfma_f32_32x32x16_bf16(kf[4],qr[2],C0,0,0,0),   P1[2],P1[3],P1[4],P1[5],     pw2[0]=PKW(P1,0), pw2[1]=PKW(P1,2), pw2); \
    VRD(6); SBAR(); GAPA(C1=__builtin_amdgcn_mfma_f32_32x32x16_bf16(kf[5],qr[2],C1,0,0,0),   P1[6],P1[7],P1[8],P1[9],     pw2[2]=PKW(P1,4), pw2[3]=PKW(P1,6), pw2); \
    VRD(3); SBAR(); GAPA(C0=__builtin_amdgcn_mfma_f32_32x32x16_bf16(kf[6],qr[3],C0,0,0,0),   P1[10],P1[11],P1[12],P1[13], pw3[0]=PKW(P1,8), pw3[1]=PKW(P1,10), pw3); \
    VRD(7); SBAR(); GAPA(C1=__builtin_amdgcn_mfma_f32_32x32x16_bf16(kf[7],qr[3],C1,0,0,0),   P1[14],P1[15],0.f,0.f,       pw3[2]=PKW(P1,12),pw3[3]=PKW(P1,14), pw3); \
    l_reg+=sacc; \
    if(GK){DMA_K((t)+3,sl_cur);} if(GV){DMA_V((t)+1,sl_next);} \
    CMASK(C0,C1,t); \
    { float a=MX3(C0[0],C0[1],C1[0]),b=MX3(C0[2],C0[3],C1[1]); a=MX3(a,C1[2],C1[3]); \
      _Pragma("unroll") for(int r=4;r<16;r+=4){a=MX3(a,C0[r],C0[r+1]);b=MX3(b,C0[r+2],C0[r+3]);a=MX3(a,C1[r],C1[r+1]);b=MX3(b,C1[r+2],C1[r+3]);} \
      float rm=__builtin_fmaxf(a,b); { auto rr=__builtin_amdgcn_permlane32_swap(__float_as_uint(rm),__float_as_uint(rm),false,false); rm=__builtin_fmaxf(__uint_as_float(rr[0]),__uint_as_float(rr[1])); } \
      resc=false; \
      rm-=mhat; \
      if(__builtin_expect(__any(rm>(float)THRL),0)){ const float dl=__builtin_fmaxf(rm,0.f); mhat+=dl; \
        const float f=__builtin_amdgcn_exp2f(-dl); l_reg*=f; if(hi==0)wsf[r32]=f; resc=true; } } \
    SBAR(); \
    GAPB(o[0]=__builtin_amdgcn_mfma_f32_32x32x16_bf16(PAF(0),VFR(0),o[0],0,0,0), C0,0); \
    GAPB(o[1]=__builtin_amdgcn_mfma_f32_32x32x16_bf16(PAF(0),VFR(4),o[1],0,0,0), C0,4); \
    KRD(GL,0); GAPB(o[0]=__builtin_amdgcn_mfma_f32_32x32x16_bf16(PAF(1),VFR(1),o[0],0,0,0), C0,8); \
    KRD(GL,1); GAPB(o[1]=__builtin_amdgcn_mfma_f32_32x32x16_bf16(PAF(1),VFR(5),o[1],0,0,0), C0,12); \
    KRD(GL,2); GAPB(o[0]=__builtin_amdgcn_mfma_f32_32x32x16_bf16(PAF(2),VFR(2),o[0],0,0,0), C1,0); \
    KRD(GL,3); GAPB(o[1]=__builtin_amdgcn_mfma_f32_32x32x16_bf16(PAF(2),VFR(6),o[1],0,0,0), C1,4); \
    GAPB(o[0]=__builtin_amdgcn_mfma_f32_32x32x16_bf16(PAF(3),VFR(3),o[0],0,0,0), C1,8); \
    GAPB(o[1]=__builtin_amdgcn_mfma_f32_32x32x16_bf16(PAF(3),VFR(7),o[1],0,0,0), C1,12); \
    }while(0)
  int t=1;
  #undef CMASK
  #define CMASK(P0,P1,t) do{}while(0)
  for(;t+5<NT;t+=2){
    STEP(pB0,pB1,pA0,pA1,t,true,true,true);     WAIT_BAR(2); RESC(); ROT();
    STEP(pA0,pA1,pB0,pB1,t+1,true,true,true);   WAIT_BAR(2); RESC(); ROT();
  }
  #undef CMASK
  #define CMASK(P0,P1,t) do{int jb_=(t)-(NT-4); if(jb_>=0)cmask(P0,P1,jb_,qrel,hi);}while(0)
  #define ENDW(tt) do{ if((tt)+3<NT){WAIT_BAR(2);} else if((tt)+2<NT){WAIT_BAR(1);} else {WAIT_BAR(0);} }while(0)
  for(;t+1<NT;t+=2){
    STEP(pB0,pB1,pA0,pA1,t,(t+3<NT),(t+1<NT),(t+1<NT));       ENDW(t);   RESC(); ROT();
    STEP(pA0,pA1,pB0,pB1,t+1,(t+4<NT),(t+2<NT),(t+2<NT));     ENDW(t+1); RESC(); ROT();
  }
  STEP(pB0,pB1,pA0,pA1,NT-1,false,false,false); RESC();
  { float sacc=pB0[0]+pB0[1]; _Pragma("unroll") for(int r=2;r<16;++r)sacc+=pB0[r]; _Pragma("unroll") for(int r=0;r<16;++r)sacc+=pB1[r]; l_reg+=sacc;
    pw0=(u32x4){PKW(pB0,0),PKW(pB0,2),PKW(pB0,4),PKW(pB0,6)};pw1=(u32x4){PKW(pB0,8),PKW(pB0,10),PKW(pB0,12),PKW(pB0,14)};pw2=(u32x4){PKW(pB1,0),PKW(pB1,2),PKW(pB1,4),PKW(pB1,6)};pw3=(u32x4){PKW(pB1,8),PKW(pB1,10),PKW(pB1,12),PKW(pB1,14)};
    SBAR(); pv(o,vb0+sl_cur,PAF(0),PAF(1),PAF(2),PAF(3)); }
  #undef PKW
  #undef PAF
  #undef VFR
  #undef PIN
  #undef MX3
  #undef GAPA
  #undef GAPB
  #undef EX
  #undef VRD
  #undef KRD
  #undef STEP
  #undef ENDW
  {auto rr=__builtin_amdgcn_permlane32_swap(__float_as_uint(l_reg),__float_as_uint(l_reg),false,false);l_reg=__uint_as_float(rr[0])+__uint_as_float(rr[1]);}
  if(hi==0)wsf[32+r32]=l_reg;asm volatile("s_waitcnt lgkmcnt(0)":::"memory");
  float rli[16];
  #pragma unroll
  for(int r=0;r<16;++r)rli[r]=__builtin_amdgcn_rcpf(wsf[32+crow(r,hi)]);
  { bf16*stg=(bf16*)(shm+LDS_OST)+wid*2048;
    bf16*xst=(bf16*)(shm+LDS_X)+wid*2048; float*ssq=(float*)(shm+LDS_SSQ)+wid*32;
    bf16*cur=(mode&2)?stg:xst;
    if((mode&1)==0){
      #pragma unroll
      for(int r=0;r<16;++r){const int orow=crow(r,hi);
        #pragma unroll
        for(int d0=0;d0<2;++d0)cur[orow*64+d0*32+r32]=__float2bfloat16(o[d0][r]*rli[r]);}
    } else {
      #pragma unroll
      for(int r=0;r<16;++r){const int orow=crow(r,hi);
        #pragma unroll
        for(int d0=0;d0<2;++d0){const int pos=orow*64+d0*32+r32; const float dd=__bfloat162float(cur[pos])-lam*(o[d0][r]*rli[r]); cur[pos]=__float2bfloat16(dd);}}
      asm volatile("s_waitcnt lgkmcnt(0)":::"memory");
      const long trow=rowbase+q0+wid*QBLK;
      #pragma unroll
      for(int i=0;i<4;++i){const int row=i*8+(lane>>3),ch=lane&7; const u32x4 vb=*(const u32x4*)(cur+row*64+ch*8);
        float fb[8];
        #pragma unroll
        for(int e=0;e<4;++e){fb[2*e]=__uint_as_float(vb[e]<<16);fb[2*e+1]=__uint_as_float(vb[e]&0xffff0000u);}
        float ss=0.f;
        #pragma unroll
        for(int e=0;e<8;++e)ss+=fb[e]*fb[e];
        ss+=__shfl_xor(ss,1);ss+=__shfl_xor(ss,2);ss+=__shfl_xor(ss,4);
        if(mode==1){ if(ch==0)ssq[row]=ss; }
        else{
          const u32x4 va=*(const u32x4*)(xst+row*64+ch*8);
          const float rr=(1.0f-LAM_INIT)/sqrtf((ssq[row]+ss)/128.0f+EPS);
          const float4 ga0=*(const float4*)(hgp+ch*8),ga1=*(const float4*)(hgp+ch*8+4),gb0=*(const float4*)(hgp+64+ch*8),gb1=*(const float4*)(hgp+64+ch*8+4);
          const float ga[8]={ga0.x,ga0.y,ga0.z,ga0.w,ga1.x,ga1.y,ga1.z,ga1.w},gb[8]={gb0.x,gb0.y,gb0.z,gb0.w,gb1.x,gb1.y,gb1.z,gb1.w};
          u32x4 oa,ob;
          #pragma unroll
          for(int e=0;e<4;++e){
            oa[e]=cvtpk_s(__uint_as_float(va[e]<<16)*rr*ga[2*e],__uint_as_float(va[e]&0xffff0000u)*rr*ga[2*e+1]);
            ob[e]=cvtpk_s(fb[2*e]*rr*gb[2*e],fb[2*e+1]*rr*gb[2*e+1]);}
          bf16*cp=CATp+(trow+row)*2048+(hv>>1)*128+ch*8;
          ATTN_STORE16(cp,oa); ATTN_STORE16(cp+64,ob);
        }
      }
    }
  }
  asm volatile("s_waitcnt lgkmcnt(0)\n\ts_barrier":::"memory");
  #undef DMA_K
  #undef DMA_V
  #undef CMASK
  #undef START
  #undef RESC
  #undef ROT
}
constexpr int ATTN_LDS_BYTES=LDS_BYTES+NW*4096+NW*128;
struct AttnTensors { const bf16* Q; const bf16* K; const bf16* V; bf16* CAT; float lam; const float* hg; };
template<int THRL=8> __device__ __forceinline__ void attn_phase(char*lds,const AttnTensors&T,int vcu,int G){
  for(int item=vcu;item<BATCH*8*4;item+=G){
    const int b=item>>5,h=(item>>2)&7,j=item&3;
    for(int q2=0;q2<2;++q2){ const int qb=q2?j:NQB-1-j;
      for(int mode=0;mode<4;++mode) attn_unit<THRL>(b,2*h+(mode&1),2*h+(mode>>1),qb,T.Q,T.K,T.V,T.CAT,mode,T.lam,T.hg,lds); }
  }
}
#undef SBAR
#undef WAIT_BAR
}

__device__ __forceinline__ void p_s5_stepA(const Frame& F, const Args& A);
__device__ __forceinline__ void p3_attn(const Frame& F, const Args& A) {
    const attn_body::AttnTensors AT{(const attn_body::bf16*)WSB(WS_QB), (const attn_body::bf16*)WSB(WS_KB), (const attn_body::bf16*)WSB(WS_VB), (attn_body::bf16*)WSB(WS_B), *WSF(WS_LAM), IN_F(9)};
    const int vcu = (F.G % 8 == 0) ? (F.bid % 8) * (F.G / 8) + F.bid / 8 : F.bid;
    p_s5_stepA(F, A);
    attn_body::attn_phase<8>((char*)F.lds, AT, vcu, F.G);
}
__device__ __forceinline__ void p0_s5_setup(const Frame& F, const Args& A) {
    LAS float* Apr = (LAS float*)F.ldsl;
    LAS float* Api = Apr + 33 * 64;
    LAS float* Bbr = Api + 33 * 64;
    LAS float* Bbi = Bbr + 1024;
    LAS float* Cr = Bbi + 1024;
    LAS float* Ci = Cr + 1024;
    LAS float* Kk = Ci + 1024;
    const float* a_re = IN_F(10); const float* a_im = IN_F(11); const float* log_dt = IN_F(12);
    const float* b_re = IN_F(13); const float* b_im = IN_F(14); const float* c_re = IN_F(15); const float* c_im = IN_F(16); const float* dsk = IN_F(17);
    bf16* BtC = WSB(WS_BTC); bf16* BtA = WSB(WS_BTA); float* AL = WSF(WS_AL);
    const int tid = F.tid;
    const float* xin = IN_F(0); const float* g3 = IN_F(3); bf16* XN = WSB(WS_B);
    const int gw4 = 4 * (F.bid * NWAVES + F.wave), step4 = 4 * F.G * NWAVES; int nbat = 0;
#define S5_BAR() asm volatile("s_waitcnt lgkmcnt(0)\n\ts_barrier" ::: "memory")
    for (int item = F.bid; item < SG * 4; item += F.G) {
        const int g = item >> 2, hq = item & 3; const bool first = item == F.bid;
        S5_BAR();
        const float dtf = expf(log_dt[g]); const double dt = (double)dtf;
        for (int e = tid; e < 33 * 64; e += NTHR) {
            const int k = e >> 6, p = e & 63;
            const float lre = a_re[g * SP + p], lim = a_im[g * SP + p];
            const float mag = expf(lre * dtf * (float)k), af = lim * dtf * (float)k;
            Apr[e] = mag * cosf(af); Api[e] = mag * sinf(af);
        }
        for (int e = tid; e < 1024; e += NTHR) {
            const int p = e >> 4, h = e & 15;
            const double lre = a_re[g * SP + p], lim = a_im[g * SP + p];
            const double mag = exp(lre * dt), ang = lim * dt;
            const double rev = ang * 0.15915494309189533577, frr = rev - floor(rev);
            const float af = (float)(frr * 6.283185307179586477);
            const double ar = mag * (double)cosf(af), ai = mag * (double)sinf(af);
            const double den = lre * lre + lim * lim;
            const double fre = ((ar - 1.0) * lre + ai * lim) / den, fim = (ai * lre - (ar - 1.0) * lim) / den;
            const double br = b_re[(g * SP + p) * 16 + h], bi = b_im[(g * SP + p) * 16 + h];
            Bbr[e] = (float)(fre * br - fim * bi); Bbi[e] = (float)(fre * bi + fim * br);
            Cr[h * 64 + p] = c_re[(g * 16 + h) * SP + p]; Ci[h * 64 + p] = c_im[(g * 16 + h) * SP + p];
        }
        S5_BAR();
        float4 pv[32]; const int r0 = gw4 + nbat * step4; const bool has0 = first && r0 < T;
        if (has0) { norm4_load(xin + (size_t)r0 * DM, F.lane, pv); ++nbat; }
        if (hq == 0 && tid < 64) { AL[(g * 64 + tid) * 2] = Apr[32 * 64 + tid]; AL[(g * 64 + tid) * 2 + 1] = Api[32 * 64 + tid]; }
        if (tid < 128) {
            const int k = tid >> 2, hl = tid & 3, h = 4 * hq + hl;
            float acc[16];
#pragma unroll
            for (int q = 0; q < 16; ++q) acc[q] = 0.f;
            for (int p = 0; p < 64; ++p) {
                const float cr = Cr[h * 64 + p], ci = Ci[h * 64 + p], ar = Apr[k * 64 + p], ai = Api[k * 64 + p];
                const float gr = cr * ar - ci * ai, gi = cr * ai + ci * ar;
#pragma unroll
                for (int q = 0; q < 16; ++q) acc[q] += gr * Bbr[p * 16 + q] - gi * Bbi[p * 16 + q];
            }
#pragma unroll
            for (int q = 0; q < 16; ++q) Kk[tid * 16 + q] = acc[q];
        }
        S5_BAR();
        const float dk0 = dsk[g * 16 + 4 * hq], dk1 = dsk[g * 16 + 4 * hq + 1], dk2 = dsk[g * 16 + 4 * hq + 2], dk3 = dsk[g * 16 + 4 * hq + 3];
        if (has0) norm4_finish(pv, g3, XN + (size_t)r0 * DM, F.lane);
        const int r1 = gw4 + nbat * step4; const bool has1 = first && r1 < T;
        if (has1) { norm4_load(xin + (size_t)r1 * DM, F.lane, pv); ++nbat; }
        asm volatile("" ::: "memory");
        for (int e = tid; e < 128 * 80; e += NTHR) {
            const int rr = e / 80, k0 = (e - rr * 80) * 8; const int tau = rr >> 2, hl = rr & 3, h = 4 * hq + hl;
            float v[8];
            if (k0 < 512) { const int sg = k0 >> 4, hp0 = k0 & 15;
#pragma unroll
                for (int q = 0; q < 8; ++q) { float x = 0.f; if (sg <= tau) { x = Kk[(((tau - sg) << 2) + hl) * 16 + hp0 + q]; if (sg == tau && hp0 + q == h) x += (hl == 0 ? dk0 : hl == 1 ? dk1 : hl == 2 ? dk2 : dk3); } v[q] = x; } }
            else { const int kp = k0 - 512, ri = kp >> 6, p0 = kp & 63;
#pragma unroll
                for (int q = 0; q < 8; ++q) { const int p = p0 + q; const float ar = Apr[(tau + 1) * 64 + p], ai = Api[(tau + 1) * 64 + p];
                    const float gr = Cr[h * 64 + p] * ar - Ci[h * 64 + p] * ai, gi = Cr[h * 64 + p] * ai + Ci[h * 64 + p] * ar; v[q] = ri ? -gi : gr; } }
            v4u o; o.x = pk2(v[0], v[1]); o.y = pk2(v[2], v[3]); o.z = pk2(v[4], v[5]); o.w = pk2(v[6], v[7]);
            *(v4u*)(BtC + ((size_t)g * 512 + tau * 16 + h) * 640 + k0) = o;
        }
        for (int e = tid; e < 32 * 64; e += NTHR) {
            const int rr = e >> 6, k0 = (e & 63) * 8; const int ri = rr >> 4, p = 16 * hq + (rr & 15), sg = k0 >> 4, hp0 = k0 & 15;
            const float ar = Apr[(31 - sg) * 64 + p], ai = Api[(31 - sg) * 64 + p];
            float v[8];
#pragma unroll
            for (int q = 0; q < 8; ++q) { const float br = Bbr[p * 16 + hp0 + q], bi = Bbi[p * 16 + hp0 + q]; v[q] = ri ? (ar * bi + ai * br) : (ar * br - ai * bi); }
            v4u o; o.x = pk2(v[0], v[1]); o.y = pk2(v[2], v[3]); o.z = pk2(v[4], v[5]); o.w = pk2(v[6], v[7]);
            *(v4u*)(BtA + ((size_t)g * 256 + ri * 64 + p) * 512 + k0) = o;
        }
        if (has1) norm4_finish(pv, g3, XN + (size_t)r1 * DM, F.lane);
    }
    {
        float4 pv[32];
        for (int r = gw4 + nbat * step4; r < T; r += step4) { norm4_load(xin + (size_t)r * DM, F.lane, pv); norm4_finish(pv, g3, XN + (size_t)r * DM, F.lane); }
    }
#undef S5_BAR
    __syncthreads();
}
__device__ __forceinline__ void p_s5_stepA(const Frame& F, const Args& A) {
    pg8::Gemm g{WSB(WS_UCAT), WSB(WS_BTA), NCH, 256, 512, UCK, 512, (long)NCH * UCK, (long)256 * 512, SG}; pg8::StaticOrder S; S.init(NCH, 256, F.G, F.bid, SG);
    pg8::EpiSl E{WSF(WS_SL)}; GEMM_RUN(pg8::EpiSl, true, g, S, E);
}
__device__ __forceinline__ void p4_s5_scan(const Frame& F, const Args& A) {
    const float* Sl = WSF(WS_SL); const float* AL = WSF(WS_AL); bf16* UC = WSB(WS_UCAT);
    if (F.wave >= 4) return;
    pg8::StaticOrder S; S.init(NCH, 512, F.G, F.bid, SG); pg8::Unit u;
    for (int i = 0; S.next(i, u); ++i) {
        const int p = F.lane, b = u.pm * 4 + F.wave, g = u.bz;
        const float ar = AL[(g * 64 + p) * 2], ai = AL[(g * 64 + p) * 2 + 1];
        const size_t row0 = (size_t)g * NCH + b * 64;
        float lr[64], li[64];
#pragma unroll
        for (int c = 0; c < 64; ++c) { lr[c] = Sl[(row0 + c) * 128 + p]; li[c] = Sl[(row0 + c) * 128 + 64 + p]; }
        asm volatile("" ::: "memory");
        float sr = 0.f, si = 0.f;
#pragma unroll
        for (int c = 0; c < 64; ++c) {
            bf16* up = UC + (row0 + c) * UCK + 512;
            up[p] = (bf16)f2bf(sr); up[64 + p] = (bf16)f2bf(si);
            const float nr = ar * sr - ai * si + lr[c], ni = ar * si + ai * sr + li[c];
            sr = nr; si = ni;
        }
    }
}
__device__ __forceinline__ void p5_s5_out(const Frame& F, const Args& A) {
    pg8::Gemm g{WSB(WS_UCAT), WSB(WS_BTC), NCH, 512, UCK, UCK, UCK, (long)NCH * UCK, (long)512 * UCK, SG}; pg8::StaticOrder S; S.init(NCH, 512, F.G, F.bid, SG);
    pg8::EpiS5 E{WSB(WS_GB)}; GEMM_RUN(pg8::EpiS5, true, g, S, E);
}
__device__ __forceinline__ void p10_xscores(const Frame& F, const Args& A) {
    for (int sel = 0; sel * F.G + F.bid < 256; ++sel) {
        pg8::Gemm g{WSB(WS_XQB), WSB(WS_KP), 2048, 256, 256, XW, 256, 0, 0, 1}; pg8::XsOrder S{F.G, F.bid, sel};
        pg8::EpiXs E{WSB(WS_XP), WSF(WS_LSUM)};
        pg8::gemm_phase<pg8::EpiXs, pg8::XsOrder, false, true>(F.ldsl, g, S, E);
        __syncthreads();
    }
}
__device__ __forceinline__ void p10_xpv(const Frame& F, const Args& A) {
    pg8::Gemm g{WSB(WS_XP), WSB(WS_VT2), 2048, 256, 256, 1024, 512, 0, 0, 1}; pg8::XoOrder S{F.G, F.bid};
    pg8::EpiXo E{WSB(WS_XO), WSF(WS_LSUM)};
    pg8::gemm_phase<pg8::EpiXo, pg8::XoOrder, true, true>(F.ldsl, g, S, E);
}
__device__ __forceinline__ unsigned f2key(float f) { const unsigned u = __float_as_uint(f); return (u & 0x80000000u) ? ~u : (u | 0x80000000u); }
__device__ __forceinline__ float key2f(unsigned k) { const unsigned u = (k & 0x80000000u) ? (k ^ 0x80000000u) : ~k; return __uint_as_float(u); }
#define INS16(L, xk) do { unsigned x_ = (xk); _Pragma("unroll") for (int s_ = 0; s_ < 16; ++s_) { const unsigned hi_ = L[s_] > x_ ? L[s_] : x_; x_ = L[s_] > x_ ? x_ : L[s_]; L[s_] = hi_; } } while (0)
#define CE_DESC(a_, b_) do { const unsigned hi_ = (a_) > (b_) ? (a_) : (b_), lo_ = (a_) > (b_) ? (b_) : (a_); (a_) = hi_; (b_) = lo_; } while (0)
__device__ __forceinline__ void sort16_desc(unsigned (&v)[16]) {
#pragma unroll
    for (int k = 2; k <= 16; k <<= 1)
#pragma unroll
        for (int j = k >> 1; j > 0; j >>= 1)
#pragma unroll
            for (int i = 0; i < 16; ++i) { const int l = i ^ j; if (l > i) { if ((i & k) == 0) CE_DESC(v[i], v[l]); else CE_DESC(v[l], v[i]); } }
}
__device__ __forceinline__ void merge16_desc(unsigned (&a)[16], const unsigned (&b)[16]) {
#pragma unroll
    for (int i = 0; i < 16; ++i) a[i] = a[i] > b[15 - i] ? a[i] : b[15 - i];
#pragma unroll
    for (int j = 8; j > 0; j >>= 1)
#pragma unroll
        for (int i = 0; i < 16; ++i) { const int l = i ^ j; if (l > i) CE_DESC(a[i], a[l]); }
}
__device__ __forceinline__ void top16_of_128(const float* sp, unsigned (&L)[16]) {
#pragma unroll 1
    for (int c = 0; c < 8; ++c) {
        unsigned ch[16];
#pragma unroll
        for (int i = 0; i < 16; ++i) ch[i] = (f2key(sp[(size_t)(c * 16 + i) * T]) & ~127u) | (unsigned)(127 - (c * 16 + i));
        sort16_desc(ch);
        if (c == 0) {
#pragma unroll
            for (int i = 0; i < 16; ++i) L[i] = ch[i];
        } else merge16_desc(L, ch);
    }
}
namespace pg8 {
struct TkOrder {
    int G, c, sel;
    __device__ __forceinline__ bool next(int i, Unit& u) const { if (i > 0) return false; const int L = sel * G + c; if (L >= PH * (T / BM)) return false; u.pm = 0; u.pn = L & (T / BM - 1); u.bz = L / (T / BM); return true; }
    __device__ __forceinline__ void a_ready(const Unit&) const {}
    __device__ __forceinline__ void done(const Unit&) const {}
    template <class G_> __device__ __forceinline__ long offA(const Unit& u, const G_& g) const { return (long)u.bz * g.sA; }
    template <class G_> __device__ __forceinline__ long offB(const Unit& u, const G_& g) const { return (long)u.bz * g.sB; }
};
struct EpiTopk {
    static constexpr bool PERM = false, AFTER_DRAIN = true;
    static constexpr int PITCH = 260;
    unsigned short* IDX; float* GATE;
    __device__ __forceinline__ void stage(const f32x4 (&acc)[2][2][4][2], int ai, int wr, int wc, int fr, int fq, PG8_LAS float* SCL) const {
#pragma unroll
        for (int m = 0; m < 4; ++m)
#pragma unroll
            for (int bj = 0; bj < 2; ++bj)
#pragma unroll
                for (int n = 0; n < 2; ++n) *(PG8_LAS f32x4*)(SCL + (wr * 64 + m * 16 + fr) * PITCH + bj * HALF + wc * 32 + n * 16 + 4 * fq) = acc[ai][bj][m][n];
    }
    static __device__ __forceinline__ unsigned blend(unsigned m, unsigned a, unsigned b) { return (a & m) | (b & ~m); }
    static __device__ __forceinline__ unsigned swap1(unsigned v) { return (unsigned)__builtin_amdgcn_update_dpp(0, (int)v, 0xB1, 0xF, 0xF, true); }
    __device__ __forceinline__ void top16(const PG8_LAS float* sp, int nb, unsigned (&L)[16]) const {
#pragma unroll 1
        for (int c = 0; c < 4; ++c) {
            unsigned ch[16];
#pragma unroll
            for (int i = 0; i < 16; ++i) ch[i] = (f2key(sp[(c * 16 + i) * PITCH]) & ~127u) | (unsigned)(nb - (c * 16 + i));
            sort16_desc(ch);
            if (c == 0) {
#pragma unroll
                for (int i = 0; i < 16; ++i) L[i] = ch[i];
            } else merge16_desc(L, ch);
        }
        unsigned P[16];
#pragma unroll
        for (int i = 0; i < 16; ++i) P[i] = swap1(L[i]);
        merge16_desc(L, P);
    }
    __device__ __forceinline__ void fused(f32x4 (&acc)[2][2][4][2], const Unit& u, int wr, int wc, int fr, int fq, PG8_LAS unsigned char* lds, int wid, int lane) const {
        PG8_LAS float* SCL = (PG8_LAS float*)lds;
        int ln = lane; asm volatile("" : "+v"(ln));
        const int tl = wid * 32 + (ln >> 1), kh = ln & 1; const unsigned km = 0u - (unsigned)kh;
        PG8_LAS unsigned char* li = lds + PK * PITCH * 4 + tl * 32;
        const PG8_LAS float* col = SCL + tl;
        float t1[16], t2[16];
        stage(acc, 0, wr, wc, fr, fq, SCL);
        asm volatile("s_waitcnt lgkmcnt(0)" ::: "memory"); __builtin_amdgcn_s_barrier(); asm volatile("" ::: "memory");
        { unsigned L1[16]; top16(col + kh * 64 * PITCH, 127 - kh * 64, L1);
#pragma unroll
          for (int s = 0; s < 16; ++s) { const int i1 = 127 - (int)(L1[s] & 127u); if (kh == 0) li[s] = (unsigned char)i1; t1[s] = col[i1 * PITCH]; } }
        asm volatile("s_waitcnt lgkmcnt(0)" ::: "memory"); __builtin_amdgcn_s_barrier(); asm volatile("" ::: "memory");
        stage(acc, 1, wr, wc, fr, fq, SCL);
        asm volatile("s_waitcnt lgkmcnt(0)" ::: "memory"); __builtin_amdgcn_s_barrier(); asm volatile("" ::: "memory");
        { unsigned L2[16]; top16(col + kh * 64 * PITCH, 127 - kh * 64, L2);
#pragma unroll
          for (int s = 0; s < 16; ++s) { const int i2 = 127 - (int)(L2[s] & 127u); if (kh == 0) li[16 + s] = (unsigned char)i2; t2[s] = col[i2 * PITCH]; } }
        unsigned Lc[16], c1[16];
        {
            int n = 0;
#pragma unroll
            for (int a = 0; a < 16; ++a)
#pragma unroll
                for (int m = 0; m < 8; ++m)
                    if ((a + 1) * (2 * m + 1) <= 16) {
                        const bool odd_ok = (a + 1) * (2 * m + 2) <= 16;
                        const float tb = __uint_as_float(blend(km, __float_as_uint(t2[(2 * m + 1) & 15]), __float_as_uint(t2[2 * m])));
                        unsigned k = (f2key(t1[a] + tb) & ~255u) | (unsigned)((255 - (a * 16 + 2 * m)) - kh);
                        if (!odd_ok) k = kh ? 0u : k;
                        if (n < 16) Lc[n] = k; else c1[n - 16] = k; ++n; }
            c1[14] = 0u; c1[15] = 0u;
        }
        sort16_desc(Lc); sort16_desc(c1); merge16_desc(Lc, c1);
        {
            unsigned P[16];
#pragma unroll
            for (int i = 0; i < 16; ++i) P[i] = swap1(Lc[i]);
            merge16_desc(Lc, P);
        }
        float ts[16]; const float mx = key2f(Lc[0] & ~255u); float sum = 0.f;
#pragma unroll
        for (int s = 0; s < 16; ++s) { ts[s] = expf(key2f(Lc[s] & ~255u) - mx); sum += ts[s]; }
        const float inv = 1.0f / sum;
        const size_t ob = (size_t)(u.pn * BM + tl) * 128 + u.bz * 16 + kh * 8;
        asm volatile("s_waitcnt lgkmcnt(0)" ::: "memory");
#pragma unroll
        for (int s = 0; s < 8; ++s) {
            const unsigned key = blend(km, Lc[8 + s], Lc[s]); const float tv = __uint_as_float(blend(km, __float_as_uint(ts[8 + s]), __float_as_uint(ts[s])));
            const int flat = 255 - (int)(key & 255u); const int a = flat >> 4, b = flat & 15;
            const int e1 = li[a], e2 = li[16 + b];
            IDX[ob + s] = (unsigned short)(e1 * PK + e2);
            GATE[ob + s] = tv * inv;
        }
    }
};
}

struct PeerCtx { int xr, nx, nloc, rank; };
__device__ __forceinline__ PeerCtx peer_ctx(const Frame& F, volatile LAS unsigned* MISC) {
    if (F.tid == 0) {
        unsigned* barw = (unsigned*)(F.ws + WS_CTL) + CW_BAR; const unsigned x = MISC[11];
        unsigned nx = 0, xr = 0, nloc = 1;
        for (unsigned j = 0; j < 16; ++j) { const unsigned c = xb_ld(&barw[XB_XCNT(j)]); if (c) { ++nx; if (j < x) ++xr; } if (j == x) nloc = c ? c : 1u; }
        MISC[12] = xr; MISC[13] = nx ? nx : 1u; MISC[14] = nloc;
    }
    __syncthreads();
    PeerCtx c; c.xr = (int)MISC[12]; c.nx = (int)MISC[13]; c.nloc = (int)MISC[14]; c.rank = (int)MISC[10];
    return c;
}
typedef __bf16 bf16x2 __attribute__((ext_vector_type(2)));
__device__ __forceinline__ float dot2_bf16(unsigned w, unsigned x, float acc) { return __builtin_amdgcn_fdot2_f32_bf16(__builtin_bit_cast(bf16x2, w), __builtin_bit_cast(bf16x2, x), acc, false); }
__device__ __forceinline__ float dot8(const v4u& r, const v4u& x) { float a = dot2_bf16(r.x, x.x, 0.f); a = dot2_bf16(r.y, x.y, a); a = dot2_bf16(r.z, x.z, a); return dot2_bf16(r.w, x.w, a); }
__device__ __forceinline__ float xl1(float x) { return __uint_as_float((unsigned)__builtin_amdgcn_update_dpp(0, (int)__float_as_uint(x), 0xB1, 0xF, 0xF, true)); }
__device__ __forceinline__ float xl2(float x) { return __uint_as_float((unsigned)__builtin_amdgcn_update_dpp(0, (int)__float_as_uint(x), 0x4E, 0xF, 0xF, true)); }
__device__ __forceinline__ float xl4(float x) { const int v = (int)__float_as_uint(x); int r = __builtin_amdgcn_update_dpp(0, v, 0x104, 0xF, 0x5, false); r = __builtin_amdgcn_update_dpp(r, v, 0x114, 0xF, 0xA, false); return __uint_as_float((unsigned)r); }
__device__ __forceinline__ float xl8(float x) { return __uint_as_float((unsigned)__builtin_amdgcn_update_dpp(0, (int)__float_as_uint(x), 0x128, 0xF, 0xF, true)); }
__device__ __forceinline__ float sum16x(float a, float b) { const auto r = __builtin_amdgcn_permlane16_swap(__float_as_uint(a), __float_as_uint(b), false, false); return __uint_as_float(r[0]) + __uint_as_float(r[1]); }
__device__ __forceinline__ float sum32x(float a, float b) { const auto r = __builtin_amdgcn_permlane32_swap(__float_as_uint(a), __float_as_uint(b), false, false); return __uint_as_float(r[0]) + __uint_as_float(r[1]); }
__device__ __forceinline__ float wave_sum_valu(float x) {
    x += xl1(x); x += xl2(x);
    x += __uint_as_float((unsigned)__builtin_amdgcn_update_dpp(0, (int)__float_as_uint(x), 0x141, 0xF, 0xF, true));
    x += __uint_as_float((unsigned)__builtin_amdgcn_update_dpp(0, (int)__float_as_uint(x), 0x140, 0xF, 0xF, true));
    x = sum16x(x, x); return sum32x(x, x);
}
#define RED8J(v0, v1, v2, v3, v4, v5, v6, v7, B2, B1, B0, out) do { \
    const float a0_ = ((B2) ? v4 : v0) + xl4((B2) ? v0 : v4), a1_ = ((B2) ? v5 : v1) + xl4((B2) ? v1 : v5); \
    const float a2_ = ((B2) ? v6 : v2) + xl4((B2) ? v2 : v6), a3_ = ((B2) ? v7 : v3) + xl4((B2) ? v3 : v7); \
    const float c0_ = ((B1) ? a2_ : a0_) + xl2((B1) ? a0_ : a2_), c1_ = ((B1) ? a3_ : a1_) + xl2((B1) ? a1_ : a3_); \
    out = ((B0) ? c1_ : c0_) + xl1((B0) ? c0_ : c1_); } while (0)
__device__ __forceinline__ int xi1(int x) { return __builtin_amdgcn_update_dpp(0, x, 0xB1, 0xF, 0xF, true); }
__device__ __forceinline__ int xi2(int x) { return __builtin_amdgcn_update_dpp(0, x, 0x4E, 0xF, 0xF, true); }
__device__ __forceinline__ int xi4(int x) { int r = __builtin_amdgcn_update_dpp(0, x, 0x104, 0xF, 0x5, false); return __builtin_amdgcn_update_dpp(r, x, 0x114, 0xF, 0xA, false); }
#define RED8JI(v0, v1, v2, v3, v4, v5, v6, v7, B2, B1, B0, out) do { \
    const int a0_ = ((B2) ? v4 : v0) + xi4((B2) ? v0 : v4), a1_ = ((B2) ? v5 : v1) + xi4((B2) ? v1 : v5); \
    const int a2_ = ((B2) ? v6 : v2) + xi4((B2) ? v2 : v6), a3_ = ((B2) ? v7 : v3) + xi4((B2) ? v3 : v7); \
    const int c0_ = ((B1) ? a2_ : a0_) + xi2((B1) ? a0_ : a2_), c1_ = ((B1) ? a3_ : a1_) + xi2((B1) ? a1_ : a3_); \
    out = ((B0) ? c1_ : c0_) + xi1((B0) ? c0_ : c1_); } while (0)
#define RED8G(v0, v1, v2, v3, v4, v5, v6, v7, B0, out) do { \
    const float a0_ = sum32x(v0, v4), a1_ = sum32x(v1, v5), a2_ = sum32x(v2, v6), a3_ = sum32x(v3, v7); \
    const float c0_ = sum16x(a0_, a2_), c1_ = sum16x(a1_, a3_); \
    out = ((B0) ? c1_ : c0_) + xl8((B0) ? c0_ : c1_); } while (0)
#define RED8(v0, v1, v2, v3, v4, v5, v6, v7, B2, B1, B0, X2, X1, X0, out) do { \
    const float a0_ = ((B2) ? v4 : v0) + __shfl_xor((B2) ? v0 : v4, X2), a1_ = ((B2) ? v5 : v1) + __shfl_xor((B2) ? v1 : v5, X2); \
    const float a2_ = ((B2) ? v6 : v2) + __shfl_xor((B2) ? v2 : v6, X2), a3_ = ((B2) ? v7 : v3) + __shfl_xor((B2) ? v3 : v7, X2); \
    const float c0_ = ((B1) ? a2_ : a0_) + __shfl_xor((B1) ? a0_ : a2_, X1), c1_ = ((B1) ? a3_ : a1_) + __shfl_xor((B1) ? a1_ : a3_, X1); \
    out = ((B0) ? c1_ : c0_) + __shfl_xor((B0) ? c0_ : c1_, X0); } while (0)
typedef float f32x2 __attribute__((ext_vector_type(2)));
struct PTok { unsigned ix[8]; v4u xa; float xs; float oa, ob; };
#define PK_IDX(TK, k) (((k) & 1) ? (TK.ix[(k) >> 1] >> 16) : (TK.ix[(k) >> 1] & 0xffffu))
#define LD_IDX16(TK, ip_) do { _Pragma("unroll") for (int q_ = 0; q_ < 2; ++q_) { const int4 v_ = (ip_)[q_]; TK.ix[4 * q_] = (unsigned)v_.x; TK.ix[4 * q_ + 1] = (unsigned)v_.y; TK.ix[4 * q_ + 2] = (unsigned)v_.z; TK.ix[4 * q_ + 3] = (unsigned)v_.w; } } while (0)
__device__ __forceinline__ float dot16_fp8(const v4u& r, const f32x2 (&X)[8]) {
    f32x2 a = {0.f, 0.f};
#pragma unroll
    for (int q = 0; q < 4; ++q) { const f32x2 lo = __builtin_amdgcn_cvt_pk_f32_fp8((int)r[q], false), hi = __builtin_amdgcn_cvt_pk_f32_fp8((int)r[q], true);
        a = lo * X[2 * q] + a; a = hi * X[2 * q + 1] + a; }
    return a.x + a.y;
}
__device__ __forceinline__ void p17_peer_u(const Frame& F, const Args& A, volatile LAS unsigned* MISC) {
    const PeerCtx cx = peer_ctx(F, MISC);
    const unsigned char* UB = F.ws + WS_UB; const unsigned char* X8 = F.ws + WS_X8; const float* XS = WSF(WS_XS); const unsigned short* IDX = (const unsigned short*)(F.ws + WS_IDX); float* PACT = WSF(WS_PACT) + (size_t)cx.xr * T * 128;
    const int lane = F.lane, j = lane & 7, g = lane >> 3;
    const bool b2 = lane & 4, b1 = lane & 2, b0 = lane & 1;
    const int NI = (T / 8 - cx.rank + cx.nloc - 1) / cx.nloc;
#define U_TOK(i_) (((cx.rank + (i_) * cx.nloc) * 8) + F.wave)
    for (int p = 0; cx.xr + cx.nx * p < NSL; ++p) {
        const int s = cx.xr + cx.nx * p;
        const __amdgpu_buffer_rsrc_t rs = __builtin_amdgcn_make_buffer_rsrc((void*)(UB + (size_t)s * (PK * PK) * SLW), 0, PK * PK * SLW, 0x00020000);
#define U_LOAD(TK, t_) do { const int4* ip_ = (const int4*)(IDX + (size_t)(t_) * 128 + 16 * g); LD_IDX16(TK, ip_); \
        TK.xa = *(const v4u*)(X8 + (size_t)(t_) * DM + s * SLW + j * 16); TK.xs = XS[(size_t)(t_) * 16 + s]; \
        TK.oa = 0.f; TK.ob = 0.f; if (p != 0) { const float2 pp_ = *(const float2*)(PACT + (size_t)(t_) * 128 + 16 * g + 2 * j); TK.oa = pp_.x; TK.ob = pp_.y; } } while (0)
#define U_GATHER(R, TK) do { _Pragma("unroll") for (int k = 0; k < 16; ++k) R[k] = __builtin_amdgcn_raw_buffer_load_b128(rs, ((unsigned)PK_IDX(TK, k) << 7) + (unsigned)(j * 16), 0, 0); } while (0)
#define U_COMPUTE(R, XA, XS_, OA, OB, t_) do { \
        int v[16]; _Pragma("unroll") for (int k = 0; k < 16; ++k) { int a_ = __builtin_amdgcn_sdot4((int)R[k][0], (int)XA[0], 0, false); a_ = __builtin_amdgcn_sdot4((int)R[k][1], (int)XA[1], a_, false); \
            a_ = __builtin_amdgcn_sdot4((int)R[k][2], (int)XA[2], a_, false); v[k] = __builtin_amdgcn_sdot4((int)R[k][3], (int)XA[3], a_, false); } \
        int ie_, io_; \
        RED8JI(v[0], v[2], v[4], v[6], v[8], v[10], v[12], v[14], b2, b1, b0, ie_); \
        RED8JI(v[1], v[3], v[5], v[7], v[9], v[11], v[13], v[15], b2, b1, b0, io_); \
        *(float2*)(PACT + (size_t)(t_) * 128 + 16 * g + 2 * j) = make_float2(OA + (float)ie_ * XS_, OB + (float)io_ * XS_); } while (0)
        PTok TA, TB; v4u RA[16], RB[16];
        if (NI > 0) U_LOAD(TA, U_TOK(0));
        if (NI > 1) U_LOAD(TB, U_TOK(1));
        if (NI > 0) U_GATHER(RA, TA);
        for (int i = 0; i < NI; i += 2) {
            { const v4u xa = TA.xa; const float xs = TA.xs, oa = TA.oa, ob = TA.ob;
              if (i + 2 < NI) U_LOAD(TA, U_TOK(i + 2));
              if (i + 1 < NI) U_GATHER(RB, TB);
              U_COMPUTE(RA, xa, xs, oa, ob, U_TOK(i)); }
            if (i + 1 < NI) {
                const v4u xa = TB.xa; const float xs = TB.xs, oa = TB.oa, ob = TB.ob;
                if (i + 3 < NI) U_LOAD(TB, U_TOK(i + 3));
                if (i + 2 < NI) U_GATHER(RA, TA);
                U_COMPUTE(RB, xa, xs, oa, ob, U_TOK(i + 1));
            }
        }
    }
#undef U_LOAD
#undef U_GATHER
#undef U_COMPUTE
#undef U_TOK
}
__device__ __forceinline__ void p18_peer_w(const Frame& F, const Args& A, volatile LAS unsigned* MISC) {
    const PeerCtx cx = peer_ctx(F, MISC);
    const float* PACT = WSF(WS_PACT); const float* GATE = WSF(WS_GATE); unsigned short* W = (unsigned short*)(F.ws + WS_PW);            const unsigned short* IDX = (const unsigned short*)(F.ws + WS_IDX);
    const float* iu = WSF(WS_ISCU); const float* iv = WSF(WS_ISCV); const float* ssq2 = WSF(WS_SSQ2);
    const size_t gt = (size_t)F.bid * NTHR + F.tid, NGT = (size_t)F.G * NTHR;
    for (size_t i = gt * 4; i < (size_t)T * 128; i += NGT * 4) {
        float4 a = make_float4(0.f, 0.f, 0.f, 0.f);
        for (int q0 = 0; q0 < cx.nx; q0 += 8) {
            float4 pa[8];
#pragma unroll
            for (int j = 0; j < 8; ++j) pa[j] = (q0 + j < cx.nx) ? *(const float4*)(PACT + (size_t)(q0 + j) * T * 128 + i) : make_float4(0.f, 0.f, 0.f, 0.f);
#pragma unroll
            for (int j = 0; j < 8; ++j) { a.x += pa[j].x; a.y += pa[j].y; a.z += pa[j].z; a.w += pa[j].w; }
        }
        const uint2 e2_ = *(const uint2*)(IDX + i); const int4 e = make_int4((int)(e2_.x & 0xffffu), (int)(e2_.x >> 16), (int)(e2_.y & 0xffffu), (int)(e2_.y >> 16)); const float4 gt4 = *(const float4*)(GATE + i);
        const float rs = 1.0f / sqrtf(ssq2[i >> 7] * (1.0f / 2048.0f) + EPS);
        float4 w;
        w.x = gt4.x * gelu_exact(a.x * iu[e.x] * rs) * iv[e.x]; w.y = gt4.y * gelu_exact(a.y * iu[e.y] * rs) * iv[e.y];
        w.z = gt4.z * gelu_exact(a.z * iu[e.z] * rs) * iv[e.z]; w.w = gt4.w * gelu_exact(a.w * iu[e.w] * rs) * iv[e.w];
        *(uint2*)(W + i) = make_uint2(pk2(w.x, w.y), pk2(w.z, w.w));
    }
}
struct VTok { unsigned ix[8]; unsigned w[8]; float h0, h1; };
__device__ __forceinline__ void p19_peer_v(const Frame& F, const Args& A, volatile LAS unsigned* MISC) {
    const PeerCtx cx = peer_ctx(F, MISC);
    const unsigned char* VT = F.ws + WS_VT; float* SSQP = WSF(WS_SSQP);
    const __amdgpu_buffer_rsrc_t rsI = __builtin_amdgcn_make_buffer_rsrc((void*)(F.ws + WS_IDX), 0, T * 128 * 2, 0x00020000);
    const __amdgpu_buffer_rsrc_t rsW = __builtin_amdgcn_make_buffer_rsrc((void*)(F.ws + WS_PW), 0, T * 128 * 2, 0x00020000);
    const __amdgpu_buffer_rsrc_t rsHB = __builtin_amdgcn_make_buffer_rsrc((void*)(F.ws + WS_B), 0, T * DM * 2, 0x00020000);
    const int lane = F.lane, j = lane & 7, g = lane >> 3;
    const bool b5 = lane & 32, b4 = lane & 16, b3 = lane & 8;
    const int NI = (T / 8 - cx.rank + cx.nloc - 1) / cx.nloc;
#define U_TOK(i_) (((cx.rank + (i_) * cx.nloc) * 8) + F.wave)
    for (int p = 0; cx.xr + cx.nx * p < NSL; ++p) {
        const int s = cx.xr + cx.nx * p;
        const __amdgpu_buffer_rsrc_t rs = __builtin_amdgcn_make_buffer_rsrc((void*)(VT + (size_t)s * (PK * PK) * SLW), 0, PK * PK * SLW, 0x00020000);
        const unsigned hoff = (unsigned)(s * SLW + 16 * j + 2 * g) * 2u;
#define V_LOAD(TK, t_) do { const unsigned io_ = ((unsigned)(t_) * 128u + 16u * g) * 2u; \
        _Pragma("unroll") for (int q_ = 0; q_ < 2; ++q_) { const v4u v_ = __builtin_amdgcn_raw_buffer_load_b128(rsI, io_ + 16u * q_, 0, 0); TK.ix[4 * q_] = v_[0]; TK.ix[4 * q_ + 1] = v_[1]; TK.ix[4 * q_ + 2] = v_[2]; TK.ix[4 * q_ + 3] = v_[3]; } \
        _Pragma("unroll") for (int q_ = 0; q_ < 2; ++q_) { const v4u v_ = __builtin_amdgcn_raw_buffer_load_b128(rsW, io_ + 16u * q_, 0, 0); TK.w[4 * q_] = v_[0]; TK.w[4 * q_ + 1] = v_[1]; TK.w[4 * q_ + 2] = v_[2]; TK.w[4 * q_ + 3] = v_[3]; } \
        const unsigned hb_ = (unsigned)(t_) * (DM * 2u) + hoff; const unsigned hw_ = (unsigned)__builtin_amdgcn_raw_buffer_load_b32(rsHB, hb_, 0, 0); TK.h0 = __uint_as_float(hw_ << 16); TK.h1 = __uint_as_float(hw_ & 0xffff0000u); } while (0)
#define V_GATHER(R, TK) do { _Pragma("unroll") for (int k = 0; k < 16; ++k) R[k] = __builtin_amdgcn_raw_buffer_load_b128(rs, ((unsigned)PK_IDX(TK, k) << 7) + (unsigned)(j * 16), 0, 0); } while (0)
#define V_COMPUTE(R, WQ, H0, H1, t_) do { f32x2 acc[8]; _Pragma("unroll") for (int q = 0; q < 8; ++q) acc[q] = (f32x2){0.f, 0.f}; \
        _Pragma("unroll") for (int k = 0; k < 16; ++k) { const unsigned wd_ = WQ[k >> 1]; const float wk_ = __uint_as_float((k & 1) ? (wd_ & 0xffff0000u) : (wd_ << 16)); const f32x2 w2 = (f32x2){wk_, wk_}; \
            _Pragma("unroll") for (int q = 0; q < 4; ++q) { const f32x2 lo = __builtin_amdgcn_cvt_pk_f32_fp8((int)R[k][q], false), hi = __builtin_amdgcn_cvt_pk_f32_fp8((int)R[k][q], true); \
                acc[2 * q] = lo * w2 + acc[2 * q]; acc[2 * q + 1] = hi * w2 + acc[2 * q + 1]; } } \
        float f0_, f1_; \
        RED8G(acc[0].x, acc[1].x, acc[2].x, acc[3].x, acc[4].x, acc[5].x, acc[6].x, acc[7].x, b3, f0_); \
        RED8G(acc[0].y, acc[1].y, acc[2].y, acc[3].y, acc[4].y, acc[5].y, acc[6].y, acc[7].y, b3, f1_); \
        const unsigned hb2_ = (unsigned)(t_) * (DM * 2u) + hoff; const float n0_ = H0 + f0_, n1_ = H1 + f1_; \
        __builtin_amdgcn_raw_buffer_store_b32(pk2(n0_, n1_), rsHB, hb2_, 0, 0); \
        const float s0_ = wave_sum_valu(n0_ * n0_ + n1_ * n1_); if (lane == 0) SSQP[(size_t)s * T + (t_)] = s0_; } while (0)
        VTok TA, TB; v4u RA[16], RB[16];
        if (NI > 0) V_LOAD(TA, U_TOK(0));
        if (NI > 1) V_LOAD(TB, U_TOK(1));
        if (NI > 0) V_GATHER(RA, TA);
        for (int i = 0; i < NI; i += 2) {
            { const float h0 = TA.h0, h1 = TA.h1; unsigned wv[8];
              _Pragma("unroll") for (int q = 0; q < 8; ++q) wv[q] = TA.w[q];
              if (i + 2 < NI) V_LOAD(TA, U_TOK(i + 2));
              if (i + 1 < NI) V_GATHER(RB, TB);
              V_COMPUTE(RA, wv, h0, h1, U_TOK(i)); }
            if (i + 1 < NI) {
                const float h0 = TB.h0, h1 = TB.h1; unsigned wv[8];
                _Pragma("unroll") for (int q = 0; q < 8; ++q) wv[q] = TB.w[q];
                if (i + 3 < NI) V_LOAD(TB, U_TOK(i + 3));
                if (i + 2 < NI) V_GATHER(RA, TA);
                V_COMPUTE(RB, wv, h0, h1, U_TOK(i + 1));
            }
        }
    }
#undef V_LOAD
#undef V_GATHER
#undef V_COMPUTE
#undef U_TOK
}
__device__ __forceinline__ void p20_final(const Frame& F, const Args& A) {
    float* O = F.out; const bf16* HB = WSB(WS_B); const float* fg = IN_F(33); const float* SSQP = WSF(WS_SSQP);
    const int gw = F.bid * NWAVES + F.wave, NGW = F.G * NWAVES, lane = F.lane;
    for (int t = gw; t < T; t += NGW) {
        float sq = 0.f;
#pragma unroll
        for (int sl = 0; sl < NSL; ++sl) sq += SSQP[(size_t)sl * T + t];
        const float r = 1.0f / sqrtf(sq / (float)DM + EPS);
#pragma unroll
        for (int q = 0; q < 4; ++q) { const int c = 512 * q + 8 * lane; const v4u h = *(const v4u*)(HB + (size_t)t * DM + c);
            const float4 g0 = *(const float4*)(fg + c), g1 = *(const float4*)(fg + c + 4);
            ntst4(O + (size_t)t * DM + c, make_float4(__uint_as_float(h.x << 16) * r * g0.x, __uint_as_float(h.x & 0xffff0000u) * r * g0.y, __uint_as_float(h.y << 16) * r * g0.z, __uint_as_float(h.y & 0xffff0000u) * r * g0.w));
            ntst4(O + (size_t)t * DM + c + 4, make_float4(__uint_as_float(h.z << 16) * r * g1.x, __uint_as_float(h.z & 0xffff0000u) * r * g1.y, __uint_as_float(h.w << 16) * r * g1.z, __uint_as_float(h.w & 0xffff0000u) * r * g1.w)); }
    }
}
__device__ __forceinline__ void p0_prep(const Frame& F, const Args& A) {
    const int gw = F.bid * NWAVES + F.wave, NGW = F.G * NWAVES, lane = F.lane;
    LAS float* scr = (LAS float*)(F.ldsl + F.wave * 16384);
    constexpr int I_IN = 32 * 128, I_GLU = 16 * 32, I_OUT = 32 * 64, I_XQ = 32 * 16, I_XKV = 32 * 32, I_XO = 8 * 64, I_PQ = 32 * 64;
    constexpr int NITEMS = I_IN + I_GLU + I_OUT + I_XQ + I_XKV + I_XO + I_PQ;
    for (int it = gw; it < NITEMS; it += NGW) {
        int r = it;
        if (r < I_IN) { p0_transpose_item(IN_F(4), DM, INC, WSB(WS_WIN), 0, scr, r, lane); continue; } r -= I_IN;
        if (r < I_GLU) { p0_transpose_item(IN_F(18), SSMW, SSMW, WSB(WS_WGLU), 0, scr, r, lane); continue; } r -= I_GLU;
        if (r < I_OUT) { p0_transpose_item(IN_F(21), DM, DM, WSB(WS_WOUT), 0, scr, r, lane, IN_F(20), 1024); continue; } r -= I_OUT;
        if (r < I_XQ) { p0_transpose_item(IN_F(24), DM, XW, WSB(WS_WXQ), 0, scr, r, lane, IN_F(22)); continue; } r -= I_XQ;
        if (r < I_XKV) { p0_transpose_item(IN_F(25), DM, 2 * XW, WSB(WS_WXKV), 0, scr, r, lane); continue; } r -= I_XKV;
        if (r < I_XO) { p0_transpose_item(IN_F(26), XW, DM, WSB(WS_WXO), 0, scr, r, lane); continue; } r -= I_XO;
        p0_transpose_item(IN_F(28), DM, PH * PQD, WSB(WS_WPQ), 0, scr, r, lane, IN_F(27));
    }
    const float* x = IN_F(0); const float* mem = IN_F(1);
    { const float* g3 = IN_F(3); bf16* XN = WSB(WS_B);
      (void)x; (void)g3; (void)XN; }
    { const float* g23 = IN_F(23); bf16* MN = WSB(WS_MN);
      for (int r = 2 * gw; r < BATCH * NMEM; r += 2 * NGW) { norm_2rows_to_bf16(mem + (size_t)r * DM, g23, MN + (size_t)r * DM, lane); } }
    const int* pos = IN_I(2); float* rope = WSF(WS_ROPE);
    const int gt = F.bid * NTHR + F.tid, NGT = F.G * NTHR;
    for (int e = gt; e < T * 8; e += NGT) {
        const int t = e >> 3, i = e & 7;
        const float freq = expf(-(float)i * (13.122363377404328f / 8.0f));
        const float a = (float)pos[t] * freq;
        rope[e * 2 + 0] = cosf(a); rope[e * 2 + 1] = sinf(a);
    }
    if (gt == 0) {
        const float* q1 = IN_F(5); const float* k1 = IN_F(6); const float* q2 = IN_F(7); const float* k2 = IN_F(8);
        float s1 = 0.f, s2 = 0.f;
        for (int i = 0; i < 64; ++i) { s1 += q1[i] * k1[i]; s2 += q2[i] * k2[i]; }
        *WSF(WS_LAM) = expf(s1) - expf(s2) + LAM_INIT;
    }
    bf16* KD = WSB(WS_KD); const float* k1 = IN_F(29); const float* k2 = IN_F(30);
    for (int e = gt; e < PH * 256 * 256; e += NGT) {
        const int kk = e & 255, nn = (e >> 8) & 255, h = e >> 16;
        float v = 0.f;
        if ((kk >> 7) == (nn >> 7)) { const float* ks = (nn >> 7) ? k2 : k1; v = ks[((size_t)h * PK + (nn & 127)) * 128 + (kk & 127)]; }
        KD[e] = (bf16)f2bf(v);
    }
}
__device__ __forceinline__ void p1_win(const Frame& F, const Args& A) {
    { pg8::Gemm g{WSB(WS_B), WSB(WS_WIN), T, INC, DM, DM, DM, 0, 0, 1}; pg8::StaticOrder S; S.init(T, INC, F.G, F.bid); pg8::EpiWin E{WSB(WS_QB), (size_t)(WS_KB - WS_QB) / 2, WSB(WS_UCAT), WSF(WS_ROPE), attn_body::C2}; GEMM_RUN(pg8::EpiWin, true, g, S, E); }
}
__device__ __forceinline__ void p5_glu(const Frame& F, const Args& A) {
    pg8::Gemm g{WSB(WS_GB), WSB(WS_WGLU), T, SSMW, SSMW, SSMW, SSMW, 0, 0, 1}; pg8::StaticOrder S; S.init(T, SSMW, F.G, F.bid);
    pg8::EpiGlu E{WSB(WS_GB), IN_F(19), WSB(WS_B), WSF(WS_SSQ)}; GEMM_RUN(pg8::EpiGlu, true, g, S, E);
}

__device__ __forceinline__ void p5_tables(const Frame& F, const Args& A) {
    unsigned char* UB = F.ws + WS_UB; unsigned char* VT = F.ws + WS_VT;
    const float* Uin = IN_F(31); const float* Vin = IN_F(32); const float* gfn = IN_F(27); float* iscu = WSF(WS_ISCU); float* iscv = WSF(WS_ISCV);
    const int gw = F.bid * NWAVES + F.wave, NGW = F.G * NWAVES, lane = F.lane;
    for (int it = 2 * gw; it < 2 * PK * PK; it += 2 * NGW) {
        const int tb = it >= PK * PK, e = tb ? it - PK * PK : it;
        const float* src = (tb ? Vin : Uin) + (size_t)e * DM; unsigned char* dst = tb ? VT : UB; float* isc = tb ? iscv : iscu;
        float4 v[16]; float am0 = 0.f, am1 = 0.f;
#pragma unroll
        for (int q = 0; q < 16; ++q) v[q] = ntld4(src + (q >> 3) * DM + 256 * (q & 7) + 4 * lane);
        if (!tb) {
#pragma unroll
            for (int q = 0; q < 8; ++q) { const float4 g4 = *(const float4*)(gfn + 256 * q + 4 * lane);
                v[q].x *= g4.x; v[q].y *= g4.y; v[q].z *= g4.z; v[q].w *= g4.w; v[8 + q].x *= g4.x; v[8 + q].y *= g4.y; v[8 + q].z *= g4.z; v[8 + q].w *= g4.w; }
        }
#pragma unroll
        for (int q = 0; q < 8; ++q) { am0 = fmaxf(am0, fmaxf(fmaxf(fabsf(v[q].x), fabsf(v[q].y)), fmaxf(fabsf(v[q].z), fabsf(v[q].w))));
                                      am1 = fmaxf(am1, fmaxf(fmaxf(fabsf(v[8 + q].x), fabsf(v[8 + q].y)), fmaxf(fabsf(v[8 + q].z), fabsf(v[8 + q].w)))); }
        am0 = wave_max(am0); am1 = wave_max(am1);
        float sc0 = 1.0f, sc1 = 1.0f;
        if (tb) { if (am0 > 1e-30f) sc0 = __uint_as_float(__float_as_uint(448.0f / am0) & 0x7f800000u);
                  if (am1 > 1e-30f) sc1 = __uint_as_float(__float_as_uint(448.0f / am1) & 0x7f800000u); }
        else    { if (am0 > 1e-30f) sc0 = 127.0f / am0; if (am1 > 1e-30f) sc1 = 127.0f / am1; }
        if (lane == 0) { isc[e] = 1.0f / sc0; isc[e + 1] = 1.0f / sc1; }
#pragma unroll
        for (int q = 0; q < 16; ++q) {
            const float sc = q < 8 ? sc0 : sc1; int w = 0;
            if (tb) { w = __builtin_amdgcn_cvt_pk_fp8_f32(v[q].x * sc, v[q].y * sc, w, false);
                      w = __builtin_amdgcn_cvt_pk_fp8_f32(v[q].z * sc, v[q].w * sc, w, true); }
            else { const int q0 = (int)__builtin_rintf(v[q].x * sc), q1 = (int)__builtin_rintf(v[q].y * sc), q2 = (int)__builtin_rintf(v[q].z * sc), q3 = (int)__builtin_rintf(v[q].w * sc);
                   w = (int)((unsigned)(q0 & 255) | ((unsigned)(q1 & 255) << 8) | ((unsigned)(q2 & 255) << 16) | ((unsigned)q3 << 24)); }
            const int c = 256 * (q & 7) + 4 * lane;
            *(int*)(dst + ((size_t)(c >> 7) * (PK * PK) + e + (q >> 3)) * SLW + (c & 127)) = w;
        }
    }
}
__device__ __forceinline__ void p7_wout(const Frame& F, const Args& A) {
    pg8::Gemm g{WSB(WS_B), WSB(WS_WOUT), T, DM, DM, DM, DM, 0, 0, 1}; pg8::StaticOrder S; S.init(T, DM, F.G, F.bid);
    pg8::EpiWout E{IN_F(0), WSB(WS_HB2), WSF(WS_SSQ1), DM, WSF(WS_SSQ), 16}; GEMM_RUN(pg8::EpiWout, true, g, S, E);
}
__device__ __forceinline__ void p9_xq(const Frame& F, const Args& A) {
    pg8::Gemm g{WSB(WS_HB2), WSB(WS_WXQ), T, XW, DM, DM, DM, 0, 0, 1}; pg8::StaticOrder S; S.init(T, XW, F.G, F.bid);
    pg8::EpiRowBf16 E{WSB(WS_XQB), XW, WSF(WS_SSQ1), 0.08838834764831845f}; GEMM_RUN(pg8::EpiRowBf16, true, g, S, E);
    { pg8::Gemm g2{WSB(WS_MN), WSB(WS_WXKV), BATCH * NMEM, 2 * XW, DM, DM, DM, 0, 0, 1}; pg8::StaticOrder S2; S2.init(BATCH * NMEM, 2 * XW, F.G, F.G - 1 - F.bid); pg8::EpiXkv E2{WSB(WS_KP), WSB(WS_VT2)}; GEMM_RUN(pg8::EpiXkv, true, g2, S2, E2); }
}
__device__ __forceinline__ void p11_xo(const Frame& F, const Args& A) {
    pg8::Gemm g{WSB(WS_XO), WSB(WS_WXO), T, DM, XW, XW, XW, 0, 0, 1}; pg8::StaticOrder S; S.init(T, DM, F.G, F.bid);
    pg8::EpiResidB<false> E{WSB(WS_HB2), WSB(WS_B), WSF(WS_SSQ2), DM}; GEMM_RUN(pg8::EpiResidB<false>, true, g, S, E);
}
__device__ __forceinline__ void p13_pq(const Frame& F, const Args& A) {
    pg8::Gemm g{WSB(WS_B), WSB(WS_WPQ), T, PH * PQD, DM, DM, DM, 0, 0, 1}; pg8::StaticOrder S; S.init(T, PH * PQD, F.G, F.bid);
    pg8::EpiRowBf16 E{WSB(WS_PQ), PH * PQD, WSF(WS_SSQ2), 1.0f}; GEMM_RUN(pg8::EpiRowBf16, true, g, S, E);
}
__device__ __forceinline__ void p14_quant_x(const Frame& F, const Args& A) {
    const bf16* HB = WSB(WS_B); unsigned char* X8 = F.ws + WS_X8; float* XS = WSF(WS_XS);
    const int gw = F.bid * NWAVES + F.wave, NGW = F.G * NWAVES, lane = F.lane;
    for (int t = gw; t < T; t += NGW) {
        const v4u* src = (const v4u*)(HB + (size_t)t * DM + lane * 32);
        const v4u q0 = src[0], q1 = src[1], q2 = src[2], q3 = src[3];
        float x[32];
#pragma unroll
        for (int e = 0; e < 4; ++e) { x[2 * e] = __uint_as_float(q0[e] << 16); x[2 * e + 1] = __uint_as_float(q0[e] & 0xffff0000u); x[8 + 2 * e] = __uint_as_float(q1[e] << 16); x[8 + 2 * e + 1] = __uint_as_float(q1[e] & 0xffff0000u);
            x[16 + 2 * e] = __uint_as_float(q2[e] << 16); x[16 + 2 * e + 1] = __uint_as_float(q2[e] & 0xffff0000u); x[24 + 2 * e] = __uint_as_float(q3[e] << 16); x[24 + 2 * e + 1] = __uint_as_float(q3[e] & 0xffff0000u); }
        float am = 0.f;
#pragma unroll
        for (int e = 0; e < 32; ++e) am = fmaxf(am, fabsf(x[e]));
        am = fmaxf(am, xl1(am)); am = fmaxf(am, xl2(am));
        const float sc = am > 1e-30f ? 127.0f / am : 0.0f;
        if ((lane & 3) == 0) XS[(size_t)t * 16 + (lane >> 2)] = am * (1.0f / 127.0f);
        unsigned w[8];
#pragma unroll
        for (int d = 0; d < 8; ++d) { const int a0 = (int)__builtin_rintf(x[4 * d] * sc), a1 = (int)__builtin_rintf(x[4 * d + 1] * sc), a2 = (int)__builtin_rintf(x[4 * d + 2] * sc), a3 = (int)__builtin_rintf(x[4 * d + 3] * sc);
            w[d] = (unsigned)(a0 & 255) | ((unsigned)(a1 & 255) << 8) | ((unsigned)(a2 & 255) << 16) | ((unsigned)a3 << 24); }
        v4u o0, o1; o0.x = w[0]; o0.y = w[1]; o0.z = w[2]; o0.w = w[3]; o1.x = w[4]; o1.y = w[5]; o1.z = w[6]; o1.w = w[7];
        v4u* dst = (v4u*)(X8 + (size_t)t * DM + lane * 32); dst[0] = o0; dst[1] = o1;
    }
}
__device__ __forceinline__ void p14_scores(const Frame& F, const Args& A) {
    for (int sel = 0; sel * F.G + F.bid < PH * (T / 256); ++sel) {
        pg8::Gemm g{WSB(WS_KD), WSB(WS_PQ), 256, T, 256, 256, PH * PQD, 65536, 256, PH}; pg8::TkOrder S{F.G, F.bid, sel};
        pg8::EpiTopk E{(unsigned short*)(F.ws + WS_IDX), WSF(WS_GATE)};
        pg8::gemm_phase<pg8::EpiTopk, pg8::TkOrder, false, true>(F.ldsl, g, S, E);
        __syncthreads();
    }
}

constexpr int NPHASE = 15;
__global__ void __launch_bounds__(NTHR, 2) mk_fwd(Args args) {
    extern __shared__ __attribute__((aligned(16))) unsigned char lds[];
#define MKFRAME() Frame F; { int t_ = threadIdx.x; asm volatile("" : "+v"(t_)); F.lds = lds; F.ldsl = (LAS unsigned char*)lds; F.tid = t_; F.lane = t_ & 63; F.wave = __builtin_amdgcn_readfirstlane(t_ >> 6); \
    F.G = gridDim.x; F.bid = blockIdx.x; F.ws = args.ws; F.out = args.out; }
    volatile LAS unsigned* MISC = (volatile LAS unsigned*)((LAS unsigned char*)lds + MISC_OFF);
    if (threadIdx.x < 32) MISC[threadIdx.x] = 0u;
    __syncthreads();
    (void)xcd_barrier_post((unsigned*)(args.ws + WS_CTL) + CW_BAR, MISC + 8);
    if (threadIdx.x == 0) { const unsigned x = xb_xcc_id(); MISC[11] = x; MISC[10] = xb_add((unsigned*)(args.ws + WS_CTL) + CW_TICKET + 64 * x, 1u); }
    const int lo = args.ph_lo, hi = args.ph_hi;
#define IN(k) (lo <= (k) && (k) < hi)
#define SEAM(k) do { if (IN(k) && IN((k) + 1)) { XcdBarrier b_; b_.bar = (unsigned*)(args.ws + WS_CTL) + CW_BAR; b_.x = 0; b_.st = MISC + 8; xcd_barrier(b_); } } while (0)
    if (IN(0)) { MKFRAME(); p0_prep(F, args); __syncthreads(); p0_s5_setup(F, args); }  SEAM(0);
    if (IN(1)) { MKFRAME(); p1_win(F, args); }             SEAM(1);
    if (IN(2)) { MKFRAME(); p3_attn(F, args); }            SEAM(2);
    if (IN(3)) { MKFRAME(); p4_s5_scan(F, args); }
    { int g3_ = __builtin_amdgcn_readfirstlane(IN(3) ? 1 : 0); asm volatile("s_waitcnt vmcnt(0)" : "+s"(g3_) :: "memory"); __syncthreads(); if (g3_) { MKFRAME(); p5_s5_out(F, args); } }   SEAM(3);
    if (IN(4)) { MKFRAME(); p5_glu(F, args); p5_tables(F, args); }  SEAM(4);
    if (IN(5)) { MKFRAME(); p7_wout(F, args); }            SEAM(5);
    if (IN(6)) { MKFRAME(); p9_xq(F, args); }              SEAM(6);
    if (IN(7)) { MKFRAME(); p10_xscores(F, args); }
    { int g8_ = __builtin_amdgcn_readfirstlane(IN(7) ? 1 : 0); asm volatile("s_waitcnt vmcnt(0)" : "+s"(g8_) :: "memory"); __syncthreads(); if (g8_) { MKFRAME(); p10_xpv(F, args); } }   SEAM(7);
    if (IN(8)) { MKFRAME(); p11_xo(F, args); }            SEAM(8);
    if (IN(9)) { MKFRAME(); p13_pq(F, args); }            SEAM(9);
    if (IN(10)) { MKFRAME(); p14_scores(F, args); p14_quant_x(F, args); }        SEAM(10);
    if (IN(11)) { MKFRAME(); p17_peer_u(F, args, MISC); }  SEAM(11);
    if (IN(12)) { MKFRAME(); p18_peer_w(F, args, MISC); }  SEAM(12);
    if (IN(13)) { MKFRAME(); p19_peer_v(F, args, MISC); }  SEAM(13);
    if (IN(14)) { MKFRAME(); p20_final(F, args); }
#undef IN
#undef SEAM
}
extern "C" void kernel_launch(void* const* d_in, const int* in_sizes, int n_in, void* d_out, int out_size, void* d_ws, size_t ws_size, hipStream_t stream) {
    static int grid = 0;
    if (grid == 0) {
        if (n_in != 34 || out_size != T * DM || ws_size < WS_END) { fprintf(stderr, "kernel_launch: unexpected shapes n_in %d out %d ws %zu\n", n_in, out_size, ws_size); grid = -1; return; }
        int dev = 0, cus = 0;
        if (hipGetDevice(&dev) != hipSuccess || hipDeviceGetAttribute(&cus, hipDeviceAttributeMultiprocessorCount, dev) != hipSuccess) { grid = -1; return; }
        if (hipFuncSetAttribute((const void*)mk_fwd, hipFuncAttributeMaxDynamicSharedMemorySize, LDS_BYTES) != hipSuccess) { fprintf(stderr, "kernel_launch: hipFuncSetAttribute failed\n"); grid = -1; return; }
        int per_cu = 0;
        (void)hipOccupancyMaxActiveBlocksPerMultiprocessor(&per_cu, (const void*)mk_fwd, NTHR, LDS_BYTES);
        (void)hipGetLastError();
        grid = cus;
    }
    if (grid < 0) return;
    (void)hipMemsetAsync((char*)d_ws + WS_CTL, 0, CTL_ZERO_BYTES, stream);
    Args a{};
    for (int i = 0; i < 34; ++i) a.in[i] = d_in[i];
    a.out = (float*)d_out; a.ws = (unsigned char*)d_ws;
    a.ph_lo = 0; a.ph_hi = NPHASE; a.li = 0;
    hipLaunchKernelGGL(mk_fwd, dim3(grid), dim3(NTHR), LDS_BYTES, stream, a);
}
```

```cpp
#include <hip/hip_runtime.h>
#include <hip/hip_bf16.h>
#include <cstdio>
#include <cstdint>
#include <cmath>

constexpr int BATCH = 8, SEQ = 2048, DM = 2048, T = BATCH * SEQ;
constexpr int NMEM = 256;
constexpr float EPS = 1e-6f;
constexpr int ATTW = 1024, SSMW = 1024, INC = 4096;
constexpr int NH = 8;
constexpr int SG = 64, SP = 64;
constexpr int XH = 4, XD = 128, XW = 512;
constexpr int PH = 8, PK = 128, PQD = 256, PTOP = 16;
constexpr float LAM_INIT = 0.2f;

#ifndef MK_ONE_LAUNCH
#define MK_ONE_LAUNCH 1
#endif

constexpr int NWAVES = 8, NTHR = 512;
constexpr int LDS_BYTES = 147456;
constexpr int MISC_OFF = 147456 - 512;

constexpr size_t MiB = 1u << 20;
constexpr size_t WS_CTL = 0, CTL_ZERO_BYTES = 1 * MiB;
constexpr size_t WS_RSTD0 = 1 * MiB, WS_RSTDM = WS_RSTD0 + 65536, WS_RSTD1 = WS_RSTDM + 65536, WS_RSTD2 = WS_RSTD1 + 65536, WS_LAM = WS_RSTD2 + 65536;
constexpr size_t WS_ROPE = 2 * MiB;
constexpr size_t WS_WIN = 8 * MiB, WS_WGLU = 24 * MiB, WS_WOUT = 26 * MiB, WS_WXQ = 34 * MiB, WS_WXKV = 36 * MiB, WS_WXO = 40 * MiB, WS_WPQ = 42 * MiB, WS_KD = 50 * MiB;
constexpr size_t WS_UCAT = 56 * MiB, WS_BTC = 96 * MiB, WS_BTA = 136 * MiB, WS_QB = 152 * MiB, WS_KB = 184 * MiB, WS_VB = 216 * MiB, WS_O0 = 248 * MiB, WS_O1 = 280 * MiB;
constexpr size_t WS_UB = 56 * MiB, WS_VT = 120 * MiB, WS_XQ = 184 * MiB, WS_SC = 184 * MiB;
constexpr size_t WS_B = 312 * MiB;
constexpr size_t WS_SL = 376 * MiB, WS_IDX = 376 * MiB, WS_GATE = 384 * MiB;
constexpr size_t WS_GB = 392 * MiB, WS_XO = 392 * MiB;
constexpr size_t WS_PQ = 424 * MiB;
constexpr size_t WS_HB2 = 408 * MiB;
constexpr size_t WS_XKV = 472 * MiB;
constexpr size_t WS_MN = 480 * MiB;
constexpr size_t WS_END = 488 * MiB;
constexpr size_t WS_SSQ = 128 * 1024;
constexpr size_t WS_SSQ3 = 512 * 1024;
constexpr size_t WS_X8 = 152 * MiB;
constexpr size_t WS_XS = 3 * MiB;
constexpr size_t WS_SSQP = 2 * MiB;
constexpr size_t WS_SSQ1 = 704 * 1024, WS_SSQ2 = 768 * 1024;
constexpr int CW_TICKET = 160 * 1024;
constexpr size_t WS_PACT = 184 * MiB, WS_PW = 248 * MiB;
constexpr size_t WS_ISCU = 4 * MiB, WS_ISCV = 4 * MiB + 65536;
constexpr int NSL = 16, SLW = 128;
constexpr size_t WS_LSUM = 256 * 1024;
constexpr size_t WS_KP = 472 * MiB, WS_VT2 = 476 * MiB;
constexpr size_t WS_XQB = 184 * MiB, WS_XP = 200 * MiB;
constexpr size_t WS_AL = WS_LAM + 4096;
constexpr int S5L = 32, NCH = T / S5L, UCK = 640;
constexpr int CW_BAR = 4096;

#define GAS __attribute__((address_space(1)))
#define LAS __attribute__((address_space(3)))
typedef GAS unsigned gu32;
#define RLX_AGENT __ATOMIC_RELAXED, __HIP_MEMORY_SCOPE_AGENT

#define XB_TMO      128
#define XB_XCNT(j)  (256  + 64 * (j))
#define XB_XSUB(j)  (1280 + 64 * (j))
#define XB_XGEN(j)  (2304 + 64 * (j))
#define XB_TOP      3328
#define XB_TOPGEN   3392
#define XCD_BAR_WORDS 3456
#define XB_SPIN_CAP (1u << 26)
__device__ __forceinline__ unsigned xb_ld(unsigned* p)              { return __hip_atomic_load(p, __ATOMIC_RELAXED, __HIP_MEMORY_SCOPE_AGENT); }
__device__ __forceinline__ unsigned xb_add(unsigned* p, unsigned v) { return __hip_atomic_fetch_add(p, v, __ATOMIC_RELAXED, __HIP_MEMORY_SCOPE_AGENT); }
__device__ __forceinline__ unsigned xb_xcc_id() { return (unsigned)__builtin_amdgcn_s_getreg((3 << 11) | 20) & 0xFu; }
#define XB_SPIN(cond, bar) do { unsigned _sp = 0; while (cond) { __builtin_amdgcn_s_sleep(1); \
    if ((++_sp & 255u) == 0u) { if (xb_ld(&(bar)[XB_TMO])) break; if (_sp > XB_SPIN_CAP) { atomicAdd(&(bar)[XB_TMO], 1u); break; } } } } while (0)
struct XcdBarrier { unsigned* bar; unsigned x; volatile LAS unsigned* st; };
__device__ __forceinline__ XcdBarrier xcd_barrier_post(unsigned* bar, volatile LAS unsigned* st) {
    XcdBarrier b; b.bar = bar; b.x = xb_xcc_id(); b.st = st;
    if (threadIdx.x == 0) (void)xb_add(&bar[XB_XCNT(b.x)], 1u);
    return b;
}
__device__ __forceinline__ void xcd_barrier_complete(unsigned* bar, unsigned x, unsigned& nloc, unsigned& nx) {
    const unsigned G = gridDim.x * gridDim.y * gridDim.z;
    unsigned sum, cnt, mine, sp = 0u;
    for (;;) {
        sum = 0u; cnt = 0u; mine = 0u;
#pragma unroll
        for (unsigned j = 0; j < 16; ++j) { const unsigned c = xb_ld(&bar[XB_XCNT(j)]); sum += c; cnt += (c > 0u) ? 1u : 0u; mine = (j == x) ? c : mine; }
        if (sum == G) break;
        __builtin_amdgcn_s_sleep(1);
        if ((++sp & 255u) == 0u) { if (xb_ld(&bar[XB_TMO])) break; if (sp > XB_SPIN_CAP) { atomicAdd(&bar[XB_TMO], 1u); break; } }
    }
    nloc = mine > 0u ? mine : 1u; nx = cnt > 0u ? cnt : 1u;
}
__device__ __forceinline__ void xcd_barrier(const XcdBarrier& b) {
    asm volatile("s_waitcnt vmcnt(0)" ::: "memory");
    __syncthreads();
    if (threadIdx.x == 0) {
        unsigned* bar = b.bar;
        __builtin_amdgcn_s_waitcnt(0);
        unsigned nloc = b.st[0], nx = b.st[1]; const unsigned bx = b.st[3];
        if (nloc == 0u) { xcd_barrier_complete(bar, bx, nloc, nx); b.st[0] = nloc; b.st[1] = nx; }
        const unsigned old = xb_add(&bar[XB_XSUB(bx)], 1u);
        const unsigned gen = old / nloc;
        if (old + 1u == (gen + 1u) * nloc) {
            __builtin_amdgcn_fence(__ATOMIC_RELEASE, "agent");
            asm volatile("s_waitcnt vmcnt(0)" ::: "memory");
            const unsigned og = xb_add(&bar[XB_TOP], 1u);
            const unsigned tg = og / nx;
            if (og + 1u == (tg + 1u) * nx) xb_add(&bar[XB_TOPGEN], 1u);
            else XB_SPIN(xb_ld(&bar[XB_TOPGEN]) == tg, bar);
            __builtin_amdgcn_fence(__ATOMIC_ACQUIRE, "agent");
            xb_add(&bar[XB_XGEN(bx)], 1u);
            asm volatile("s_waitcnt vmcnt(0)" ::: "memory");
        } else {
            XB_SPIN(xb_ld(&bar[XB_XGEN(bx)]) == gen, bar);
            __builtin_amdgcn_fence(__ATOMIC_ACQUIRE, "agent");
            asm volatile("s_waitcnt vmcnt(0)" ::: "memory");
        }
    }
    __syncthreads();
}

struct Args { const void* in[34]; float* out; unsigned char* ws; int ph_lo, ph_hi, li, pad; };
struct Frame {
    unsigned char* lds;
    LAS unsigned char* ldsl;
    int tid, lane, wave, G, bid;
    float* out;
    unsigned char* ws;
};
__device__ __forceinline__ float wave_sum(float v) {
#pragma unroll
    for (int o = 1; o < 64; o <<= 1) v += __shfl_xor(v, o);
    return v;
}
__device__ __forceinline__ float wave_max(float v) {
#pragma unroll
    for (int o = 1; o < 64; o <<= 1) v = fmaxf(v, __shfl_xor(v, o));
    return v;
}
__device__ __forceinline__ float gelu_exact(float x) { return 0.5f * x * (1.0f + erff(x * 0.70710678118654752f)); }

__device__ __forceinline__ const void* ldarg(int byte_off) {
    const void* p; auto k = __builtin_amdgcn_kernarg_segment_ptr();
    asm volatile("s_load_dwordx2 %0, %1, %2\n\ts_waitcnt lgkmcnt(0)" : "=s"(p) : "s"(k), "i"(byte_off) : "memory");
    return p;
}
#define IN_F(i) ((const float*)ldarg((i) * 8))
#define IN_I(i) ((const int*)ldarg((i) * 8))
#define WSF(off) ((float*)(F.ws + (off)))


typedef float nt_f4 __attribute__((ext_vector_type(4)));
__device__ __forceinline__ float4 ntld4(const float* p) { const nt_f4 v = __builtin_nontemporal_load((const GAS nt_f4*)p); return make_float4(v[0], v[1], v[2], v[3]); }
__device__ __forceinline__ void ntst4(float* p, float4 v) { const nt_f4 w = {v.x, v.y, v.z, v.w}; __builtin_nontemporal_store(w, (GAS nt_f4*)p); }
typedef unsigned short bf16;
typedef unsigned v4u __attribute__((ext_vector_type(4)));
__device__ __forceinline__ unsigned f2bf(float f) { unsigned u = __builtin_bit_cast(unsigned, f); return (u + 0x7fffu + ((u >> 16) & 1u)) >> 16; }
__device__ __forceinline__ unsigned pk2(float lo, float hi) { return f2bf(lo) | (f2bf(hi) << 16); }
__device__ __forceinline__ float bf2f(unsigned short b) { return __uint_as_float((unsigned)b << 16); }
#define WSB(off) ((bf16*)(F.ws + (off)))
#define LDS_WAIT() asm volatile("s_waitcnt lgkmcnt(0)" ::: "memory")

__device__ __forceinline__ void norm_2rows_to_bf16(const float* xrow, const float* g, bf16* orow, int lane) {
    float4 v[16]; float s0 = 0.f, s1 = 0.f;
#pragma unroll
    for (int j = 0; j < 16; ++j) v[j] = ntld4(xrow + (j >> 3) * DM + 256 * (j & 7) + 4 * lane);
#pragma unroll
    for (int j = 0; j < 8; ++j) { s0 += v[j].x * v[j].x + v[j].y * v[j].y + v[j].z * v[j].z + v[j].w * v[j].w; s1 += v[8 + j].x * v[8 + j].x + v[8 + j].y * v[8 + j].y + v[8 + j].z * v[8 + j].z + v[8 + j].w * v[8 + j].w; }
    s0 = wave_sum(s0); s1 = wave_sum(s1);
    const float r0 = 1.0f / sqrtf(s0 / (float)DM + EPS), r1 = 1.0f / sqrtf(s1 / (float)DM + EPS);
#pragma unroll
    for (int j = 0; j < 8; ++j) { const float4 g4 = *(const float4*)(g + 256 * j + 4 * lane);
        *(unsigned long long*)(orow + 256 * j + 4 * lane) = (unsigned long long)pk2(v[j].x * r0 * g4.x, v[j].y * r0 * g4.y) | ((unsigned long long)pk2(v[j].z * r0 * g4.z, v[j].w * r0 * g4.w) << 32);
        *(unsigned long long*)(orow + DM + 256 * j + 4 * lane) = (unsigned long long)pk2(v[8 + j].x * r1 * g4.x, v[8 + j].y * r1 * g4.y) | ((unsigned long long)pk2(v[8 + j].z * r1 * g4.z, v[8 + j].w * r1 * g4.w) << 32); }
}
__device__ __forceinline__ void norm4_load(const float* xrow, int lane, float4 (&v)[32]) {
#pragma unroll
    for (int j = 0; j < 32; ++j) v[j] = ntld4(xrow + (j >> 3) * DM + 256 * (j & 7) + 4 * lane);
}
__device__ __forceinline__ void norm4_finish(const float4 (&v)[32], const float* g, bf16* orow, int lane) {
    float s[4] = {0.f, 0.f, 0.f, 0.f};
#pragma unroll
    for (int j = 0; j < 32; ++j) s[j >> 3] += v[j].x * v[j].x + v[j].y * v[j].y + v[j].z * v[j].z + v[j].w * v[j].w;
    float r[4];
#pragma unroll
    for (int q = 0; q < 4; ++q) { s[q] = wave_sum(s[q]); r[q] = 1.0f / sqrtf(s[q] / (float)DM + EPS); }
#pragma unroll
    for (int j = 0; j < 8; ++j) { const float4 g4 = *(const float4*)(g + 256 * j + 4 * lane);
#pragma unroll
        for (int q = 0; q < 4; ++q) { const float4 w = v[8 * q + j]; const float rq = r[q];
            *(unsigned long long*)(orow + q * DM + 256 * j + 4 * lane) = (unsigned long long)pk2(w.x * rq * g4.x, w.y * rq * g4.y) | ((unsigned long long)pk2(w.z * rq * g4.z, w.w * rq * g4.w) << 32); } }
}
__device__ __forceinline__ void p0_transpose_item(const float* W, int K, int N, bf16* WT, int row_off, LAS float* scr, int item, int lane, const float* gain = nullptr, int goff = 0) {
    const int nblk = N / 32, kb = item / nblk, nb = item % nblk, k0 = 64 * kb, n0 = 32 * nb;
    float4 v[8];
#pragma unroll
    for (int i = 0; i < 8; ++i) v[i] = ntld4(W + (size_t)(k0 + 8 * i + (lane >> 3)) * N + n0 + 4 * (lane & 7));
#pragma unroll
    for (int i = 0; i < 8; ++i) { const int kk = 8 * i + (lane >> 3); const float gk = (gain && k0 + kk >= goff) ? gain[k0 + kk - goff] : 1.0f; LAS float* d = scr + kk * 33 + 4 * (lane & 7);
        d[0] = v[i].x * gk; d[1] = v[i].y * gk; d[2] = v[i].z * gk; d[3] = v[i].w * gk; }
    LDS_WAIT(); asm volatile("" ::: "memory");
    const int c = lane & 7;
#pragma unroll
    for (int j = 0; j < 4; ++j) { const int n = (lane >> 3) + 8 * j; const LAS float* s = scr + (8 * c) * 33 + n;
        v4u o; o.x = pk2(s[0 * 33], s[1 * 33]); o.y = pk2(s[2 * 33], s[3 * 33]); o.z = pk2(s[4 * 33], s[5 * 33]); o.w = pk2(s[6 * 33], s[7 * 33]);
        *(GAS v4u*)(WT + (size_t)(row_off + n0 + n) * K + k0 + 8 * c) = o; }
    LDS_WAIT(); asm volatile("" ::: "memory");
}
namespace pg8 {
#define PG8_LAS __attribute__((address_space(3)))
typedef unsigned short bf16_t;
typedef short bf16x8 __attribute__((ext_vector_type(8)));
typedef float f32x4 __attribute__((ext_vector_type(4)));
typedef unsigned u32x4 __attribute__((ext_vector_type(4)));
constexpr int BM = 256, BK = 64, HALF = 128, HTB = HALF * BK * 2  , STAGE_BYTES = 8 * HTB, NXCD = 8, WGM = 8;

__host__ __device__ __forceinline__ int lds_byte(int r, int c) { const int st = (r >> 4) * 2 + (c >> 5), rr = r & 15, cc = c & 31, ob = rr * 64 + cc * 2; return st * 1024 + (ob ^ (((ob >> 9) & 1) << 5)); }
__host__ __device__ __forceinline__ void stage_rc(int b, int& R, int& C) { const int st = b / 1024, sb = b % 1024, swz = sb ^ (((sb >> 9) & 1) << 5); R = (st >> 1) * 16 + swz / 64; C = (st & 1) * 32 + (swz % 64) / 2; }
__host__ __device__ __forceinline__ int perm32(int rho) { const int n = rho >> 4, i = rho & 15; return 8 * (i >> 2) + 4 * n + (i & 3); }

struct Unit { int pm, pn, bz; };
struct Gemm { const bf16_t* A; const bf16_t* Bt; int M, N, K; int lda, ldb; long sA, sB; int nb; };

struct StaticOrder {
    int nM, nN, nwg, G, c;
    int nb, per; __host__ __device__ void init(int M, int N, int G_, int c_, int nb_ = 1) { nM = M / BM; nN = N / BM; nb = nb_; per = nM * nN; nwg = per * nb; G = G_; c = c_; }
    __host__ __device__ bool next(int i, Unit& u) const {
        const long L = (long)i * G + c; if (L >= nwg) return false;
        int wgid = (int)L; { const int q = nwg / NXCD, r = nwg % NXCD, xcd = wgid % NXCD, off = wgid / NXCD; wgid = (xcd < r ? xcd * (q + 1) : r * (q + 1) + (xcd - r) * q) + off; }
        u.bz = wgid / per; wgid -= u.bz * per; const int nig = WGM * nN, gid = wgid / nig, fm = gid * WGM, gsz = (nM - fm) < WGM ? (nM - fm) : WGM;
        u.pm = fm + ((wgid % nig) % gsz); u.pn = (wgid % nig) / gsz; return true;
    }
    __device__ __forceinline__ void a_ready(const Unit&) const {}
    __device__ __forceinline__ void done(const Unit&) const {}
    template <class G_> __device__ __forceinline__ long offA(const Unit& u, const G_& g) const { return (long)u.bz * g.sA; }
    template <class G_> __device__ __forceinline__ long offB(const Unit& u, const G_& g) const { return (long)u.bz * g.sB; }
};

__device__ __forceinline__ unsigned cvt_pk_bf16(float lo, float hi) { unsigned r; asm volatile("v_cvt_pk_bf16_f32 %0, %1, %2" : "=v"(r) : "v"(lo), "v"(hi)); return r; }
typedef float f32x2 __attribute__((ext_vector_type(2)));
__device__ __forceinline__ f32x2 gelu_pk(f32x2 v) {
    const f32x2 av = __builtin_elementwise_abs(v), d = av * 0.2316418882f + 1.0f;
    f32x2 t; t.x = __builtin_amdgcn_rcpf(d.x); t.y = __builtin_amdgcn_rcpf(d.y);
    f32x2 q = t * 0.5307027145f + (-0.7265760135f); q = q * t + 0.7107068705f; q = q * t + (-0.142248368f); q = q * t + 0.127414796f; q = q * t;
    const f32x2 s = (v * v) * (-0.72134752044f);
    f32x2 e; e.x = __builtin_amdgcn_exp2f(s.x); e.y = __builtin_amdgcn_exp2f(s.y);
    const f32x2 m = v * (q * e), r = v - m;
    f32x2 o; o.x = v.x < 0.f ? m.x : r.x; o.y = v.y < 0.f ? m.y : r.y; return o;
}

template <int ACT  > struct EpiBf16 {
    static constexpr bool PERM = true, AFTER_DRAIN = false; static_assert(ACT == 0 || ACT == 1, "EpiBf16: ACT is 0 (none) or 1 (gelu_pk)");
    bf16_t* O; int ldc; const float* bias; int split_cols; size_t split_stride; float scale0;
    __device__ __forceinline__ void operator()(const f32x4 (&acc)[2][2][4][2], const Unit& u, int wr, int wc, int fr, int fq) const {
        const int row0 = u.pm * BM + wr * 64 + fr; int colt = u.pn * BM; bf16_t* base = O;
        float sc = 1.f; if (split_cols) { const int t = colt / split_cols; base += (size_t)t * split_stride; colt -= t * split_cols; if (t == 0) sc = scale0; }
        const int col0 = colt + wc * 32 + 8 * fq, bcol0 = u.pn * BM + wc * 32 + 8 * fq;
        f32x4 bv[2][2];
#pragma unroll
        for (int bj = 0; bj < 2; ++bj)
#pragma unroll
            for (int n = 0; n < 2; ++n) bv[bj][n] = bias ? *(const f32x4*)(bias + bcol0 + bj * HALF + 4 * n) : (f32x4){0.f, 0.f, 0.f, 0.f};
#pragma unroll
        for (int ai = 0; ai < 2; ++ai)
#pragma unroll
            for (int m = 0; m < 4; ++m) { bf16_t* rowp = base + (size_t)(row0 + ai * HALF + m * 16) * ldc + col0;
#pragma unroll
                for (int bj = 0; bj < 2; ++bj) { f32x4 v0 = acc[ai][bj][m][0] + bv[bj][0], v1 = acc[ai][bj][m][1] + bv[bj][1];
                    if (ACT == 1) { f32x2 a = gelu_pk((f32x2){v0[0], v0[1]}), b = gelu_pk((f32x2){v0[2], v0[3]}), c = gelu_pk((f32x2){v1[0], v1[1]}), d = gelu_pk((f32x2){v1[2], v1[3]});
                        v0 = (f32x4){a.x, a.y, b.x, b.y}; v1 = (f32x4){c.x, c.y, d.x, d.y}; }
                    v0 = v0 * sc; v1 = v1 * sc; u32x4 w; w.x = cvt_pk_bf16(v0[0], v0[1]); w.y = cvt_pk_bf16(v0[2], v0[3]); w.z = cvt_pk_bf16(v1[0], v1[1]); w.w = cvt_pk_bf16(v1[2], v1[3]);
                    *(u32x4*)(rowp + bj * HALF) = w; } }
    }
};
template <class T, class = void> struct MidK { static constexpr bool v = false; };
template <class T> struct MidK<T, decltype((void)T::MIDK)> { static constexpr bool v = T::MIDK; };
template <class Epi, class Sched, bool ALIGN_EPI = false, bool SP2 = false>
__device__ __forceinline__ void gemm_phase(PG8_LAS unsigned char* lds, const Gemm g, const Sched& S, const Epi& E) {
    const int tid = threadIdx.x, wid = __builtin_amdgcn_readfirstlane(tid >> 6), lane = tid & 63, wr = wid >> 2, wc = wid & 3, fr = lane & 15, fq = lane >> 4;
    const int K = g.K, nt = K / BK;
    unsigned voffA[2], voffB[2];
#pragma unroll
    for (int i = 0; i < 2; ++i) { int R, C; stage_rc(tid * 16 + i * 8192, R, C); const int Rb = Epi::PERM ? ((R & ~31) + perm32(R & 31)) : R;
        voffA[i] = (unsigned)(R * g.lda + C) * 2u; voffB[i] = (unsigned)(Rb * g.ldb + C) * 2u; }
    const size_t kstep = (size_t)(BK * 2);
    const size_t hstepA = (size_t)HALF * g.lda * 2, hstepB = (size_t)HALF * g.ldb * 2;
    const size_t tstepA = 2 * hstepA, tstepB = 2 * hstepB;
    const unsigned ldsw = (unsigned)wid * 1024u;
    const int aoff = lds_byte(wr * 64 + fr, fq * 8), boff = lds_byte(wc * 32 + fr, fq * 8);
#define PG8_SA(b, h) (((b) * 2 + (h)) * HTB)
#define PG8_SB(b, h) ((4 + (b) * 2 + (h)) * HTB)
#define PG8_STAGE(bufoff, gbase, voff) do { _Pragma("unroll") for (int _i = 0; _i < 2; ++_i) \
        __builtin_amdgcn_global_load_lds((const unsigned*)((const char*)(gbase) + (voff)[_i]), (PG8_LAS unsigned*)(lds + (bufoff) + ldsw + _i * 8192), 16, 0, 0); } while (0)
#define PG8_LDA(dst, b, h) do { _Pragma("unroll") for (int m = 0; m < 4; ++m) _Pragma("unroll") for (int k = 0; k < 2; ++k) dst[m][k] = *(const PG8_LAS bf16x8*)(lds + PG8_SA(b, h) + aoff + m * 2048 + k * 1024); } while (0)
#define PG8_LDB(dst, b, h) do { _Pragma("unroll") for (int n = 0; n < 2; ++n) _Pragma("unroll") for (int k = 0; k < 2; ++k) dst[n][k] = *(const PG8_LAS bf16x8*)(lds + PG8_SB(b, h) + boff + n * 2048 + k * 1024); } while (0)
#define PG8_MMA(ai, bj, At, Bt) do { __builtin_amdgcn_s_setprio(1); _Pragma("unroll") for (int m = 0; m < 4; ++m) _Pragma("unroll") for (int n = 0; n < 2; ++n) _Pragma("unroll") for (int k = 0; k < 2; ++k) \
        acc[ai][bj][m][n] = __builtin_amdgcn_mfma_f32_16x16x32_bf16(Bt[n][k], At[m][k], acc[ai][bj][m][n], 0, 0, 0); __builtin_amdgcn_s_setprio(0); } while (0)
#define PG8_WAIT_V(n) asm volatile("s_waitcnt vmcnt(" #n ")" ::: "memory")
#define PG8_WAIT_L(n) asm volatile("s_waitcnt lgkmcnt(" #n ")" ::: "memory")
#define PG8_BAR __builtin_amdgcn_s_barrier()
#define PG8_SCHED __builtin_amdgcn_sched_barrier(0)
    Unit cur, nxt; int ui = 0;
    if (!S.next(0, cur)) return;
    f32x4 acc[2][2][4][2];
#pragma unroll
    for (int a = 0; a < 2; ++a)
#pragma unroll
        for (int b = 0; b < 2; ++b)
#pragma unroll
            for (int m = 0; m < 4; ++m)
#pragma unroll
                for (int n = 0; n < 2; ++n) acc[a][b][m][n] = (f32x4){0.f, 0.f, 0.f, 0.f};
    bf16x8 At[4][2], B0[2][2], B1[2][2];
    const char* cA = (const char*)g.A + (size_t)S.offA(cur, g) * 2 + (size_t)cur.pm * tstepA; const char* cB = (const char*)g.Bt + (size_t)S.offB(cur, g) * 2 + (size_t)cur.pn * tstepB;
    S.a_ready(cur);
    if constexpr (SP2) {
        PG8_STAGE(PG8_SB(0, 0), cB, voffB); PG8_STAGE(PG8_SB(0, 1), cB + hstepB, voffB); PG8_STAGE(PG8_SA(0, 0), cA, voffA); PG8_STAGE(PG8_SA(0, 1), cA + hstepA, voffA);
        if (wr == 1) PG8_BAR;
        PG8_WAIT_V(2); PG8_BAR;
        PG8_STAGE(PG8_SB(1, 0), cB + kstep, voffB); PG8_STAGE(PG8_SA(1, 0), cA + kstep, voffA); PG8_STAGE(PG8_SB(1, 1), cB + hstepB + kstep, voffB);
        PG8_WAIT_V(6); PG8_BAR;
    } else {
        PG8_STAGE(PG8_SB(0, 0), cB, voffB); PG8_STAGE(PG8_SA(0, 0), cA, voffA); PG8_STAGE(PG8_SB(0, 1), cB + hstepB, voffB); PG8_STAGE(PG8_SA(0, 1), cA + hstepA, voffA);
        if (wr == 1) PG8_BAR;
        PG8_WAIT_V(4); PG8_BAR;
        PG8_STAGE(PG8_SB(1, 0), cB + kstep, voffB); PG8_STAGE(PG8_SA(1, 0), cA + kstep, voffA); PG8_STAGE(PG8_SB(1, 1), cB + hstepB + kstep, voffB);
        PG8_WAIT_V(6); PG8_BAR;
    }
    for (;;) {
        const bool has_next = S.next(ui + 1, nxt);
        const char* nA = has_next ? (const char*)g.A + (size_t)S.offA(nxt, g) * 2 + (size_t)nxt.pm * tstepA : cA; const char* nB = has_next ? (const char*)g.Bt + (size_t)S.offB(nxt, g) * 2 + (size_t)nxt.pn * tstepB : cB;
        for (int t = 0; t < nt; t += 2) {
            if constexpr (MidK<Epi>::v) { if (t == E.midk_t) E.midk(acc, cur, wr, wc, fr, fq); }
            const bool last = (t == nt - 2);
            const char* a1 = cA + (size_t)(t + 1) * kstep;
            const char* a2 = last ? nA : cA + (size_t)(t + 2) * kstep; const char* b2 = last ? nB : cB + (size_t)(t + 2) * kstep;
            const char* a3 = a2 + kstep; const char* b3 = b2 + kstep;
            if (last && has_next) S.a_ready(nxt);
            if constexpr (SP2) {
            PG8_LDB(B0, 0, 0); PG8_LDB(B1, 0, 1); PG8_SCHED; PG8_LDA(At, 0, 0); PG8_STAGE(PG8_SA(1, 1), a1 + hstepA, voffA);
            PG8_WAIT_V(8); PG8_WAIT_L(0); PG8_BAR; PG8_MMA(0, 0, At, B0); PG8_MMA(0, 1, At, B1); PG8_BAR; PG8_SCHED;
            PG8_LDA(At, 0, 1); PG8_STAGE(PG8_SB(0, 0), b2, voffB); PG8_STAGE(PG8_SB(0, 1), b2 + hstepB, voffB); PG8_STAGE(PG8_SA(0, 0), a2, voffA);
            PG8_WAIT_V(8); PG8_WAIT_L(0); PG8_BAR; PG8_MMA(1, 0, At, B0); PG8_MMA(1, 1, At, B1); PG8_BAR; PG8_SCHED;
            PG8_LDB(B0, 1, 0); PG8_LDB(B1, 1, 1); PG8_SCHED; PG8_LDA(At, 1, 0); PG8_STAGE(PG8_SA(0, 1), a2 + hstepA, voffA);
            PG8_WAIT_V(8); PG8_WAIT_L(0); PG8_BAR; PG8_MMA(0, 0, At, B0); PG8_MMA(0, 1, At, B1); PG8_BAR; PG8_SCHED;
            PG8_LDA(At, 1, 1); PG8_STAGE(PG8_SB(1, 0), b3, voffB); PG8_STAGE(PG8_SB(1, 1), b3 + hstepB, voffB); PG8_STAGE(PG8_SA(1, 0), a3, voffA);
            PG8_WAIT_V(8); PG8_WAIT_L(0); PG8_BAR; PG8_MMA(1, 0, At, B0); PG8_MMA(1, 1, At, B1); PG8_BAR; PG8_SCHED;
            } else {
            PG8_LDB(B0, 0, 0); PG8_SCHED; PG8_LDA(At, 0, 0); PG8_STAGE(PG8_SA(1, 1), a1 + hstepA, voffA);
            PG8_WAIT_L(8); PG8_BAR; PG8_WAIT_L(0); PG8_MMA(0, 0, At, B0); PG8_BAR; PG8_SCHED;
            PG8_LDB(B1, 0, 1); PG8_STAGE(PG8_SB(0, 0), b2, voffB);
            PG8_BAR; PG8_WAIT_L(0); PG8_MMA(0, 1, At, B1); PG8_BAR;
            PG8_LDA(At, 0, 1); PG8_STAGE(PG8_SA(0, 0), a2, voffA);
            PG8_BAR; PG8_WAIT_L(0); PG8_MMA(1, 0, At, B0); PG8_BAR; PG8_SCHED;
            PG8_STAGE(PG8_SB(0, 1), b2 + hstepB, voffB);
            PG8_WAIT_V(6); PG8_BAR; PG8_MMA(1, 1, At, B1); PG8_BAR;
            PG8_LDB(B0, 1, 0); PG8_SCHED; PG8_LDA(At, 1, 0); PG8_STAGE(PG8_SA(0, 1), a2 + hstepA, voffA);
            PG8_WAIT_L(8); PG8_BAR; PG8_WAIT_L(0); PG8_MMA(0, 0, At, B0); PG8_BAR; PG8_SCHED;
            PG8_LDB(B1, 1, 1); PG8_STAGE(PG8_SB(1, 0), b3, voffB);
            PG8_BAR; PG8_WAIT_L(0); PG8_MMA(0, 1, At, B1); PG8_BAR;
            PG8_LDA(At, 1, 1); PG8_STAGE(PG8_SA(1, 0), a3, voffA);
            PG8_BAR; PG8_WAIT_L(0); PG8_MMA(1, 0, At, B0); PG8_BAR; PG8_SCHED;
            PG8_STAGE(PG8_SB(1, 1), b3 + hstepB, voffB);
            PG8_WAIT_V(6); PG8_BAR; PG8_MMA(1, 1, At, B1); PG8_BAR;
            }
        }
        if constexpr (ALIGN_EPI) { if (wr == 0) PG8_BAR; }
        if constexpr (!Epi::AFTER_DRAIN) { E(acc, cur, wr, wc, fr, fq); S.done(cur); }
        if (!has_next) break;
#pragma unroll
        for (int a = 0; a < 2; ++a)
#pragma unroll
            for (int b = 0; b < 2; ++b)
#pragma unroll
                for (int m = 0; m < 4; ++m)
#pragma unroll
                    for (int n = 0; n < 2; ++n) acc[a][b][m][n] = (f32x4){0.f, 0.f, 0.f, 0.f};
        cur = nxt; cA = nA; cB = nB; ++ui;
        if constexpr (ALIGN_EPI) { if (wr == 1) PG8_BAR; }
    }
    PG8_WAIT_V(0);
    if constexpr (!ALIGN_EPI) { if (wr == 0) PG8_BAR; }
    PG8_BAR;
    if constexpr (Epi::AFTER_DRAIN) { E.fused(acc, cur, wr, wc, fr, fq, lds, wid, lane); S.done(cur); }
#undef PG8_SA
#undef PG8_SB
#undef PG8_STAGE
#undef PG8_LDA
#undef PG8_LDB
#undef PG8_MMA
#undef PG8_WAIT_V
#undef PG8_WAIT_L
#undef PG8_BAR
#undef PG8_SCHED
}
}

namespace pg8 {
struct EpiF32 {
    static constexpr bool PERM = false, AFTER_DRAIN = false;
    float* C; int ldc; const float* resid; long sC;
    __device__ __forceinline__ void operator()(const f32x4 (&acc)[2][2][4][2], const Unit& u, int wr, int wc, int fr, int fq) const {
        const int row0 = u.pm * BM + wr * 64 + fr, col0 = u.pn * BM + wc * 32 + 4 * fq;
        float* base = C + (size_t)u.bz * sC;
#pragma unroll
        for (int ai = 0; ai < 2; ++ai)
#pragma unroll
            for (int m = 0; m < 4; ++m) { const size_t ro = (size_t)(row0 + ai * HALF + m * 16) * ldc;
#pragma unroll
                for (int bj = 0; bj < 2; ++bj)
#pragma unroll
                    for (int n = 0; n < 2; ++n) { const size_t o = ro + col0 + bj * HALF + n * 16; f32x4 v = acc[ai][bj][m][n];
                        if (resid) v += *(const f32x4*)(resid + o);
                        *(f32x4*)(base + o) = v; } }
    }
};


template <bool RF32> struct EpiResidB {
    static constexpr bool PERM = true, AFTER_DRAIN = false;
    const void* resid; bf16_t* HB; float* ssq; int ldc;
    __device__ __forceinline__ void operator()(const f32x4 (&acc)[2][2][4][2], const Unit& u, int wr, int wc, int fr, int fq) const {
        const int row0 = u.pm * BM + wr * 64 + fr, col0 = u.pn * BM + wc * 32 + 8 * fq;
#pragma unroll
        for (int ai = 0; ai < 2; ++ai)
#pragma unroll
            for (int m = 0; m < 4; ++m) { const int r = row0 + ai * HALF + m * 16; const size_t ro = (size_t)r * ldc + col0; float ss = 0.f;
#pragma unroll
                for (int bj = 0; bj < 2; ++bj) { const size_t o = ro + bj * HALF; f32x4 v0 = acc[ai][bj][m][0], v1 = acc[ai][bj][m][1];
                    if (RF32) { v0 += *(const f32x4*)((const float*)resid + o); v1 += *(const f32x4*)((const float*)resid + o + 4); }
                    else { const u32x4 rb = *(const u32x4*)((const bf16_t*)resid + o);
                        v0[0] += __uint_as_float(rb.x << 16); v0[1] += __uint_as_float(rb.x & 0xffff0000u); v0[2] += __uint_as_float(rb.y << 16); v0[3] += __uint_as_float(rb.y & 0xffff0000u);
                        v1[0] += __uint_as_float(rb.z << 16); v1[1] += __uint_as_float(rb.z & 0xffff0000u); v1[2] += __uint_as_float(rb.w << 16); v1[3] += __uint_as_float(rb.w & 0xffff0000u); }
                    ss += (v0[0] * v0[0] + v0[1] * v0[1]) + (v0[2] * v0[2] + v0[3] * v0[3]) + (v1[0] * v1[0] + v1[1] * v1[1]) + (v1[2] * v1[2] + v1[3] * v1[3]);
                    u32x4 w; w.x = cvt_pk_bf16(v0[0], v0[1]); w.y = cvt_pk_bf16(v0[2], v0[3]); w.z = cvt_pk_bf16(v1[0], v1[1]); w.w = cvt_pk_bf16(v1[2], v1[3]);
                    *(u32x4*)(HB + o) = w; }
                ss += __shfl_xor(ss, 16); ss += __shfl_xor(ss, 32);
                if (fq == 0) atomicAdd(ssq + r, ss); }
    }
};

struct EpiWout {
    static constexpr bool PERM = true, AFTER_DRAIN = false, MIDK = true;
    const float* resid; bf16_t* HB; float* ssq; int ldc; const float* ssq_ssm; int midk_t;
    __device__ __forceinline__ void midk(f32x4 (&acc)[2][2][4][2], const Unit& u, int wr, int wc, int fr, int fq) const {
        const int row0 = u.pm * BM + wr * 64 + fr;
#pragma unroll
        for (int ai = 0; ai < 2; ++ai)
#pragma unroll
            for (int m = 0; m < 4; ++m) { const float ir = sqrtf(ssq_ssm[row0 + ai * HALF + m * 16] * (1.0f / 1024.0f) + 1e-6f);
#pragma unroll
                for (int bj = 0; bj < 2; ++bj) { acc[ai][bj][m][0] *= ir; acc[ai][bj][m][1] *= ir; } }
    }
    __device__ __forceinline__ void operator()(const f32x4 (&acc)[2][2][4][2], const Unit& u, int wr, int wc, int fr, int fq) const {
        const int row0 = u.pm * BM + wr * 64 + fr, col0 = u.pn * BM + wc * 32 + 8 * fq;
#pragma unroll
        for (int ai = 0; ai < 2; ++ai)
#pragma unroll
            for (int m = 0; m < 4; ++m) { const int r = row0 + ai * HALF + m * 16; const size_t ro = (size_t)r * ldc + col0; float ss = 0.f;
                const float rs = 1.0f / sqrtf(ssq_ssm[r] * (1.0f / 1024.0f) + 1e-6f);
#pragma unroll
                for (int bj = 0; bj < 2; ++bj) { const size_t o = ro + bj * HALF;
                    const f32x4 v0 = acc[ai][bj][m][0] * rs + *(const f32x4*)(resid + o), v1 = acc[ai][bj][m][1] * rs + *(const f32x4*)(resid + o + 4);
                    ss += (v0[0] * v0[0] + v0[1] * v0[1]) + (v0[2] * v0[2] + v0[3] * v0[3]) + (v1[0] * v1[0] + v1[1] * v1[1]) + (v1[2] * v1[2] + v1[3] * v1[3]);
                    u32x4 w; w.x = cvt_pk_bf16(v0[0], v0[1]); w.y = cvt_pk_bf16(v0[2], v0[3]); w.z = cvt_pk_bf16(v1[0], v1[1]); w.w = cvt_pk_bf16(v1[2], v1[3]);
                    *(u32x4*)(HB + o) = w; }
                ss += __shfl_xor(ss, 16); ss += __shfl_xor(ss, 32);
                if (fq == 0) atomicAdd(ssq + r, ss); }
    }
};
struct EpiRowBf16 {
    static constexpr bool PERM = true, AFTER_DRAIN = false;
    bf16_t* O; int ldc; const float* ssq; float scale;
    __device__ __forceinline__ void operator()(const f32x4 (&acc)[2][2][4][2], const Unit& u, int wr, int wc, int fr, int fq) const {
        const int row0 = u.pm * BM + wr * 64 + fr, col0 = u.pn * BM + wc * 32 + 8 * fq;
#pragma unroll
        for (int ai = 0; ai < 2; ++ai)
#pragma unroll
            for (int m = 0; m < 4; ++m) { const int r = row0 + ai * HALF + m * 16; const float sc = scale / sqrtf(ssq[r] * (1.0f / 2048.0f) + 1e-6f); bf16_t* rowp = O + (size_t)r * ldc + col0;
#pragma unroll
                for (int bj = 0; bj < 2; ++bj) { const f32x4 v0 = acc[ai][bj][m][0] * sc, v1 = acc[ai][bj][m][1] * sc;
                    u32x4 w; w.x = cvt_pk_bf16(v0[0], v0[1]); w.y = cvt_pk_bf16(v0[2], v0[3]); w.z = cvt_pk_bf16(v1[0], v1[1]); w.w = cvt_pk_bf16(v1[2], v1[3]);
                    *(u32x4*)(rowp + bj * HALF) = w; } }
    }
};
struct EpiSl {
    static constexpr bool PERM = false, AFTER_DRAIN = false;
    float* Sl;
    __device__ __forceinline__ void operator()(const f32x4 (&acc)[2][2][4][2], const Unit& u, int wr, int wc, int fr, int fq) const {
        const int row0 = u.pm * BM + wr * 64 + fr, col0 = wc * 32 + 4 * fq;
        float* base = Sl + (size_t)u.bz * 512 * 128;
#pragma unroll
        for (int ai = 0; ai < 2; ++ai)
#pragma unroll
            for (int m = 0; m < 4; ++m) { float* rowp = base + (size_t)(row0 + ai * HALF + m * 16) * 128 + col0;
#pragma unroll
                for (int n = 0; n < 2; ++n) *(f32x4*)(rowp + n * 16) = acc[ai][0][m][n]; }
    }
};
struct EpiS5 {
    static constexpr bool PERM = true, AFTER_DRAIN = false;
    bf16_t* Gb;
    __device__ __forceinline__ void operator()(const f32x4 (&acc)[2][2][4][2], const Unit& u, int wr, int wc, int fr, int fq) const {
        const int row0 = u.pm * BM + wr * 64 + fr, col0 = u.pn * BM + wc * 32 + 8 * fq;
#pragma unroll
        for (int ai = 0; ai < 2; ++ai)
#pragma unroll
            for (int m = 0; m < 4; ++m) { const int cb = row0 + ai * HALF + m * 16;
#pragma unroll
                for (int bj = 0; bj < 2; ++bj) { const int n0 = col0 + bj * HALF; const int tau = n0 >> 4, h0 = n0 & 15;
                    const f32x4 v0 = acc[ai][bj][m][0], v1 = acc[ai][bj][m][1];
                    const f32x2 a = gelu_pk((f32x2){v0[0], v0[1]}), b = gelu_pk((f32x2){v0[2], v0[3]}), c = gelu_pk((f32x2){v1[0], v1[1]}), d = gelu_pk((f32x2){v1[2], v1[3]});
                    u32x4 w; w.x = cvt_pk_bf16(a.x, a.y); w.y = cvt_pk_bf16(b.x, b.y); w.z = cvt_pk_bf16(c.x, c.y); w.w = cvt_pk_bf16(d.x, d.y);
                    *(u32x4*)(Gb + ((size_t)cb * 32 + tau) * 1024 + 16 * u.bz + h0) = w; } }
    }
};

struct EpiXkv {
    static constexpr bool PERM = false, AFTER_DRAIN = false;
    bf16_t* KP; bf16_t* VT2;
    __device__ __forceinline__ void operator()(const f32x4 (&acc)[2][2][4][2], const Unit& u, int wr, int wc, int fr, int fq) const {
        const int row0 = u.pm * BM + wr * 64 + fr, col0 = u.pn * BM + wc * 32 + 4 * fq;
#pragma unroll
        for (int ai = 0; ai < 2; ++ai)
#pragma unroll
            for (int m = 0; m < 4; ++m) { const int r = row0 + ai * HALF + m * 16; const int b = r >> 8, mm = r & 255;
#pragma unroll
                for (int bj = 0; bj < 2; ++bj)
#pragma unroll
                    for (int n = 0; n < 2; ++n) { const int c = col0 + bj * HALF + n * 16; const f32x4 v = acc[ai][bj][m][n];
                        if (c < 512) { const int hd = c >> 7, d = c & 127; bf16_t* p = KP + ((size_t)(b * 4 + hd) * 256 + mm) * 256;
                            *(unsigned long long*)(p + (hd & 1) * 128 + d) = (unsigned long long)cvt_pk_bf16(v[0], v[1]) | ((unsigned long long)cvt_pk_bf16(v[2], v[3]) << 32);
                            *(unsigned long long*)(p + ((hd & 1) ^ 1) * 128 + d) = 0ull; }
                        else { const int c2 = c - 512, hd = c2 >> 7, d = c2 & 127; bf16_t* p = VT2 + ((size_t)(b * 2 + (hd >> 1)) * 256 + (hd & 1) * 128 + d) * 512;
                            const unsigned w01 = cvt_pk_bf16(v[0], v[1]), w23 = cvt_pk_bf16(v[2], v[3]);
                            const int k1 = (hd & 1) * 256 + mm, k0 = ((hd & 1) ^ 1) * 256 + mm;
                            p[k1] = (bf16_t)(w01 & 0xffffu); p[512 + k1] = (bf16_t)(w01 >> 16); p[1024 + k1] = (bf16_t)(w23 & 0xffffu); p[1536 + k1] = (bf16_t)(w23 >> 16);
                            p[k0] = 0; p[512 + k0] = 0; p[1024 + k0] = 0; p[1536 + k0] = 0; } } }
    }
};
struct EpiXs {
    static constexpr bool PERM = true, AFTER_DRAIN = true;
    bf16_t* XP; float* Lsum;
    __device__ __forceinline__ void fused(f32x4 (&acc)[2][2][4][2], const Unit& u, int wr, int wc, int fr, int fq, PG8_LAS unsigned char* lds, int wid, int lane) const {
        PG8_LAS float* Mx = (PG8_LAS float*)lds;
        const int b = u.bz >> 2, hd = u.bz & 3;
#pragma unroll
        for (int ai = 0; ai < 2; ++ai)
#pragma unroll
            for (int m = 0; m < 4; ++m) { float mx = -INFINITY;
#pragma unroll
                for (int bj = 0; bj < 2; ++bj)
#pragma unroll
                    for (int n = 0; n < 2; ++n) { const f32x4 v = acc[ai][bj][m][n]; mx = fmaxf(mx, fmaxf(fmaxf(v[0], v[1]), fmaxf(v[2], v[3]))); }
                mx = fmaxf(mx, __shfl_xor(mx, 16)); mx = fmaxf(mx, __shfl_xor(mx, 32));
                if (fq == 0) Mx[(ai * HALF + wr * 64 + m * 16 + fr) * 4 + wc] = mx; }
        asm volatile("s_waitcnt lgkmcnt(0)" ::: "memory"); __builtin_amdgcn_s_barrier(); asm volatile("" ::: "memory");
#pragma unroll
        for (int ai = 0; ai < 2; ++ai)
#pragma unroll
            for (int m = 0; m < 4; ++m) { const int rl = ai * HALF + wr * 64 + m * 16 + fr; const f32x4 mv = *(const PG8_LAS f32x4*)(Mx + rl * 4);
                const float mx = fmaxf(fmaxf(mv[0], mv[1]), fmaxf(mv[2], mv[3])); float ss = 0.f;
                const size_t t = (size_t)b * 2048 + u.pm * BM + rl; bf16_t* rowp = XP + t * 1024 + hd * 256 + wc * 32 + 8 * fq;
#pragma unroll
                for (int bj = 0; bj < 2; ++bj) { f32x4 p0, p1;
#pragma unroll
                    for (int e = 0; e < 4; ++e) { p0[e] = __expf(acc[ai][bj][m][0][e] - mx); p1[e] = __expf(acc[ai][bj][m][1][e] - mx); }
                    ss += (p0[0] + p0[1]) + (p0[2] + p0[3]) + (p1[0] + p1[1]) + (p1[2] + p1[3]);
                    u32x4 w; w.x = cvt_pk_bf16(p0[0], p0[1]); w.y = cvt_pk_bf16(p0[2], p0[3]); w.z = cvt_pk_bf16(p1[0], p1[1]); w.w = cvt_pk_bf16(p1[2], p1[3]);
                    *(u32x4*)(rowp + bj * HALF) = w; }
                ss += __shfl_xor(ss, 16); ss += __shfl_xor(ss, 32);
                if (fq == 0) atomicAdd(Lsum + t * 4 + hd, ss); }
    }
};
struct EpiXo {
    static constexpr bool PERM = true, AFTER_DRAIN = false;
    bf16_t* XO; const float* Lsum;
    __device__ __forceinline__ void operator()(const f32x4 (&acc)[2][2][4][2], const Unit& u, int wr, int wc, int fr, int fq) const {
        const int b = u.bz >> 2, pair = (u.bz >> 1) & 1, kh = u.bz & 1;
#pragma unroll
        for (int ai = 0; ai < 2; ++ai)
#pragma unroll
            for (int m = 0; m < 4; ++m) { const size_t t = (size_t)b * 2048 + u.pm * BM + ai * HALF + wr * 64 + m * 16 + fr; bf16_t* rowp = XO + t * 512 + pair * 256 + wc * 32 + 8 * fq;
                { const float il = 1.0f / Lsum[t * 4 + pair * 2 + kh]; const f32x4 v0 = (kh ? acc[ai][1][m][0] : acc[ai][0][m][0]) * il, v1 = (kh ? acc[ai][1][m][1] : acc[ai][0][m][1]) * il;
                    u32x4 w; w.x = cvt_pk_bf16(v0[0], v0[1]); w.y = cvt_pk_bf16(v0[2], v0[3]); w.z = cvt_pk_bf16(v1[0], v1[1]); w.w = cvt_pk_bf16(v1[2], v1[3]);
                    *(u32x4*)(rowp + kh * HALF) = w; } }
    }
};
struct XsOrder {
    int G, c, sel;
    __device__ __forceinline__ bool next(int i, Unit& u) const { if (i > 0) return false; const int L = sel * G + c; if (L >= 256) return false; u.pm = L & 7; u.pn = 0; u.bz = L >> 3; return true; }
    __device__ __forceinline__ void a_ready(const Unit&) const {}
    __device__ __forceinline__ void done(const Unit&) const {}
    template <class G_> __device__ __forceinline__ long offA(const Unit& u, const G_&) const { return (long)(u.bz >> 2) * 2048 * 512 + ((u.bz & 3) >> 1) * 256; }
    template <class G_> __device__ __forceinline__ long offB(const Unit& u, const G_&) const { return (long)u.bz * 256 * 256; }
};
struct XoOrder {
    int G, c;
    __device__ __forceinline__ bool next(int i, Unit& u) const { const int L = i * G + c; if (L >= 256) return false; u.pm = L & 7; u.pn = 0; u.bz = L >> 3; return true; }
    __device__ __forceinline__ void a_ready(const Unit&) const {}
    __device__ __forceinline__ void done(const Unit&) const {}
    template <class G_> __device__ __forceinline__ long offA(const Unit& u, const G_&) const { return (long)(u.bz >> 2) * 2048 * 1024 + (u.bz & 3) * 256; }
    template <class G_> __device__ __forceinline__ long offB(const Unit& u, const G_&) const { return (long)(u.bz >> 1) * 256 * 512 + (u.bz & 1) * 256; }
};
struct EpiGlu {
    static constexpr bool PERM = false, AFTER_DRAIN = false;
    const bf16_t* G; const float* bias; bf16_t* CAT; float* ssq;
    __device__ __forceinline__ void operator()(const f32x4 (&acc)[2][2][4][2], const Unit& u, int wr, int wc, int fr, int fq) const {
        const int row0 = u.pm * BM + wr * 64 + fr, col0 = u.pn * BM + wc * 32 + 4 * fq;
#pragma unroll
        for (int ai = 0; ai < 2; ++ai)
#pragma unroll
            for (int m = 0; m < 4; ++m) { const int r = row0 + ai * HALF + m * 16; float ss = 0.f;
#pragma unroll
                for (int bj = 0; bj < 2; ++bj)
#pragma unroll
                    for (int n = 0; n < 2; ++n) { const int c = col0 + bj * HALF + n * 16; const f32x4 z = acc[ai][bj][m][n] + *(const f32x4*)(bias + c); const unsigned long long gb = *(const unsigned long long*)(G + (size_t)r * 1024 + c);
                        f32x4 gv; gv[0] = __uint_as_float((unsigned)gb << 16); gv[1] = __uint_as_float((unsigned)gb & 0xffff0000u); gv[2] = __uint_as_float((unsigned)(gb >> 32) << 16); gv[3] = __uint_as_float((unsigned)(gb >> 32) & 0xffff0000u);
                        f32x4 o; o[0] = gv[0] / (1.0f + __expf(-z[0])); o[1] = gv[1] / (1.0f + __expf(-z[1])); o[2] = gv[2] / (1.0f + __expf(-z[2])); o[3] = gv[3] / (1.0f + __expf(-z[3]));
                        ss += o[0] * o[0] + o[1] * o[1] + o[2] * o[2] + o[3] * o[3];
                        const unsigned long long w = (unsigned long long)cvt_pk_bf16(o[0], o[1]) | ((unsigned long long)cvt_pk_bf16(o[2], o[3]) << 32);
                        *(unsigned long long*)(CAT + (size_t)r * 2048 + 1024 + c) = w; }
                ss += __shfl_xor(ss, 16); ss += __shfl_xor(ss, 32);
                if (fq == 0) atomicAdd(ssq + r, ss); }
    }
};
struct EpiWin {
    static constexpr bool PERM = true, AFTER_DRAIN = false;
    bf16_t* QKV; size_t sec_stride; bf16_t* UC; const float* rope; float qscale;
    __device__ __forceinline__ void operator()(const f32x4 (&acc)[2][2][4][2], const Unit& u, int wr, int wc, int fr, int fq) const {
        const int row0 = u.pm * BM + wr * 64 + fr;
        const int sec = u.pn >> 2;
        const int col0 = (u.pn & 3) * BM + wc * 32 + 8 * fq;
        if (sec == 3) {
#pragma unroll
            for (int ai = 0; ai < 2; ++ai)
#pragma unroll
                for (int m = 0; m < 4; ++m) { const int r = row0 + ai * HALF + m * 16; const int cb = r >> 5, sg = r & 31;
#pragma unroll
                    for (int bj = 0; bj < 2; ++bj) { const int col = col0 + bj * HALF; const int g = col >> 4, h0 = col & 15;
                        const f32x4 v0 = acc[ai][bj][m][0], v1 = acc[ai][bj][m][1];
                        u32x4 w; w.x = cvt_pk_bf16(v0[0], v0[1]); w.y = cvt_pk_bf16(v0[2], v0[3]); w.z = cvt_pk_bf16(v1[0], v1[1]); w.w = cvt_pk_bf16(v1[2], v1[3]);
                        *(u32x4*)(UC + ((size_t)g * 512 + cb) * 640 + sg * 16 + h0) = w; } }
            return;
        }
        bf16_t* base = QKV + (size_t)sec * sec_stride;
        const float sc = sec == 0 ? qscale : 1.0f;
        const bool rot = (sec < 2) && ((wc & 1) == 0);
        const float sgn = (fq & 1) ? 1.0f : -1.0f;
        const bool mine = fq < 2;
#pragma unroll
        for (int ai = 0; ai < 2; ++ai)
#pragma unroll
            for (int m = 0; m < 4; ++m) { const int r = row0 + ai * HALF + m * 16; bf16_t* rowp = base + (size_t)r * 1024 + col0;
                f32x4 cs[4];
                if (rot) {
#pragma unroll
                    for (int q = 0; q < 4; ++q) cs[q] = *(const f32x4*)(rope + (size_t)r * 16 + 4 * q);
                }
#pragma unroll
                for (int bj = 0; bj < 2; ++bj) { f32x4 v0 = acc[ai][bj][m][0], v1 = acc[ai][bj][m][1];
                    if (rot) {
                        f32x4 p0, p1;
#pragma unroll
                        for (int e = 0; e < 4; ++e) { p0[e] = __shfl_xor(v0[e], 16); p1[e] = __shfl_xor(v1[e], 16); }
                        if (mine) {
#pragma unroll
                            for (int e = 0; e < 4; ++e) {
                                const float c0 = cs[e >> 1][(e & 1) * 2], s0 = cs[e >> 1][(e & 1) * 2 + 1];
                                const float c1 = cs[2 + (e >> 1)][(e & 1) * 2], s1 = cs[2 + (e >> 1)][(e & 1) * 2 + 1];
                                v0[e] = v0[e] * c0 + sgn * p0[e] * s0; v1[e] = v1[e] * c1 + sgn * p1[e] * s1; }
                        }
                    }
                    v0 = v0 * sc; v1 = v1 * sc; u32x4 w; w.x = cvt_pk_bf16(v0[0], v0[1]); w.y = cvt_pk_bf16(v0[2], v0[3]); w.z = cvt_pk_bf16(v1[0], v1[1]); w.w = cvt_pk_bf16(v1[2], v1[3]);
                    *(u32x4*)(rowp + bj * HALF) = w; } }
    }
};
}
#define GEMM_RUN(EPI, ALIGN, g, S, E) pg8::gemm_phase<EPI, pg8::StaticOrder, ALIGN, true>(F.ldsl, g, S, E)
namespace attn_body {
using bf16=__hip_bfloat16;
using bf16x8=__attribute__((ext_vector_type(8)))short;
using s16x4=__attribute__((ext_vector_type(4)))short;
using f32x16=__attribute__((ext_vector_type(16)))float;
using u32x4=__attribute__((ext_vector_type(4)))unsigned;
constexpr int BATCH=8,NHEAD=16,SEQ=2048,D=64,DM=NHEAD*D;
constexpr int NW=8,QBLK=32,QB=QBLK*NW,KVBLK=64,NQB=SEQ/QB;
constexpr int ATTN_PITCH=DM, ATTN_UNIT_ROWS=QB;
__device__ __forceinline__ int crow(int r,int hi){return (r&3)+8*(r>>2)+4*hi;}
#define SBAR() __builtin_amdgcn_sched_barrier(0)
__device__ __forceinline__ void cmask(f32x16&p0,f32x16&p1,int jb,int qrel,int hi){
  asm volatile("":"+v"(qrel),"+v"(hi));
  const float NEG=-INFINITY; int kb=64*jb+4*hi;
  #pragma unroll
  for(int r=0;r<16;++r){int kv=kb+(r&3)+8*(r>>2); if(kv>qrel)p0[r]=NEG; if(kv+32>qrel)p1[r]=NEG;}
}

constexpr int NSLOT=3, SLOTB=8192;
constexpr int LDS_K=0, LDS_V=NSLOT*SLOTB, LDS_WS=2*NSLOT*SLOTB, LDS_OST=LDS_WS+NW*64*4, LDS_BYTES=LDS_OST+NW*4096, LDS_X=LDS_BYTES, LDS_SSQ=LDS_X+NW*4096;
constexpr float C2=0.125f*1.4426950408889634f;
__device__ __forceinline__ void glds16(const void*gsrc,unsigned lds_dst){unsigned keep;
  asm volatile("s_mov_b32 %0, m0\n\ts_mov_b32 m0, %2\n\ts_nop 0\n\tglobal_load_lds_dwordx4 %1, off\n\ts_mov_b32 m0, %0":"=&s"(keep):"v"(gsrc),"s"(lds_dst):"memory");}
__device__ __forceinline__ float max3f(float a,float b,float c){float r;asm("v_max3_f32 %0, %1, %2, %3":"=v"(r):"v"(a),"v"(b),"v"(c));return r;}
__device__ __forceinline__ float max2f(float a,float b){float r;asm("v_max_f32_e32 %0, %1, %2":"=v"(r):"v"(a),"v"(b));return r;}
__device__ __forceinline__ float fadd_s(float a,float b){float r;asm("v_add_f32_e32 %0, %1, %2":"=v"(r):"v"(a),"v"(b));return r;}
__device__ __forceinline__ float fsub_s(float a,float b){float r;asm("v_sub_f32_e32 %0, %1, %2":"=v"(r):"v"(a),"v"(b));return r;}
typedef float f32x2_t __attribute__((ext_vector_type(2))); typedef __bf16 bf16x2_t __attribute__((ext_vector_type(2)));
__device__ __forceinline__ unsigned cvtpk_s(float lo,float hi){f32x2_t v={lo,hi};bf16x2_t b=__builtin_convertvector(v,bf16x2_t);return __builtin_bit_cast(unsigned,b);}
#define WAIT_BAR(N) asm volatile("s_waitcnt vmcnt(" #N ") lgkmcnt(0)\n\ts_barrier":::"memory")

__device__ __forceinline__ void qkt(f32x16&p0,f32x16&p1,const char*Kslot,const bf16x8*qr,int r32,int hi){ const f32x16 zc=f32x16{};
  const char*kb=Kslot+hi*1024+r32*16;
  #pragma unroll
  for(int d0=0;d0<4;++d0){
    const bf16x8 b0=*reinterpret_cast<const bf16x8*>(kb+d0*2048);
    const bf16x8 b1=*reinterpret_cast<const bf16x8*>(kb+d0*2048+512);
    if(d0==0){p0=__builtin_amdgcn_mfma_f32_32x32x16_bf16(b0,qr[0],zc,0,0,0);p1=__builtin_amdgcn_mfma_f32_32x32x16_bf16(b1,qr[0],zc,0,0,0);}
    else{p0=__builtin_amdgcn_mfma_f32_32x32x16_bf16(b0,qr[d0],p0,0,0,0);p1=__builtin_amdgcn_mfma_f32_32x32x16_bf16(b1,qr[d0],p1,0,0,0);}}
}
typedef __attribute__((address_space(3))) const char* lds_cptr;
typedef short v4i16_t __attribute__((ext_vector_type(4)));
__device__ __forceinline__ void kload8(bf16x8*kf,lds_cptr kp){
  kf[0]=*(const __attribute__((address_space(3))) bf16x8*)(kp);      kf[1]=*(const __attribute__((address_space(3))) bf16x8*)(kp+512);
  kf[2]=*(const __attribute__((address_space(3))) bf16x8*)(kp+2048); kf[3]=*(const __attribute__((address_space(3))) bf16x8*)(kp+2560);
  kf[4]=*(const __attribute__((address_space(3))) bf16x8*)(kp+4096); kf[5]=*(const __attribute__((address_space(3))) bf16x8*)(kp+4608);
  kf[6]=*(const __attribute__((address_space(3))) bf16x8*)(kp+6144); kf[7]=*(const __attribute__((address_space(3))) bf16x8*)(kp+6656);
}
__device__ __forceinline__ void kload2(bf16x8*kf,lds_cptr kp,int j){ kf[2*j]=*(const __attribute__((address_space(3))) bf16x8*)(kp+j*2048); kf[2*j+1]=*(const __attribute__((address_space(3))) bf16x8*)(kp+j*2048+512); }
__device__ __forceinline__ s16x4 vtr(lds_cptr p){ return __builtin_bit_cast(s16x4,__builtin_amdgcn_ds_read_tr16_b64_v4i16((__attribute__((address_space(3))) v4i16_t*)p)); }
__device__ __forceinline__ float rowmax(const f32x16&p0,const f32x16&p1){
  float a=max3f(p0[0],p0[1],p1[0]),b=max3f(p0[2],p0[3],p1[1]);a=max3f(a,p1[2],p1[3]);
  #pragma unroll
  for(int r=4;r<16;r+=4){a=max3f(a,p0[r],p0[r+1]);b=max3f(b,p0[r+2],p0[r+3]);a=max3f(a,p1[r],p1[r+1]);b=max3f(b,p1[r+2],p1[r+3]);}
  const float m=max2f(a,b);
  auto rr=__builtin_amdgcn_permlane32_swap(__float_as_uint(m),__float_as_uint(m),false,false);
  return max2f(__uint_as_float(rr[0]),__uint_as_float(rr[1]));
}
__device__ __forceinline__ void pv(f32x16*o,int vb,bf16x8 pa0,bf16x8 pa1,bf16x8 pa2,bf16x8 pa3){
  #pragma unroll
  for(int d0=0;d0<2;++d0){s16x4 lo[4],hi[4];
    #pragma unroll
    for(int ks=0;ks<4;++ks){
      asm volatile("ds_read_b64_tr_b16 %0,%1 offset:%c2":"=&v"(lo[ks]):"v"(vb),"i"(d0*4096+ks*1024):"memory");
      asm volatile("ds_read_b64_tr_b16 %0,%1 offset:%c2":"=&v"(hi[ks]):"v"(vb),"i"(d0*4096+ks*1024+512):"memory");}
    asm volatile("s_waitcnt lgkmcnt(0)":::"memory");SBAR();
    #define PK(k) (bf16x8){lo[k][0],lo[k][1],lo[k][2],lo[k][3],hi[k][0],hi[k][1],hi[k][2],hi[k][3]}
    o[d0]=__builtin_amdgcn_mfma_f32_32x32x16_bf16(pa0,PK(0),o[d0],0,0,0);
    o[d0]=__builtin_amdgcn_mfma_f32_32x32x16_bf16(pa1,PK(1),o[d0],0,0,0);
    o[d0]=__builtin_amdgcn_mfma_f32_32x32x16_bf16(pa2,PK(2),o[d0],0,0,0);
    o[d0]=__builtin_amdgcn_mfma_f32_32x32x16_bf16(pa3,PK(3),o[d0],0,0,0);
    #undef PK
  }
}

#ifndef ATTN_STORE16
#define ATTN_STORE16(p,v) (*(u32x4*)(p)=(v))
#endif
template<int THRL> __device__ __forceinline__ void attn_unit(int b,int h,int hv,int qb,const bf16*Q,const bf16*__restrict__ K,const bf16*__restrict__ V,bf16*CATp,const int mode,const float lam,const float*hgp,char*shm){
  const int tid=threadIdx.x,lane=tid&63,r32=lane&31,hi=lane>>5; const int wid=__builtin_amdgcn_readfirstlane(tid>>6);
  const long rowbase=(long)b*SEQ; const int q0=qb*QB;
  const bf16*Qw=Q+(rowbase+q0+wid*QBLK)*DM+h*D;
  const bf16*Kh=K+rowbase*DM+h*D,*Vh=V+rowbase*DM+hv*D;
  const unsigned lds0=(unsigned)(uintptr_t)shm;
  float*wsf=(float*)(shm+LDS_WS)+wid*64;
  const bf16*ksrc=Kh+(long)lane*DM+wid*8;
  const bf16*vsrc=Vh+(long)(16*(wid&3)+(lane>>2))*DM+(wid>>2)*32+(lane&3)*8;
  const unsigned kdst=lds0+LDS_K+wid*1024, vdst=lds0+LDS_V+wid*1024;
  #define DMA_K(t,slot) glds16(ksrc+(long)(t)*KVBLK*DM,(unsigned)__builtin_amdgcn_readfirstlane(kdst+(slot)))
  #define DMA_V(t,slot) glds16(vsrc+(long)(t)*KVBLK*DM,(unsigned)__builtin_amdgcn_readfirstlane(vdst+(slot)))
  const int vb0=(int)(lds0+LDS_V)+((lane>>4)&1)*32+(lane&3)*8+(4*hi+((lane&15)>>2))*64;
  const char*Kbase=shm+LDS_K; bf16x8 kf[8];
  const lds_cptr shm3=(lds_cptr)shm; const lds_cptr kp0=shm3+LDS_K+hi*1024+r32*16; const lds_cptr vp0=shm3+LDS_V+((lane>>4)&1)*32+(lane&3)*8+(4*hi+((lane&15)>>2))*64;
  const int NT=(q0+QB)/KVBLK;
  DMA_K(0,0);DMA_V(0,0);DMA_K(1,SLOTB);
  bf16x8 qr[4];
  #pragma unroll
  for(int d0=0;d0<4;++d0)qr[d0]=*reinterpret_cast<const bf16x8*>(&Qw[(long)r32*DM+d0*16+hi*8]);
  float mhat=0.f,l_reg=0.f;f32x16 o[2];o[0]=f32x16{};o[1]=f32x16{};
  const int qrel=wid*QBLK+r32;
  #define CMASK(P0,P1,t) do{int jb_=(t)-(NT-4); if(jb_>=0)cmask(P0,P1,jb_,qrel,hi);}while(0)
  bool resc=false;
  #define START(P0,P1) do{ const float rm=rowmax(P0,P1); resc=false; mhat=rm; \
    _Pragma("unroll") for(int r=0;r<16;++r)P0[r]=__builtin_amdgcn_exp2f(fsub_s(P0[r],mhat)); }while(0)
  #define RESC() do{ if(resc){ asm volatile("s_waitcnt lgkmcnt(0)":::"memory"); \
      _Pragma("unroll") for(int d_=0;d_<2;++d_) _Pragma("unroll") for(int r=0;r<16;++r)o[d_][r]*=wsf[crow(r,hi)]; } }while(0)
  f32x16 pA0,pA1,pB0,pB1;
  int sl_prev=0,sl_cur=0,sl_next=SLOTB;
  #define ROT() do{sl_prev=sl_cur;sl_cur=sl_next;sl_next=(sl_next==(NSLOT-1)*SLOTB)?0:sl_next+SLOTB;}while(0)
  DMA_K(2,2*SLOTB);
  WAIT_BAR(3);
  qkt(pA0,pA1,Kbase,qr,r32,hi);asm volatile("s_nop 15\n\ts_nop 7":"+v"(pA0),"+v"(pA1));CMASK(pA0,pA1,0);
  START(pA0,pA1);
  _Pragma("unroll") for(int r=0;r<16;++r)pA1[r]=__builtin_amdgcn_exp2f(fsub_s(pA1[r],mhat));
  WAIT_BAR(0);
  DMA_K(3,0);DMA_V(1,SLOTB);
  ROT();
  kload8(kf,kp0+sl_cur);
  WAIT_BAR(2);
  s16x4 vlo[8],vhi[8]; u32x4 pw0,pw1,pw2,pw3;
  #define PKW(P,B) cvtpk_s(P[B],P[B+1])
  #define PAF(k) __builtin_bit_cast(bf16x8,pw##k)
  #define VFR(i) (bf16x8){vlo[i][0],vlo[i][1],vlo[i][2],vlo[i][3],vhi[i][0],vhi[i][1],vhi[i][2],vhi[i][3]}
  #define PIN(x) asm volatile("":"+v"(x))
  #define MX3(a,b,c) __builtin_fmaxf(__builtin_fmaxf((a),(b)),(c))
  #define GAPA(MF,A0,A1,A2,A3,W0,W1,PW) do{ MF; sacc+=A0; sacc+=A1; sacc+=A2; sacc+=A3; PIN(sacc); W0; W1; PIN(PW); SBAR(); }while(0)
  #define EX(v) __builtin_amdgcn_exp2f((v)-mhat)
  #define GAPB(MF,X,B) do{ MF; X[B]=EX(X[B]); X[B+1]=EX(X[B+1]); X[B+2]=EX(X[B+2]); X[B+3]=EX(X[B+3]); PIN(X); SBAR(); }while(0)
  #define VRD(i) do{ vlo[i]=vtr(vp_+(((i)>>2)*4096+((i)&3)*1024)); vhi[i]=vtr(vp_+(((i)>>2)*4096+((i)&3)*1024+512)); }while(0)
  #define KRD(G,j) do{ if(G){ kload2(kf,kp0+sl_next,j); SBAR(); } }while(0)
  #define STEP(C0,C1,P0,P1,t,GK,GV,GL) do{ SBAR(); const f32x16 zc_=f32x16{}; \
    const lds_cptr vp_=vp0+sl_prev; \
    VRD(0); SBAR(); float sacc=(P0[0]+P0[1]); \
    GAPA(C0=__builtin_amdgcn_mfma_f32_32x32x16_bf16(kf[0],qr[0],zc_,0,0,0), P0[2],P0[3],P0[4],P0[5],     pw0[0]=PKW(P0,0), pw0[1]=PKW(P0,2), pw0); \
    VRD(4); SBAR(); GAPA(C1=__builtin_amdgcn_mfma_f32_32x32x16_bf16(kf[1],qr[0],zc_,0,0,0), P0[6],P0[7],P0[8],P0[9],     pw0[2]=PKW(P0,4), pw0[3]=PKW(P0,6), pw0); \
    VRD(1); SBAR(); GAPA(C0=__builtin_amdgcn_mfma_f32_32x32x16_bf16(kf[2],qr[1],C0,0,0,0),   P0[10],P0[11],P0[12],P0[13], pw1[0]=PKW(P0,8), pw1[1]=PKW(P0,10), pw1); \
    VRD(5); SBAR(); GAPA(C1=__builtin_amdgcn_mfma_f32_32x32x16_bf16(kf[3],qr[1],C1,0,0,0),   P0[14],P0[15],P1[0],P1[1],   pw1[2]=PKW(P0,12),pw1[3]=PKW(P0,14), pw1); \
    VRD(2); SBAR(); GAPA(C0=__builtin_amdgcn_mfma_f32_32x32x16_bf16(kf[4],qr[2],C0,0,0,0),   P1[2],P1[3],P1[4],P1[5],     pw2[0]=PKW(P1,0), pw2[1]=PKW(P1,2), pw2); \
    VRD(6); SBAR(); GAPA(C1=__builtin_amdgcn_mfma_f32_32x32x16_bf16(kf[5],qr[2],C1,0,0,0),   P1[6],P1[7],P1[8],P1[9],     pw2[2]=PKW(P1,4), pw2[3]=PKW(P1,6), pw2); \
    VRD(3); SBAR(); GAPA(C0=__builtin_amdgcn_mfma_f32_32x32x16_bf16(kf[6],qr[3],C0,0,0,0),   P1[10],P1[11],P1[12],P1[13], pw3[0]=PKW(P1,8), pw3[1]=PKW(P1,10), pw3); \
    VRD(7); SBAR(); GAPA(C1=__builtin_amdgcn_mfma_f32_32x32x16_bf16(kf[7],qr[3],C1,0,0,0),   P1[14],P1[15],0.f,0.f,       pw3[2]=PKW(P1,12),pw3[3]=PKW(P1,14), pw3); \
    l_reg+=sacc; \
    if(GK){DMA_K((t)+3,sl_cur);} if(GV){DMA_V((t)+1,sl_next);} \
    CMASK(C0,C1,t); \
    { float a=MX3(C0[0],C0[1],C1[0]),b=MX3(C0[2],C0[3],C1[1]); a=MX3(a,C1[2],C1[3]); \
      _Pragma("unroll") for(int r=4;r<16;r+=4){a=MX3(a,C0[r],C0[r+1]);b=MX3(b,C0[r+2],C0[r+3]);a=MX3(a,C1[r],C1[r+1]);b=MX3(b,C1[r+2],C1[r+3]);} \
      float rm=__builtin_fmaxf(a,b); { auto rr=__builtin_amdgcn_permlane32_swap(__float_as_uint(rm),__float_as_uint(rm),false,false); rm=__builtin_fmaxf(__uint_as_float(rr[0]),__uint_as_float(rr[1])); } \
      resc=false; \
      rm-=mhat; \
      if(__builtin_expect(__any(rm>(float)THRL),0)){ const float dl=__builtin_fmaxf(rm,0.f); mhat+=dl; \
        const float f=__builtin_amdgcn_exp2f(-dl); l_reg*=f; if(hi==0)wsf[r32]=f; resc=true; } } \
    SBAR(); \
    GAPB(o[0]=__builtin_amdgcn_mfma_f32_32x32x16_bf16(PAF(0),VFR(0),o[0],0,0,0), C0,0); \
    GAPB(o[1]=__builtin_amdgcn_mfma_f32_32x32x16_bf16(PAF(0),VFR(4),o[1],0,0,0), C0,4); \
    KRD(GL,0); GAPB(o[0]=__builtin_amdgcn_mfma_f32_32x32x16_bf16(PAF(1),VFR(1),o[0],0,0,0), C0,8); \
    KRD(GL,1); GAPB(o[1]=__builtin_amdgcn_mfma_f32_32x32x16_bf16(PAF(1),VFR(5),o[1],0,0,0), C0,12); \
    KRD(GL,2); GAPB(o[0]=__builtin_amdgcn_mfma_f32_32x32x16_bf16(PAF(2),VFR(2),o[0],0,0,0), C1,0); \
    KRD(GL,3); GAPB(o[1]=__builtin_amdgcn_mfma_f32_32x32x16_bf16(PAF(2),VFR(6),o[1],0,0,0), C1,4); \
    GAPB(o[0]=__builtin_amdgcn_mfma_f32_32x32x16_bf16(PAF(3),VFR(3),o[0],0,0,0), C1,8); \
    GAPB(o[1]=__builtin_amdgcn_mfma_f32_32x32x16_bf16(PAF(3),VFR(7),o[1],0,0,0), C1,12); \
    }while(0)
  int t=1;
  #undef CMASK
  #define CMASK(P0,P1,t) do{}while(0)
  for(;t+5<NT;t+=2){
    STEP(pB0,pB1,pA0,pA1,t,true,true,true);     WAIT_BAR(2); RESC(); ROT();
    STEP(pA0,pA1,pB0,pB1,t+1,true,true,true);   WAIT_BAR(2); RESC(); ROT();
  }
  #undef CMASK
  #define CMASK(P0,P1,t) do{int jb_=(t)-(NT-4); if(jb_>=0)cmask(P0,P1,jb_,qrel,hi);}while(0)
  #define ENDW(tt) do{ if((tt)+3<NT){WAIT_BAR(2);} else if((tt)+2<NT){WAIT_BAR(1);} else {WAIT_BAR(0);} }while(0)
  for(;t+1<NT;t+=2){
    STEP(pB0,pB1,pA0,pA1,t,(t+3<NT),(t+1<NT),(t+1<NT));       ENDW(t);   RESC(); ROT();
    STEP(pA0,pA1,pB0,pB1,t+1,(t+4<NT),(t+2<NT),(t+2<NT));     ENDW(t+1); RESC(); ROT();
  }
  STEP(pB0,pB1,pA0,pA1,NT-1,false,false,false); RESC();
  { float sacc=pB0[0]+pB0[1]; _Pragma("unroll") for(int r=2;r<16;++r)sacc+=pB0[r]; _Pragma("unroll") for(int r=0;r<16;++r)sacc+=pB1[r]; l_reg+=sacc;
    pw0=(u32x4){PKW(pB0,0),PKW(pB0,2),PKW(pB0,4),PKW(pB0,6)};pw1=(u32x4){PKW(pB0,8),PKW(pB0,10),PKW(pB0,12),PKW(pB0,14)};pw2=(u32x4){PKW(pB1,0),PKW(pB1,2),PKW(pB1,4),PKW(pB1,6)};pw3=(u32x4){PKW(pB1,8),PKW(pB1,10),PKW(pB1,12),PKW(pB1,14)};
    SBAR(); pv(o,vb0+sl_cur,PAF(0),PAF(1),PAF(2),PAF(3)); }
  #undef PKW
  #undef PAF
  #undef VFR
  #undef PIN
  #undef MX3
  #undef GAPA
  #undef GAPB
  #undef EX
  #undef VRD
  #undef KRD
  #undef STEP
  #undef ENDW
  {auto rr=__builtin_amdgcn_permlane32_swap(__float_as_uint(l_reg),__float_as_uint(l_reg),false,false);l_reg=__uint_as_float(rr[0])+__uint_as_float(rr[1]);}
  if(hi==0)wsf[32+r32]=l_reg;asm volatile("s_waitcnt lgkmcnt(0)":::"memory");
  float rli[16];
  #pragma unroll
  for(int r=0;r<16;++r)rli[r]=__builtin_amdgcn_rcpf(wsf[32+crow(r,hi)]);
  { bf16*stg=(bf16*)(shm+LDS_OST)+wid*2048;
    bf16*xst=(bf16*)(shm+LDS_X)+wid*2048; float*ssq=(float*)(shm+LDS_SSQ)+wid*32;
    bf16*cur=(mode&2)?stg:xst;
    if((mode&1)==0){
      #pragma unroll
      for(int r=0;r<16;++r){const int orow=crow(r,hi);
        #pragma unroll
        for(int d0=0;d0<2;++d0)cur[orow*64+d0*32+r32]=__float2bfloat16(o[d0][r]*rli[r]);}
    } else {
      #pragma unroll
      for(int r=0;r<16;++r){const int orow=crow(r,hi);
        #pragma unroll
        for(int d0=0;d0<2;++d0){const int pos=orow*64+d0*32+r32; const float dd=__bfloat162float(cur[pos])-lam*(o[d0][r]*rli[r]); cur[pos]=__float2bfloat16(dd);}}
      asm volatile("s_waitcnt lgkmcnt(0)":::"memory");
      const long trow=rowbase+q0+wid*QBLK;
      #pragma unroll
      for(int i=0;i<4;++i){const int row=i*8+(lane>>3),ch=lane&7; const u32x4 vb=*(const u32x4*)(cur+row*64+ch*8);
        float fb[8];
        #pragma unroll
        for(int e=0;e<4;++e){fb[2*e]=__uint_as_float(vb[e]<<16);fb[2*e+1]=__uint_as_float(vb[e]&0xffff0000u);}
        float ss=0.f;
        #pragma unroll
        for(int e=0;e<8;++e)ss+=fb[e]*fb[e];
        ss+=__shfl_xor(ss,1);ss+=__shfl_xor(ss,2);ss+=__shfl_xor(ss,4);
        if(mode==1){ if(ch==0)ssq[row]=ss; }
        else{
          const u32x4 va=*(const u32x4*)(xst+row*64+ch*8);
          const float rr=(1.0f-LAM_INIT)/sqrtf((ssq[row]+ss)/128.0f+EPS);
          const float4 ga0=*(const float4*)(hgp+ch*8),ga1=*(const float4*)(hgp+ch*8+4),gb0=*(const float4*)(hgp+64+ch*8),gb1=*(const float4*)(hgp+64+ch*8+4);
          const float ga[8]={ga0.x,ga0.y,ga0.z,ga0.w,ga1.x,ga1.y,ga1.z,ga1.w},gb[8]={gb0.x,gb0.y,gb0.z,gb0.w,gb1.x,gb1.y,gb1.z,gb1.w};
          u32x4 oa,ob;
          #pragma unroll
          for(int e=0;e<4;++e){
            oa[e]=cvtpk_s(__uint_as_float(va[e]<<16)*rr*ga[2*e],__uint_as_float(va[e]&0xffff0000u)*rr*ga[2*e+1]);
            ob[e]=cvtpk_s(fb[2*e]*rr*gb[2*e],fb[2*e+1]*rr*gb[2*e+1]);}
          bf16*cp=CATp+(trow+row)*2048+(hv>>1)*128+ch*8;
          ATTN_STORE16(cp,oa); ATTN_STORE16(cp+64,ob);
        }
      }
    }
  }
  asm volatile("s_waitcnt lgkmcnt(0)\n\ts_barrier":::"memory");
  #undef DMA_K
  #undef DMA_V
  #undef CMASK
  #undef START
  #undef RESC
  #undef ROT
}
constexpr int ATTN_LDS_BYTES=LDS_BYTES+NW*4096+NW*128;
struct AttnTensors { const bf16* Q; const bf16* K; const bf16* V; bf16* CAT; float lam; const float* hg; };
template<int THRL=8> __device__ __forceinline__ void attn_phase(char*lds,const AttnTensors&T,int vcu,int G){
  for(int item=vcu;item<BATCH*8*4;item+=G){
    const int b=item>>5,h=(item>>2)&7,j=item&3;
    for(int q2=0;q2<2;++q2){ const int qb=q2?j:NQB-1-j;
      for(int mode=0;mode<4;++mode) attn_unit<THRL>(b,2*h+(mode&1),2*h+(mode>>1),qb,T.Q,T.K,T.V,T.CAT,mode,T.lam,T.hg,lds); }
  }
}
#undef SBAR
#undef WAIT_BAR
}

__device__ __forceinline__ void p_s5_stepA(const Frame& F, const Args& A);
__device__ __forceinline__ void p3_attn(const Frame& F, const Args& A) {
    const attn_body::AttnTensors AT{(const attn_body::bf16*)WSB(WS_QB), (const attn_body::bf16*)WSB(WS_KB), (const attn_body::bf16*)WSB(WS_VB), (attn_body::bf16*)WSB(WS_B), *WSF(WS_LAM), IN_F(9)};
    const int vcu = (F.G % 8 == 0) ? (F.bid % 8) * (F.G / 8) + F.bid / 8 : F.bid;
    p_s5_stepA(F, A);
    attn_body::attn_phase<8>((char*)F.lds, AT, vcu, F.G);
}
__device__ __forceinline__ void p0_s5_setup(const Frame& F, const Args& A) {
    LAS float* Apr = (LAS float*)F.ldsl;
    LAS float* Api = Apr + 33 * 64;
    LAS float* Bbr = Api + 33 * 64;
    LAS float* Bbi = Bbr + 1024;
    LAS float* Cr = Bbi + 1024;
    LAS float* Ci = Cr + 1024;
    LAS float* Kk = Ci + 1024;
    const float* a_re = IN_F(10); const float* a_im = IN_F(11); const float* log_dt = IN_F(12);
    const float* b_re = IN_F(13); const float* b_im = IN_F(14); const float* c_re = IN_F(15); const float* c_im = IN_F(16); const float* dsk = IN_F(17);
    bf16* BtC = WSB(WS_BTC); bf16* BtA = WSB(WS_BTA); float* AL = WSF(WS_AL);
    const int tid = F.tid;
    const float* xin = IN_F(0); const float* g3 = IN_F(3); bf16* XN = WSB(WS_B);
    const int gw4 = 4 * (F.bid * NWAVES + F.wave), step4 = 4 * F.G * NWAVES; int nbat = 0;
#define S5_BAR() asm volatile("s_waitcnt lgkmcnt(0)\n\ts_barrier" ::: "memory")
    for (int item = F.bid; item < SG * 4; item += F.G) {
        const int g = item >> 2, hq = item & 3; const bool first = item == F.bid;
        S5_BAR();
        const float dtf = expf(log_dt[g]); const double dt = (double)dtf;
        for (int e = tid; e < 33 * 64; e += NTHR) {
            const int k = e >> 6, p = e & 63;
            const float lre = a_re[g * SP + p], lim = a_im[g * SP + p];
            const float mag = expf(lre * dtf * (float)k), af = lim * dtf * (float)k;
            Apr[e] = mag * cosf(af); Api[e] = mag * sinf(af);
        }
        for (int e = tid; e < 1024; e += NTHR) {
            const int p = e >> 4, h = e & 15;
            const double lre = a_re[g * SP + p], lim = a_im[g * SP + p];
            const double mag = exp(lre * dt), ang = lim * dt;
            const double rev = ang * 0.15915494309189533577, frr = rev - floor(rev);
            const float af = (float)(frr * 6.283185307179586477);
            const double ar = mag * (double)cosf(af), ai = mag * (double)sinf(af);
            const double den = lre * lre + lim * lim;
            const double fre = ((ar - 1.0) * lre + ai * lim) / den, fim = (ai * lre - (ar - 1.0) * lim) / den;
            const double br = b_re[(g * SP + p) * 16 + h], bi = b_im[(g * SP + p) * 16 + h];
            Bbr[e] = (float)(fre * br - fim * bi); Bbi[e] = (float)(fre * bi + fim * br);
            Cr[h * 64 + p] = c_re[(g * 16 + h) * SP + p]; Ci[h * 64 + p] = c_im[(g * 16 + h) * SP + p];
        }
        S5_BAR();
        float4 pv[32]; const int r0 = gw4 + nbat * step4; const bool has0 = first && r0 < T;
        if (has0) { norm4_load(xin + (size_t)r0 * DM, F.lane, pv); ++nbat; }
        if (hq == 0 && tid < 64) { AL[(g * 64 + tid) * 2] = Apr[32 * 64 + tid]; AL[(g * 64 + tid) * 2 + 1] = Api[32 * 64 + tid]; }
        if (tid < 128) {
            const int k = tid >> 2, hl = tid & 3, h = 4 * hq + hl;
            float acc[16];
#pragma unroll
            for (int q = 0; q < 16; ++q) acc[q] = 0.f;
            for (int p = 0; p < 64; ++p) {
                const float cr = Cr[h * 64 + p], ci = Ci[h * 64 + p], ar = Apr[k * 64 + p], ai = Api[k * 64 + p];
                const float gr = cr * ar - ci * ai, gi = cr * ai + ci * ar;
#pragma unroll
                for (int q = 0; q < 16; ++q) acc[q] += gr * Bbr[p * 16 + q] - gi * Bbi[p * 16 + q];
            }
#pragma unroll
            for (int q = 0; q < 16; ++q) Kk[tid * 16 + q] = acc[q];
        }
        S5_BAR();
        const float dk0 = dsk[g * 16 + 4 * hq], dk1 = dsk[g * 16 + 4 * hq + 1], dk2 = dsk[g * 16 + 4 * hq + 2], dk3 = dsk[g * 16 + 4 * hq + 3];
        if (has0) norm4_finish(pv, g3, XN + (size_t)r0 * DM, F.lane);
        const int r1 = gw4 + nbat * step4; const bool has1 = first && r1 < T;
        if (has1) { norm4_load(xin + (size_t)r1 * DM, F.lane, pv); ++nbat; }
        asm volatile("" ::: "memory");
        for (int e = tid; e < 128 * 80; e += NTHR) {
            const int rr = e / 80, k0 = (e - rr * 80) * 8; const int tau = rr >> 2, hl = rr & 3, h = 4 * hq + hl;
            float v[8];
            if (k0 < 512) { const int sg = k0 >> 4, hp0 = k0 & 15;
#pragma unroll
                for (int q = 0; q < 8; ++q) { float x = 0.f; if (sg <= tau) { x = Kk[(((tau - sg) << 2) + hl) * 16 + hp0 + q]; if (sg == tau && hp0 + q == h) x += (hl == 0 ? dk0 : hl == 1 ? dk1 : hl == 2 ? dk2 : dk3); } v[q] = x; } }
            else { const int kp = k0 - 512, ri = kp >> 6, p0 = kp & 63;
#pragma unroll
                for (int q = 0; q < 8; ++q) { const int p = p0 + q; const float ar = Apr[(tau + 1) * 64 + p], ai = Api[(tau + 1) * 64 + p];
                    const float gr = Cr[h * 64 + p] * ar - Ci[h * 64 + p] * ai, gi = Cr[h * 64 + p] * ai + Ci[h * 64 + p] * ar; v[q] = ri ? -gi : gr; } }
            v4u o; o.x = pk2(v[0], v[1]); o.y = pk2(v[2], v[3]); o.z = pk2(v[4], v[5]); o.w = pk2(v[6], v[7]);
            *(v4u*)(BtC + ((size_t)g * 512 + tau * 16 + h) * 640 + k0) = o;
        }
        for (int e = tid; e < 32 * 64; e += NTHR) {
            const int rr = e >> 6, k0 = (e & 63) * 8; const int ri = rr >> 4, p = 16 * hq + (rr & 15), sg = k0 >> 4, hp0 = k0 & 15;
            const float ar = Apr[(31 - sg) * 64 + p], ai = Api[(31 - sg) * 64 + p];
            float v[8];
#pragma unroll
            for (int q = 0; q < 8; ++q) { const float br = Bbr[p * 16 + hp0 + q], bi = Bbi[p * 16 + hp0 + q]; v[q] = ri ? (ar * bi + ai * br) : (ar * br - ai * bi); }
            v4u o; o.x = pk2(v[0], v[1]); o.y = pk2(v[2], v[3]); o.z = pk2(v[4], v[5]); o.w = pk2(v[6], v[7]);
            *(v4u*)(BtA + ((size_t)g * 256 + ri * 64 + p) * 512 + k0) = o;
        }
        if (has1) norm4_finish(pv, g3, XN + (size_t)r1 * DM, F.lane);
    }
    {
        float4 pv[32];
        for (int r = gw4 + nbat * step4; r < T; r += step4) { norm4_load(xin + (size_t)r * DM, F.lane, pv); norm4_finish(pv, g3, XN + (size_t)r * DM, F.lane); }
    }
#undef S5_BAR
    __syncthreads();
}
__device__ __forceinline__ void p_s5_stepA(const Frame& F, const Args& A) {
    pg8::Gemm g{WSB(WS_UCAT), WSB(WS_BTA), NCH, 256, 512, UCK, 512, (long)NCH * UCK, (long)256 * 512, SG}; pg8::StaticOrder S; S.init(NCH, 256, F.G, F.bid, SG);
    pg8::EpiSl E{WSF(WS_SL)}; GEMM_RUN(pg8::EpiSl, true, g, S, E);
}
__device__ __forceinline__ void p4_s5_scan(const Frame& F, const Args& A) {
    const float* Sl = WSF(WS_SL); const float* AL = WSF(WS_AL); bf16* UC = WSB(WS_UCAT);
    if (F.wave >= 4) return;
    pg8::StaticOrder S; S.init(NCH, 512, F.G, F.bid, SG); pg8::Unit u;
    for (int i = 0; S.next(i, u); ++i) {
        const int p = F.lane, b = u.pm * 4 + F.wave, g = u.bz;
        const float ar = AL[(g * 64 + p) * 2], ai = AL[(g * 64 + p) * 2 + 1];
        const size_t row0 = (size_t)g * NCH + b * 64;
        float lr[64], li[64];
#pragma unroll
        for (int c = 0; c < 64; ++c) { lr[c] = Sl[(row0 + c) * 128 + p]; li[c] = Sl[(row0 + c) * 128 + 64 + p]; }
        asm volatile("" ::: "memory");
        float sr = 0.f, si = 0.f;
#pragma unroll
        for (int c = 0; c < 64; ++c) {
            bf16* up = UC + (row0 + c) * UCK + 512;
            up[p] = (bf16)f2bf(sr); up[64 + p] = (bf16)f2bf(si);
            const float nr = ar * sr - ai * si + lr[c], ni = ar * si + ai * sr + li[c];
            sr = nr; si = ni;
        }
    }
}
__device__ __forceinline__ void p5_s5_out(const Frame& F, const Args& A) {
    pg8::Gemm g{WSB(WS_UCAT), WSB(WS_BTC), NCH, 512, UCK, UCK, UCK, (long)NCH * UCK, (long)512 * UCK, SG}; pg8::StaticOrder S; S.init(NCH, 512, F.G, F.bid, SG);
    pg8::EpiS5 E{WSB(WS_GB)}; GEMM_RUN(pg8::EpiS5, true, g, S, E);
}
__device__ __forceinline__ void p10_xscores(const Frame& F, const Args& A) {
    for (int sel = 0; sel * F.G + F.bid < 256; ++sel) {
        pg8::Gemm g{WSB(WS_XQB), WSB(WS_KP), 2048, 256, 256, XW, 256, 0, 0, 1}; pg8::XsOrder S{F.G, F.bid, sel};
        pg8::EpiXs E{WSB(WS_XP), WSF(WS_LSUM)};
        pg8::gemm_phase<pg8::EpiXs, pg8::XsOrder, false, true>(F.ldsl, g, S, E);
        __syncthreads();
    }
}
__device__ __forceinline__ void p10_xpv(const Frame& F, const Args& A) {
    pg8::Gemm g{WSB(WS_XP), WSB(WS_VT2), 2048, 256, 256, 1024, 512, 0, 0, 1}; pg8::XoOrder S{F.G, F.bid};
    pg8::EpiXo E{WSB(WS_XO), WSF(WS_LSUM)};
    pg8::gemm_phase<pg8::EpiXo, pg8::XoOrder, true, true>(F.ldsl, g, S, E);
}
__device__ __forceinline__ unsigned f2key(float f) { const unsigned u = __float_as_uint(f); return (u & 0x80000000u) ? ~u : (u | 0x80000000u); }
__device__ __forceinline__ float key2f(unsigned k) { const unsigned u = (k & 0x80000000u) ? (k ^ 0x80000000u) : ~k; return __uint_as_float(u); }
#define INS16(L, xk) do { unsigned x_ = (xk); _Pragma("unroll") for (int s_ = 0; s_ < 16; ++s_) { const unsigned hi_ = L[s_] > x_ ? L[s_] : x_; x_ = L[s_] > x_ ? x_ : L[s_]; L[s_] = hi_; } } while (0)
#define CE_DESC(a_, b_) do { const unsigned hi_ = (a_) > (b_) ? (a_) : (b_), lo_ = (a_) > (b_) ? (b_) : (a_); (a_) = hi_; (b_) = lo_; } while (0)
__device__ __forceinline__ void sort16_desc(unsigned (&v)[16]) {
#pragma unroll
    for (int k = 2; k <= 16; k <<= 1)
#pragma unroll
        for (int j = k >> 1; j > 0; j >>= 1)
#pragma unroll
            for (int i = 0; i < 16; ++i) { const int l = i ^ j; if (l > i) { if ((i & k) == 0) CE_DESC(v[i], v[l]); else CE_DESC(v[l], v[i]); } }
}
__device__ __forceinline__ void merge16_desc(unsigned (&a)[16], const unsigned (&b)[16]) {
#pragma unroll
    for (int i = 0; i < 16; ++i) a[i] = a[i] > b[15 - i] ? a[i] : b[15 - i];
#pragma unroll
    for (int j = 8; j > 0; j >>= 1)
#pragma unroll
        for (int i = 0; i < 16; ++i) { const int l = i ^ j; if (l > i) CE_DESC(a[i], a[l]); }
}
__device__ __forceinline__ void top16_of_128(const float* sp, unsigned (&L)[16]) {
#pragma unroll 1
    for (int c = 0; c < 8; ++c) {
        unsigned ch[16];
#pragma unroll
        for (int i = 0; i < 16; ++i) ch[i] = (f2key(sp[(size_t)(c * 16 + i) * T]) & ~127u) | (unsigned)(127 - (c * 16 + i));
        sort16_desc(ch);
        if (c == 0) {
#pragma unroll
            for (int i = 0; i < 16; ++i) L[i] = ch[i];
        } else merge16_desc(L, ch);
    }
}
namespace pg8 {
struct TkOrder {
    int G, c, sel;
    __device__ __forceinline__ bool next(int i, Unit& u) const { if (i > 0) return false; const int L = sel * G + c; if (L >= PH * (T / BM)) return false; u.pm = 0; u.pn = L & (T / BM - 1); u.bz = L / (T / BM); return true; }
    __device__ __forceinline__ void a_ready(const Unit&) const {}
    __device__ __forceinline__ void done(const Unit&) const {}
    template <class G_> __device__ __forceinline__ long offA(const Unit& u, const G_& g) const { return (long)u.bz * g.sA; }
    template <class G_> __device__ __forceinline__ long offB(const Unit& u, const G_& g) const { return (long)u.bz * g.sB; }
};
struct EpiTopk {
    static constexpr bool PERM = false, AFTER_DRAIN = true;
    static constexpr int PITCH = 260;
    unsigned short* IDX; float* GATE;
    __device__ __forceinline__ void stage(const f32x4 (&acc)[2][2][4][2], int ai, int wr, int wc, int fr, int fq, PG8_LAS float* SCL) const {
#pragma unroll
        for (int m = 0; m < 4; ++m)
#pragma unroll
            for (int bj = 0; bj < 2; ++bj)
#pragma unroll
                for (int n = 0; n < 2; ++n) *(PG8_LAS f32x4*)(SCL + (wr * 64 + m * 16 + fr) * PITCH + bj * HALF + wc * 32 + n * 16 + 4 * fq) = acc[ai][bj][m][n];
    }
    static __device__ __forceinline__ unsigned blend(unsigned m, unsigned a, unsigned b) { return (a & m) | (b & ~m); }
    static __device__ __forceinline__ unsigned swap1(unsigned v) { return (unsigned)__builtin_amdgcn_update_dpp(0, (int)v, 0xB1, 0xF, 0xF, true); }
    __device__ __forceinline__ void top16(const PG8_LAS float* sp, int nb, unsigned (&L)[16]) const {
#pragma unroll 1
        for (int c = 0; c < 4; ++c) {
            unsigned ch[16];
#pragma unroll
            for (int i = 0; i < 16; ++i) ch[i] = (f2key(sp[(c * 16 + i) * PITCH]) & ~127u) | (unsigned)(nb - (c * 16 + i));
            sort16_desc(ch);
            if (c == 0) {
#pragma unroll
                for (int i = 0; i < 16; ++i) L[i] = ch[i];
            } else merge16_desc(L, ch);
        }
        unsigned P[16];
#pragma unroll
        for (int i = 0; i < 16; ++i) P[i] = swap1(L[i]);
        merge16_desc(L, P);
    }
    __device__ __forceinline__ void fused(f32x4 (&acc)[2][2][4][2], const Unit& u, int wr, int wc, int fr, int fq, PG8_LAS unsigned char* lds, int wid, int lane) const {
        PG8_LAS float* SCL = (PG8_LAS float*)lds;
        int ln = lane; asm volatile("" : "+v"(ln));
        const int tl = wid * 32 + (ln >> 1), kh = ln & 1; const unsigned km = 0u - (unsigned)kh;
        PG8_LAS unsigned char* li = lds + PK * PITCH * 4 + tl * 32;
        const PG8_LAS float* col = SCL + tl;
        float t1[16], t2[16];
        stage(acc, 0, wr, wc, fr, fq, SCL);
        asm volatile("s_waitcnt lgkmcnt(0)" ::: "memory"); __builtin_amdgcn_s_barrier(); asm volatile("" ::: "memory");
        { unsigned L1[16]; top16(col + kh * 64 * PITCH, 127 - kh * 64, L1);
#pragma unroll
          for (int s = 0; s < 16; ++s) { const int i1 = 127 - (int)(L1[s] & 127u); if (kh == 0) li[s] = (unsigned char)i1; t1[s] = col[i1 * PITCH]; } }
        asm volatile("s_waitcnt lgkmcnt(0)" ::: "memory"); __builtin_amdgcn_s_barrier(); asm volatile("" ::: "memory");
        stage(acc, 1, wr, wc, fr, fq, SCL);
        asm volatile("s_waitcnt lgkmcnt(0)" ::: "memory"); __builtin_amdgcn_s_barrier(); asm volatile("" ::: "memory");
        { unsigned L2[16]; top16(col + kh * 64 * PITCH, 127 - kh * 64, L2);
#pragma unroll
          for (int s = 0; s < 16; ++s) { const int i2 = 127 - (int)(L2[s] & 127u); if (kh == 0) li[16 + s] = (unsigned char)i2; t2[s] = col[i2 * PITCH]; } }
        unsigned Lc[16], c1[16];
        {
            int n = 0;
#pragma unroll
            for (int a = 0; a < 16; ++a)
#pragma unroll
                for (int m = 0; m < 8; ++m)
                    if ((a + 1) * (2 * m + 1) <= 16) {
                        const bool odd_ok = (a + 1) * (2 * m + 2) <= 16;
                        const float tb = __uint_as_float(blend(km, __float_as_uint(t2[(2 * m + 1) & 15]), __float_as_uint(t2[2 * m])));
                        unsigned k = (f2key(t1[a] + tb) & ~255u) | (unsigned)((255 - (a * 16 + 2 * m)) - kh);
                        if (!odd_ok) k = kh ? 0u : k;
                        if (n < 16) Lc[n] = k; else c1[n - 16] = k; ++n; }
            c1[14] = 0u; c1[15] = 0u;
        }
        sort16_desc(Lc); sort16_desc(c1); merge16_desc(Lc, c1);
        {
            unsigned P[16];
#pragma unroll
            for (int i = 0; i < 16; ++i) P[i] = swap1(Lc[i]);
            merge16_desc(Lc, P);
        }
        float ts[16]; const float mx = key2f(Lc[0] & ~255u); float sum = 0.f;
#pragma unroll
        for (int s = 0; s < 16; ++s) { ts[s] = expf(key2f(Lc[s] & ~255u) - mx); sum += ts[s]; }
        const float inv = 1.0f / sum;
        const size_t ob = (size_t)(u.pn * BM + tl) * 128 + u.bz * 16 + kh * 8;
        asm volatile("s_waitcnt lgkmcnt(0)" ::: "memory");
#pragma unroll
        for (int s = 0; s < 8; ++s) {
            const unsigned key = blend(km, Lc[8 + s], Lc[s]); const float tv = __uint_as_float(blend(km, __float_as_uint(ts[8 + s]), __float_as_uint(ts[s])));
            const int flat = 255 - (int)(key & 255u); const int a = flat >> 4, b = flat & 15;
            const int e1 = li[a], e2 = li[16 + b];
            IDX[ob + s] = (unsigned short)(e1 * PK + e2);
            GATE[ob + s] = tv * inv;
        }
    }
};
}

struct PeerCtx { int xr, nx, nloc, rank; };
__device__ __forceinline__ PeerCtx peer_ctx(const Frame& F, volatile LAS unsigned* MISC) {
    if (F.tid == 0) {
        unsigned* barw = (unsigned*)(F.ws + WS_CTL) + CW_BAR; const unsigned x = MISC[11];
        unsigned nx = 0, xr = 0, nloc = 1;
        for (unsigned j = 0; j < 16; ++j) { const unsigned c = xb_ld(&barw[XB_XCNT(j)]); if (c) { ++nx; if (j < x) ++xr; } if (j == x) nloc = c ? c : 1u; }
        MISC[12] = xr; MISC[13] = nx ? nx : 1u; MISC[14] = nloc;
    }
    __syncthreads();
    PeerCtx c; c.xr = (int)MISC[12]; c.nx = (int)MISC[13]; c.nloc = (int)MISC[14]; c.rank = (int)MISC[10];
    return c;
}
typedef __bf16 bf16x2 __attribute__((ext_vector_type(2)));
__device__ __forceinline__ float dot2_bf16(unsigned w, unsigned x, float acc) { return __builtin_amdgcn_fdot2_f32_bf16(__builtin_bit_cast(bf16x2, w), __builtin_bit_cast(bf16x2, x), acc, false); }
__device__ __forceinline__ float dot8(const v4u& r, const v4u& x) { float a = dot2_bf16(r.x, x.x, 0.f); a = dot2_bf16(r.y, x.y, a); a = dot2_bf16(r.z, x.z, a); return dot2_bf16(r.w, x.w, a); }
__device__ __forceinline__ float xl1(float x) { return __uint_as_float((unsigned)__builtin_amdgcn_update_dpp(0, (int)__float_as_uint(x), 0xB1, 0xF, 0xF, true)); }
__device__ __forceinline__ float xl2(float x) { return __uint_as_float((unsigned)__builtin_amdgcn_update_dpp(0, (int)__float_as_uint(x), 0x4E, 0xF, 0xF, true)); }
__device__ __forceinline__ float xl4(float x) { const int v = (int)__float_as_uint(x); int r = __builtin_amdgcn_update_dpp(0, v, 0x104, 0xF, 0x5, false); r = __builtin_amdgcn_update_dpp(r, v, 0x114, 0xF, 0xA, false); return __uint_as_float((unsigned)r); }
__device__ __forceinline__ float xl8(float x) { return __uint_as_float((unsigned)__builtin_amdgcn_update_dpp(0, (int)__float_as_uint(x), 0x128, 0xF, 0xF, true)); }
__device__ __forceinline__ float sum16x(float a, float b) { const auto r = __builtin_amdgcn_permlane16_swap(__float_as_uint(a), __float_as_uint(b), false, false); return __uint_as_float(r[0]) + __uint_as_float(r[1]); }
__device__ __forceinline__ float sum32x(float a, float b) { const auto r = __builtin_amdgcn_permlane32_swap(__float_as_uint(a), __float_as_uint(b), false, false); return __uint_as_float(r[0]) + __uint_as_float(r[1]); }
__device__ __forceinline__ float wave_sum_valu(float x) {
    x += xl1(x); x += xl2(x);
    x += __uint_as_float((unsigned)__builtin_amdgcn_update_dpp(0, (int)__float_as_uint(x), 0x141, 0xF, 0xF, true));
    x += __uint_as_float((unsigned)__builtin_amdgcn_update_dpp(0, (int)__float_as_uint(x), 0x140, 0xF, 0xF, true));
    x = sum16x(x, x); return sum32x(x, x);
}
#define RED8J(v0, v1, v2, v3, v4, v5, v6, v7, B2, B1, B0, out) do { \
    const float a0_ = ((B2) ? v4 : v0) + xl4((B2) ? v0 : v4), a1_ = ((B2) ? v5 : v1) + xl4((B2) ? v1 : v5); \
    const float a2_ = ((B2) ? v6 : v2) + xl4((B2) ? v2 : v6), a3_ = ((B2) ? v7 : v3) + xl4((B2) ? v3 : v7); \
    const float c0_ = ((B1) ? a2_ : a0_) + xl2((B1) ? a0_ : a2_), c1_ = ((B1) ? a3_ : a1_) + xl2((B1) ? a1_ : a3_); \
    out = ((B0) ? c1_ : c0_) + xl1((B0) ? c0_ : c1_); } while (0)
__device__ __forceinline__ int xi1(int x) { return __builtin_amdgcn_update_dpp(0, x, 0xB1, 0xF, 0xF, true); }
__device__ __forceinline__ int xi2(int x) { return __builtin_amdgcn_update_dpp(0, x, 0x4E, 0xF, 0xF, true); }
__device__ __forceinline__ int xi4(int x) { int r = __builtin_amdgcn_update_dpp(0, x, 0x104, 0xF, 0x5, false); return __builtin_amdgcn_update_dpp(r, x, 0x114, 0xF, 0xA, false); }
#define RED8JI(v0, v1, v2, v3, v4, v5, v6, v7, B2, B1, B0, out) do { \
    const int a0_ = ((B2) ? v4 : v0) + xi4((B2) ? v0 : v4), a1_ = ((B2) ? v5 : v1) + xi4((B2) ? v1 : v5); \
    const int a2_ = ((B2) ? v6 : v2) + xi4((B2) ? v2 : v6), a3_ = ((B2) ? v7 : v3) + xi4((B2) ? v3 : v7); \
    const int c0_ = ((B1) ? a2_ : a0_) + xi2((B1) ? a0_ : a2_), c1_ = ((B1) ? a3_ : a1_) + xi2((B1) ? a1_ : a3_); \
    out = ((B0) ? c1_ : c0_) + xi1((B0) ? c0_ : c1_); } while (0)
#define RED8G(v0, v1, v2, v3, v4, v5, v6, v7, B0, out) do { \
    const float a0_ = sum32x(v0, v4), a1_ = sum32x(v1, v5), a2_ = sum32x(v2, v6), a3_ = sum32x(v3, v7); \
    const float c0_ = sum16x(a0_, a2_), c1_ = sum16x(a1_, a3_); \
    out = ((B0) ? c1_ : c0_) + xl8((B0) ? c0_ : c1_); } while (0)
#define RED8(v0, v1, v2, v3, v4, v5, v6, v7, B2, B1, B0, X2, X1, X0, out) do { \
    const float a0_ = ((B2) ? v4 : v0) + __shfl_xor((B2) ? v0 : v4, X2), a1_ = ((B2) ? v5 : v1) + __shfl_xor((B2) ? v1 : v5, X2); \
    const float a2_ = ((B2) ? v6 : v2) + __shfl_xor((B2) ? v2 : v6, X2), a3_ = ((B2) ? v7 : v3) + __shfl_xor((B2) ? v3 : v7, X2); \
    const float c0_ = ((B1) ? a2_ : a0_) + __shfl_xor((B1) ? a0_ : a2_, X1), c1_ = ((B1) ? a3_ : a1_) + __shfl_xor((B1) ? a1_ : a3_, X1); \
    out = ((B0) ? c1_ : c0_) + __shfl_xor((B0) ? c0_ : c1_, X0); } while (0)
typedef float f32x2 __attribute__((ext_vector_type(2)));
struct PTok { unsigned ix[8]; v4u xa; float xs; float oa, ob; };
#define PK_IDX(TK, k) (((k) & 1) ? (TK.ix[(k) >> 1] >> 16) : (TK.ix[(k) >> 1] & 0xffffu))
#define LD_IDX16(TK, ip_) do { _Pragma("unroll") for (int q_ = 0; q_ < 2; ++q_) { const int4 v_ = (ip_)[q_]; TK.ix[4 * q_] = (unsigned)v_.x; TK.ix[4 * q_ + 1] = (unsigned)v_.y; TK.ix[4 * q_ + 2] = (unsigned)v_.z; TK.ix[4 * q_ + 3] = (unsigned)v_.w; } } while (0)
__device__ __forceinline__ float dot16_fp8(const v4u& r, const f32x2 (&X)[8]) {
    f32x2 a = {0.f, 0.f};
#pragma unroll
    for (int q = 0; q < 4; ++q) { const f32x2 lo = __builtin_amdgcn_cvt_pk_f32_fp8((int)r[q], false), hi = __builtin_amdgcn_cvt_pk_f32_fp8((int)r[q], true);
        a = lo * X[2 * q] + a; a = hi * X[2 * q + 1] + a; }
    return a.x + a.y;
}
__device__ __forceinline__ void p17_peer_u(const Frame& F, const Args& A, volatile LAS unsigned* MISC) {
    const PeerCtx cx = peer_ctx(F, MISC);
    const unsigned char* UB = F.ws + WS_UB; const unsigned char* X8 = F.ws + WS_X8; const float* XS = WSF(WS_XS); const unsigned short* IDX = (const unsigned short*)(F.ws + WS_IDX); float* PACT = WSF(WS_PACT) + (size_t)cx.xr * T * 128;
    const int lane = F.lane, j = lane & 7, g = lane >> 3;
    const bool b2 = lane & 4, b1 = lane & 2, b0 = lane & 1;
    const int NI = (T / 8 - cx.rank + cx.nloc - 1) / cx.nloc;
#define U_TOK(i_) (((cx.rank + (i_) * cx.nloc) * 8) + F.wave)
    for (int p = 0; cx.xr + cx.nx * p < NSL; ++p) {
        const int s = cx.xr + cx.nx * p;
        const __amdgpu_buffer_rsrc_t rs = __builtin_amdgcn_make_buffer_rsrc((void*)(UB + (size_t)s * (PK * PK) * SLW), 0, PK * PK * SLW, 0x00020000);
#define U_LOAD(TK, t_) do { const int4* ip_ = (const int4*)(IDX + (size_t)(t_) * 128 + 16 * g); LD_IDX16(TK, ip_); \
        TK.xa = *(const v4u*)(X8 + (size_t)(t_) * DM + s * SLW + j * 16); TK.xs = XS[(size_t)(t_) * 16 + s]; \
        TK.oa = 0.f; TK.ob = 0.f; if (p != 0) { const float2 pp_ = *(const float2*)(PACT + (size_t)(t_) * 128 + 16 * g + 2 * j); TK.oa = pp_.x; TK.ob = pp_.y; } } while (0)
#define U_GATHER(R, TK) do { _Pragma("unroll") for (int k = 0; k < 16; ++k) R[k] = __builtin_amdgcn_raw_buffer_load_b128(rs, ((unsigned)PK_IDX(TK, k) << 7) + (unsigned)(j * 16), 0, 0); } while (0)
#define U_COMPUTE(R, XA, XS_, OA, OB, t_) do { \
        int v[16]; _Pragma("unroll") for (int k = 0; k < 16; ++k) { int a_ = __builtin_amdgcn_sdot4((int)R[k][0], (int)XA[0], 0, false); a_ = __builtin_amdgcn_sdot4((int)R[k][1], (int)XA[1], a_, false); \
            a_ = __builtin_amdgcn_sdot4((int)R[k][2], (int)XA[2], a_, false); v[k] = __builtin_amdgcn_sdot4((int)R[k][3], (int)XA[3], a_, false); } \
        int ie_, io_; \
        RED8JI(v[0], v[2], v[4], v[6], v[8], v[10], v[12], v[14], b2, b1, b0, ie_); \
        RED8JI(v[1], v[3], v[5], v[7], v[9], v[11], v[13], v[15], b2, b1, b0, io_); \
        *(float2*)(PACT + (size_t)(t_) * 128 + 16 * g + 2 * j) = make_float2(OA + (float)ie_ * XS_, OB + (float)io_ * XS_); } while (0)
        PTok TA, TB; v4u RA[16], RB[16];
        if (NI > 0) U_LOAD(TA, U_TOK(0));
        if (NI > 1) U_LOAD(TB, U_TOK(1));
        if (NI > 0) U_GATHER(RA, TA);
        for (int i = 0; i < NI; i += 2) {
            { const v4u xa = TA.xa; const float xs = TA.xs, oa = TA.oa, ob = TA.ob;
              if (i + 2 < NI) U_LOAD(TA, U_TOK(i + 2));
              if (i + 1 < NI) U_GATHER(RB, TB);
              U_COMPUTE(RA, xa, xs, oa, ob, U_TOK(i)); }
            if (i + 1 < NI) {
                const v4u xa = TB.xa; const float xs = TB.xs, oa = TB.oa, ob = TB.ob;
                if (i + 3 < NI) U_LOAD(TB, U_TOK(i + 3));
                if (i + 2 < NI) U_GATHER(RA, TA);
                U_COMPUTE(RB, xa, xs, oa, ob, U_TOK(i + 1));
            }
        }
    }
#undef U_LOAD
#undef U_GATHER
#undef U_COMPUTE
#undef U_TOK
}
__device__ __forceinline__ void p18_peer_w(const Frame& F, const Args& A, volatile LAS unsigned* MISC) {
    const PeerCtx cx = peer_ctx(F, MISC);
    const float* PACT = WSF(WS_PACT); const float* GATE = WSF(WS_GATE); unsigned short* W = (unsigned short*)(F.ws + WS_PW);            const unsigned short* IDX = (const unsigned short*)(F.ws + WS_IDX);
    const float* iu = WSF(WS_ISCU); const float* iv = WSF(WS_ISCV); const float* ssq2 = WSF(WS_SSQ2);
    const size_t gt = (size_t)F.bid * NTHR + F.tid, NGT = (size_t)F.G * NTHR;
    for (size_t i = gt * 4; i < (size_t)T * 128; i += NGT * 4) {
        float4 a = make_float4(0.f, 0.f, 0.f, 0.f);
        for (int q0 = 0; q0 < cx.nx; q0 += 8) {
            float4 pa[8];
#pragma unroll
            for (int j = 0; j < 8; ++j) pa[j] = (q0 + j < cx.nx) ? *(const float4*)(PACT + (size_t)(q0 + j) * T * 128 + i) : make_float4(0.f, 0.f, 0.f, 0.f);
#pragma unroll
            for (int j = 0; j < 8; ++j) { a.x += pa[j].x; a.y += pa[j].y; a.z += pa[j].z; a.w += pa[j].w; }
        }
        const uint2 e2_ = *(const uint2*)(IDX + i); const int4 e = make_int4((int)(e2_.x & 0xffffu), (int)(e2_.x >> 16), (int)(e2_.y & 0xffffu), (int)(e2_.y >> 16)); const float4 gt4 = *(const float4*)(GATE + i);
        const float rs = 1.0f / sqrtf(ssq2[i >> 7] * (1.0f / 2048.0f) + EPS);
        float4 w;
        w.x = gt4.x * gelu_exact(a.x * iu[e.x] * rs) * iv[e.x]; w.y = gt4.y * gelu_exact(a.y * iu[e.y] * rs) * iv[e.y];
        w.z = gt4.z * gelu_exact(a.z * iu[e.z] * rs) * iv[e.z]; w.w = gt4.w * gelu_exact(a.w * iu[e.w] * rs) * iv[e.w];
        *(uint2*)(W + i) = make_uint2(pk2(w.x, w.y), pk2(w.z, w.w));
    }
}
struct VTok { unsigned ix[8]; unsigned w[8]; float h0, h1; };
__device__ __forceinline__ void p19_peer_v(const Frame& F, const Args& A, volatile LAS unsigned* MISC) {
    const PeerCtx cx = peer_ctx(F, MISC);
    const unsigned char* VT = F.ws + WS_VT;
    const __amdgpu_buffer_rsrc_t rsI = __builtin_amdgcn_make_buffer_rsrc((void*)(F.ws + WS_IDX), 0, T * 128 * 2, 0x00020000);
    const __amdgpu_buffer_rsrc_t rsW = __builtin_amdgcn_make_buffer_rsrc((void*)(F.ws + WS_PW), 0, T * 128 * 2, 0x00020000);
    const __amdgpu_buffer_rsrc_t rsHB = __builtin_amdgcn_make_buffer_rsrc((void*)(F.ws + WS_B), 0, T * DM * 2, 0x00020000);
    const int lane = F.lane, j = lane & 7, g = lane >> 3;
    const bool b5 = lane & 32, b4 = lane & 16, b3 = lane & 8;
    const int NI = (T / 8 - cx.rank + cx.nloc - 1) / cx.nloc;
#define U_TOK(i_) (((cx.rank + (i_) * cx.nloc) * 8) + F.wave)
    for (int p = 0; cx.xr + cx.nx * p < NSL; ++p) {
        const int s = cx.xr + cx.nx * p;
        const __amdgpu_buffer_rsrc_t rs = __builtin_amdgcn_make_buffer_rsrc((void*)(VT + (size_t)s * (PK * PK) * SLW), 0, PK * PK * SLW, 0x00020000);
        const unsigned hoff = (unsigned)(s * SLW + 16 * j + 2 * g) * 2u;
#define V_LOAD(TK, t_) do { const unsigned io_ = ((unsigned)(t_) * 128u + 16u * g) * 2u; \
        _Pragma("unroll") for (int q_ = 0; q_ < 2; ++q_) { const v4u v_ = __builtin_amdgcn_raw_buffer_load_b128(rsI, io_ + 16u * q_, 0, 0); TK.ix[4 * q_] = v_[0]; TK.ix[4 * q_ + 1] = v_[1]; TK.ix[4 * q_ + 2] = v_[2]; TK.ix[4 * q_ + 3] = v_[3]; } \
        _Pragma("unroll") for (int q_ = 0; q_ < 2; ++q_) { const v4u v_ = __builtin_amdgcn_raw_buffer_load_b128(rsW, io_ + 16u * q_, 0, 0); TK.w[4 * q_] = v_[0]; TK.w[4 * q_ + 1] = v_[1]; TK.w[4 * q_ + 2] = v_[2]; TK.w[4 * q_ + 3] = v_[3]; } \
        const unsigned hb_ = (unsigned)(t_) * (DM * 2u) + hoff; const unsigned hw_ = (unsigned)__builtin_amdgcn_raw_buffer_load_b32(rsHB, hb_, 0, 0); TK.h0 = __uint_as_float(hw_ << 16); TK.h1 = __uint_as_float(hw_ & 0xffff0000u); } while (0)
#define V_GATHER(R, TK) do { _Pragma("unroll") for (int k = 0; k < 16; ++k) R[k] = __builtin_amdgcn_raw_buffer_load_b128(rs, ((unsigned)PK_IDX(TK, k) << 7) + (unsigned)(j * 16), 0, 0); } while (0)
#define V_COMPUTE(R, WQ, H0, H1, t_) do { f32x2 acc[8]; _Pragma("unroll") for (int q = 0; q < 8; ++q) acc[q] = (f32x2){0.f, 0.f}; \
        _Pragma("unroll") for (int k = 0; k < 16; ++k) { const unsigned wd_ = WQ[k >> 1]; const float wk_ = __uint_as_float((k & 1) ? (wd_ & 0xffff0000u) : (wd_ << 16)); const f32x2 w2 = (f32x2){wk_, wk_}; \
            _Pragma("unroll") for (int q = 0; q < 4; ++q) { const f32x2 lo = __builtin_amdgcn_cvt_pk_f32_fp8((int)R[k][q], false), hi = __builtin_amdgcn_cvt_pk_f32_fp8((int)R[k][q], true); \
                acc[2 * q] = lo * w2 + acc[2 * q]; acc[2 * q + 1] = hi * w2 + acc[2 * q + 1]; } } \
        float f0_, f1_; \
        RED8G(acc[0].x, acc[1].x, acc[2].x, acc[3].x, acc[4].x, acc[5].x, acc[6].x, acc[7].x, b3, f0_); \
        RED8G(acc[0].y, acc[1].y, acc[2].y, acc[3].y, acc[4].y, acc[5].y, acc[6].y, acc[7].y, b3, f1_); \
        const unsigned hb2_ = (unsigned)(t_) * (DM * 2u) + hoff; const float n0_ = H0 + f0_, n1_ = H1 + f1_; \
        __builtin_amdgcn_raw_buffer_store_b32(pk2(n0_, n1_), rsHB, hb2_, 0, 0); \
        } while (0)
        VTok TA, TB; v4u RA[16], RB[16];
        if (NI > 0) V_LOAD(TA, U_TOK(0));
        if (NI > 1) V_LOAD(TB, U_TOK(1));
        if (NI > 0) V_GATHER(RA, TA);
        for (int i = 0; i < NI; i += 2) {
            { const float h0 = TA.h0, h1 = TA.h1; unsigned wv[8];
              _Pragma("unroll") for (int q = 0; q < 8; ++q) wv[q] = TA.w[q];
              if (i + 2 < NI) V_LOAD(TA, U_TOK(i + 2));
              if (i + 1 < NI) V_GATHER(RB, TB);
              V_COMPUTE(RA, wv, h0, h1, U_TOK(i)); }
            if (i + 1 < NI) {
                const float h0 = TB.h0, h1 = TB.h1; unsigned wv[8];
                _Pragma("unroll") for (int q = 0; q < 8; ++q) wv[q] = TB.w[q];
                if (i + 3 < NI) V_LOAD(TB, U_TOK(i + 3));
                if (i + 2 < NI) V_GATHER(RA, TA);
                V_COMPUTE(RB, wv, h0, h1, U_TOK(i + 1));
            }
        }
    }
#undef V_LOAD
#undef V_GATHER
#undef V_COMPUTE
#undef U_TOK
}
__device__ __forceinline__ void p20_final(const Frame& F, const Args& A) {
    float* O = F.out; const bf16* HB = WSB(WS_B); const float* fg = IN_F(33);
    const int gw = F.bid * NWAVES + F.wave, NGW = F.G * NWAVES, lane = F.lane;
    for (int t = gw; t < T; t += NGW) {
        v4u h[4]; float sq = 0.f;
#pragma unroll
        for (int q = 0; q < 4; ++q) h[q] = *(const v4u*)(HB + (size_t)t * DM + 512 * q + 8 * lane);
#pragma unroll
        for (int q = 0; q < 4; ++q)
#pragma unroll
            for (int e = 0; e < 4; ++e) { const float a = __uint_as_float(h[q][e] << 16), b = __uint_as_float(h[q][e] & 0xffff0000u); sq += a * a + b * b; }
        sq = wave_sum_valu(sq);
        const float r = 1.0f / sqrtf(sq / (float)DM + EPS);
#pragma unroll
        for (int q = 0; q < 4; ++q) { const int c = 512 * q + 8 * lane;
            const float4 g0 = *(const float4*)(fg + c), g1 = *(const float4*)(fg + c + 4);
            ntst4(O + (size_t)t * DM + c, make_float4(__uint_as_float(h[q].x << 16) * r * g0.x, __uint_as_float(h[q].x & 0xffff0000u) * r * g0.y, __uint_as_float(h[q].y << 16) * r * g0.z, __uint_as_float(h[q].y & 0xffff0000u) * r * g0.w));
            ntst4(O + (size_t)t * DM + c + 4, make_float4(__uint_as_float(h[q].z << 16) * r * g1.x, __uint_as_float(h[q].z & 0xffff0000u) * r * g1.y, __uint_as_float(h[q].w << 16) * r * g1.z, __uint_as_float(h[q].w & 0xffff0000u) * r * g1.w)); }
    }
}
__device__ __forceinline__ void p0_prep(const Frame& F, const Args& A) {
    const int gw = F.bid * NWAVES + F.wave, NGW = F.G * NWAVES, lane = F.lane;
    LAS float* scr = (LAS float*)(F.ldsl + F.wave * 16384);
    constexpr int I_IN = 32 * 128, I_GLU = 16 * 32, I_OUT = 32 * 64, I_XQ = 32 * 16, I_XKV = 32 * 32, I_XO = 8 * 64, I_PQ = 32 * 64;
    constexpr int NITEMS = I_IN + I_GLU + I_OUT + I_XQ + I_XKV + I_XO + I_PQ;
    for (int it = gw; it < NITEMS; it += NGW) {
        int r = it;
        if (r < I_IN) { p0_transpose_item(IN_F(4), DM, INC, WSB(WS_WIN), 0, scr, r, lane); continue; } r -= I_IN;
        if (r < I_GLU) { p0_transpose_item(IN_F(18), SSMW, SSMW, WSB(WS_WGLU), 0, scr, r, lane); continue; } r -= I_GLU;
        if (r < I_OUT) { p0_transpose_item(IN_F(21), DM, DM, WSB(WS_WOUT), 0, scr, r, lane, IN_F(20), 1024); continue; } r -= I_OUT;
        if (r < I_XQ) { p0_transpose_item(IN_F(24), DM, XW, WSB(WS_WXQ), 0, scr, r, lane, IN_F(22)); continue; } r -= I_XQ;
        if (r < I_XKV) { p0_transpose_item(IN_F(25), DM, 2 * XW, WSB(WS_WXKV), 0, scr, r, lane); continue; } r -= I_XKV;
        if (r < I_XO) { p0_transpose_item(IN_F(26), XW, DM, WSB(WS_WXO), 0, scr, r, lane); continue; } r -= I_XO;
        p0_transpose_item(IN_F(28), DM, PH * PQD, WSB(WS_WPQ), 0, scr, r, lane, IN_F(27));
    }
    const float* x = IN_F(0); const float* mem = IN_F(1);
    { const float* g3 = IN_F(3); bf16* XN = WSB(WS_B);
      (void)x; (void)g3; (void)XN; }
    { const float* g23 = IN_F(23); bf16* MN = WSB(WS_MN);
      for (int r = 2 * gw; r < BATCH * NMEM; r += 2 * NGW) { norm_2rows_to_bf16(mem + (size_t)r * DM, g23, MN + (size_t)r * DM, lane); } }
    const int* pos = IN_I(2); float* rope = WSF(WS_ROPE);
    const int gt = F.bid * NTHR + F.tid, NGT = F.G * NTHR;
    for (int e = gt; e < T * 8; e += NGT) {
        const int t = e >> 3, i = e & 7;
        const float freq = expf(-(float)i * (13.122363377404328f / 8.0f));
        const float a = (float)pos[t] * freq;
        rope[e * 2 + 0] = cosf(a); rope[e * 2 + 1] = sinf(a);
    }
    if (gt == 0) {
        const float* q1 = IN_F(5); const float* k1 = IN_F(6); const float* q2 = IN_F(7); const float* k2 = IN_F(8);
        float s1 = 0.f, s2 = 0.f;
        for (int i = 0; i < 64; ++i) { s1 += q1[i] * k1[i]; s2 += q2[i] * k2[i]; }
        *WSF(WS_LAM) = expf(s1) - expf(s2) + LAM_INIT;
    }
    bf16* KD = WSB(WS_KD); const float* k1 = IN_F(29); const float* k2 = IN_F(30);
    for (int e = gt; e < PH * 256 * 256; e += NGT) {
        const int kk = e & 255, nn = (e >> 8) & 255, h = e >> 16;
        float v = 0.f;
        if ((kk >> 7) == (nn >> 7)) { const float* ks = (nn >> 7) ? k2 : k1; v = ks[((size_t)h * PK + (nn & 127)) * 128 + (kk & 127)]; }
        KD[e] = (bf16)f2bf(v);
    }
}
__device__ __forceinline__ void p1_win(const Frame& F, const Args& A) {
    { pg8::Gemm g{WSB(WS_B), WSB(WS_WIN), T, INC, DM, DM, DM, 0, 0, 1}; pg8::StaticOrder S; S.init(T, INC, F.G, F.bid); pg8::EpiWin E{WSB(WS_QB), (size_t)(WS_KB - WS_QB) / 2, WSB(WS_UCAT), WSF(WS_ROPE), attn_body::C2}; GEMM_RUN(pg8::EpiWin, true, g, S, E); }
}
__device__ __forceinline__ void p5_glu(const Frame& F, const Args& A) {
    pg8::Gemm g{WSB(WS_GB), WSB(WS_WGLU), T, SSMW, SSMW, SSMW, SSMW, 0, 0, 1}; pg8::StaticOrder S; S.init(T, SSMW, F.G, F.bid);
    pg8::EpiGlu E{WSB(WS_GB), IN_F(19), WSB(WS_B), WSF(WS_SSQ)}; GEMM_RUN(pg8::EpiGlu, true, g, S, E);
}

__device__ __forceinline__ void p5_tables(const Frame& F, const Args& A) {
    unsigned char* UB = F.ws + WS_UB; unsigned char* VT = F.ws + WS_VT;
    const float* Uin = IN_F(31); const float* Vin = IN_F(32); const float* gfn = IN_F(27); float* iscu = WSF(WS_ISCU); float* iscv = WSF(WS_ISCV);
    const int gw = F.bid * NWAVES + F.wave, NGW = F.G * NWAVES, lane = F.lane;
    for (int it = 2 * gw; it < 2 * PK * PK; it += 2 * NGW) {
        const int tb = it >= PK * PK, e = tb ? it - PK * PK : it;
        const float* src = (tb ? Vin : Uin) + (size_t)e * DM; unsigned char* dst = tb ? VT : UB; float* isc = tb ? iscv : iscu;
        float4 v[16]; float am0 = 0.f, am1 = 0.f;
#pragma unroll
        for (int q = 0; q < 16; ++q) v[q] = ntld4(src + (q >> 3) * DM + 256 * (q & 7) + 4 * lane);
        if (!tb) {
#pragma unroll
            for (int q = 0; q < 8; ++q) { const float4 g4 = *(const float4*)(gfn + 256 * q + 4 * lane);
                v[q].x *= g4.x; v[q].y *= g4.y; v[q].z *= g4.z; v[q].w *= g4.w; v[8 + q].x *= g4.x; v[8 + q].y *= g4.y; v[8 + q].z *= g4.z; v[8 + q].w *= g4.w; }
        }
#pragma unroll
        for (int q = 0; q < 8; ++q) { am0 = fmaxf(am0, fmaxf(fmaxf(fabsf(v[q].x), fabsf(v[q].y)), fmaxf(fabsf(v[q].z), fabsf(v[q].w))));
                                      am1 = fmaxf(am1, fmaxf(fmaxf(fabsf(v[8 + q].x), fabsf(v[8 + q].y)), fmaxf(fabsf(v[8 + q].z), fabsf(v[8 + q].w)))); }
        am0 = wave_max(am0); am1 = wave_max(am1);
        float sc0 = 1.0f, sc1 = 1.0f;
        if (tb) { if (am0 > 1e-30f) sc0 = __uint_as_float(__float_as_uint(448.0f / am0) & 0x7f800000u);
                  if (am1 > 1e-30f) sc1 = __uint_as_float(__float_as_uint(448.0f / am1) & 0x7f800000u); }
        else    { if (am0 > 1e-30f) sc0 = 127.0f / am0; if (am1 > 1e-30f) sc1 = 127.0f / am1; }
        if (lane == 0) { isc[e] = 1.0f / sc0; isc[e + 1] = 1.0f / sc1; }
#pragma unroll
        for (int q = 0; q < 16; ++q) {
            const float sc = q < 8 ? sc0 : sc1; int w = 0;
            if (tb) { w = __builtin_amdgcn_cvt_pk_fp8_f32(v[q].x * sc, v[q].y * sc, w, false);
                      w = __builtin_amdgcn_cvt_pk_fp8_f32(v[q].z * sc, v[q].w * sc, w, true); }
            else { const int q0 = (int)__builtin_rintf(v[q].x * sc), q1 = (int)__builtin_rintf(v[q].y * sc), q2 = (int)__builtin_rintf(v[q].z * sc), q3 = (int)__builtin_rintf(v[q].w * sc);
                   w = (int)((unsigned)(q0 & 255) | ((unsigned)(q1 & 255) << 8) | ((unsigned)(q2 & 255) << 16) | ((unsigned)q3 << 24)); }
            const int c = 256 * (q & 7) + 4 * lane;
            *(int*)(dst + ((size_t)(c >> 7) * (PK * PK) + e + (q >> 3)) * SLW + (c & 127)) = w;
        }
    }
}
__device__ __forceinline__ void p7_wout(const Frame& F, const Args& A) {
    pg8::Gemm g{WSB(WS_B), WSB(WS_WOUT), T, DM, DM, DM, DM, 0, 0, 1}; pg8::StaticOrder S; S.init(T, DM, F.G, F.bid);
    pg8::EpiWout E{IN_F(0), WSB(WS_HB2), WSF(WS_SSQ1), DM, WSF(WS_SSQ), 16}; GEMM_RUN(pg8::EpiWout, true, g, S, E);
}
__device__ __forceinline__ void p9_xq(const Frame& F, const Args& A) {
    pg8::Gemm g{WSB(WS_HB2), WSB(WS_WXQ), T, XW, DM, DM, DM, 0, 0, 1}; pg8::StaticOrder S; S.init(T, XW, F.G, F.bid);
    pg8::EpiRowBf16 E{WSB(WS_XQB), XW, WSF(WS_SSQ1), 0.08838834764831845f}; GEMM_RUN(pg8::EpiRowBf16, true, g, S, E);
    { pg8::Gemm g2{WSB(WS_MN), WSB(WS_WXKV), BATCH * NMEM, 2 * XW, DM, DM, DM, 0, 0, 1}; pg8::StaticOrder S2; S2.init(BATCH * NMEM, 2 * XW, F.G, F.G - 1 - F.bid); pg8::EpiXkv E2{WSB(WS_KP), WSB(WS_VT2)}; GEMM_RUN(pg8::EpiXkv, true, g2, S2, E2); }
}
__device__ __forceinline__ void p11_xo(const Frame& F, const Args& A) {
    pg8::Gemm g{WSB(WS_XO), WSB(WS_WXO), T, DM, XW, XW, XW, 0, 0, 1}; pg8::StaticOrder S; S.init(T, DM, F.G, F.bid);
    pg8::EpiResidB<false> E{WSB(WS_HB2), WSB(WS_B), WSF(WS_SSQ2), DM}; GEMM_RUN(pg8::EpiResidB<false>, true, g, S, E);
}
__device__ __forceinline__ void p13_pq(const Frame& F, const Args& A) {
    pg8::Gemm g{WSB(WS_B), WSB(WS_WPQ), T, PH * PQD, DM, DM, DM, 0, 0, 1}; pg8::StaticOrder S; S.init(T, PH * PQD, F.G, F.bid);
    pg8::EpiRowBf16 E{WSB(WS_PQ), PH * PQD, WSF(WS_SSQ2), 1.0f}; GEMM_RUN(pg8::EpiRowBf16, true, g, S, E);
}
__device__ __forceinline__ void p14_quant_x(const Frame& F, const Args& A) {
    const bf16* HB = WSB(WS_B); unsigned char* X8 = F.ws + WS_X8; float* XS = WSF(WS_XS);
    const int gw = F.bid * NWAVES + F.wave, NGW = F.G * NWAVES, lane = F.lane;
    for (int t = gw; t < T; t += NGW) {
        const v4u* src = (const v4u*)(HB + (size_t)t * DM + lane * 32);
        const v4u q0 = src[0], q1 = src[1], q2 = src[2], q3 = src[3];
        float x[32];
#pragma unroll
        for (int e = 0; e < 4; ++e) { x[2 * e] = __uint_as_float(q0[e] << 16); x[2 * e + 1] = __uint_as_float(q0[e] & 0xffff0000u); x[8 + 2 * e] = __uint_as_float(q1[e] << 16); x[8 + 2 * e + 1] = __uint_as_float(q1[e] & 0xffff0000u);
            x[16 + 2 * e] = __uint_as_float(q2[e] << 16); x[16 + 2 * e + 1] = __uint_as_float(q2[e] & 0xffff0000u); x[24 + 2 * e] = __uint_as_float(q3[e] << 16); x[24 + 2 * e + 1] = __uint_as_float(q3[e] & 0xffff0000u); }
        float am = 0.f;
#pragma unroll
        for (int e = 0; e < 32; ++e) am = fmaxf(am, fabsf(x[e]));
        am = fmaxf(am, xl1(am)); am = fmaxf(am, xl2(am));
        const float sc = am > 1e-30f ? 127.0f / am : 0.0f;
        if ((lane & 3) == 0) XS[(size_t)t * 16 + (lane >> 2)] = am * (1.0f / 127.0f);
        unsigned w[8];
#pragma unroll
        for (int d = 0; d < 8; ++d) { const int a0 = (int)__builtin_rintf(x[4 * d] * sc), a1 = (int)__builtin_rintf(x[4 * d + 1] * sc), a2 = (int)__builtin_rintf(x[4 * d + 2] * sc), a3 = (int)__builtin_rintf(x[4 * d + 3] * sc);
            w[d] = (unsigned)(a0 & 255) | ((unsigned)(a1 & 255) << 8) | ((unsigned)(a2 & 255) << 16) | ((unsigned)a3 << 24); }
        v4u o0, o1; o0.x = w[0]; o0.y = w[1]; o0.z = w[2]; o0.w = w[3]; o1.x = w[4]; o1.y = w[5]; o1.z = w[6]; o1.w = w[7];
        v4u* dst = (v4u*)(X8 + (size_t)t * DM + lane * 32); dst[0] = o0; dst[1] = o1;
    }
}
__device__ __forceinline__ void p14_scores(const Frame& F, const Args& A) {
    for (int sel = 0; sel * F.G + F.bid < PH * (T / 256); ++sel) {
        pg8::Gemm g{WSB(WS_KD), WSB(WS_PQ), 256, T, 256, 256, PH * PQD, 65536, 256, PH}; pg8::TkOrder S{F.G, F.bid, sel};
        pg8::EpiTopk E{(unsigned short*)(F.ws + WS_IDX), WSF(WS_GATE)};
        pg8::gemm_phase<pg8::EpiTopk, pg8::TkOrder, false, true>(F.ldsl, g, S, E);
        __syncthreads();
    }
}

constexpr int NPHASE = 15;
__global__ void __launch_bounds__(NTHR, 2) mk_fwd(Args args) {
    extern __shared__ __attribute__((aligned(16))) unsigned char lds[];
#define MKFRAME() Frame F; { int t_ = threadIdx.x; asm volatile("" : "+v"(t_)); F.lds = lds; F.ldsl = (LAS unsigned char*)lds; F.tid = t_; F.lane = t_ & 63; F.wave = __builtin_amdgcn_readfirstlane(t_ >> 6); \
    F.G = gridDim.x; F.bid = blockIdx.x; F.ws = args.ws; F.out = args.out; }
    volatile LAS unsigned* MISC = (volatile LAS unsigned*)((LAS unsigned char*)lds + MISC_OFF);
    if (threadIdx.x < 32) MISC[threadIdx.x] = 0u;
    __syncthreads();
    (void)xcd_barrier_post((unsigned*)(args.ws + WS_CTL) + CW_BAR, MISC + 8);
    if (threadIdx.x == 0) { const unsigned x = xb_xcc_id(); MISC[11] = x; MISC[10] = xb_add((unsigned*)(args.ws + WS_CTL) + CW_TICKET + 64 * x, 1u); }
    const int lo = args.ph_lo, hi = args.ph_hi;
#define IN(k) (lo <= (k) && (k) < hi)
#define SEAM(k) do { if (IN(k) && IN((k) + 1)) { XcdBarrier b_; b_.bar = (unsigned*)(args.ws + WS_CTL) + CW_BAR; b_.x = 0; b_.st = MISC + 8; xcd_barrier(b_); } } while (0)
    if (IN(0)) { MKFRAME(); p0_prep(F, args); __syncthreads(); p0_s5_setup(F, args); }  SEAM(0);
    if (IN(1)) { MKFRAME(); p1_win(F, args); }             SEAM(1);
    if (IN(2)) { MKFRAME(); p3_attn(F, args); }            SEAM(2);
    if (IN(3)) { MKFRAME(); p4_s5_scan(F, args); }
    { int g3_ = __builtin_amdgcn_readfirstlane(IN(3) ? 1 : 0); asm volatile("s_waitcnt vmcnt(0)" : "+s"(g3_) :: "memory"); __syncthreads(); if (g3_) { MKFRAME(); p5_s5_out(F, args); } }   SEAM(3);
    if (IN(4)) { MKFRAME(); p5_glu(F, args); p5_tables(F, args); }  SEAM(4);
    if (IN(5)) { MKFRAME(); p7_wout(F, args); }            SEAM(5);
    if (IN(6)) { MKFRAME(); p9_xq(F, args); }              SEAM(6);
    if (IN(7)) { MKFRAME(); p10_xscores(F, args); }
    { int g8_ = __builtin_amdgcn_readfirstlane(IN(7) ? 1 : 0); asm volatile("s_waitcnt vmcnt(0)" : "+s"(g8_) :: "memory"); __syncthreads(); if (g8_) { MKFRAME(); p10_xpv(F, args); } }   SEAM(7);
    if (IN(8)) { MKFRAME(); p11_xo(F, args); }            SEAM(8);
    if (IN(9)) { MKFRAME(); p13_pq(F, args); }            SEAM(9);
    if (IN(10)) { MKFRAME(); p14_scores(F, args); p14_quant_x(F, args); }        SEAM(10);
    if (IN(11)) { MKFRAME(); p17_peer_u(F, args, MISC); }  SEAM(11);
    if (IN(12)) { MKFRAME(); p18_peer_w(F, args, MISC); }  SEAM(12);
    if (IN(13)) { MKFRAME(); p19_peer_v(F, args, MISC); }  SEAM(13);
    if (IN(14)) { MKFRAME(); p20_final(F, args); }
#undef IN
#undef SEAM
}
extern "C" void kernel_launch(void* const* d_in, const int* in_sizes, int n_in, void* d_out, int out_size, void* d_ws, size_t ws_size, hipStream_t stream) {
    static int grid = 0;
    if (grid == 0) {
        if (n_in != 34 || out_size != T * DM || ws_size < WS_END) { fprintf(stderr, "kernel_launch: unexpected shapes n_in %d out %d ws %zu\n", n_in, out_size, ws_size); grid = -1; return; }
        int dev = 0, cus = 0;
        if (hipGetDevice(&dev) != hipSuccess || hipDeviceGetAttribute(&cus, hipDeviceAttributeMultiprocessorCount, dev) != hipSuccess) { grid = -1; return; }
        if (hipFuncSetAttribute((const void*)mk_fwd, hipFuncAttributeMaxDynamicSharedMemorySize, LDS_BYTES) != hipSuccess) { fprintf(stderr, "kernel_launch: hipFuncSetAttribute failed\n"); grid = -1; return; }
        int per_cu = 0;
        (void)hipOccupancyMaxActiveBlocksPerMultiprocessor(&per_cu, (const void*)mk_fwd, NTHR, LDS_BYTES);
        (void)hipGetLastError();
        grid = cus;
    }
    if (grid < 0) return;
    (void)hipMemsetAsync((char*)d_ws + WS_CTL, 0, CTL_ZERO_BYTES, stream);
    Args a{};
    for (int i = 0; i < 34; ++i) a.in[i] = d_in[i];
    a.out = (float*)d_out; a.ws = (unsigned char*)d_ws;
    a.ph_lo = 0; a.ph_hi = NPHASE; a.li = 0;
    hipLaunchKernelGGL(mk_fwd, dim3(grid), dim3(NTHR), LDS_BYTES, stream, a);
}
```

```cpp
#include <hip/hip_runtime.h>
#include <hip/hip_bf16.h>
#include <cstdio>
#include <cstdint>
#include <cmath>

constexpr int BATCH = 8, SEQ = 2048, DM = 2048, T = BATCH * SEQ;
constexpr int NMEM = 256;
constexpr float EPS = 1e-6f;
constexpr int ATTW = 1024, SSMW = 1024, INC = 4096;
constexpr int NH = 8;
constexpr int SG = 64, SP = 64;
constexpr int XH = 4, XD = 128, XW = 512;
constexpr int PH = 8, PK = 128, PQD = 256, PTOP = 16;
constexpr float LAM_INIT = 0.2f;

#ifndef MK_ONE_LAUNCH
#define MK_ONE_LAUNCH 1
#endif

constexpr int NWAVES = 8, NTHR = 512;
constexpr int LDS_BYTES = 147456;
constexpr int MISC_OFF = 147456 - 512;

constexpr size_t MiB = 1u << 20;
constexpr size_t WS_CTL = 0, CTL_ZERO_BYTES = 1 * MiB;
constexpr size_t WS_RSTD0 = 1 * MiB, WS_RSTDM = WS_RSTD0 + 65536, WS_RSTD1 = WS_RSTDM + 65536, WS_RSTD2 = WS_RSTD1 + 65536, WS_LAM = WS_RSTD2 + 65536;
constexpr size_t WS_ROPE = 2 * MiB;
constexpr size_t WS_WIN = 8 * MiB, WS_WGLU = 24 * MiB, WS_WOUT = 26 * MiB, WS_WXQ = 34 * MiB, WS_WXKV = 36 * MiB, WS_WXO = 40 * MiB, WS_WPQ = 42 * MiB, WS_KD = 50 * MiB;
constexpr size_t WS_UCAT = 56 * MiB, WS_BTC = 96 * MiB, WS_BTA = 136 * MiB, WS_QB = 152 * MiB, WS_KB = 184 * MiB, WS_VB = 216 * MiB, WS_O0 = 248 * MiB, WS_O1 = 280 * MiB;
constexpr size_t WS_UB = 56 * MiB, WS_VT = 120 * MiB, WS_XQ = 184 * MiB, WS_SC = 184 * MiB;
constexpr size_t WS_B = 312 * MiB;
constexpr size_t WS_SL = 376 * MiB, WS_IDX = 376 * MiB, WS_GATE = 384 * MiB;
constexpr size_t WS_GB = 392 * MiB, WS_XO = 392 * MiB;
constexpr size_t WS_PQ = 424 * MiB;
constexpr size_t WS_HB2 = 408 * MiB;
constexpr size_t WS_XKV = 472 * MiB;
constexpr size_t WS_MN = 480 * MiB;
constexpr size_t WS_END = 488 * MiB;
constexpr size_t WS_SSQ = 128 * 1024;
constexpr size_t WS_SSQ3 = 512 * 1024;
constexpr size_t WS_SSQP = 2 * MiB;
constexpr size_t WS_SSQ1 = 704 * 1024, WS_SSQ2 = 768 * 1024;
constexpr int CW_TICKET = 160 * 1024;
constexpr size_t WS_PACT = 184 * MiB, WS_PW = 248 * MiB;
constexpr size_t WS_ISCU = 4 * MiB, WS_ISCV = 4 * MiB + 65536;
constexpr int NSL = 16, SLW = 128;
constexpr size_t WS_LSUM = 256 * 1024;
constexpr size_t WS_KP = 472 * MiB, WS_VT2 = 476 * MiB;
constexpr size_t WS_XQB = 184 * MiB, WS_XP = 200 * MiB;
constexpr size_t WS_AL = WS_LAM + 4096;
constexpr int S5L = 32, NCH = T / S5L, UCK = 640;
constexpr int CW_BAR = 4096;

#define GAS __attribute__((address_space(1)))
#define LAS __attribute__((address_space(3)))
typedef GAS unsigned gu32;
#define RLX_AGENT __ATOMIC_RELAXED, __HIP_MEMORY_SCOPE_AGENT

#define XB_TMO      128
#define XB_XCNT(j)  (256  + 64 * (j))
#define XB_XSUB(j)  (1280 + 64 * (j))
#define XB_XGEN(j)  (2304 + 64 * (j))
#define XB_TOP      3328
#define XB_TOPGEN   3392
#define XCD_BAR_WORDS 3456
#define XB_SPIN_CAP (1u << 26)
__device__ __forceinline__ unsigned xb_ld(unsigned* p)              { return __hip_atomic_load(p, __ATOMIC_RELAXED, __HIP_MEMORY_SCOPE_AGENT); }
__device__ __forceinline__ unsigned xb_add(unsigned* p, unsigned v) { return __hip_atomic_fetch_add(p, v, __ATOMIC_RELAXED, __HIP_MEMORY_SCOPE_AGENT); }
__device__ __forceinline__ unsigned xb_xcc_id() { return (unsigned)__builtin_amdgcn_s_getreg((3 << 11) | 20) & 0xFu; }
#define XB_SPIN(cond, bar) do { unsigned _sp = 0; while (cond) { __builtin_amdgcn_s_sleep(1); \
    if ((++_sp & 255u) == 0u) { if (xb_ld(&(bar)[XB_TMO])) break; if (_sp > XB_SPIN_CAP) { atomicAdd(&(bar)[XB_TMO], 1u); break; } } } } while (0)
struct XcdBarrier { unsigned* bar; unsigned x; volatile LAS unsigned* st; };
__device__ __forceinline__ XcdBarrier xcd_barrier_post(unsigned* bar, volatile LAS unsigned* st) {
    XcdBarrier b; b.bar = bar; b.x = xb_xcc_id(); b.st = st;
    if (threadIdx.x == 0) (void)xb_add(&bar[XB_XCNT(b.x)], 1u);
    return b;
}
__device__ __forceinline__ void xcd_barrier_complete(unsigned* bar, unsigned x, unsigned& nloc, unsigned& nx) {
    const unsigned G = gridDim.x * gridDim.y * gridDim.z;
    unsigned sum, cnt, mine, sp = 0u;
    for (;;) {
        sum = 0u; cnt = 0u; mine = 0u;
#pragma unroll
        for (unsigned j = 0; j < 16; ++j) { const unsigned c = xb_ld(&bar[XB_XCNT(j)]); sum += c; cnt += (c > 0u) ? 1u : 0u; mine = (j == x) ? c : mine; }
        if (sum == G) break;
        __builtin_amdgcn_s_sleep(1);
        if ((++sp & 255u) == 0u) { if (xb_ld(&bar[XB_TMO])) break; if (sp > XB_SPIN_CAP) { atomicAdd(&bar[XB_TMO], 1u); break; } }
    }
    nloc = mine > 0u ? mine : 1u; nx = cnt > 0u ? cnt : 1u;
}
__device__ __forceinline__ void xcd_barrier(const XcdBarrier& b) {
    asm volatile("s_waitcnt vmcnt(0)" ::: "memory");
    __syncthreads();
    if (threadIdx.x == 0) {
        unsigned* bar = b.bar;
        __builtin_amdgcn_s_waitcnt(0);
        unsigned nloc = b.st[0], nx = b.st[1]; const unsigned bx = b.st[3];
        if (nloc == 0u) { xcd_barrier_complete(bar, bx, nloc, nx); b.st[0] = nloc; b.st[1] = nx; }
        const unsigned old = xb_add(&bar[XB_XSUB(bx)], 1u);
        const unsigned gen = old / nloc;
        if (old + 1u == (gen + 1u) * nloc) {
            __builtin_amdgcn_fence(__ATOMIC_RELEASE, "agent");
            asm volatile("s_waitcnt vmcnt(0)" ::: "memory");
            const unsigned og = xb_add(&bar[XB_TOP], 1u);
            const unsigned tg = og / nx;
            if (og + 1u == (tg + 1u) * nx) xb_add(&bar[XB_TOPGEN], 1u);
            else XB_SPIN(xb_ld(&bar[XB_TOPGEN]) == tg, bar);
            __builtin_amdgcn_fence(__ATOMIC_ACQUIRE, "agent");
            xb_add(&bar[XB_XGEN(bx)], 1u);
            asm volatile("s_waitcnt vmcnt(0)" ::: "memory");
        } else {
            XB_SPIN(xb_ld(&bar[XB_XGEN(bx)]) == gen, bar);
            __builtin_amdgcn_fence(__ATOMIC_ACQUIRE, "agent");
            asm volatile("s_waitcnt vmcnt(0)" ::: "memory");
        }
    }
    __syncthreads();
}

struct Args { const void* in[34]; float* out; unsigned char* ws; int ph_lo, ph_hi, li, pad; };
struct Frame {
    unsigned char* lds;
    LAS unsigned char* ldsl;
    int tid, lane, wave, G, bid;
    float* out;
    unsigned char* ws;
};
__device__ __forceinline__ float wave_sum(float v) {
#pragma unroll
    for (int o = 1; o < 64; o <<= 1) v += __shfl_xor(v, o);
    return v;
}
__device__ __forceinline__ float wave_max(float v) {
#pragma unroll
    for (int o = 1; o < 64; o <<= 1) v = fmaxf(v, __shfl_xor(v, o));
    return v;
}
__device__ __forceinline__ float gelu_exact(float x) { return 0.5f * x * (1.0f + erff(x * 0.70710678118654752f)); }

__device__ __forceinline__ const void* ldarg(int byte_off) {
    const void* p; auto k = __builtin_amdgcn_kernarg_segment_ptr();
    asm volatile("s_load_dwordx2 %0, %1, %2\n\ts_waitcnt lgkmcnt(0)" : "=s"(p) : "s"(k), "i"(byte_off) : "memory");
    return p;
}
#define IN_F(i) ((const float*)ldarg((i) * 8))
#define IN_I(i) ((const int*)ldarg((i) * 8))
#define WSF(off) ((float*)(F.ws + (off)))


typedef float nt_f4 __attribute__((ext_vector_type(4)));
__device__ __forceinline__ float4 ntld4(const float* p) { const nt_f4 v = __builtin_nontemporal_load((const GAS nt_f4*)p); return make_float4(v[0], v[1], v[2], v[3]); }
__device__ __forceinline__ void ntst4(float* p, float4 v) { const nt_f4 w = {v.x, v.y, v.z, v.w}; __builtin_nontemporal_store(w, (GAS nt_f4*)p); }
typedef unsigned short bf16;
typedef unsigned v4u __attribute__((ext_vector_type(4)));
__device__ __forceinline__ unsigned f2bf(float f) { unsigned u = __builtin_bit_cast(unsigned, f); return (u + 0x7fffu + ((u >> 16) & 1u)) >> 16; }
__device__ __forceinline__ unsigned pk2(float lo, float hi) { return f2bf(lo) | (f2bf(hi) << 16); }
__device__ __forceinline__ float bf2f(unsigned short b) { return __uint_as_float((unsigned)b << 16); }
#define WSB(off) ((bf16*)(F.ws + (off)))
#define LDS_WAIT() asm volatile("s_waitcnt lgkmcnt(0)" ::: "memory")

__device__ __forceinline__ void norm_2rows_to_bf16(const float* xrow, const float* g, bf16* orow, int lane) {
    float4 v[16]; float s0 = 0.f, s1 = 0.f;
#pragma unroll
    for (int j = 0; j < 16; ++j) v[j] = ntld4(xrow + (j >> 3) * DM + 256 * (j & 7) + 4 * lane);
#pragma unroll
    for (int j = 0; j < 8; ++j) { s0 += v[j].x * v[j].x + v[j].y * v[j].y + v[j].z * v[j].z + v[j].w * v[j].w; s1 += v[8 + j].x * v[8 + j].x + v[8 + j].y * v[8 + j].y + v[8 + j].z * v[8 + j].z + v[8 + j].w * v[8 + j].w; }
    s0 = wave_sum(s0); s1 = wave_sum(s1);
    const float r0 = 1.0f / sqrtf(s0 / (float)DM + EPS), r1 = 1.0f / sqrtf(s1 / (float)DM + EPS);
#pragma unroll
    for (int j = 0; j < 8; ++j) { const float4 g4 = *(const float4*)(g + 256 * j + 4 * lane);
        *(unsigned long long*)(orow + 256 * j + 4 * lane) = (unsigned long long)pk2(v[j].x * r0 * g4.x, v[j].y * r0 * g4.y) | ((unsigned long long)pk2(v[j].z * r0 * g4.z, v[j].w * r0 * g4.w) << 32);
        *(unsigned long long*)(orow + DM + 256 * j + 4 * lane) = (unsigned long long)pk2(v[8 + j].x * r1 * g4.x, v[8 + j].y * r1 * g4.y) | ((unsigned long long)pk2(v[8 + j].z * r1 * g4.z, v[8 + j].w * r1 * g4.w) << 32); }
}
__device__ __forceinline__ void norm4_load(const float* xrow, int lane, float4 (&v)[32]) {
#pragma unroll
    for (int j = 0; j < 32; ++j) v[j] = ntld4(xrow + (j >> 3) * DM + 256 * (j & 7) + 4 * lane);
}
__device__ __forceinline__ void norm4_finish(const float4 (&v)[32], const float* g, bf16* orow, int lane) {
    float s[4] = {0.f, 0.f, 0.f, 0.f};
#pragma unroll
    for (int j = 0; j < 32; ++j) s[j >> 3] += v[j].x * v[j].x + v[j].y * v[j].y + v[j].z * v[j].z + v[j].w * v[j].w;
    float r[4];
#pragma unroll
    for (int q = 0; q < 4; ++q) { s[q] = wave_sum(s[q]); r[q] = 1.0f / sqrtf(s[q] / (float)DM + EPS); }
#pragma unroll
    for (int j = 0; j < 8; ++j) { const float4 g4 = *(const float4*)(g + 256 * j + 4 * lane);
#pragma unroll
        for (int q = 0; q < 4; ++q) { const float4 w = v[8 * q + j]; const float rq = r[q];
            *(unsigned long long*)(orow + q * DM + 256 * j + 4 * lane) = (unsigned long long)pk2(w.x * rq * g4.x, w.y * rq * g4.y) | ((unsigned long long)pk2(w.z * rq * g4.z, w.w * rq * g4.w) << 32); } }
}
__device__ __forceinline__ void p0_transpose_item(const float* W, int K, int N, bf16* WT, int row_off, LAS float* scr, int item, int lane, const float* gain = nullptr, int goff = 0) {
    const int nblk = N / 32, kb = item / nblk, nb = item % nblk, k0 = 64 * kb, n0 = 32 * nb;
    float4 v[8];
#pragma unroll
    for (int i = 0; i < 8; ++i) v[i] = ntld4(W + (size_t)(k0 + 8 * i + (lane >> 3)) * N + n0 + 4 * (lane & 7));
#pragma unroll
    for (int i = 0; i < 8; ++i) { const int kk = 8 * i + (lane >> 3); const float gk = (gain && k0 + kk >= goff) ? gain[k0 + kk - goff] : 1.0f; LAS float* d = scr + kk * 33 + 4 * (lane & 7);
        d[0] = v[i].x * gk; d[1] = v[i].y * gk; d[2] = v[i].z * gk; d[3] = v[i].w * gk; }
    LDS_WAIT(); asm volatile("" ::: "memory");
    const int c = lane & 7;
#pragma unroll
    for (int j = 0; j < 4; ++j) { const int n = (lane >> 3) + 8 * j; const LAS float* s = scr + (8 * c) * 33 + n;
        v4u o; o.x = pk2(s[0 * 33], s[1 * 33]); o.y = pk2(s[2 * 33], s[3 * 33]); o.z = pk2(s[4 * 33], s[5 * 33]); o.w = pk2(s[6 * 33], s[7 * 33]);
        *(GAS v4u*)(WT + (size_t)(row_off + n0 + n) * K + k0 + 8 * c) = o; }
    LDS_WAIT(); asm volatile("" ::: "memory");
}
namespace pg8 {
#define PG8_LAS __attribute__((address_space(3)))
typedef unsigned short bf16_t;
typedef short bf16x8 __attribute__((ext_vector_type(8)));
typedef float f32x4 __attribute__((ext_vector_type(4)));
typedef unsigned u32x4 __attribute__((ext_vector_type(4)));
constexpr int BM = 256, BK = 64, HALF = 128, HTB = HALF * BK * 2  , STAGE_BYTES = 8 * HTB, NXCD = 8, WGM = 8;

__host__ __device__ __forceinline__ int lds_byte(int r, int c) { const int st = (r >> 4) * 2 + (c >> 5), rr = r & 15, cc = c & 31, ob = rr * 64 + cc * 2; return st * 1024 + (ob ^ (((ob >> 9) & 1) << 5)); }
__host__ __device__ __forceinline__ void stage_rc(int b, int& R, int& C) { const int st = b / 1024, sb = b % 1024, swz = sb ^ (((sb >> 9) & 1) << 5); R = (st >> 1) * 16 + swz / 64; C = (st & 1) * 32 + (swz % 64) / 2; }
__host__ __device__ __forceinline__ int perm32(int rho) { const int n = rho >> 4, i = rho & 15; return 8 * (i >> 2) + 4 * n + (i & 3); }

struct Unit { int pm, pn, bz; };
struct Gemm { const bf16_t* A; const bf16_t* Bt; int M, N, K; int lda, ldb; long sA, sB; int nb; };

struct StaticOrder {
    int nM, nN, nwg, G, c;
    int nb, per; __host__ __device__ void init(int M, int N, int G_, int c_, int nb_ = 1) { nM = M / BM; nN = N / BM; nb = nb_; per = nM * nN; nwg = per * nb; G = G_; c = c_; }
    __host__ __device__ bool next(int i, Unit& u) const {
        const long L = (long)i * G + c; if (L >= nwg) return false;
        int wgid = (int)L; { const int q = nwg / NXCD, r = nwg % NXCD, xcd = wgid % NXCD, off = wgid / NXCD; wgid = (xcd < r ? xcd * (q + 1) : r * (q + 1) + (xcd - r) * q) + off; }
        u.bz = wgid / per; wgid -= u.bz * per; const int nig = WGM * nN, gid = wgid / nig, fm = gid * WGM, gsz = (nM - fm) < WGM ? (nM - fm) : WGM;
        u.pm = fm + ((wgid % nig) % gsz); u.pn = (wgid % nig) / gsz; return true;
    }
    __device__ __forceinline__ void a_ready(const Unit&) const {}
    __device__ __forceinline__ void done(const Unit&) const {}
    template <class G_> __device__ __forceinline__ long offA(const Unit& u, const G_& g) const { return (long)u.bz * g.sA; }
    template <class G_> __device__ __forceinline__ long offB(const Unit& u, const G_& g) const { return (long)u.bz * g.sB; }
};

__device__ __forceinline__ unsigned cvt_pk_bf16(float lo, float hi) { unsigned r; asm volatile("v_cvt_pk_bf16_f32 %0, %1, %2" : "=v"(r) : "v"(lo), "v"(hi)); return r; }
typedef float f32x2 __attribute__((ext_vector_type(2)));
__device__ __forceinline__ f32x2 gelu_pk(f32x2 v) {
    const f32x2 av = __builtin_elementwise_abs(v), d = av * 0.2316418882f + 1.0f;
    f32x2 t; t.x = __builtin_amdgcn_rcpf(d.x); t.y = __builtin_amdgcn_rcpf(d.y);
    f32x2 q = t * 0.5307027145f + (-0.7265760135f); q = q * t + 0.7107068705f; q = q * t + (-0.142248368f); q = q * t + 0.127414796f; q = q * t;
    const f32x2 s = (v * v) * (-0.72134752044f);
    f32x2 e; e.x = __builtin_amdgcn_exp2f(s.x); e.y = __builtin_amdgcn_exp2f(s.y);
    const f32x2 m = v * (q * e), r = v - m;
    f32x2 o; o.x = v.x < 0.f ? m.x : r.x; o.y = v.y < 0.f ? m.y : r.y; return o;
}

template <int ACT  > struct EpiBf16 {
    static constexpr bool PERM = true, AFTER_DRAIN = false; static_assert(ACT == 0 || ACT == 1, "EpiBf16: ACT is 0 (none) or 1 (gelu_pk)");
    bf16_t* O; int ldc; const float* bias; int split_cols; size_t split_stride; float scale0;
    __device__ __forceinline__ void operator()(const f32x4 (&acc)[2][2][4][2], const Unit& u, int wr, int wc, int fr, int fq) const {
        const int row0 = u.pm * BM + wr * 64 + fr; int colt = u.pn * BM; bf16_t* base = O;
        float sc = 1.f; if (split_cols) { const int t = colt / split_cols; base += (size_t)t * split_stride; colt -= t * split_cols; if (t == 0) sc = scale0; }
        const int col0 = colt + wc * 32 + 8 * fq, bcol0 = u.pn * BM + wc * 32 + 8 * fq;
        f32x4 bv[2][2];
#pragma unroll
        for (int bj = 0; bj < 2; ++bj)
#pragma unroll
            for (int n = 0; n < 2; ++n) bv[bj][n] = bias ? *(const f32x4*)(bias + bcol0 + bj * HALF + 4 * n) : (f32x4){0.f, 0.f, 0.f, 0.f};
#pragma unroll
        for (int ai = 0; ai < 2; ++ai)
#pragma unroll
            for (int m = 0; m < 4; ++m) { bf16_t* rowp = base + (size_t)(row0 + ai * HALF + m * 16) * ldc + col0;
#pragma unroll
                for (int bj = 0; bj < 2; ++bj) { f32x4 v0 = acc[ai][bj][m][0] + bv[bj][0], v1 = acc[ai][bj][m][1] + bv[bj][1];
                    if (ACT == 1) { f32x2 a = gelu_pk((f32x2){v0[0], v0[1]}), b = gelu_pk((f32x2){v0[2], v0[3]}), c = gelu_pk((f32x2){v1[0], v1[1]}), d = gelu_pk((f32x2){v1[2], v1[3]});
                        v0 = (f32x4){a.x, a.y, b.x, b.y}; v1 = (f32x4){c.x, c.y, d.x, d.y}; }
                    v0 = v0 * sc; v1 = v1 * sc; u32x4 w; w.x = cvt_pk_bf16(v0[0], v0[1]); w.y = cvt_pk_bf16(v0[2], v0[3]); w.z = cvt_pk_bf16(v1[0], v1[1]); w.w = cvt_pk_bf16(v1[2], v1[3]);
                    *(u32x4*)(rowp + bj * HALF) = w; } }
    }
};
template <class T, class = void> struct MidK { static constexpr bool v = false; };
template <class T> struct MidK<T, decltype((void)T::MIDK)> { static constexpr bool v = T::MIDK; };
template <class Epi, class Sched, bool ALIGN_EPI = false, bool SP2 = false>
__device__ __forceinline__ void gemm_phase(PG8_LAS unsigned char* lds, const Gemm g, const Sched& S, const Epi& E) {
    const int tid = threadIdx.x, wid = __builtin_amdgcn_readfirstlane(tid >> 6), lane = tid & 63, wr = wid >> 2, wc = wid & 3, fr = lane & 15, fq = lane >> 4;
    const int K = g.K, nt = K / BK;
    unsigned voffA[2], voffB[2];
#pragma unroll
    for (int i = 0; i < 2; ++i) { int R, C; stage_rc(tid * 16 + i * 8192, R, C); const int Rb = Epi::PERM ? ((R & ~31) + perm32(R & 31)) : R;
        voffA[i] = (unsigned)(R * g.lda + C) * 2u; voffB[i] = (unsigned)(Rb * g.ldb + C) * 2u; }
    const size_t kstep = (size_t)(BK * 2);
    const size_t hstepA = (size_t)HALF * g.lda * 2, hstepB = (size_t)HALF * g.ldb * 2;
    const size_t tstepA = 2 * hstepA, tstepB = 2 * hstepB;
    const unsigned ldsw = (unsigned)wid * 1024u;
    const int aoff = lds_byte(wr * 64 + fr, fq * 8), boff = lds_byte(wc * 32 + fr, fq * 8);
#define PG8_SA(b, h) (((b) * 2 + (h)) * HTB)
#define PG8_SB(b, h) ((4 + (b) * 2 + (h)) * HTB)
#define PG8_STAGE(bufoff, gbase, voff) do { _Pragma("unroll") for (int _i = 0; _i < 2; ++_i) \
        __builtin_amdgcn_global_load_lds((const unsigned*)((const char*)(gbase) + (voff)[_i]), (PG8_LAS unsigned*)(lds + (bufoff) + ldsw + _i * 8192), 16, 0, 0); } while (0)
#define PG8_LDA(dst, b, h) do { _Pragma("unroll") for (int m = 0; m < 4; ++m) _Pragma("unroll") for (int k = 0; k < 2; ++k) dst[m][k] = *(const PG8_LAS bf16x8*)(lds + PG8_SA(b, h) + aoff + m * 2048 + k * 1024); } while (0)
#define PG8_LDB(dst, b, h) do { _Pragma("unroll") for (int n = 0; n < 2; ++n) _Pragma("unroll") for (int k = 0; k < 2; ++k) dst[n][k] = *(const PG8_LAS bf16x8*)(lds + PG8_SB(b, h) + boff + n * 2048 + k * 1024); } while (0)
#define PG8_MMA(ai, bj, At, Bt) do { __builtin_amdgcn_s_setprio(1); _Pragma("unroll") for (int m = 0; m < 4; ++m) _Pragma("unroll") for (int n = 0; n < 2; ++n) _Pragma("unroll") for (int k = 0; k < 2; ++k) \
        acc[ai][bj][m][n] = __builtin_amdgcn_mfma_f32_16x16x32_bf16(Bt[n][k], At[m][k], acc[ai][bj][m][n], 0, 0, 0); __builtin_amdgcn_s_setprio(0); } while (0)
#define PG8_WAIT_V(n) asm volatile("s_waitcnt vmcnt(" #n ")" ::: "memory")
#define PG8_WAIT_L(n) asm volatile("s_waitcnt lgkmcnt(" #n ")" ::: "memory")
#define PG8_BAR __builtin_amdgcn_s_barrier()
#define PG8_SCHED __builtin_amdgcn_sched_barrier(0)
    Unit cur, nxt; int ui = 0;
    if (!S.next(0, cur)) return;
    f32x4 acc[2][2][4][2];
#pragma unroll
    for (int a = 0; a < 2; ++a)
#pragma unroll
        for (int b = 0; b < 2; ++b)
#pragma unroll
            for (int m = 0; m < 4; ++m)
#pragma unroll
                for (int n = 0; n < 2; ++n) acc[a][b][m][n] = (f32x4){0.f, 0.f, 0.f, 0.f};
    bf16x8 At[4][2], B0[2][2], B1[2][2];
    const char* cA = (const char*)g.A + (size_t)S.offA(cur, g) * 2 + (size_t)cur.pm * tstepA; const char* cB = (const char*)g.Bt + (size_t)S.offB(cur, g) * 2 + (size_t)cur.pn * tstepB;
    S.a_ready(cur);
    if constexpr (SP2) {
        PG8_STAGE(PG8_SB(0, 0), cB, voffB); PG8_STAGE(PG8_SB(0, 1), cB + hstepB, voffB); PG8_STAGE(PG8_SA(0, 0), cA, voffA); PG8_STAGE(PG8_SA(0, 1), cA + hstepA, voffA);
        if (wr == 1) PG8_BAR;
        PG8_WAIT_V(2); PG8_BAR;
        PG8_STAGE(PG8_SB(1, 0), cB + kstep, voffB); PG8_STAGE(PG8_SA(1, 0), cA + kstep, voffA); PG8_STAGE(PG8_SB(1, 1), cB + hstepB + kstep, voffB);
        PG8_WAIT_V(6); PG8_BAR;
    } else {
        PG8_STAGE(PG8_SB(0, 0), cB, voffB); PG8_STAGE(PG8_SA(0, 0), cA, voffA); PG8_STAGE(PG8_SB(0, 1), cB + hstepB, voffB); PG8_STAGE(PG8_SA(0, 1), cA + hstepA, voffA);
        if (wr == 1) PG8_BAR;
        PG8_WAIT_V(4); PG8_BAR;
        PG8_STAGE(PG8_SB(1, 0), cB + kstep, voffB); PG8_STAGE(PG8_SA(1, 0), cA + kstep, voffA); PG8_STAGE(PG8_SB(1, 1), cB + hstepB + kstep, voffB);
        PG8_WAIT_V(6); PG8_BAR;
    }
    for (;;) {
        const bool has_next = S.next(ui + 1, nxt);
        const char* nA = has_next ? (const char*)g.A + (size_t)S.offA(nxt, g) * 2 + (size_t)nxt.pm * tstepA : cA; const char* nB = has_next ? (const char*)g.Bt + (size_t)S.offB(nxt, g) * 2 + (size_t)nxt.pn * tstepB : cB;
        for (int t = 0; t < nt; t += 2) {
            if constexpr (MidK<Epi>::v) { if (t == E.midk_t) E.midk(acc, cur, wr, wc, fr, fq); }
            const bool last = (t == nt - 2);
            const char* a1 = cA + (size_t)(t + 1) * kstep;
            const char* a2 = last ? nA : cA + (size_t)(t + 2) * kstep; const char* b2 = last ? nB : cB + (size_t)(t + 2) * kstep;
            const char* a3 = a2 + kstep; const char* b3 = b2 + kstep;
            if (last && has_next) S.a_ready(nxt);
            if constexpr (SP2) {
            PG8_LDB(B0, 0, 0); PG8_LDB(B1, 0, 1); PG8_SCHED; PG8_LDA(At, 0, 0); PG8_STAGE(PG8_SA(1, 1), a1 + hstepA, voffA);
            PG8_WAIT_V(8); PG8_WAIT_L(0); PG8_BAR; PG8_MMA(0, 0, At, B0); PG8_MMA(0, 1, At, B1); PG8_BAR; PG8_SCHED;
            PG8_LDA(At, 0, 1); PG8_STAGE(PG8_SB(0, 0), b2, voffB); PG8_STAGE(PG8_SB(0, 1), b2 + hstepB, voffB); PG8_STAGE(PG8_SA(0, 0), a2, voffA);
            PG8_WAIT_V(8); PG8_WAIT_L(0); PG8_BAR; PG8_MMA(1, 0, At, B0); PG8_MMA(1, 1, At, B1); PG8_BAR; PG8_SCHED;
            PG8_LDB(B0, 1, 0); PG8_LDB(B1, 1, 1); PG8_SCHED; PG8_LDA(At, 1, 0); PG8_STAGE(PG8_SA(0, 1), a2 + hstepA, voffA);
            PG8_WAIT_V(8); PG8_WAIT_L(0); PG8_BAR; PG8_MMA(0, 0, At, B0); PG8_MMA(0, 1, At, B1); PG8_BAR; PG8_SCHED;
            PG8_LDA(At, 1, 1); PG8_STAGE(PG8_SB(1, 0), b3, voffB); PG8_STAGE(PG8_SB(1, 1), b3 + hstepB, voffB); PG8_STAGE(PG8_SA(1, 0), a3, voffA);
            PG8_WAIT_V(8); PG8_WAIT_L(0); PG8_BAR; PG8_MMA(1, 0, At, B0); PG8_MMA(1, 1, At, B1); PG8_BAR; PG8_SCHED;
            } else {
            PG8_LDB(B0, 0, 0); PG8_SCHED; PG8_LDA(At, 0, 0); PG8_STAGE(PG8_SA(1, 1), a1 + hstepA, voffA);
            PG8_WAIT_L(8); PG8_BAR; PG8_WAIT_L(0); PG8_MMA(0, 0, At, B0); PG8_BAR; PG8_SCHED;
            PG8_LDB(B1, 0, 1); PG8_STAGE(PG8_SB(0, 0), b2, voffB);
            PG8_BAR; PG8_WAIT_L(0); PG8_MMA(0, 1, At, B1); PG8_BAR;
            PG8_LDA(At, 0, 1); PG8_STAGE(PG8_SA(0, 0), a2, voffA);
            PG8_BAR; PG8_WAIT_L(0); PG8_MMA(1, 0, At, B0); PG8_BAR; PG8_SCHED;
            PG8_STAGE(PG8_SB(0, 1), b2 + hstepB, voffB);
            PG8_WAIT_V(6); PG8_BAR; PG8_MMA(1, 1, At, B1); PG8_BAR;
            PG8_LDB(B0, 1, 0); PG8_SCHED; PG8_LDA(At, 1, 0); PG8_STAGE(PG8_SA(0, 1), a2 + hstepA, voffA);
            PG8_WAIT_L(8); PG8_BAR; PG8_WAIT_L(0); PG8_MMA(0, 0, At, B0); PG8_BAR; PG8_SCHED;
            PG8_LDB(B1, 1, 1); PG8_STAGE(PG8_SB(1, 0), b3, voffB);
            PG8_BAR; PG8_WAIT_L(0); PG8_MMA(0, 1, At, B1); PG8_BAR;
            PG8_LDA(At, 1, 1); PG8_STAGE(PG8_SA(1, 0), a3, voffA);
            PG8_BAR; PG8_WAIT_L(0); PG8_MMA(1, 0, At, B0); PG8_BAR; PG8_SCHED;
            PG8_STAGE(PG8_SB(1, 1), b3 + hstepB, voffB);
            PG8_WAIT_V(6); PG8_BAR; PG8_MMA(1, 1, At, B1); PG8_BAR;
            }
        }
        if constexpr (ALIGN_EPI) { if (wr == 0) PG8_BAR; }
        if constexpr (!Epi::AFTER_DRAIN) { E(acc, cur, wr, wc, fr, fq); S.done(cur); }
        if (!has_next) break;
#pragma unroll
        for (int a = 0; a < 2; ++a)
#pragma unroll
            for (int b = 0; b < 2; ++b)
#pragma unroll
                for (int m = 0; m < 4; ++m)
#pragma unroll
                    for (int n = 0; n < 2; ++n) acc[a][b][m][n] = (f32x4){0.f, 0.f, 0.f, 0.f};
        cur = nxt; cA = nA; cB = nB; ++ui;
        if constexpr (ALIGN_EPI) { if (wr == 1) PG8_BAR; }
    }
    PG8_WAIT_V(0);
    if constexpr (!ALIGN_EPI) { if (wr == 0) PG8_BAR; }
    PG8_BAR;
    if constexpr (Epi::AFTER_DRAIN) { E.fused(acc, cur, wr, wc, fr, fq, lds, wid, lane); S.done(cur); }
#undef PG8_SA
#undef PG8_SB
#undef PG8_STAGE
#undef PG8_LDA
#undef PG8_LDB
#undef PG8_MMA
#undef PG8_WAIT_V
#undef PG8_WAIT_L
#undef PG8_BAR
#undef PG8_SCHED
}
}

namespace pg8 {
struct EpiF32 {
    static constexpr bool PERM = false, AFTER_DRAIN = false;
    float* C; int ldc; const float* resid; long sC;
    __device__ __forceinline__ void operator()(const f32x4 (&acc)[2][2][4][2], const Unit& u, int wr, int wc, int fr, int fq) const {
        const int row0 = u.pm * BM + wr * 64 + fr, col0 = u.pn * BM + wc * 32 + 4 * fq;
        float* base = C + (size_t)u.bz * sC;
#pragma unroll
        for (int ai = 0; ai < 2; ++ai)
#pragma unroll
            for (int m = 0; m < 4; ++m) { const size_t ro = (size_t)(row0 + ai * HALF + m * 16) * ldc;
#pragma unroll
                for (int bj = 0; bj < 2; ++bj)
#pragma unroll
                    for (int n = 0; n < 2; ++n) { const size_t o = ro + col0 + bj * HALF + n * 16; f32x4 v = acc[ai][bj][m][n];
                        if (resid) v += *(const f32x4*)(resid + o);
                        *(f32x4*)(base + o) = v; } }
    }
};


template <bool RF32> struct EpiResidB {
    static constexpr bool PERM = true, AFTER_DRAIN = false;
    const void* resid; bf16_t* HB; float* ssq; int ldc;
    __device__ __forceinline__ void operator()(const f32x4 (&acc)[2][2][4][2], const Unit& u, int wr, int wc, int fr, int fq) const {
        const int row0 = u.pm * BM + wr * 64 + fr, col0 = u.pn * BM + wc * 32 + 8 * fq;
#pragma unroll
        for (int ai = 0; ai < 2; ++ai)
#pragma unroll
            for (int m = 0; m < 4; ++m) { const int r = row0 + ai * HALF + m * 16; const size_t ro = (size_t)r * ldc + col0; float ss = 0.f;
#pragma unroll
                for (int bj = 0; bj < 2; ++bj) { const size_t o = ro + bj * HALF; f32x4 v0 = acc[ai][bj][m][0], v1 = acc[ai][bj][m][1];
                    if (RF32) { v0 += *(const f32x4*)((const float*)resid + o); v1 += *(const f32x4*)((const float*)resid + o + 4); }
                    else { const u32x4 rb = *(const u32x4*)((const bf16_t*)resid + o);
                        v0[0] += __uint_as_float(rb.x << 16); v0[1] += __uint_as_float(rb.x & 0xffff0000u); v0[2] += __uint_as_float(rb.y << 16); v0[3] += __uint_as_float(rb.y & 0xffff0000u);
                        v1[0] += __uint_as_float(rb.z << 16); v1[1] += __uint_as_float(rb.z & 0xffff0000u); v1[2] += __uint_as_float(rb.w << 16); v1[3] += __uint_as_float(rb.w & 0xffff0000u); }
                    ss += (v0[0] * v0[0] + v0[1] * v0[1]) + (v0[2] * v0[2] + v0[3] * v0[3]) + (v1[0] * v1[0] + v1[1] * v1[1]) + (v1[2] * v1[2] + v1[3] * v1[3]);
                    u32x4 w; w.x = cvt_pk_bf16(v0[0], v0[1]); w.y = cvt_pk_bf16(v0[2], v0[3]); w.z = cvt_pk_bf16(v1[0], v1[1]); w.w = cvt_pk_bf16(v1[2], v1[3]);
                    *(u32x4*)(HB + o) = w; }
                ss += __shfl_xor(ss, 16); ss += __shfl_xor(ss, 32);
                if (fq == 0) atomicAdd(ssq + r, ss); }
    }
};

struct EpiWout {
    static constexpr bool PERM = true, AFTER_DRAIN = false, MIDK = true;
    const float* resid; bf16_t* HB; float* ssq; int ldc; const float* ssq_ssm; int midk_t;
    __device__ __forceinline__ void midk(f32x4 (&acc)[2][2][4][2], const Unit& u, int wr, int wc, int fr, int fq) const {
        const int row0 = u.pm * BM + wr * 64 + fr;
#pragma unroll
        for (int ai = 0; ai < 2; ++ai)
#pragma unroll
            for (int m = 0; m < 4; ++m) { const float ir = sqrtf(ssq_ssm[row0 + ai * HALF + m * 16] * (1.0f / 1024.0f) + 1e-6f);
#pragma unroll
                for (int bj = 0; bj < 2; ++bj) { acc[ai][bj][m][0] *= ir; acc[ai][bj][m][1] *= ir; } }
    }
    __device__ __forceinline__ void operator()(const f32x4 (&acc)[2][2][4][2], const Unit& u, int wr, int wc, int fr, int fq) const {
        const int row0 = u.pm * BM + wr * 64 + fr, col0 = u.pn * BM + wc * 32 + 8 * fq;
#pragma unroll
        for (int ai = 0; ai < 2; ++ai)
#pragma unroll
            for (int m = 0; m < 4; ++m) { const int r = row0 + ai * HALF + m * 16; const size_t ro = (size_t)r * ldc + col0; float ss = 0.f;
                const float rs = 1.0f / sqrtf(ssq_ssm[r] * (1.0f / 1024.0f) + 1e-6f);
#pragma unroll
                for (int bj = 0; bj < 2; ++bj) { const size_t o = ro + bj * HALF;
                    const f32x4 v0 = acc[ai][bj][m][0] * rs + *(const f32x4*)(resid + o), v1 = acc[ai][bj][m][1] * rs + *(const f32x4*)(resid + o + 4);
                    ss += (v0[0] * v0[0] + v0[1] * v0[1]) + (v0[2] * v0[2] + v0[3] * v0[3]) + (v1[0] * v1[0] + v1[1] * v1[1]) + (v1[2] * v1[2] + v1[3] * v1[3]);
                    u32x4 w; w.x = cvt_pk_bf16(v0[0], v0[1]); w.y = cvt_pk_bf16(v0[2], v0[3]); w.z = cvt_pk_bf16(v1[0], v1[1]); w.w = cvt_pk_bf16(v1[2], v1[3]);
                    *(u32x4*)(HB + o) = w; }
                ss += __shfl_xor(ss, 16); ss += __shfl_xor(ss, 32);
                if (fq == 0) atomicAdd(ssq + r, ss); }
    }
};
struct EpiRowBf16 {
    static constexpr bool PERM = true, AFTER_DRAIN = false;
    bf16_t* O; int ldc; const float* ssq; float scale;
    __device__ __forceinline__ void operator()(const f32x4 (&acc)[2][2][4][2], const Unit& u, int wr, int wc, int fr, int fq) const {
        const int row0 = u.pm * BM + wr * 64 + fr, col0 = u.pn * BM + wc * 32 + 8 * fq;
#pragma unroll
        for (int ai = 0; ai < 2; ++ai)
#pragma unroll
            for (int m = 0; m < 4; ++m) { const int r = row0 + ai * HALF + m * 16; const float sc = scale / sqrtf(ssq[r] * (1.0f / 2048.0f) + 1e-6f); bf16_t* rowp = O + (size_t)r * ldc + col0;
#pragma unroll
                for (int bj = 0; bj < 2; ++bj) { const f32x4 v0 = acc[ai][bj][m][0] * sc, v1 = acc[ai][bj][m][1] * sc;
                    u32x4 w; w.x = cvt_pk_bf16(v0[0], v0[1]); w.y = cvt_pk_bf16(v0[2], v0[3]); w.z = cvt_pk_bf16(v1[0], v1[1]); w.w = cvt_pk_bf16(v1[2], v1[3]);
                    *(u32x4*)(rowp + bj * HALF) = w; } }
    }
};
struct EpiSl {
    static constexpr bool PERM = false, AFTER_DRAIN = false;
    float* Sl;
    __device__ __forceinline__ void operator()(const f32x4 (&acc)[2][2][4][2], const Unit& u, int wr, int wc, int fr, int fq) const {
        const int row0 = u.pm * BM + wr * 64 + fr, col0 = wc * 32 + 4 * fq;
        float* base = Sl + (size_t)u.bz * 512 * 128;
#pragma unroll
        for (int ai = 0; ai < 2; ++ai)
#pragma unroll
            for (int m = 0; m < 4; ++m) { float* rowp = base + (size_t)(row0 + ai * HALF + m * 16) * 128 + col0;
#pragma unroll
                for (int n = 0; n < 2; ++n) *(f32x4*)(rowp + n * 16) = acc[ai][0][m][n]; }
    }
};
struct EpiS5 {
    static constexpr bool PERM = true, AFTER_DRAIN = false;
    bf16_t* Gb;
    __device__ __forceinline__ void operator()(const f32x4 (&acc)[2][2][4][2], const Unit& u, int wr, int wc, int fr, int fq) const {
        const int row0 = u.pm * BM + wr * 64 + fr, col0 = u.pn * BM + wc * 32 + 8 * fq;
#pragma unroll
        for (int ai = 0; ai < 2; ++ai)
#pragma unroll
            for (int m = 0; m < 4; ++m) { const int cb = row0 + ai * HALF + m * 16;
#pragma unroll
                for (int bj = 0; bj < 2; ++bj) { const int n0 = col0 + bj * HALF; const int tau = n0 >> 4, h0 = n0 & 15;
                    const f32x4 v0 = acc[ai][bj][m][0], v1 = acc[ai][bj][m][1];
                    const f32x2 a = gelu_pk((f32x2){v0[0], v0[1]}), b = gelu_pk((f32x2){v0[2], v0[3]}), c = gelu_pk((f32x2){v1[0], v1[1]}), d = gelu_pk((f32x2){v1[2], v1[3]});
                    u32x4 w; w.x = cvt_pk_bf16(a.x, a.y); w.y = cvt_pk_bf16(b.x, b.y); w.z = cvt_pk_bf16(c.x, c.y); w.w = cvt_pk_bf16(d.x, d.y);
                    *(u32x4*)(Gb + ((size_t)cb * 32 + tau) * 1024 + 16 * u.bz + h0) = w; } }
    }
};

struct EpiXkv {
    static constexpr bool PERM = false, AFTER_DRAIN = false;
    bf16_t* KP; bf16_t* VT2;
    __device__ __forceinline__ void operator()(const f32x4 (&acc)[2][2][4][2], const Unit& u, int wr, int wc, int fr, int fq) const {
        const int row0 = u.pm * BM + wr * 64 + fr, col0 = u.pn * BM + wc * 32 + 4 * fq;
#pragma unroll
        for (int ai = 0; ai < 2; ++ai)
#pragma unroll
            for (int m = 0; m < 4; ++m) { const int r = row0 + ai * HALF + m * 16; const int b = r >> 8, mm = r & 255;
#pragma unroll
                for (int bj = 0; bj < 2; ++bj)
#pragma unroll
                    for (int n = 0; n < 2; ++n) { const int c = col0 + bj * HALF + n * 16; const f32x4 v = acc[ai][bj][m][n];
                        if (c < 512) { const int hd = c >> 7, d = c & 127; bf16_t* p = KP + ((size_t)(b * 4 + hd) * 256 + mm) * 256;
                            *(unsigned long long*)(p + (hd & 1) * 128 + d) = (unsigned long long)cvt_pk_bf16(v[0], v[1]) | ((unsigned long long)cvt_pk_bf16(v[2], v[3]) << 32);
                            *(unsigned long long*)(p + ((hd & 1) ^ 1) * 128 + d) = 0ull; }
                        else { const int c2 = c - 512, hd = c2 >> 7, d = c2 & 127; bf16_t* p = VT2 + ((size_t)(b * 2 + (hd >> 1)) * 256 + (hd & 1) * 128 + d) * 512;
                            const unsigned w01 = cvt_pk_bf16(v[0], v[1]), w23 = cvt_pk_bf16(v[2], v[3]);
                            const int k1 = (hd & 1) * 256 + mm, k0 = ((hd & 1) ^ 1) * 256 + mm;
                            p[k1] = (bf16_t)(w01 & 0xffffu); p[512 + k1] = (bf16_t)(w01 >> 16); p[1024 + k1] = (bf16_t)(w23 & 0xffffu); p[1536 + k1] = (bf16_t)(w23 >> 16);
                            p[k0] = 0; p[512 + k0] = 0; p[1024 + k0] = 0; p[1536 + k0] = 0; } } }
    }
};
struct EpiXs {
    static constexpr bool PERM = true, AFTER_DRAIN = true;
    bf16_t* XP; float* Lsum;
    __device__ __forceinline__ void fused(f32x4 (&acc)[2][2][4][2], const Unit& u, int wr, int wc, int fr, int fq, PG8_LAS unsigned char* lds, int wid, int lane) const {
        PG8_LAS float* Mx = (PG8_LAS float*)lds;
        const int b = u.bz >> 2, hd = u.bz & 3;
#pragma unroll
        for (int ai = 0; ai < 2; ++ai)
#pragma unroll
            for (int m = 0; m < 4; ++m) { float mx = -INFINITY;
#pragma unroll
                for (int bj = 0; bj < 2; ++bj)
#pragma unroll
                    for (int n = 0; n < 2; ++n) { const f32x4 v = acc[ai][bj][m][n]; mx = fmaxf(mx, fmaxf(fmaxf(v[0], v[1]), fmaxf(v[2], v[3]))); }
                mx = fmaxf(mx, __shfl_xor(mx, 16)); mx = fmaxf(mx, __shfl_xor(mx, 32));
                if (fq == 0) Mx[(ai * HALF + wr * 64 + m * 16 + fr) * 4 + wc] = mx; }
        asm volatile("s_waitcnt lgkmcnt(0)" ::: "memory"); __builtin_amdgcn_s_barrier(); asm volatile("" ::: "memory");
#pragma unroll
        for (int ai = 0; ai < 2; ++ai)
#pragma unroll
            for (int m = 0; m < 4; ++m) { const int rl = ai * HALF + wr * 64 + m * 16 + fr; const f32x4 mv = *(const PG8_LAS f32x4*)(Mx + rl * 4);
                const float mx = fmaxf(fmaxf(mv[0], mv[1]), fmaxf(mv[2], mv[3])); float ss = 0.f;
                const size_t t = (size_t)b * 2048 + u.pm * BM + rl; bf16_t* rowp = XP + t * 1024 + hd * 256 + wc * 32 + 8 * fq;
#pragma unroll
                for (int bj = 0; bj < 2; ++bj) { f32x4 p0, p1;
#pragma unroll
                    for (int e = 0; e < 4; ++e) { p0[e] = __expf(acc[ai][bj][m][0][e] - mx); p1[e] = __expf(acc[ai][bj][m][1][e] - mx); }
                    ss += (p0[0] + p0[1]) + (p0[2] + p0[3]) + (p1[0] + p1[1]) + (p1[2] + p1[3]);
                    u32x4 w; w.x = cvt_pk_bf16(p0[0], p0[1]); w.y = cvt_pk_bf16(p0[2], p0[3]); w.z = cvt_pk_bf16(p1[0], p1[1]); w.w = cvt_pk_bf16(p1[2], p1[3]);
                    *(u32x4*)(rowp + bj * HALF) = w; }
                ss += __shfl_xor(ss, 16); ss += __shfl_xor(ss, 32);
                if (fq == 0) atomicAdd(Lsum + t * 4 + hd, ss); }
    }
};
struct EpiXo {
    static constexpr bool PERM = true, AFTER_DRAIN = false;
    bf16_t* XO; const float* Lsum;
    __device__ __forceinline__ void operator()(const f32x4 (&acc)[2][2][4][2], const Unit& u, int wr, int wc, int fr, int fq) const {
        const int b = u.bz >> 2, pair = (u.bz >> 1) & 1, kh = u.bz & 1;
#pragma unroll
        for (int ai = 0; ai < 2; ++ai)
#pragma unroll
            for (int m = 0; m < 4; ++m) { const size_t t = (size_t)b * 2048 + u.pm * BM + ai * HALF + wr * 64 + m * 16 + fr; bf16_t* rowp = XO + t * 512 + pair * 256 + wc * 32 + 8 * fq;
                { const float il = 1.0f / Lsum[t * 4 + pair * 2 + kh]; const f32x4 v0 = (kh ? acc[ai][1][m][0] : acc[ai][0][m][0]) * il, v1 = (kh ? acc[ai][1][m][1] : acc[ai][0][m][1]) * il;
                    u32x4 w; w.x = cvt_pk_bf16(v0[0], v0[1]); w.y = cvt_pk_bf16(v0[2], v0[3]); w.z = cvt_pk_bf16(v1[0], v1[1]); w.w = cvt_pk_bf16(v1[2], v1[3]);
                    *(u32x4*)(rowp + kh * HALF) = w; } }
    }
};
struct XsOrder {
    int G, c, sel;
    __device__ __forceinline__ bool next(int i, Unit& u) const { if (i > 0) return false; const int L = sel * G + c; if (L >= 256) return false; u.pm = L & 7; u.pn = 0; u.bz = L >> 3; return true; }
    __device__ __forceinline__ void a_ready(const Unit&) const {}
    __device__ __forceinline__ void done(const Unit&) const {}
    template <class G_> __device__ __forceinline__ long offA(const Unit& u, const G_&) const { return (long)(u.bz >> 2) * 2048 * 512 + ((u.bz & 3) >> 1) * 256; }
    template <class G_> __device__ __forceinline__ long offB(const Unit& u, const G_&) const { return (long)u.bz * 256 * 256; }
};
struct XoOrder {
    int G, c;
    __device__ __forceinline__ bool next(int i, Unit& u) const { const int L = i * G + c; if (L >= 256) return false; u.pm = L & 7; u.pn = 0; u.bz = L >> 3; return true; }
    __device__ __forceinline__ void a_ready(const Unit&) const {}
    __device__ __forceinline__ void done(const Unit&) const {}
    template <class G_> __device__ __forceinline__ long offA(const Unit& u, const G_&) const { return (long)(u.bz >> 2) * 2048 * 1024 + (u.bz & 3) * 256; }
    template <class G_> __device__ __forceinline__ long offB(const Unit& u, const G_&) const { return (long)(u.bz >> 1) * 256 * 512 + (u.bz & 1) * 256; }
};
struct EpiGlu {
    static constexpr bool PERM = false, AFTER_DRAIN = false;
    const bf16_t* G; const float* bias; bf16_t* CAT; float* ssq;
    __device__ __forceinline__ void operator()(const f32x4 (&acc)[2][2][4][2], const Unit& u, int wr, int wc, int fr, int fq) const {
        const int row0 = u.pm * BM + wr * 64 + fr, col0 = u.pn * BM + wc * 32 + 4 * fq;
#pragma unroll
        for (int ai = 0; ai < 2; ++ai)
#pragma unroll
            for (int m = 0; m < 4; ++m) { const int r = row0 + ai * HALF + m * 16; float ss = 0.f;
#pragma unroll
                for (int bj = 0; bj < 2; ++bj)
#pragma unroll
                    for (int n = 0; n < 2; ++n) { const int c = col0 + bj * HALF + n * 16; const f32x4 z = acc[ai][bj][m][n] + *(const f32x4*)(bias + c); const unsigned long long gb = *(const unsigned long long*)(G + (size_t)r * 1024 + c);
                        f32x4 gv; gv[0] = __uint_as_float((unsigned)gb << 16); gv[1] = __uint_as_float((unsigned)gb & 0xffff0000u); gv[2] = __uint_as_float((unsigned)(gb >> 32) << 16); gv[3] = __uint_as_float((unsigned)(gb >> 32) & 0xffff0000u);
                        f32x4 o; o[0] = gv[0] / (1.0f + __expf(-z[0])); o[1] = gv[1] / (1.0f + __expf(-z[1])); o[2] = gv[2] / (1.0f + __expf(-z[2])); o[3] = gv[3] / (1.0f + __expf(-z[3]));
                        ss += o[0] * o[0] + o[1] * o[1] + o[2] * o[2] + o[3] * o[3];
                        const unsigned long long w = (unsigned long long)cvt_pk_bf16(o[0], o[1]) | ((unsigned long long)cvt_pk_bf16(o[2], o[3]) << 32);
                        *(unsigned long long*)(CAT + (size_t)r * 2048 + 1024 + c) = w; }
                ss += __shfl_xor(ss, 16); ss += __shfl_xor(ss, 32);
                if (fq == 0) atomicAdd(ssq + r, ss); }
    }
};
struct EpiWin {
    static constexpr bool PERM = true, AFTER_DRAIN = false;
    bf16_t* QKV; size_t sec_stride; bf16_t* UC; const float* rope; float qscale;
    __device__ __forceinline__ void operator()(const f32x4 (&acc)[2][2][4][2], const Unit& u, int wr, int wc, int fr, int fq) const {
        const int row0 = u.pm * BM + wr * 64 + fr;
        const int sec = u.pn >> 2;
        const int col0 = (u.pn & 3) * BM + wc * 32 + 8 * fq;
        if (sec == 3) {
#pragma unroll
            for (int ai = 0; ai < 2; ++ai)
#pragma unroll
                for (int m = 0; m < 4; ++m) { const int r = row0 + ai * HALF + m * 16; const int cb = r >> 5, sg = r & 31;
#pragma unroll
                    for (int bj = 0; bj < 2; ++bj) { const int col = col0 + bj * HALF; const int g = col >> 4, h0 = col & 15;
                        const f32x4 v0 = acc[ai][bj][m][0], v1 = acc[ai][bj][m][1];
                        u32x4 w; w.x = cvt_pk_bf16(v0[0], v0[1]); w.y = cvt_pk_bf16(v0[2], v0[3]); w.z = cvt_pk_bf16(v1[0], v1[1]); w.w = cvt_pk_bf16(v1[2], v1[3]);
                        *(u32x4*)(UC + ((size_t)g * 512 + cb) * 640 + sg * 16 + h0) = w; } }
            return;
        }
        bf16_t* base = QKV + (size_t)sec * sec_stride;
        const float sc = sec == 0 ? qscale : 1.0f;
        const bool rot = (sec < 2) && ((wc & 1) == 0);
        const float sgn = (fq & 1) ? 1.0f : -1.0f;
        const bool mine = fq < 2;
#pragma unroll
        for (int ai = 0; ai < 2; ++ai)
#pragma unroll
            for (int m = 0; m < 4; ++m) { const int r = row0 + ai * HALF + m * 16; bf16_t* rowp = base + (size_t)r * 1024 + col0;
                f32x4 cs[4];
                if (rot) {
#pragma unroll
                    for (int q = 0; q < 4; ++q) cs[q] = *(const f32x4*)(rope + (size_t)r * 16 + 4 * q);
                }
#pragma unroll
                for (int bj = 0; bj < 2; ++bj) { f32x4 v0 = acc[ai][bj][m][0], v1 = acc[ai][bj][m][1];
                    if (rot) {
                        f32x4 p0, p1;
#pragma unroll
                        for (int e = 0; e < 4; ++e) { p0[e] = __shfl_xor(v0[e], 16); p1[e] = __shfl_xor(v1[e], 16); }
                        if (mine) {
#pragma unroll
                            for (int e = 0; e < 4; ++e) {
                                const float c0 = cs[e >> 1][(e & 1) * 2], s0 = cs[e >> 1][(e & 1) * 2 + 1];
                                const float c1 = cs[2 + (e >> 1)][(e & 1) * 2], s1 = cs[2 + (e >> 1)][(e & 1) * 2 + 1];
                                v0[e] = v0[e] * c0 + sgn * p0[e] * s0; v1[e] = v1[e] * c1 + sgn * p1[e] * s1; }
                        }
                    }
                    v0 = v0 * sc; v1 = v1 * sc; u32x4 w; w.x = cvt_pk_bf16(v0[0], v0[1]); w.y = cvt_pk_bf16(v0[2], v0[3]); w.z = cvt_pk_bf16(v1[0], v1[1]); w.w = cvt_pk_bf16(v1[2], v1[3]);
                    *(u32x4*)(rowp + bj * HALF) = w; } }
    }
};
}
#define GEMM_RUN(EPI, ALIGN, g, S, E) pg8::gemm_phase<EPI, pg8::StaticOrder, ALIGN, true>(F.ldsl, g, S, E)
namespace attn_body {
using bf16=__hip_bfloat16;
using bf16x8=__attribute__((ext_vector_type(8)))short;
using s16x4=__attribute__((ext_vector_type(4)))short;
using f32x16=__attribute__((ext_vector_type(16)))float;
using u32x4=__attribute__((ext_vector_type(4)))unsigned;
constexpr int BATCH=8,NHEAD=16,SEQ=2048,D=64,DM=NHEAD*D;
constexpr int NW=8,QBLK=32,QB=QBLK*NW,KVBLK=64,NQB=SEQ/QB;
constexpr int ATTN_PITCH=DM, ATTN_UNIT_ROWS=QB;
__device__ __forceinline__ int crow(int r,int hi){return (r&3)+8*(r>>2)+4*hi;}
#define SBAR() __builtin_amdgcn_sched_barrier(0)
__device__ __forceinline__ void cmask(f32x16&p0,f32x16&p1,int jb,int qrel,int hi){
  asm volatile("":"+v"(qrel),"+v"(hi));
  const float NEG=-INFINITY; int kb=64*jb+4*hi;
  #pragma unroll
  for(int r=0;r<16;++r){int kv=kb+(r&3)+8*(r>>2); if(kv>qrel)p0[r]=NEG; if(kv+32>qrel)p1[r]=NEG;}
}

constexpr int NSLOT=3, SLOTB=8192;
constexpr int LDS_K=0, LDS_V=NSLOT*SLOTB, LDS_WS=2*NSLOT*SLOTB, LDS_OST=LDS_WS+NW*64*4, LDS_BYTES=LDS_OST+NW*4096, LDS_X=LDS_BYTES, LDS_SSQ=LDS_X+NW*4096;
constexpr float C2=0.125f*1.4426950408889634f;
__device__ __forceinline__ void glds16(const void*gsrc,unsigned lds_dst){unsigned keep;
  asm volatile("s_mov_b32 %0, m0\n\ts_mov_b32 m0, %2\n\ts_nop 0\n\tglobal_load_lds_dwordx4 %1, off\n\ts_mov_b32 m0, %0":"=&s"(keep):"v"(gsrc),"s"(lds_dst):"memory");}
__device__ __forceinline__ float max3f(float a,float b,float c){float r;asm("v_max3_f32 %0, %1, %2, %3":"=v"(r):"v"(a),"v"(b),"v"(c));return r;}
__device__ __forceinline__ float max2f(float a,float b){float r;asm("v_max_f32_e32 %0, %1, %2":"=v"(r):"v"(a),"v"(b));return r;}
__device__ __forceinline__ float fadd_s(float a,float b){float r;asm("v_add_f32_e32 %0, %1, %2":"=v"(r):"v"(a),"v"(b));return r;}
__device__ __forceinline__ float fsub_s(float a,float b){float r;asm("v_sub_f32_e32 %0, %1, %2":"=v"(r):"v"(a),"v"(b));return r;}
typedef float f32x2_t __attribute__((ext_vector_type(2))); typedef __bf16 bf16x2_t __attribute__((ext_vector_type(2)));
__device__ __forceinline__ unsigned cvtpk_s(float lo,float hi){f32x2_t v={lo,hi};bf16x2_t b=__builtin_convertvector(v,bf16x2_t);return __builtin_bit_cast(unsigned,b);}
#define WAIT_BAR(N) asm volatile("s_waitcnt vmcnt(" #N ") lgkmcnt(0)\n\ts_barrier":::"memory")

__device__ __forceinline__ void qkt(f32x16&p0,f32x16&p1,const char*Kslot,const bf16x8*qr,int r32,int hi){ const f32x16 zc=f32x16{};
  const char*kb=Kslot+hi*1024+r32*16;
  #pragma unroll
  for(int d0=0;d0<4;++d0){
    const bf16x8 b0=*reinterpret_cast<const bf16x8*>(kb+d0*2048);
    const bf16x8 b1=*reinterpret_cast<const bf16x8*>(kb+d0*2048+512);
    if(d0==0){p0=__builtin_amdgcn_mfma_f32_32x32x16_bf16(b0,qr[0],zc,0,0,0);p1=__builtin_amdgcn_mfma_f32_32x32x16_bf16(b1,qr[0],zc,0,0,0);}
    else{p0=__builtin_amdgcn_mfma_f32_32x32x16_bf16(b0,qr[d0],p0,0,0,0);p1=__builtin_amdgcn_mfma_f32_32x32x16_bf16(b1,qr[d0],p1,0,0,0);}}
}
typedef __attribute__((address_space(3))) const char* lds_cptr;
typedef short v4i16_t __attribute__((ext_vector_type(4)));
__device__ __forceinline__ void kload8(bf16x8*kf,lds_cptr kp){
  kf[0]=*(const __attribute__((address_space(3))) bf16x8*)(kp);      kf[1]=*(const __attribute__((address_space(3))) bf16x8*)(kp+512);
  kf[2]=*(const __attribute__((address_space(3))) bf16x8*)(kp+2048); kf[3]=*(const __attribute__((address_space(3))) bf16x8*)(kp+2560);
  kf[4]=*(const __attribute__((address_space(3))) bf16x8*)(kp+4096); kf[5]=*(const __attribute__((address_space(3))) bf16x8*)(kp+4608);
  kf[6]=*(const __attribute__((address_space(3))) bf16x8*)(kp+6144); kf[7]=*(const __attribute__((address_space(3))) bf16x8*)(kp+6656);
}
__device__ __forceinline__ void kload2(bf16x8*kf,lds_cptr kp,int j){ kf[2*j]=*(const __attribute__((address_space(3))) bf16x8*)(kp+j*2048); kf[2*j+1]=*(const __attribute__((address_space(3))) bf16x8*)(kp+j*2048+512); }
__device__ __forceinline__ s16x4 vtr(lds_cptr p){ return __builtin_bit_cast(s16x4,__builtin_amdgcn_ds_read_tr16_b64_v4i16((__attribute__((address_space(3))) v4i16_t*)p)); }
__device__ __forceinline__ float rowmax(const f32x16&p0,const f32x16&p1){
  float a=max3f(p0[0],p0[1],p1[0]),b=max3f(p0[2],p0[3],p1[1]);a=max3f(a,p1[2],p1[3]);
  #pragma unroll
  for(int r=4;r<16;r+=4){a=max3f(a,p0[r],p0[r+1]);b=max3f(b,p0[r+2],p0[r+3]);a=max3f(a,p1[r],p1[r+1]);b=max3f(b,p1[r+2],p1[r+3]);}
  const float m=max2f(a,b);
  auto rr=__builtin_amdgcn_permlane32_swap(__float_as_uint(m),__float_as_uint(m),false,false);
  return max2f(__uint_as_float(rr[0]),__uint_as_float(rr[1]));
}
__device__ __forceinline__ void pv(f32x16*o,int vb,bf16x8 pa0,bf16x8 pa1,bf16x8 pa2,bf16x8 pa3){
  #pragma unroll
  for(int d0=0;d0<2;++d0){s16x4 lo[4],hi[4];
    #pragma unroll
    for(int ks=0;ks<4;++ks){
      asm volatile("ds_read_b64_tr_b16 %0,%1 offset:%c2":"=&v"(lo[ks]):"v"(vb),"i"(d0*4096+ks*1024):"memory");
      asm volatile("ds_read_b64_tr_b16 %0,%1 offset:%c2":"=&v"(hi[ks]):"v"(vb),"i"(d0*4096+ks*1024+512):"memory");}
    asm volatile("s_waitcnt lgkmcnt(0)":::"memory");SBAR();
    #define PK(k) (bf16x8){lo[k][0],lo[k][1],lo[k][2],lo[k][3],hi[k][0],hi[k][1],hi[k][2],hi[k][3]}
    o[d0]=__builtin_amdgcn_mfma_f32_32x32x16_bf16(pa0,PK(0),o[d0],0,0,0);
    o[d0]=__builtin_amdgcn_mfma_f32_32x32x16_bf16(pa1,PK(1),o[d0],0,0,0);
    o[d0]=__builtin_amdgcn_mfma_f32_32x32x16_bf16(pa2,PK(2),o[d0],0,0,0);
    o[d0]=__builtin_amdgcn_mfma_f32_32x32x16_bf16(pa3,PK(3),o[d0],0,0,0);
    #undef PK
  }
}

#ifndef ATTN_STORE16
#define ATTN_STORE16(p,v) (*(u32x4*)(p)=(v))
#endif
template<int THRL> __device__ __forceinline__ void attn_unit(int b,int h,int hv,int qb,const bf16*Q,const bf16*__restrict__ K,const bf16*__restrict__ V,bf16*CATp,const int mode,const float lam,const float*hgp,char*shm){
  const int tid=threadIdx.x,lane=tid&63,r32=lane&31,hi=lane>>5; const int wid=__builtin_amdgcn_readfirstlane(tid>>6);
  const long rowbase=(long)b*SEQ; const int q0=qb*QB;
  const bf16*Qw=Q+(rowbase+q0+wid*QBLK)*DM+h*D;
  const bf16*Kh=K+rowbase*DM+h*D,*Vh=V+rowbase*DM+hv*D;
  const unsigned lds0=(unsigned)(uintptr_t)shm;
  float*wsf=(float*)(shm+LDS_WS)+wid*64;
  const bf16*ksrc=Kh+(long)lane*DM+wid*8;
  const bf16*vsrc=Vh+(long)(16*(wid&3)+(lane>>2))*DM+(wid>>2)*32+(lane&3)*8;
  const unsigned kdst=lds0+LDS_K+wid*1024, vdst=lds0+LDS_V+wid*1024;
  #define DMA_K(t,slot) glds16(ksrc+(long)(t)*KVBLK*DM,(unsigned)__builtin_amdgcn_readfirstlane(kdst+(slot)))
  #define DMA_V(t,slot) glds16(vsrc+(long)(t)*KVBLK*DM,(unsigned)__builtin_amdgcn_readfirstlane(vdst+(slot)))
  const int vb0=(int)(lds0+LDS_V)+((lane>>4)&1)*32+(lane&3)*8+(4*hi+((lane&15)>>2))*64;
  const char*Kbase=shm+LDS_K; bf16x8 kf[8];
  const lds_cptr shm3=(lds_cptr)shm; const lds_cptr kp0=shm3+LDS_K+hi*1024+r32*16; const lds_cptr vp0=shm3+LDS_V+((lane>>4)&1)*32+(lane&3)*8+(4*hi+((lane&15)>>2))*64;
  const int NT=(q0+QB)/KVBLK;
  DMA_K(0,0);DMA_V(0,0);DMA_K(1,SLOTB);
  bf16x8 qr[4];
  #pragma unroll
  for(int d0=0;d0<4;++d0)qr[d0]=*reinterpret_cast<const bf16x8*>(&Qw[(long)r32*DM+d0*16+hi*8]);
  float mhat=0.f,l_reg=0.f;f32x16 o[2];o[0]=f32x16{};o[1]=f32x16{};
  const int qrel=wid*QBLK+r32;
  #define CMASK(P0,P1,t) do{int jb_=(t)-(NT-4); if(jb_>=0)cmask(P0,P1,jb_,qrel,hi);}while(0)
  bool resc=false;
  #define START(P0,P1) do{ const float rm=rowmax(P0,P1); resc=false; mhat=rm; \
    _Pragma("unroll") for(int r=0;r<16;++r)P0[r]=__builtin_amdgcn_exp2f(fsub_s(P0[r],mhat)); }while(0)
  #define RESC() do{ if(resc){ asm volatile("s_waitcnt lgkmcnt(0)":::"memory"); \
      _Pragma("unroll") for(int d_=0;d_<2;++d_) _Pragma("unroll") for(int r=0;r<16;++r)o[d_][r]*=wsf[crow(r,hi)]; } }while(0)
  f32x16 pA0,pA1,pB0,pB1;
  int sl_prev=0,sl_cur=0,sl_next=SLOTB;
  #define ROT() do{sl_prev=sl_cur;sl_cur=sl_next;sl_next=(sl_next==(NSLOT-1)*SLOTB)?0:sl_next+SLOTB;}while(0)
  DMA_K(2,2*SLOTB);
  WAIT_BAR(3);
  qkt(pA0,pA1,Kbase,qr,r32,hi);asm volatile("s_nop 15\n\ts_nop 7":"+v"(pA0),"+v"(pA1));CMASK(pA0,pA1,0);
  START(pA0,pA1);
  _Pragma("unroll") for(int r=0;r<16;++r)pA1[r]=__builtin_amdgcn_exp2f(fsub_s(pA1[r],mhat));
  WAIT_BAR(0);
  DMA_K(3,0);DMA_V(1,SLOTB);
  ROT();
  kload8(kf,kp0+sl_cur);
  WAIT_BAR(2);
  s16x4 vlo[8],vhi[8]; u32x4 pw0,pw1,pw2,pw3;
  #define PKW(P,B) cvtpk_s(P[B],P[B+1])
  #define PAF(k) __builtin_bit_cast(bf16x8,pw##k)
  #define VFR(i) (bf16x8){vlo[i][0],vlo[i][1],vlo[i][2],vlo[i][3],vhi[i][0],vhi[i][1],vhi[i][2],vhi[i][3]}
  #define PIN(x) asm volatile("":"+v"(x))
  #define MX3(a,b,c) __builtin_fmaxf(__builtin_fmaxf((a),(b)),(c))
  #define GAPA(MF,A0,A1,A2,A3,W0,W1,PW) do{ MF; sacc+=A0; sacc+=A1; sacc+=A2; sacc+=A3; PIN(sacc); W0; W1; PIN(PW); SBAR(); }while(0)
  #define EX(v) __builtin_amdgcn_exp2f((v)-mhat)
  #define GAPB(MF,X,B) do{ MF; X[B]=EX(X[B]); X[B+1]=EX(X[B+1]); X[B+2]=EX(X[B+2]); X[B+3]=EX(X[B+3]); PIN(X); SBAR(); }while(0)
  #define VRD(i) do{ vlo[i]=vtr(vp_+(((i)>>2)*4096+((i)&3)*1024)); vhi[i]=vtr(vp_+(((i)>>2)*4096+((i)&3)*1024+512)); }while(0)
  #define KRD(G,j) do{ if(G){ kload2(kf,kp0+sl_next,j); SBAR(); } }while(0)
  #define STEP(C0,C1,P0,P1,t,GK,GV,GL) do{ SBAR(); const f32x16 zc_=f32x16{}; \
    const lds_cptr vp_=vp0+sl_prev; \
    VRD(0); SBAR(); float sacc=(P0[0]+P0[1]); \
    GAPA(C0=__builtin_amdgcn_mfma_f32_32x32x16_bf16(kf[0],qr[0],zc_,0,0,0), P0[2],P0[3],P0[4],P0[5],     pw0[0]=PKW(P0,0), pw0[1]=PKW(P0,2), pw0); \
    VRD(4); SBAR(); GAPA(C1=__builtin_amdgcn_mfma_f32_32x32x16_bf16(kf[1],qr[0],zc_,0,0,0), P0[6],P0[7],P0[8],P0[9],     pw0[2]=PKW(P0,4), pw0[3]=PKW(P0,6), pw0); \
    VRD(1); SBAR(); GAPA(C0=__builtin_amdgcn_mfma_f32_32x32x16_bf16(kf[2],qr[1],C0,0,0,0),   P0[10],P0[11],P0[12],P0[13], pw1[0]=PKW(P0,8), pw1[1]=PKW(P0,10), pw1); \
    VRD(5); SBAR(); GAPA(C1=__builtin_amdgcn_mfma_f32_32x32x16_bf16(kf[3],qr[1],C1,0,0,0),   P0[14],P0[15],P1[0],P1[1],   pw1[2]=PKW(P0,12),pw1[3]=PKW(P0,14), pw1); \
    VRD(2); SBAR(); GAPA(C0=__builtin_amdgcn_mfma_f32_32x32x16_bf16(kf[4],qr[2],C0,0,0,0),   P1[2],P1[3],P1[4],P1[5],     pw2[0]=PKW(P1,0), pw2[1]=PKW(P1,2), pw2); \
    VRD(6); SBAR(); GAPA(C1=__builtin_amdgcn_mfma_f32_32x32x16_bf16(kf[5],qr[2],C1,0,0,0),   P1[6],P1[7],P1[8],P1[9],     pw2[2]=PKW(P1,4), pw2[3]=PKW(P1,6), pw2); \
    VRD(3); SBAR(); GAPA(C0=__builtin_amdgcn_mfma_f32_32x32x16_bf16(kf[6],qr[3],C0,0,0,0),   P1[10],P1[11],P1[12],P1[13], pw3[0]=PKW(P1,8), pw3[1]=PKW(P1,10), pw3); \
    VRD(7); SBAR(); GAPA(C1=__builtin_amdgcn_mfma_f32_32x32x16_bf16(kf[7],qr[3],C1,0,0,0),   P1[14],P1[15],0.f,0.f,       pw3[2]=PKW(P1,12),pw3[3]=PKW(P1,14), pw3); \
    l_reg+=sacc; \
    if(GK){DMA_K((t)+3,sl_cur);} if(GV){DMA_V((t)+1,sl_next);} \
    CMASK(C0,C1,t); \
    { float a=MX3(C0[0],C0[1],C1[0]),b=MX3(C0[2],C0[3],C1[1]); a=MX3(a,C1[2],C1[3]); \
      _Pragma("unroll") for(int r=4;r<16;r+=4){a=MX3(a,C0[r],C0[r+1]);b=MX3(b,C0[r+2],C0[r+3]);a=MX3(a,C1[r],C1[r+1]);b=MX3(b,C1[r+2],C1[r+3]);} \
      float rm=__builtin_fmaxf(a,b); { auto rr=__builtin_amdgcn_permlane32_swap(__float_as_uint(rm),__float_as_uint(rm),false,false); rm=__builtin_fmaxf(__uint_as_float(rr[0]),__uint_as_float(rr[1])); } \
      resc=false; \
      rm-=mhat; \
      if(__builtin_expect(__any(rm>(float)THRL),0)){ const float dl=__builtin_fmaxf(rm,0.f); mhat+=dl; \
        const float f=__builtin_amdgcn_exp2f(-dl); l_reg*=f; if(hi==0)wsf[r32]=f; resc=true; } } \
    SBAR(); \
    GAPB(o[0]=__builtin_amdgcn_mfma_f32_32x32x16_bf16(PAF(0),VFR(0),o[0],0,0,0), C0,0); \
    GAPB(o[1]=__builtin_amdgcn_mfma_f32_32x32x16_bf16(PAF(0),VFR(4),o[1],0,0,0), C0,4); \
    KRD(GL,0); GAPB(o[0]=__builtin_amdgcn_mfma_f32_32x32x16_bf16(PAF(1),VFR(1),o[0],0,0,0), C0,8); \
    KRD(GL,1); GAPB(o[1]=__builtin_amdgcn_mfma_f32_32x32x16_bf16(PAF(1),VFR(5),o[1],0,0,0), C0,12); \
    KRD(GL,2); GAPB(o[0]=__builtin_amdgcn_mfma_f32_32x32x16_bf16(PAF(2),VFR(2),o[0],0,0,0), C1,0); \
    KRD(GL,3); GAPB(o[1]=__builtin_amdgcn_mfma_f32_32x32x16_bf16(PAF(2),VFR(6),o[1],0,0,0), C1,4); \
    GAPB(o[0]=__builtin_amdgcn_mfma_f32_32x32x16_bf16(PAF(3),VFR(3),o[0],0,0,0), C1,8); \
    GAPB(o[1]=__builtin_amdgcn_mfma_f32_32x32x16_bf16(PAF(3),VFR(7),o[1],0,0,0), C1,12); \
    }while(0)
  int t=1;
  #undef CMASK
  #define CMASK(P0,P1,t) do{}while(0)
  for(;t+5<NT;t+=2){
    STEP(pB0,pB1,pA0,pA1,t,true,true,true);     WAIT_BAR(2); RESC(); ROT();
    STEP(pA0,pA1,pB0,pB1,t+1,true,true,true);   WAIT_BAR(2); RESC(); ROT();
  }
  #undef CMASK
  #define CMASK(P0,P1,t) do{int jb_=(t)-(NT-4); if(jb_>=0)cmask(P0,P1,jb_,qrel,hi);}while(0)
  #define ENDW(tt) do{ if((tt)+3<NT){WAIT_BAR(2);} else if((tt)+2<NT){WAIT_BAR(1);} else {WAIT_BAR(0);} }while(0)
  for(;t+1<NT;t+=2){
    STEP(pB0,pB1,pA0,pA1,t,(t+3<NT),(t+1<NT),(t+1<NT));       ENDW(t);   RESC(); ROT();
    STEP(pA0,pA1,pB0,pB1,t+1,(t+4<NT),(t+2<NT),(t+2<NT));     ENDW(t+1); RESC(); ROT();
  }
  STEP(pB0,pB1,pA0,pA1,NT-1,false,false,false); RESC();
  { float sacc=pB0[0]+pB0[1]; _Pragma("unroll") for(int r=2;r<16;++r)sacc+=pB0[r]; _Pragma("unroll") for(int r=0;r<16;++r)sacc+=pB1[r]; l_reg+=sacc;
    pw0=(u32x4){PKW(pB0,0),PKW(pB0,2),PKW(pB0,4),PKW(pB0,6)};pw1=(u32x4){PKW(pB0,8),PKW(pB0,10),PKW(pB0,12),PKW(pB0,14)};pw2=(u32x4){PKW(pB1,0),PKW(pB1,2),PKW(pB1,4),PKW(pB1,6)};pw3=(u32x4){PKW(pB1,8),PKW(pB1,10),PKW(pB1,12),PKW(pB1,14)};
    SBAR(); pv(o,vb0+sl_cur,PAF(0),PAF(1),PAF(2),PAF(3)); }
  #undef PKW
  #undef PAF
  #undef VFR
  #undef PIN
  #undef MX3
  #undef GAPA
  #undef GAPB
  #undef EX
  #undef VRD
  #undef KRD
  #undef STEP
  #undef ENDW
  {auto rr=__builtin_amdgcn_permlane32_swap(__float_as_uint(l_reg),__float_as_uint(l_reg),false,false);l_reg=__uint_as_float(rr[0])+__uint_as_float(rr[1]);}
  if(hi==0)wsf[32+r32]=l_reg;asm volatile("s_waitcnt lgkmcnt(0)":::"memory");
  float rli[16];
  #pragma unroll
  for(int r=0;r<16;++r)rli[r]=__builtin_amdgcn_rcpf(wsf[32+crow(r,hi)]);
  { bf16*stg=(bf16*)(shm+LDS_OST)+wid*2048;
    bf16*xst=(bf16*)(shm+LDS_X)+wid*2048; float*ssq=(float*)(shm+LDS_SSQ)+wid*32;
    bf16*cur=(mode&2)?stg:xst;
    if((mode&1)==0){
      #pragma unroll
      for(int r=0;r<16;++r){const int orow=crow(r,hi);
        #pragma unroll
        for(int d0=0;d0<2;++d0)cur[orow*64+d0*32+r32]=__float2bfloat16(o[d0][r]*rli[r]);}
    } else {
      #pragma unroll
      for(int r=0;r<16;++r){const int orow=crow(r,hi);
        #pragma unroll
        for(int d0=0;d0<2;++d0){const int pos=orow*64+d0*32+r32; const float dd=__bfloat162float(cur[pos])-lam*(o[d0][r]*rli[r]); cur[pos]=__float2bfloat16(dd);}}
      asm volatile("s_waitcnt lgkmcnt(0)":::"memory");
      const long trow=rowbase+q0+wid*QBLK;
      #pragma unroll
      for(int i=0;i<4;++i){const int row=i*8+(lane>>3),ch=lane&7; const u32x4 vb=*(const u32x4*)(cur+row*64+ch*8);
        float fb[8];
        #pragma unroll
        for(int e=0;e<4;++e){fb[2*e]=__uint_as_float(vb[e]<<16);fb[2*e+1]=__uint_as_float(vb[e]&0xffff0000u);}
        float ss=0.f;
        #pragma unroll
        for(int e=0;e<8;++e)ss+=fb[e]*fb[e];
        ss+=__shfl_xor(ss,1);ss+=__shfl_xor(ss,2);ss+=__shfl_xor(ss,4);
        if(mode==1){ if(ch==0)ssq[row]=ss; }
        else{
          const u32x4 va=*(const u32x4*)(xst+row*64+ch*8);
          const float rr=(1.0f-LAM_INIT)/sqrtf((ssq[row]+ss)/128.0f+EPS);
          const float4 ga0=*(const float4*)(hgp+ch*8),ga1=*(const float4*)(hgp+ch*8+4),gb0=*(const float4*)(hgp+64+ch*8),gb1=*(const float4*)(hgp+64+ch*8+4);
          const float ga[8]={ga0.x,ga0.y,ga0.z,ga0.w,ga1.x,ga1.y,ga1.z,ga1.w},gb[8]={gb0.x,gb0.y,gb0.z,gb0.w,gb1.x,gb1.y,gb1.z,gb1.w};
          u32x4 oa,ob;
          #pragma unroll
          for(int e=0;e<4;++e){
            oa[e]=cvtpk_s(__uint_as_float(va[e]<<16)*rr*ga[2*e],__uint_as_float(va[e]&0xffff0000u)*rr*ga[2*e+1]);
            ob[e]=cvtpk_s(fb[2*e]*rr*gb[2*e],fb[2*e+1]*rr*gb[2*e+1]);}
          bf16*cp=CATp+(trow+row)*2048+(hv>>1)*128+ch*8;
          ATTN_STORE16(cp,oa); ATTN_STORE16(cp+64,ob);
        }
      }
    }
  }
  asm volatile("s_waitcnt lgkmcnt(0)\n\ts_barrier":::"memory");
  #undef DMA_K
  #undef DMA_V
  #undef CMASK
  #undef START
  #undef RESC
  #undef ROT
}
constexpr int ATTN_LDS_BYTES=LDS_BYTES+NW*4096+NW*128;
struct AttnTensors { const bf16* Q; const bf16* K; const bf16* V; bf16* CAT; float lam; const float* hg; };
template<int THRL=8> __device__ __forceinline__ void attn_phase(char*lds,const AttnTensors&T,int vcu,int G){
  for(int item=vcu;item<BATCH*8*4;item+=G){
    const int b=item>>5,h=(item>>2)&7,j=item&3;
    for(int q2=0;q2<2;++q2){ const int qb=q2?j:NQB-1-j;
      for(int mode=0;mode<4;++mode) attn_unit<THRL>(b,2*h+(mode&1),2*h+(mode>>1),qb,T.Q,T.K,T.V,T.CAT,mode,T.lam,T.hg,lds); }
  }
}
#undef SBAR
#undef WAIT_BAR
}

__device__ __forceinline__ void p_s5_stepA(const Frame& F, const Args& A);
__device__ __forceinline__ void p3_attn(const Frame& F, const Args& A) {
    const attn_body::AttnTensors AT{(const attn_body::bf16*)WSB(WS_QB), (const attn_body::bf16*)WSB(WS_KB), (const attn_body::bf16*)WSB(WS_VB), (attn_body::bf16*)WSB(WS_B), *WSF(WS_LAM), IN_F(9)};
    const int vcu = (F.G % 8 == 0) ? (F.bid % 8) * (F.G / 8) + F.bid / 8 : F.bid;
    p_s5_stepA(F, A);
    attn_body::attn_phase<8>((char*)F.lds, AT, vcu, F.G);
}
__device__ __forceinline__ void p0_s5_setup(const Frame& F, const Args& A) {
    LAS float* Apr = (LAS float*)F.ldsl;
    LAS float* Api = Apr + 33 * 64;
    LAS float* Bbr = Api + 33 * 64;
    LAS float* Bbi = Bbr + 1024;
    LAS float* Cr = Bbi + 1024;
    LAS float* Ci = Cr + 1024;
    LAS float* Kk = Ci + 1024;
    const float* a_re = IN_F(10); const float* a_im = IN_F(11); const float* log_dt = IN_F(12);
    const float* b_re = IN_F(13); const float* b_im = IN_F(14); const float* c_re = IN_F(15); const float* c_im = IN_F(16); const float* dsk = IN_F(17);
    bf16* BtC = WSB(WS_BTC); bf16* BtA = WSB(WS_BTA); float* AL = WSF(WS_AL);
    const int tid = F.tid;
    const float* xin = IN_F(0); const float* g3 = IN_F(3); bf16* XN = WSB(WS_B);
    const int gw4 = 4 * (F.bid * NWAVES + F.wave), step4 = 4 * F.G * NWAVES; int nbat = 0;
#define S5_BAR() asm volatile("s_waitcnt lgkmcnt(0)\n\ts_barrier" ::: "memory")
    for (int item = F.bid; item < SG * 4; item += F.G) {
        const int g = item >> 2, hq = item & 3; const bool first = item == F.bid;
        S5_BAR();
        const float dtf = expf(log_dt[g]); const double dt = (double)dtf;
        for (int e = tid; e < 33 * 64; e += NTHR) {
            const int k = e >> 6, p = e & 63;
            const float lre = a_re[g * SP + p], lim = a_im[g * SP + p];
            const float mag = expf(lre * dtf * (float)k), af = lim * dtf * (float)k;
            Apr[e] = mag * cosf(af); Api[e] = mag * sinf(af);
        }
        for (int e = tid; e < 1024; e += NTHR) {
            const int p = e >> 4, h = e & 15;
            const double lre = a_re[g * SP + p], lim = a_im[g * SP + p];
            const double mag = exp(lre * dt), ang = lim * dt;
            const double rev = ang * 0.15915494309189533577, frr = rev - floor(rev);
            const float af = (float)(frr * 6.283185307179586477);
            const double ar = mag * (double)cosf(af), ai = mag * (double)sinf(af);
            const double den = lre * lre + lim * lim;
            const double fre = ((ar - 1.0) * lre + ai * lim) / den, fim = (ai * lre - (ar - 1.0) * lim) / den;
            const double br = b_re[(g * SP + p) * 16 + h], bi = b_im[(g * SP + p) * 16 + h];
            Bbr[e] = (float)(fre * br - fim * bi); Bbi[e] = (float)(fre * bi + fim * br);
            Cr[h * 64 + p] = c_re[(g * 16 + h) * SP + p]; Ci[h * 64 + p] = c_im[(g * 16 + h) * SP + p];
        }
        S5_BAR();
        float4 pv[32]; const int r0 = gw4 + nbat * step4; const bool has0 = first && r0 < T;
        if (has0) { norm4_load(xin + (size_t)r0 * DM, F.lane, pv); ++nbat; }
        if (hq == 0 && tid < 64) { AL[(g * 64 + tid) * 2] = Apr[32 * 64 + tid]; AL[(g * 64 + tid) * 2 + 1] = Api[32 * 64 + tid]; }
        if (tid < 128) {
            const int k = tid >> 2, hl = tid & 3, h = 4 * hq + hl;
            float acc[16];
#pragma unroll
            for (int q = 0; q < 16; ++q) acc[q] = 0.f;
            for (int p = 0; p < 64; ++p) {
                const float cr = Cr[h * 64 + p], ci = Ci[h * 64 + p], ar = Apr[k * 64 + p], ai = Api[k * 64 + p];
                const float gr = cr * ar - ci * ai, gi = cr * ai + ci * ar;
#pragma unroll
                for (int q = 0; q < 16; ++q) acc[q] += gr * Bbr[p * 16 + q] - gi * Bbi[p * 16 + q];
            }
#pragma unroll
            for (int q = 0; q < 16; ++q) Kk[tid * 16 + q] = acc[q];
        }
        S5_BAR();
        const float dk0 = dsk[g * 16 + 4 * hq], dk1 = dsk[g * 16 + 4 * hq + 1], dk2 = dsk[g * 16 + 4 * hq + 2], dk3 = dsk[g * 16 + 4 * hq + 3];
        if (has0) norm4_finish(pv, g3, XN + (size_t)r0 * DM, F.lane);
        const int r1 = gw4 + nbat * step4; const bool has1 = first && r1 < T;
        if (has1) { norm4_load(xin + (size_t)r1 * DM, F.lane, pv); ++nbat; }
        asm volatile("" ::: "memory");
        for (int e = tid; e < 128 * 80; e += NTHR) {
            const int rr = e / 80, k0 = (e - rr * 80) * 8; const int tau = rr >> 2, hl = rr & 3, h = 4 * hq + hl;
            float v[8];
            if (k0 < 512) { const int sg = k0 >> 4, hp0 = k0 & 15;
#pragma unroll
                for (int q = 0; q < 8; ++q) { float x = 0.f; if (sg <= tau) { x = Kk[(((tau - sg) << 2) + hl) * 16 + hp0 + q]; if (sg == tau && hp0 + q == h) x += (hl == 0 ? dk0 : hl == 1 ? dk1 : hl == 2 ? dk2 : dk3); } v[q] = x; } }
            else { const int kp = k0 - 512, ri = kp >> 6, p0 = kp & 63;
#pragma unroll
                for (int q = 0; q < 8; ++q) { const int p = p0 + q; const float ar = Apr[(tau + 1) * 64 + p], ai = Api[(tau + 1) * 64 + p];
                    const float gr = Cr[h * 64 + p] * ar - Ci[h * 64 + p] * ai, gi = Cr[h * 64 + p] * ai + Ci[h * 64 + p] * ar; v[q] = ri ? -gi : gr; } }
            v4u o; o.x = pk2(v[0], v[1]); o.y = pk2(v[2], v[3]); o.z = pk2(v[4], v[5]); o.w = pk2(v[6], v[7]);
            *(v4u*)(BtC + ((size_t)g * 512 + tau * 16 + h) * 640 + k0) = o;
        }
        for (int e = tid; e < 32 * 64; e += NTHR) {
            const int rr = e >> 6, k0 = (e & 63) * 8; const int ri = rr >> 4, p = 16 * hq + (rr & 15), sg = k0 >> 4, hp0 = k0 & 15;
            const float ar = Apr[(31 - sg) * 64 + p], ai = Api[(31 - sg) * 64 + p];
            float v[8];
#pragma unroll
            for (int q = 0; q < 8; ++q) { const float br = Bbr[p * 16 + hp0 + q], bi = Bbi[p * 16 + hp0 + q]; v[q] = ri ? (ar * bi + ai * br) : (ar * br - ai * bi); }
            v4u o; o.x = pk2(v[0], v[1]); o.y = pk2(v[2], v[3]); o.z = pk2(v[4], v[5]); o.w = pk2(v[6], v[7]);
            *(v4u*)(BtA + ((size_t)g * 256 + ri * 64 + p) * 512 + k0) = o;
        }
        if (has1) norm4_finish(pv, g3, XN + (size_t)r1 * DM, F.lane);
    }
    {
        float4 pv[32];
        for (int r = gw4 + nbat * step4; r < T; r += step4) { norm4_load(xin + (size_t)r * DM, F.lane, pv); norm4_finish(pv, g3, XN + (size_t)r * DM, F.lane); }
    }
#undef S5_BAR
    __syncthreads();
}
__device__ __forceinline__ void p_s5_stepA(const Frame& F, const Args& A) {
    pg8::Gemm g{WSB(WS_UCAT), WSB(WS_BTA), NCH, 256, 512, UCK, 512, (long)NCH * UCK, (long)256 * 512, SG}; pg8::StaticOrder S; S.init(NCH, 256, F.G, F.bid, SG);
    pg8::EpiSl E{WSF(WS_SL)}; GEMM_RUN(pg8::EpiSl, true, g, S, E);
}
__device__ __forceinline__ void p4_s5_scan(const Frame& F, const Args& A) {
    const float* Sl = WSF(WS_SL); const float* AL = WSF(WS_AL); bf16* UC = WSB(WS_UCAT);
    if (F.wave >= 4) return;
    pg8::StaticOrder S; S.init(NCH, 512, F.G, F.bid, SG); pg8::Unit u;
    for (int i = 0; S.next(i, u); ++i) {
        const int p = F.lane, b = u.pm * 4 + F.wave, g = u.bz;
        const float ar = AL[(g * 64 + p) * 2], ai = AL[(g * 64 + p) * 2 + 1];
        const size_t row0 = (size_t)g * NCH + b * 64;
        float lr[64], li[64];
#pragma unroll
        for (int c = 0; c < 64; ++c) { lr[c] = Sl[(row0 + c) * 128 + p]; li[c] = Sl[(row0 + c) * 128 + 64 + p]; }
        asm volatile("" ::: "memory");
        float sr = 0.f, si = 0.f;
#pragma unroll
        for (int c = 0; c < 64; ++c) {
            bf16* up = UC + (row0 + c) * UCK + 512;
            up[p] = (bf16)f2bf(sr); up[64 + p] = (bf16)f2bf(si);
            const float nr = ar * sr - ai * si + lr[c], ni = ar * si + ai * sr + li[c];
            sr = nr; si = ni;
        }
    }
}
__device__ __forceinline__ void p5_s5_out(const Frame& F, const Args& A) {
    pg8::Gemm g{WSB(WS_UCAT), WSB(WS_BTC), NCH, 512, UCK, UCK, UCK, (long)NCH * UCK, (long)512 * UCK, SG}; pg8::StaticOrder S; S.init(NCH, 512, F.G, F.bid, SG);
    pg8::EpiS5 E{WSB(WS_GB)}; GEMM_RUN(pg8::EpiS5, true, g, S, E);
}
__device__ __forceinline__ void p10_xscores(const Frame& F, const Args& A) {
    for (int sel = 0; sel * F.G + F.bid < 256; ++sel) {
        pg8::Gemm g{WSB(WS_XQB), WSB(WS_KP), 2048, 256, 256, XW, 256, 0, 0, 1}; pg8::XsOrder S{F.G, F.bid, sel};
        pg8::EpiXs E{WSB(WS_XP), WSF(WS_LSUM)};
        pg8::gemm_phase<pg8::EpiXs, pg8::XsOrder, false, true>(F.ldsl, g, S, E);
        __syncthreads();
    }
}
__device__ __forceinline__ void p10_xpv(const Frame& F, const Args& A) {
    pg8::Gemm g{WSB(WS_XP), WSB(WS_VT2), 2048, 256, 256, 1024, 512, 0, 0, 1}; pg8::XoOrder S{F.G, F.bid};
    pg8::EpiXo E{WSB(WS_XO), WSF(WS_LSUM)};
    pg8::gemm_phase<pg8::EpiXo, pg8::XoOrder, true, true>(F.ldsl, g, S, E);
}
__device__ __forceinline__ unsigned f2key(float f) { const unsigned u = __float_as_uint(f); return (u & 0x80000000u) ? ~u : (u | 0x80000000u); }
__device__ __forceinline__ float key2f(unsigned k) { const unsigned u = (k & 0x80000000u) ? (k ^ 0x80000000u) : ~k; return __uint_as_float(u); }
#define INS16(L, xk) do { unsigned x_ = (xk); _Pragma("unroll") for (int s_ = 0; s_ < 16; ++s_) { const unsigned hi_ = L[s_] > x_ ? L[s_] : x_; x_ = L[s_] > x_ ? x_ : L[s_]; L[s_] = hi_; } } while (0)
#define CE_DESC(a_, b_) do { const unsigned hi_ = (a_) > (b_) ? (a_) : (b_), lo_ = (a_) > (b_) ? (b_) : (a_); (a_) = hi_; (b_) = lo_; } while (0)
__device__ __forceinline__ void sort16_desc(unsigned (&v)[16]) {
#pragma unroll
    for (int k = 2; k <= 16; k <<= 1)
#pragma unroll
        for (int j = k >> 1; j > 0; j >>= 1)
#pragma unroll
            for (int i = 0; i < 16; ++i) { const int l = i ^ j; if (l > i) { if ((i & k) == 0) CE_DESC(v[i], v[l]); else CE_DESC(v[l], v[i]); } }
}
__device__ __forceinline__ void merge16_desc(unsigned (&a)[16], const unsigned (&b)[16]) {
#pragma unroll
    for (int i = 0; i < 16; ++i) a[i] = a[i] > b[15 - i] ? a[i] : b[15 - i];
#pragma unroll
    for (int j = 8; j > 0; j >>= 1)
#pragma unroll
        for (int i = 0; i < 16; ++i) { const int l = i ^ j; if (l > i) CE_DESC(a[i], a[l]); }
}
__device__ __forceinline__ void top16_of_128(const float* sp, unsigned (&L)[16]) {
#pragma unroll 1
    for (int c = 0; c < 8; ++c) {
        unsigned ch[16];
#pragma unroll
        for (int i = 0; i < 16; ++i) ch[i] = (f2key(sp[(size_t)(c * 16 + i) * T]) & ~127u) | (unsigned)(127 - (c * 16 + i));
        sort16_desc(ch);
        if (c == 0) {
#pragma unroll
            for (int i = 0; i < 16; ++i) L[i] = ch[i];
        } else merge16_desc(L, ch);
    }
}
namespace pg8 {
struct TkOrder {
    int G, c, sel;
    __device__ __forceinline__ bool next(int i, Unit& u) const { if (i > 0) return false; const int L = sel * G + c; if (L >= PH * (T / BM)) return false; u.pm = 0; u.pn = L & (T / BM - 1); u.bz = L / (T / BM); return true; }
    __device__ __forceinline__ void a_ready(const Unit&) const {}
    __device__ __forceinline__ void done(const Unit&) const {}
    template <class G_> __device__ __forceinline__ long offA(const Unit& u, const G_& g) const { return (long)u.bz * g.sA; }
    template <class G_> __device__ __forceinline__ long offB(const Unit& u, const G_& g) const { return (long)u.bz * g.sB; }
};
struct EpiTopk {
    static constexpr bool PERM = false, AFTER_DRAIN = true;
    static constexpr int PITCH = 260;
    unsigned short* IDX; float* GATE;
    __device__ __forceinline__ void stage(const f32x4 (&acc)[2][2][4][2], int ai, int wr, int wc, int fr, int fq, PG8_LAS float* SCL) const {
#pragma unroll
        for (int m = 0; m < 4; ++m)
#pragma unroll
            for (int bj = 0; bj < 2; ++bj)
#pragma unroll
                for (int n = 0; n < 2; ++n) *(PG8_LAS f32x4*)(SCL + (wr * 64 + m * 16 + fr) * PITCH + bj * HALF + wc * 32 + n * 16 + 4 * fq) = acc[ai][bj][m][n];
    }
    static __device__ __forceinline__ unsigned blend(unsigned m, unsigned a, unsigned b) { return (a & m) | (b & ~m); }
    static __device__ __forceinline__ unsigned swap1(unsigned v) { return (unsigned)__builtin_amdgcn_update_dpp(0, (int)v, 0xB1, 0xF, 0xF, true); }
    __device__ __forceinline__ void top16(const PG8_LAS float* sp, int nb, unsigned (&L)[16]) const {
#pragma unroll 1
        for (int c = 0; c < 4; ++c) {
            unsigned ch[16];
#pragma unroll
            for (int i = 0; i < 16; ++i) ch[i] = (f2key(sp[(c * 16 + i) * PITCH]) & ~127u) | (unsigned)(nb - (c * 16 + i));
            sort16_desc(ch);
            if (c == 0) {
#pragma unroll
                for (int i = 0; i < 16; ++i) L[i] = ch[i];
            } else merge16_desc(L, ch);
        }
        unsigned P[16];
#pragma unroll
        for (int i = 0; i < 16; ++i) P[i] = swap1(L[i]);
        merge16_desc(L, P);
    }
    __device__ __forceinline__ void fused(f32x4 (&acc)[2][2][4][2], const Unit& u, int wr, int wc, int fr, int fq, PG8_LAS unsigned char* lds, int wid, int lane) const {
        PG8_LAS float* SCL = (PG8_LAS float*)lds;
        int ln = lane; asm volatile("" : "+v"(ln));
        const int tl = wid * 32 + (ln >> 1), kh = ln & 1; const unsigned km = 0u - (unsigned)kh;
        PG8_LAS unsigned char* li = lds + PK * PITCH * 4 + tl * 32;
        const PG8_LAS float* col = SCL + tl;
        float t1[16], t2[16];
        stage(acc, 0, wr, wc, fr, fq, SCL);
        asm volatile("s_waitcnt lgkmcnt(0)" ::: "memory"); __builtin_amdgcn_s_barrier(); asm volatile("" ::: "memory");
        { unsigned L1[16]; top16(col + kh * 64 * PITCH, 127 - kh * 64, L1);
#pragma unroll
          for (int s = 0; s < 16; ++s) { const int i1 = 127 - (int)(L1[s] & 127u); if (kh == 0) li[s] = (unsigned char)i1; t1[s] = col[i1 * PITCH]; } }
        asm volatile("s_waitcnt lgkmcnt(0)" ::: "memory"); __builtin_amdgcn_s_barrier(); asm volatile("" ::: "memory");
        stage(acc, 1, wr, wc, fr, fq, SCL);
        asm volatile("s_waitcnt lgkmcnt(0)" ::: "memory"); __builtin_amdgcn_s_barrier(); asm volatile("" ::: "memory");
        { unsigned L2[16]; top16(col + kh * 64 * PITCH, 127 - kh * 64, L2);
#pragma unroll
          for (int s = 0; s < 16; ++s) { const int i2 = 127 - (int)(L2[s] & 127u); if (kh == 0) li[16 + s] = (unsigned char)i2; t2[s] = col[i2 * PITCH]; } }
        unsigned Lc[16], c1[16];
        {
            int n = 0;
#pragma unroll
            for (int a = 0; a < 16; ++a)
#pragma unroll
                for (int m = 0; m < 8; ++m)
                    if ((a + 1) * (2 * m + 1) <= 16) {
                        const bool odd_ok = (a + 1) * (2 * m + 2) <= 16;
                        const float tb = __uint_as_float(blend(km, __float_as_uint(t2[(2 * m + 1) & 15]), __float_as_uint(t2[2 * m])));
                        unsigned k = (f2key(t1[a] + tb) & ~255u) | (unsigned)((255 - (a * 16 + 2 * m)) - kh);
                        if (!odd_ok) k = kh ? 0u : k;
                        if (n < 16) Lc[n] = k; else c1[n - 16] = k; ++n; }
            c1[14] = 0u; c1[15] = 0u;
        }
        sort16_desc(Lc); sort16_desc(c1); merge16_desc(Lc, c1);
        {
            unsigned P[16];
#pragma unroll
            for (int i = 0; i < 16; ++i) P[i] = swap1(Lc[i]);
            merge16_desc(Lc, P);
        }
        float ts[16]; const float mx = key2f(Lc[0] & ~255u); float sum = 0.f;
#pragma unroll
        for (int s = 0; s < 16; ++s) { ts[s] = expf(key2f(Lc[s] & ~255u) - mx); sum += ts[s]; }
        const float inv = 1.0f / sum;
        const size_t ob = (size_t)(u.pn * BM + tl) * 128 + u.bz * 16 + kh * 8;
        asm volatile("s_waitcnt lgkmcnt(0)" ::: "memory");
#pragma unroll
        for (int s = 0; s < 8; ++s) {
            const unsigned key = blend(km, Lc[8 + s], Lc[s]); const float tv = __uint_as_float(blend(km, __float_as_uint(ts[8 + s]), __float_as_uint(ts[s])));
            const int flat = 255 - (int)(key & 255u); const int a = flat >> 4, b = flat & 15;
            const int e1 = li[a], e2 = li[16 + b];
            IDX[ob + s] = (unsigned short)(e1 * PK + e2);
            GATE[ob + s] = tv * inv;
        }
    }
};
}

struct PeerCtx { int xr, nx, nloc, rank; };
__device__ __forceinline__ PeerCtx peer_ctx(const Frame& F, volatile LAS unsigned* MISC) {
    if (F.tid == 0) {
        unsigned* barw = (unsigned*)(F.ws + WS_CTL) + CW_BAR; const unsigned x = MISC[11];
        unsigned nx = 0, xr = 0, nloc = 1;
        for (unsigned j = 0; j < 16; ++j) { const unsigned c = xb_ld(&barw[XB_XCNT(j)]); if (c) { ++nx; if (j < x) ++xr; } if (j == x) nloc = c ? c : 1u; }
        MISC[12] = xr; MISC[13] = nx ? nx : 1u; MISC[14] = nloc;
    }
    __syncthreads();
    PeerCtx c; c.xr = (int)MISC[12]; c.nx = (int)MISC[13]; c.nloc = (int)MISC[14]; c.rank = (int)MISC[10];
    return c;
}
typedef __bf16 bf16x2 __attribute__((ext_vector_type(2)));
__device__ __forceinline__ float dot2_bf16(unsigned w, unsigned x, float acc) { return __builtin_amdgcn_fdot2_f32_bf16(__builtin_bit_cast(bf16x2, w), __builtin_bit_cast(bf16x2, x), acc, false); }
__device__ __forceinline__ float dot8(const v4u& r, const v4u& x) { float a = dot2_bf16(r.x, x.x, 0.f); a = dot2_bf16(r.y, x.y, a); a = dot2_bf16(r.z, x.z, a); return dot2_bf16(r.w, x.w, a); }
__device__ __forceinline__ float xl1(float x) { return __uint_as_float((unsigned)__builtin_amdgcn_update_dpp(0, (int)__float_as_uint(x), 0xB1, 0xF, 0xF, true)); }
__device__ __forceinline__ float xl2(float x) { return __uint_as_float((unsigned)__builtin_amdgcn_update_dpp(0, (int)__float_as_uint(x), 0x4E, 0xF, 0xF, true)); }
__device__ __forceinline__ float xl4(float x) { const int v = (int)__float_as_uint(x); int r = __builtin_amdgcn_update_dpp(0, v, 0x104, 0xF, 0x5, false); r = __builtin_amdgcn_update_dpp(r, v, 0x114, 0xF, 0xA, false); return __uint_as_float((unsigned)r); }
__device__ __forceinline__ float xl8(float x) { return __uint_as_float((unsigned)__builtin_amdgcn_update_dpp(0, (int)__float_as_uint(x), 0x128, 0xF, 0xF, true)); }
__device__ __forceinline__ float sum16x(float a, float b) { const auto r = __builtin_amdgcn_permlane16_swap(__float_as_uint(a), __float_as_uint(b), false, false); return __uint_as_float(r[0]) + __uint_as_float(r[1]); }
__device__ __forceinline__ float sum32x(float a, float b) { const auto r = __builtin_amdgcn_permlane32_swap(__float_as_uint(a), __float_as_uint(b), false, false); return __uint_as_float(r[0]) + __uint_as_float(r[1]); }
__device__ __forceinline__ float wave_sum_valu(float x) {
    x += xl1(x); x += xl2(x);
    x += __uint_as_float((unsigned)__builtin_amdgcn_update_dpp(0, (int)__float_as_uint(x), 0x141, 0xF, 0xF, true));
    x += __uint_as_float((unsigned)__builtin_amdgcn_update_dpp(0, (int)__float_as_uint(x), 0x140, 0xF, 0xF, true));
    x = sum16x(x, x); return sum32x(x, x);
}
#define RED8J(v0, v1, v2, v3, v4, v5, v6, v7, B2, B1, B0, out) do { \
    const float a0_ = ((B2) ? v4 : v0) + xl4((B2) ? v0 : v4), a1_ = ((B2) ? v5 : v1) + xl4((B2) ? v1 : v5); \
    const float a2_ = ((B2) ? v6 : v2) + xl4((B2) ? v2 : v6), a3_ = ((B2) ? v7 : v3) + xl4((B2) ? v3 : v7); \
    const float c0_ = ((B1) ? a2_ : a0_) + xl2((B1) ? a0_ : a2_), c1_ = ((B1) ? a3_ : a1_) + xl2((B1) ? a1_ : a3_); \
    out = ((B0) ? c1_ : c0_) + xl1((B0) ? c0_ : c1_); } while (0)
__device__ __forceinline__ int xi1(int x) { return __builtin_amdgcn_update_dpp(0, x, 0xB1, 0xF, 0xF, true); }
__device__ __forceinline__ int xi2(int x) { return __builtin_amdgcn_update_dpp(0, x, 0x4E, 0xF, 0xF, true); }
__device__ __forceinline__ int xi4(int x) { int r = __builtin_amdgcn_update_dpp(0, x, 0x104, 0xF, 0x5, false); return __builtin_amdgcn_update_dpp(r, x, 0x114, 0xF, 0xA, false); }
#define RED8JI(v0, v1, v2, v3, v4, v5, v6, v7, B2, B1, B0, out) do { \
    const int a0_ = ((B2) ? v4 : v0) + xi4((B2) ? v0 : v4), a1_ = ((B2) ? v5 : v1) + xi4((B2) ? v1 : v5); \
    const int a2_ = ((B2) ? v6 : v2) + xi4((B2) ? v2 : v6), a3_ = ((B2) ? v7 : v3) + xi4((B2) ? v3 : v7); \
    const int c0_ = ((B1) ? a2_ : a0_) + xi2((B1) ? a0_ : a2_), c1_ = ((B1) ? a3_ : a1_) + xi2((B1) ? a1_ : a3_); \
    out = ((B0) ? c1_ : c0_) + xi1((B0) ? c0_ : c1_); } while (0)
#define RED8G(v0, v1, v2, v3, v4, v5, v6, v7, B0, out) do { \
    const float a0_ = sum32x(v0, v4), a1_ = sum32x(v1, v5), a2_ = sum32x(v2, v6), a3_ = sum32x(v3, v7); \
    const float c0_ = sum16x(a0_, a2_), c1_ = sum16x(a1_, a3_); \
    out = ((B0) ? c1_ : c0_) + xl8((B0) ? c0_ : c1_); } while (0)
#define RED8(v0, v1, v2, v3, v4, v5, v6, v7, B2, B1, B0, X2, X1, X0, out) do { \
    const float a0_ = ((B2) ? v4 : v0) + __shfl_xor((B2) ? v0 : v4, X2), a1_ = ((B2) ? v5 : v1) + __shfl_xor((B2) ? v1 : v5, X2); \
    const float a2_ = ((B2) ? v6 : v2) + __shfl_xor((B2) ? v2 : v6, X2), a3_ = ((B2) ? v7 : v3) + __shfl_xor((B2) ? v3 : v7, X2); \
    const float c0_ = ((B1) ? a2_ : a0_) + __shfl_xor((B1) ? a0_ : a2_, X1), c1_ = ((B1) ? a3_ : a1_) + __shfl_xor((B1) ? a1_ : a3_, X1); \
    out = ((B0) ? c1_ : c0_) + __shfl_xor((B0) ? c0_ : c1_, X0); } while (0)
typedef float f32x2 __attribute__((ext_vector_type(2)));
struct PTok { unsigned ix[8]; v4u xa, xb; float oa, ob; };
#define PK_IDX(TK, k) (((k) & 1) ? (TK.ix[(k) >> 1] >> 16) : (TK.ix[(k) >> 1] & 0xffffu))
#define LD_IDX16(TK, ip_) do { _Pragma("unroll") for (int q_ = 0; q_ < 2; ++q_) { const int4 v_ = (ip_)[q_]; TK.ix[4 * q_] = (unsigned)v_.x; TK.ix[4 * q_ + 1] = (unsigned)v_.y; TK.ix[4 * q_ + 2] = (unsigned)v_.z; TK.ix[4 * q_ + 3] = (unsigned)v_.w; } } while (0)
__device__ __forceinline__ float dot16_fp8(const v4u& r, const f32x2 (&X)[8]) {
    f32x2 a = {0.f, 0.f};
#pragma unroll
    for (int q = 0; q < 4; ++q) { const f32x2 lo = __builtin_amdgcn_cvt_pk_f32_fp8((int)r[q], false), hi = __builtin_amdgcn_cvt_pk_f32_fp8((int)r[q], true);
        a = lo * X[2 * q] + a; a = hi * X[2 * q + 1] + a; }
    return a.x + a.y;
}
__device__ __forceinline__ void p17_peer_u(const Frame& F, const Args& A, volatile LAS unsigned* MISC) {
    const PeerCtx cx = peer_ctx(F, MISC);
    const unsigned char* UB = F.ws + WS_UB; const bf16* HB = WSB(WS_B); const unsigned short* IDX = (const unsigned short*)(F.ws + WS_IDX); float* PACT = WSF(WS_PACT) + (size_t)cx.xr * T * 128;
    const int lane = F.lane, j = lane & 7, g = lane >> 3;
    const bool b2 = lane & 4, b1 = lane & 2, b0 = lane & 1;
    const int NI = (T / 8 - cx.rank + cx.nloc - 1) / cx.nloc;
#define U_TOK(i_) (((cx.rank + (i_) * cx.nloc) * 8) + F.wave)
    for (int p = 0; cx.xr + cx.nx * p < NSL; ++p) {
        const int s = cx.xr + cx.nx * p;
        const __amdgpu_buffer_rsrc_t rs = __builtin_amdgcn_make_buffer_rsrc((void*)(UB + (size_t)s * (PK * PK) * SLW), 0, PK * PK * SLW, 0x00020000);
#define U_LOAD(TK, t_) do { const int4* ip_ = (const int4*)(IDX + (size_t)(t_) * 128 + 16 * g); LD_IDX16(TK, ip_); \
        TK.xa = *(const v4u*)(HB + (size_t)(t_) * DM + s * SLW + j * 16); TK.xb = *(const v4u*)(HB + (size_t)(t_) * DM + s * SLW + j * 16 + 8); \
        TK.oa = 0.f; TK.ob = 0.f; if (p != 0) { const float2 pp_ = *(const float2*)(PACT + (size_t)(t_) * 128 + 16 * g + 2 * j); TK.oa = pp_.x; TK.ob = pp_.y; } } while (0)
#define U_GATHER(R, TK) do { _Pragma("unroll") for (int k = 0; k < 16; ++k) R[k] = __builtin_amdgcn_raw_buffer_load_b128(rs, ((unsigned)PK_IDX(TK, k) << 7) + (unsigned)(j * 16), 0, 0); } while (0)
#define U_COMPUTE(R, XA_, XB_, OA, OB, t_) do { \
          \
        float xf_[16]; _Pragma("unroll") for (int q = 0; q < 4; ++q) { xf_[2 * q] = __uint_as_float(XA_[q] << 16); xf_[2 * q + 1] = __uint_as_float(XA_[q] & 0xffff0000u); xf_[8 + 2 * q] = __uint_as_float(XB_[q] << 16); xf_[8 + 2 * q + 1] = __uint_as_float(XB_[q] & 0xffff0000u); } \
        float am_ = 0.f; _Pragma("unroll") for (int q = 0; q < 16; ++q) am_ = fmaxf(am_, fabsf(xf_[q])); \
        am_ = fmaxf(am_, xl1(am_)); am_ = fmaxf(am_, xl2(am_)); am_ = fmaxf(am_, xl4(am_)); \
        const float qs_ = am_ > 1e-30f ? 127.0f / am_ : 0.0f, XS_ = am_ * (1.0f / 127.0f); \
        unsigned XA[4]; _Pragma("unroll") for (int d = 0; d < 4; ++d) { const int a0 = (int)__builtin_rintf(xf_[4 * d] * qs_), a1 = (int)__builtin_rintf(xf_[4 * d + 1] * qs_), a2 = (int)__builtin_rintf(xf_[4 * d + 2] * qs_), a3 = (int)__builtin_rintf(xf_[4 * d + 3] * qs_); \
            XA[d] = (unsigned)(a0 & 255) | ((unsigned)(a1 & 255) << 8) | ((unsigned)(a2 & 255) << 16) | ((unsigned)a3 << 24); } \
        int v[16]; _Pragma("unroll") for (int k = 0; k < 16; ++k) { int a_ = __builtin_amdgcn_sdot4((int)R[k][0], (int)XA[0], 0, false); a_ = __builtin_amdgcn_sdot4((int)R[k][1], (int)XA[1], a_, false); \
            a_ = __builtin_amdgcn_sdot4((int)R[k][2], (int)XA[2], a_, false); v[k] = __builtin_amdgcn_sdot4((int)R[k][3], (int)XA[3], a_, false); } \
        int ie_, io_; \
        RED8JI(v[0], v[2], v[4], v[6], v[8], v[10], v[12], v[14], b2, b1, b0, ie_); \
        RED8JI(v[1], v[3], v[5], v[7], v[9], v[11], v[13], v[15], b2, b1, b0, io_); \
        *(float2*)(PACT + (size_t)(t_) * 128 + 16 * g + 2 * j) = make_float2(OA + (float)ie_ * XS_, OB + (float)io_ * XS_); } while (0)
        PTok TA, TB; v4u RA[16], RB[16];
        if (NI > 0) U_LOAD(TA, U_TOK(0));
        if (NI > 1) U_LOAD(TB, U_TOK(1));
        if (NI > 0) U_GATHER(RA, TA);
        for (int i = 0; i < NI; i += 2) {
            { const v4u xa = TA.xa, xb = TA.xb; const float oa = TA.oa, ob = TA.ob;
              if (i + 2 < NI) U_LOAD(TA, U_TOK(i + 2));
              if (i + 1 < NI) U_GATHER(RB, TB);
              U_COMPUTE(RA, xa, xb, oa, ob, U_TOK(i)); }
            if (i + 1 < NI) {
                const v4u xa = TB.xa, xb = TB.xb; const float oa = TB.oa, ob = TB.ob;
                if (i + 3 < NI) U_LOAD(TB, U_TOK(i + 3));
                if (i + 2 < NI) U_GATHER(RA, TA);
                U_COMPUTE(RB, xa, xb, oa, ob, U_TOK(i + 1));
            }
        }
    }
#undef U_LOAD
#undef U_GATHER
#undef U_COMPUTE
#undef U_TOK
}
__device__ __forceinline__ void p18_peer_w(const Frame& F, const Args& A, volatile LAS unsigned* MISC) {
    const PeerCtx cx = peer_ctx(F, MISC);
    const float* PACT = WSF(WS_PACT); const float* GATE = WSF(WS_GATE); unsigned short* W = (unsigned short*)(F.ws + WS_PW);            const unsigned short* IDX = (const unsigned short*)(F.ws + WS_IDX);
    const float* iu = WSF(WS_ISCU); const float* iv = WSF(WS_ISCV); const float* ssq2 = WSF(WS_SSQ2);
    const size_t gt = (size_t)F.bid * NTHR + F.tid, NGT = (size_t)F.G * NTHR;
    for (size_t i = gt * 4; i < (size_t)T * 128; i += NGT * 4) {
        float4 a = make_float4(0.f, 0.f, 0.f, 0.f);
        for (int q0 = 0; q0 < cx.nx; q0 += 8) {
            float4 pa[8];
#pragma unroll
            for (int j = 0; j < 8; ++j) pa[j] = (q0 + j < cx.nx) ? *(const float4*)(PACT + (size_t)(q0 + j) * T * 128 + i) : make_float4(0.f, 0.f, 0.f, 0.f);
#pragma unroll
            for (int j = 0; j < 8; ++j) { a.x += pa[j].x; a.y += pa[j].y; a.z += pa[j].z; a.w += pa[j].w; }
        }
        const uint2 e2_ = *(const uint2*)(IDX + i); const int4 e = make_int4((int)(e2_.x & 0xffffu), (int)(e2_.x >> 16), (int)(e2_.y & 0xffffu), (int)(e2_.y >> 16)); const float4 gt4 = *(const float4*)(GATE + i);
        const float rs = 1.0f / sqrtf(ssq2[i >> 7] * (1.0f / 2048.0f) + EPS);
        float4 w;
        w.x = gt4.x * gelu_exact(a.x * iu[e.x] * rs) * iv[e.x]; w.y = gt4.y * gelu_exact(a.y * iu[e.y] * rs) * iv[e.y];
        w.z = gt4.z * gelu_exact(a.z * iu[e.z] * rs) * iv[e.z]; w.w = gt4.w * gelu_exact(a.w * iu[e.w] * rs) * iv[e.w];
        *(uint2*)(W + i) = make_uint2(pk2(w.x, w.y), pk2(w.z, w.w));
    }
}
struct VTok { unsigned ix[8]; unsigned w[8]; float h0, h1; };
__device__ __forceinline__ void p19_peer_v(const Frame& F, const Args& A, volatile LAS unsigned* MISC) {
    const PeerCtx cx = peer_ctx(F, MISC);
    const unsigned char* VT = F.ws + WS_VT;
    const __amdgpu_buffer_rsrc_t rsI = __builtin_amdgcn_make_buffer_rsrc((void*)(F.ws + WS_IDX), 0, T * 128 * 2, 0x00020000);
    const __amdgpu_buffer_rsrc_t rsW = __builtin_amdgcn_make_buffer_rsrc((void*)(F.ws + WS_PW), 0, T * 128 * 2, 0x00020000);
    const __amdgpu_buffer_rsrc_t rsHB = __builtin_amdgcn_make_buffer_rsrc((void*)(F.ws + WS_B), 0, T * DM * 2, 0x00020000);
    const int lane = F.lane, j = lane & 7, g = lane >> 3;
    const bool b5 = lane & 32, b4 = lane & 16, b3 = lane & 8;
    const int NI = (T / 8 - cx.rank + cx.nloc - 1) / cx.nloc;
#define U_TOK(i_) (((cx.rank + (i_) * cx.nloc) * 8) + F.wave)
    for (int p = 0; cx.xr + cx.nx * p < NSL; ++p) {
        const int s = cx.xr + cx.nx * p;
        const __amdgpu_buffer_rsrc_t rs = __builtin_amdgcn_make_buffer_rsrc((void*)(VT + (size_t)s * (PK * PK) * SLW), 0, PK * PK * SLW, 0x00020000);
        const unsigned hoff = (unsigned)(s * SLW + 16 * j + 2 * g) * 2u;
#define V_LOAD(TK, t_) do { const unsigned io_ = ((unsigned)(t_) * 128u + 16u * g) * 2u; \
        _Pragma("unroll") for (int q_ = 0; q_ < 2; ++q_) { const v4u v_ = __builtin_amdgcn_raw_buffer_load_b128(rsI, io_ + 16u * q_, 0, 0); TK.ix[4 * q_] = v_[0]; TK.ix[4 * q_ + 1] = v_[1]; TK.ix[4 * q_ + 2] = v_[2]; TK.ix[4 * q_ + 3] = v_[3]; } \
        _Pragma("unroll") for (int q_ = 0; q_ < 2; ++q_) { const v4u v_ = __builtin_amdgcn_raw_buffer_load_b128(rsW, io_ + 16u * q_, 0, 0); TK.w[4 * q_] = v_[0]; TK.w[4 * q_ + 1] = v_[1]; TK.w[4 * q_ + 2] = v_[2]; TK.w[4 * q_ + 3] = v_[3]; } \
        const unsigned hb_ = (unsigned)(t_) * (DM * 2u) + hoff; const unsigned hw_ = (unsigned)__builtin_amdgcn_raw_buffer_load_b32(rsHB, hb_, 0, 0); TK.h0 = __uint_as_float(hw_ << 16); TK.h1 = __uint_as_float(hw_ & 0xffff0000u); } while (0)
#define V_GATHER(R, TK) do { _Pragma("unroll") for (int k = 0; k < 16; ++k) R[k] = __builtin_amdgcn_raw_buffer_load_b128(rs, ((unsigned)PK_IDX(TK, k) << 7) + (unsigned)(j * 16), 0, 0); } while (0)
#define V_COMPUTE(R, WQ, H0, H1, t_) do { f32x2 acc[8]; _Pragma("unroll") for (int q = 0; q < 8; ++q) acc[q] = (f32x2){0.f, 0.f}; \
        _Pragma("unroll") for (int k = 0; k < 16; ++k) { const unsigned wd_ = WQ[k >> 1]; const float wk_ = __uint_as_float((k & 1) ? (wd_ & 0xffff0000u) : (wd_ << 16)); const f32x2 w2 = (f32x2){wk_, wk_}; \
            _Pragma("unroll") for (int q = 0; q < 4; ++q) { const f32x2 lo = __builtin_amdgcn_cvt_pk_f32_fp8((int)R[k][q], false), hi = __builtin_amdgcn_cvt_pk_f32_fp8((int)R[k][q], true); \
                acc[2 * q] = lo * w2 + acc[2 * q]; acc[2 * q + 1] = hi * w2 + acc[2 * q + 1]; } } \
        float f0_, f1_; \
        RED8G(acc[0].x, acc[1].x, acc[2].x, acc[3].x, acc[4].x, acc[5].x, acc[6].x, acc[7].x, b3, f0_); \
        RED8G(acc[0].y, acc[1].y, acc[2].y, acc[3].y, acc[4].y, acc[5].y, acc[6].y, acc[7].y, b3, f1_); \
        const unsigned hb2_ = (unsigned)(t_) * (DM * 2u) + hoff; const float n0_ = H0 + f0_, n1_ = H1 + f1_; \
        __builtin_amdgcn_raw_buffer_store_b32(pk2(n0_, n1_), rsHB, hb2_, 0, 0); \
        } while (0)
        VTok TA, TB; v4u RA[16], RB[16];
        if (NI > 0) V_LOAD(TA, U_TOK(0));
        if (NI > 1) V_LOAD(TB, U_TOK(1));
        if (NI > 0) V_GATHER(RA, TA);
        for (int i = 0; i < NI; i += 2) {
            { const float h0 = TA.h0, h1 = TA.h1; unsigned wv[8];
              _Pragma("unroll") for (int q = 0; q < 8; ++q) wv[q] = TA.w[q];
              if (i + 2 < NI) V_LOAD(TA, U_TOK(i + 2));
              if (i + 1 < NI) V_GATHER(RB, TB);
              V_COMPUTE(RA, wv, h0, h1, U_TOK(i)); }
            if (i + 1 < NI) {
                const float h0 = TB.h0, h1 = TB.h1; unsigned wv[8];
                _Pragma("unroll") for (int q = 0; q < 8; ++q) wv[q] = TB.w[q];
                if (i + 3 < NI) V_LOAD(TB, U_TOK(i + 3));
                if (i + 2 < NI) V_GATHER(RA, TA);
                V_COMPUTE(RB, wv, h0, h1, U_TOK(i + 1));
            }
        }
    }
#undef V_LOAD
#undef V_GATHER
#undef V_COMPUTE
#undef U_TOK
}
__device__ __forceinline__ void p20_final(const Frame& F, const Args& A) {
    float* O = F.out; const bf16* HB = WSB(WS_B); const float* fg = IN_F(33);
    const int gw = F.bid * NWAVES + F.wave, NGW = F.G * NWAVES, lane = F.lane;
    for (int t = gw; t < T; t += NGW) {
        v4u h[4]; float sq = 0.f;
#pragma unroll
        for (int q = 0; q < 4; ++q) h[q] = *(const v4u*)(HB + (size_t)t * DM + 512 * q + 8 * lane);
#pragma unroll
        for (int q = 0; q < 4; ++q)
#pragma unroll
            for (int e = 0; e < 4; ++e) { const float a = __uint_as_float(h[q][e] << 16), b = __uint_as_float(h[q][e] & 0xffff0000u); sq += a * a + b * b; }
        sq = wave_sum_valu(sq);
        const float r = 1.0f / sqrtf(sq / (float)DM + EPS);
#pragma unroll
        for (int q = 0; q < 4; ++q) { const int c = 512 * q + 8 * lane;
            const float4 g0 = *(const float4*)(fg + c), g1 = *(const float4*)(fg + c + 4);
            ntst4(O + (size_t)t * DM + c, make_float4(__uint_as_float(h[q].x << 16) * r * g0.x, __uint_as_float(h[q].x & 0xffff0000u) * r * g0.y, __uint_as_float(h[q].y << 16) * r * g0.z, __uint_as_float(h[q].y & 0xffff0000u) * r * g0.w));
            ntst4(O + (size_t)t * DM + c + 4, make_float4(__uint_as_float(h[q].z << 16) * r * g1.x, __uint_as_float(h[q].z & 0xffff0000u) * r * g1.y, __uint_as_float(h[q].w << 16) * r * g1.z, __uint_as_float(h[q].w & 0xffff0000u) * r * g1.w)); }
    }
}
__device__ __forceinline__ void p0_prep(const Frame& F, const Args& A) {
    const int gw = F.bid * NWAVES + F.wave, NGW = F.G * NWAVES, lane = F.lane;
    LAS float* scr = (LAS float*)(F.ldsl + F.wave * 16384);
    constexpr int I_IN = 32 * 128, I_GLU = 16 * 32, I_OUT = 32 * 64, I_XQ = 32 * 16, I_XKV = 32 * 32, I_XO = 8 * 64, I_PQ = 32 * 64;
    constexpr int NITEMS = I_IN + I_GLU + I_OUT + I_XQ + I_XKV + I_XO + I_PQ;
    for (int it = gw; it < NITEMS; it += NGW) {
        int r = it;
        if (r < I_IN) { p0_transpose_item(IN_F(4), DM, INC, WSB(WS_WIN), 0, scr, r, lane); continue; } r -= I_IN;
        if (r < I_GLU) { p0_transpose_item(IN_F(18), SSMW, SSMW, WSB(WS_WGLU), 0, scr, r, lane); continue; } r -= I_GLU;
        if (r < I_OUT) { p0_transpose_item(IN_F(21), DM, DM, WSB(WS_WOUT), 0, scr, r, lane, IN_F(20), 1024); continue; } r -= I_OUT;
        if (r < I_XQ) { p0_transpose_item(IN_F(24), DM, XW, WSB(WS_WXQ), 0, scr, r, lane, IN_F(22)); continue; } r -= I_XQ;
        if (r < I_XKV) { p0_transpose_item(IN_F(25), DM, 2 * XW, WSB(WS_WXKV), 0, scr, r, lane); continue; } r -= I_XKV;
        if (r < I_XO) { p0_transpose_item(IN_F(26), XW, DM, WSB(WS_WXO), 0, scr, r, lane); continue; } r -= I_XO;
        p0_transpose_item(IN_F(28), DM, PH * PQD, WSB(WS_WPQ), 0, scr, r, lane, IN_F(27));
    }
    const float* x = IN_F(0); const float* mem = IN_F(1);
    { const float* g3 = IN_F(3); bf16* XN = WSB(WS_B);
      (void)x; (void)g3; (void)XN; }
    { const float* g23 = IN_F(23); bf16* MN = WSB(WS_MN);
      for (int r = 2 * gw; r < BATCH * NMEM; r += 2 * NGW) { norm_2rows_to_bf16(mem + (size_t)r * DM, g23, MN + (size_t)r * DM, lane); } }
    const int* pos = IN_I(2); float* rope = WSF(WS_ROPE);
    const int gt = F.bid * NTHR + F.tid, NGT = F.G * NTHR;
    for (int e = gt; e < T * 8; e += NGT) {
        const int t = e >> 3, i = e & 7;
        const float freq = expf(-(float)i * (13.122363377404328f / 8.0f));
        const float a = (float)pos[t] * freq;
        rope[e * 2 + 0] = cosf(a); rope[e * 2 + 1] = sinf(a);
    }
    if (gt == 0) {
        const float* q1 = IN_F(5); const float* k1 = IN_F(6); const float* q2 = IN_F(7); const float* k2 = IN_F(8);
        float s1 = 0.f, s2 = 0.f;
        for (int i = 0; i < 64; ++i) { s1 += q1[i] * k1[i]; s2 += q2[i] * k2[i]; }
        *WSF(WS_LAM) = expf(s1) - expf(s2) + LAM_INIT;
    }
    bf16* KD = WSB(WS_KD); const float* k1 = IN_F(29); const float* k2 = IN_F(30);
    for (int e = gt; e < PH * 256 * 256; e += NGT) {
        const int kk = e & 255, nn = (e >> 8) & 255, h = e >> 16;
        float v = 0.f;
        if ((kk >> 7) == (nn >> 7)) { const float* ks = (nn >> 7) ? k2 : k1; v = ks[((size_t)h * PK + (nn & 127)) * 128 + (kk & 127)]; }
        KD[e] = (bf16)f2bf(v);
    }
}
__device__ __forceinline__ void p1_win(const Frame& F, const Args& A) {
    { pg8::Gemm g{WSB(WS_B), WSB(WS_WIN), T, INC, DM, DM, DM, 0, 0, 1}; pg8::StaticOrder S; S.init(T, INC, F.G, F.bid); pg8::EpiWin E{WSB(WS_QB), (size_t)(WS_KB - WS_QB) / 2, WSB(WS_UCAT), WSF(WS_ROPE), attn_body::C2}; GEMM_RUN(pg8::EpiWin, true, g, S, E); }
}
__device__ __forceinline__ void p5_glu(const Frame& F, const Args& A) {
    pg8::Gemm g{WSB(WS_GB), WSB(WS_WGLU), T, SSMW, SSMW, SSMW, SSMW, 0, 0, 1}; pg8::StaticOrder S; S.init(T, SSMW, F.G, F.bid);
    pg8::EpiGlu E{WSB(WS_GB), IN_F(19), WSB(WS_B), WSF(WS_SSQ)}; GEMM_RUN(pg8::EpiGlu, true, g, S, E);
}

__device__ __forceinline__ void p5_tables(const Frame& F, const Args& A) {
    unsigned char* UB = F.ws + WS_UB; unsigned char* VT = F.ws + WS_VT;
    const float* Uin = IN_F(31); const float* Vin = IN_F(32); const float* gfn = IN_F(27); float* iscu = WSF(WS_ISCU); float* iscv = WSF(WS_ISCV);
    const int gw = F.bid * NWAVES + F.wave, NGW = F.G * NWAVES, lane = F.lane;
    for (int it = 2 * gw; it < 2 * PK * PK; it += 2 * NGW) {
        const int tb = it >= PK * PK, e = tb ? it - PK * PK : it;
        const float* src = (tb ? Vin : Uin) + (size_t)e * DM; unsigned char* dst = tb ? VT : UB; float* isc = tb ? iscv : iscu;
        float4 v[16]; float am0 = 0.f, am1 = 0.f;
#pragma unroll
        for (int q = 0; q < 16; ++q) v[q] = ntld4(src + (q >> 3) * DM + 256 * (q & 7) + 4 * lane);
        if (!tb) {
#pragma unroll
            for (int q = 0; q < 8; ++q) { const float4 g4 = *(const float4*)(gfn + 256 * q + 4 * lane);
                v[q].x *= g4.x; v[q].y *= g4.y; v[q].z *= g4.z; v[q].w *= g4.w; v[8 + q].x *= g4.x; v[8 + q].y *= g4.y; v[8 + q].z *= g4.z; v[8 + q].w *= g4.w; }
        }
#pragma unroll
        for (int q = 0; q < 8; ++q) { am0 = fmaxf(am0, fmaxf(fmaxf(fabsf(v[q].x), fabsf(v[q].y)), fmaxf(fabsf(v[q].z), fabsf(v[q].w))));
                                      am1 = fmaxf(am1, fmaxf(fmaxf(fabsf(v[8 + q].x), fabsf(v[8 + q].y)), fmaxf(fabsf(v[8 + q].z), fabsf(v[8 + q].w)))); }
        am0 = wave_max(am0); am1 = wave_max(am1);
        float sc0 = 1.0f, sc1 = 1.0f;
        if (tb) { if (am0 > 1e-30f) sc0 = __uint_as_float(__float_as_uint(448.0f / am0) & 0x7f800000u);
                  if (am1 > 1e-30f) sc1 = __uint_as_float(__float_as_uint(448.0f / am1) & 0x7f800000u); }
        else    { if (am0 > 1e-30f) sc0 = 127.0f / am0; if (am1 > 1e-30f) sc1 = 127.0f / am1; }
        if (lane == 0) { isc[e] = 1.0f / sc0; isc[e + 1] = 1.0f / sc1; }
#pragma unroll
        for (int q = 0; q < 16; ++q) {
            const float sc = q < 8 ? sc0 : sc1; int w = 0;
            if (tb) { w = __builtin_amdgcn_cvt_pk_fp8_f32(v[q].x * sc, v[q].y * sc, w, false);
                      w = __builtin_amdgcn_cvt_pk_fp8_f32(v[q].z * sc, v[q].w * sc, w, true); }
            else { const int q0 = (int)__builtin_rintf(v[q].x * sc), q1 = (int)__builtin_rintf(v[q].y * sc), q2 = (int)__builtin_rintf(v[q].z * sc), q3 = (int)__builtin_rintf(v[q].w * sc);
                   w = (int)((unsigned)(q0 & 255) | ((unsigned)(q1 & 255) << 8) | ((unsigned)(q2 & 255) << 16) | ((unsigned)q3 << 24)); }
            const int c = 256 * (q & 7) + 4 * lane;
            *(int*)(dst + ((size_t)(c >> 7) * (PK * PK) + e + (q >> 3)) * SLW + (c & 127)) = w;
        }
    }
}
__device__ __forceinline__ void p7_wout(const Frame& F, const Args& A) {
    pg8::Gemm g{WSB(WS_B), WSB(WS_WOUT), T, DM, DM, DM, DM, 0, 0, 1}; pg8::StaticOrder S; S.init(T, DM, F.G, F.bid);
    pg8::EpiWout E{IN_F(0), WSB(WS_HB2), WSF(WS_SSQ1), DM, WSF(WS_SSQ), 16}; GEMM_RUN(pg8::EpiWout, true, g, S, E);
}
__device__ __forceinline__ void p9_xq(const Frame& F, const Args& A) {
    pg8::Gemm g{WSB(WS_HB2), WSB(WS_WXQ), T, XW, DM, DM, DM, 0, 0, 1}; pg8::StaticOrder S; S.init(T, XW, F.G, F.bid);
    pg8::EpiRowBf16 E{WSB(WS_XQB), XW, WSF(WS_SSQ1), 0.08838834764831845f}; GEMM_RUN(pg8::EpiRowBf16, true, g, S, E);
    { pg8::Gemm g2{WSB(WS_MN), WSB(WS_WXKV), BATCH * NMEM, 2 * XW, DM, DM, DM, 0, 0, 1}; pg8::StaticOrder S2; S2.init(BATCH * NMEM, 2 * XW, F.G, F.G - 1 - F.bid); pg8::EpiXkv E2{WSB(WS_KP), WSB(WS_VT2)}; GEMM_RUN(pg8::EpiXkv, true, g2, S2, E2); }
}
__device__ __forceinline__ void p11_xo(const Frame& F, const Args& A) {
    pg8::Gemm g{WSB(WS_XO), WSB(WS_WXO), T, DM, XW, XW, XW, 0, 0, 1}; pg8::StaticOrder S; S.init(T, DM, F.G, F.bid);
    pg8::EpiResidB<false> E{WSB(WS_HB2), WSB(WS_B), WSF(WS_SSQ2), DM}; GEMM_RUN(pg8::EpiResidB<false>, true, g, S, E);
}
__device__ __forceinline__ void p13_pq(const Frame& F, const Args& A) {
    pg8::Gemm g{WSB(WS_B), WSB(WS_WPQ), T, PH * PQD, DM, DM, DM, 0, 0, 1}; pg8::StaticOrder S; S.init(T, PH * PQD, F.G, F.bid);
    pg8::EpiRowBf16 E{WSB(WS_PQ), PH * PQD, WSF(WS_SSQ2), 1.0f}; GEMM_RUN(pg8::EpiRowBf16, true, g, S, E);
}
__device__ __forceinline__ void p14_scores(const Frame& F, const Args& A) {
    for (int sel = 0; sel * F.G + F.bid < PH * (T / 256); ++sel) {
        pg8::Gemm g{WSB(WS_KD), WSB(WS_PQ), 256, T, 256, 256, PH * PQD, 65536, 256, PH}; pg8::TkOrder S{F.G, F.bid, sel};
        pg8::EpiTopk E{(unsigned short*)(F.ws + WS_IDX), WSF(WS_GATE)};
        pg8::gemm_phase<pg8::EpiTopk, pg8::TkOrder, false, true>(F.ldsl, g, S, E);
        __syncthreads();
    }
}

constexpr int NPHASE = 15;
__global__ void __launch_bounds__(NTHR, 2) mk_fwd(Args args) {
    extern __shared__ __attribute__((aligned(16))) unsigned char lds[];
#define MKFRAME() Frame F; { int t_ = threadIdx.x; asm volatile("" : "+v"(t_)); F.lds = lds; F.ldsl = (LAS unsigned char*)lds; F.tid = t_; F.lane = t_ & 63; F.wave = __builtin_amdgcn_readfirstlane(t_ >> 6); \
    F.G = gridDim.x; F.bid = blockIdx.x; F.ws = args.ws; F.out = args.out; }
    volatile LAS unsigned* MISC = (volatile LAS unsigned*)((LAS unsigned char*)lds + MISC_OFF);
    if (threadIdx.x < 32) MISC[threadIdx.x] = 0u;
    __syncthreads();
    (void)xcd_barrier_post((unsigned*)(args.ws + WS_CTL) + CW_BAR, MISC + 8);
    if (threadIdx.x == 0) { const unsigned x = xb_xcc_id(); MISC[11] = x; MISC[10] = xb_add((unsigned*)(args.ws + WS_CTL) + CW_TICKET + 64 * x, 1u); }
    const int lo = args.ph_lo, hi = args.ph_hi;
#define IN(k) (lo <= (k) && (k) < hi)
#define SEAM(k) do { if (IN(k) && IN((k) + 1)) { XcdBarrier b_; b_.bar = (unsigned*)(args.ws + WS_CTL) + CW_BAR; b_.x = 0; b_.st = MISC + 8; xcd_barrier(b_); } } while (0)
    if (IN(0)) { MKFRAME(); p0_prep(F, args); __syncthreads(); p0_s5_setup(F, args); }  SEAM(0);
    if (IN(1)) { MKFRAME(); p1_win(F, args); }             SEAM(1);
    if (IN(2)) { MKFRAME(); p3_attn(F, args); }            SEAM(2);
    if (IN(3)) { MKFRAME(); p4_s5_scan(F, args); }
    { int g3_ = __builtin_amdgcn_readfirstlane(IN(3) ? 1 : 0); asm volatile("s_waitcnt vmcnt(0)" : "+s"(g3_) :: "memory"); __syncthreads(); if (g3_) { MKFRAME(); p5_s5_out(F, args); } }   SEAM(3);
    if (IN(4)) { MKFRAME(); p5_glu(F, args); p5_tables(F, args); }  SEAM(4);
    if (IN(5)) { MKFRAME(); p7_wout(F, args); }            SEAM(5);
    if (IN(6)) { MKFRAME(); p9_xq(F, args); }              SEAM(6);
    if (IN(7)) { MKFRAME(); p10_xscores(F, args); }
    { int g8_ = __builtin_amdgcn_readfirstlane(IN(7) ? 1 : 0); asm volatile("s_waitcnt vmcnt(0)" : "+s"(g8_) :: "memory"); __syncthreads(); if (g8_) { MKFRAME(); p10_xpv(F, args); } }   SEAM(7);
    if (IN(8)) { MKFRAME(); p11_xo(F, args); }            SEAM(8);
    if (IN(9)) { MKFRAME(); p13_pq(F, args); }            SEAM(9);
    if (IN(10)) { MKFRAME(); p14_scores(F, args); }        SEAM(10);
    if (IN(11)) { MKFRAME(); p17_peer_u(F, args, MISC); }  SEAM(11);
    if (IN(12)) { MKFRAME(); p18_peer_w(F, args, MISC); }  SEAM(12);
    if (IN(13)) { MKFRAME(); p19_peer_v(F, args, MISC); }  SEAM(13);
    if (IN(14)) { MKFRAME(); p20_final(F, args); }
#undef IN
#undef SEAM
}
extern "C" void kernel_launch(void* const* d_in, const int* in_sizes, int n_in, void* d_out, int out_size, void* d_ws, size_t ws_size, hipStream_t stream) {
    static int grid = 0;
    if (grid == 0) {
        if (n_in != 34 || out_size != T * DM || ws_size < WS_END) { fprintf(stderr, "kernel_launch: unexpected shapes n_in %d out %d ws %zu\n", n_in, out_size, ws_size); grid = -1; return; }
        int dev = 0, cus = 0;
        if (hipGetDevice(&dev) != hipSuccess || hipDeviceGetAttribute(&cus, hipDeviceAttributeMultiprocessorCount, dev) != hipSuccess) { grid = -1; return; }
        if (hipFuncSetAttribute((const void*)mk_fwd, hipFuncAttributeMaxDynamicSharedMemorySize, LDS_BYTES) != hipSuccess) { fprintf(stderr, "kernel_launch: hipFuncSetAttribute failed\n"); grid = -1; return; }
        int per_cu = 0;
        (void)hipOccupancyMaxActiveBlocksPerMultiprocessor(&per_cu, (const void*)mk_fwd, NTHR, LDS_BYTES);
        (void)hipGetLastError();
        grid = cus;
    }
    if (grid < 0) return;
    (void)hipMemsetAsync((char*)d_ws + WS_CTL, 0, CTL_ZERO_BYTES, stream);
    Args a{};
    for (int i = 0; i < 34; ++i) a.in[i] = d_in[i];
    a.out = (float*)d_out; a.ws = (unsigned char*)d_ws;
    a.ph_lo = 0; a.ph_hi = NPHASE; a.li = 0;
    hipLaunchKernelGGL(mk_fwd, dim3(grid), dim3(NTHR), LDS_BYTES, stream, a);
}
```

```cpp
#include <hip/hip_runtime.h>
#include <hip/hip_bf16.h>
#include <cstdio>
#include <cstdint>
#include <cmath>

constexpr int BATCH = 8, SEQ = 2048, DM = 2048, T = BATCH * SEQ;
constexpr int NMEM = 256;
constexpr float EPS = 1e-6f;
constexpr int ATTW = 1024, SSMW = 1024, INC = 4096;
constexpr int NH = 8;
constexpr int SG = 64, SP = 64;
constexpr int XH = 4, XD = 128, XW = 512;
constexpr int PH = 8, PK = 128, PQD = 256, PTOP = 16;
constexpr float LAM_INIT = 0.2f;

#ifndef MK_ONE_LAUNCH
#define MK_ONE_LAUNCH 1
#endif

constexpr int NWAVES = 8, NTHR = 512;
constexpr int LDS_BYTES = 147456;
constexpr int MISC_OFF = 147456 - 512;

constexpr size_t MiB = 1u << 20;
constexpr size_t WS_CTL = 0, CTL_ZERO_BYTES = 1 * MiB;
constexpr size_t WS_RSTD0 = 1 * MiB, WS_RSTDM = WS_RSTD0 + 65536, WS_RSTD1 = WS_RSTDM + 65536, WS_RSTD2 = WS_RSTD1 + 65536, WS_LAM = WS_RSTD2 + 65536;
constexpr size_t WS_ROPE = 2 * MiB;
constexpr size_t WS_WIN = 8 * MiB, WS_WGLU = 24 * MiB, WS_WOUT = 26 * MiB, WS_WXQ = 34 * MiB, WS_WXKV = 36 * MiB, WS_WXO = 40 * MiB, WS_WPQ = 42 * MiB, WS_KD = 50 * MiB;
constexpr size_t WS_UCAT = 56 * MiB, WS_BTC = 96 * MiB, WS_BTA = 136 * MiB, WS_QB = 152 * MiB, WS_KB = 184 * MiB, WS_VB = 216 * MiB, WS_O0 = 248 * MiB, WS_O1 = 280 * MiB;
constexpr size_t WS_UB = 56 * MiB, WS_VT = 120 * MiB, WS_XQ = 184 * MiB, WS_SC = 184 * MiB;
constexpr size_t WS_B = 312 * MiB;
constexpr size_t WS_SL = 376 * MiB, WS_IDX = 376 * MiB, WS_GATE = 384 * MiB;
constexpr size_t WS_GB = 392 * MiB, WS_XO = 392 * MiB;
constexpr size_t WS_PQ = 424 * MiB;
constexpr size_t WS_HB2 = 408 * MiB;
constexpr size_t WS_XKV = 472 * MiB;
constexpr size_t WS_MN = 480 * MiB;
constexpr size_t WS_END = 488 * MiB;
constexpr size_t WS_SSQ = 128 * 1024;
constexpr size_t WS_SSQ3 = 512 * 1024;
constexpr size_t WS_SSQP = 2 * MiB;
constexpr size_t WS_SSQ1 = 704 * 1024, WS_SSQ2 = 768 * 1024;
constexpr int CW_TICKET = 160 * 1024;
constexpr size_t WS_PACT = 184 * MiB, WS_PW = 248 * MiB;
constexpr size_t WS_ISCU = 4 * MiB, WS_ISCV = 4 * MiB + 65536;
constexpr int NSL = 16, SLW = 128;
constexpr size_t WS_LSUM = 256 * 1024;
constexpr size_t WS_KP = 472 * MiB, WS_VT2 = 476 * MiB;
constexpr size_t WS_XQB = 184 * MiB, WS_XP = 200 * MiB;
constexpr size_t WS_AL = WS_LAM + 4096;
constexpr int S5L = 32, NCH = T / S5L, UCK = 640;
constexpr int CW_BAR = 4096;

#define GAS __attribute__((address_space(1)))
#define LAS __attribute__((address_space(3)))
typedef GAS unsigned gu32;
#define RLX_AGENT __ATOMIC_RELAXED, __HIP_MEMORY_SCOPE_AGENT

#define XB_TMO      128
#define XB_XCNT(j)  (256  + 64 * (j))
#define XB_XSUB(j)  (1280 + 64 * (j))
#define XB_XGEN(j)  (2304 + 64 * (j))
#define XB_TOP      3328
#define XB_TOPGEN   3392
#define XCD_BAR_WORDS 3456
#define XB_SPIN_CAP (1u << 26)
__device__ __forceinline__ unsigned xb_ld(unsigned* p)              { return __hip_atomic_load(p, __ATOMIC_RELAXED, __HIP_MEMORY_SCOPE_AGENT); }
__device__ __forceinline__ unsigned xb_add(unsigned* p, unsigned v) { return __hip_atomic_fetch_add(p, v, __ATOMIC_RELAXED, __HIP_MEMORY_SCOPE_AGENT); }
__device__ __forceinline__ unsigned xb_xcc_id() { return (unsigned)__builtin_amdgcn_s_getreg((3 << 11) | 20) & 0xFu; }
#define XB_SPIN(cond, bar) do { unsigned _sp = 0; while (cond) { __builtin_amdgcn_s_sleep(1); \
    if ((++_sp & 255u) == 0u) { if (xb_ld(&(bar)[XB_TMO])) break; if (_sp > XB_SPIN_CAP) { atomicAdd(&(bar)[XB_TMO], 1u); break; } } } } while (0)
struct XcdBarrier { unsigned* bar; unsigned x; volatile LAS unsigned* st; };
__device__ __forceinline__ XcdBarrier xcd_barrier_post(unsigned* bar, volatile LAS unsigned* st) {
    XcdBarrier b; b.bar = bar; b.x = xb_xcc_id(); b.st = st;
    if (threadIdx.x == 0) (void)xb_add(&bar[XB_XCNT(b.x)], 1u);
    return b;
}
__device__ __forceinline__ void xcd_barrier_complete(unsigned* bar, unsigned x, unsigned& nloc, unsigned& nx) {
    const unsigned G = gridDim.x * gridDim.y * gridDim.z;
    unsigned sum, cnt, mine, sp = 0u;
    for (;;) {
        sum = 0u; cnt = 0u; mine = 0u;
#pragma unroll
        for (unsigned j = 0; j < 16; ++j) { const unsigned c = xb_ld(&bar[XB_XCNT(j)]); sum += c; cnt += (c > 0u) ? 1u : 0u; mine = (j == x) ? c : mine; }
        if (sum == G) break;
        __builtin_amdgcn_s_sleep(1);
        if ((++sp & 255u) == 0u) { if (xb_ld(&bar[XB_TMO])) break; if (sp > XB_SPIN_CAP) { atomicAdd(&bar[XB_TMO], 1u); break; } }
    }
    nloc = mine > 0u ? mine : 1u; nx = cnt > 0u ? cnt : 1u;
}
__device__ __forceinline__ void xcd_barrier(const XcdBarrier& b) {
    asm volatile("s_waitcnt vmcnt(0)" ::: "memory");
    __syncthreads();
    if (threadIdx.x == 0) {
        unsigned* bar = b.bar;
        __builtin_amdgcn_s_waitcnt(0);
        unsigned nloc = b.st[0], nx = b.st[1]; const unsigned bx = b.st[3];
        if (nloc == 0u) { xcd_barrier_complete(bar, bx, nloc, nx); b.st[0] = nloc; b.st[1] = nx; }
        const unsigned old = xb_add(&bar[XB_XSUB(bx)], 1u);
        const unsigned gen = old / nloc;
        if (old + 1u == (gen + 1u) * nloc) {
            __builtin_amdgcn_fence(__ATOMIC_RELEASE, "agent");
            asm volatile("s_waitcnt vmcnt(0)" ::: "memory");
            const unsigned og = xb_add(&bar[XB_TOP], 1u);
            const unsigned tg = og / nx;
            if (og + 1u == (tg + 1u) * nx) xb_add(&bar[XB_TOPGEN], 1u);
            else XB_SPIN(xb_ld(&bar[XB_TOPGEN]) == tg, bar);
            __builtin_amdgcn_fence(__ATOMIC_ACQUIRE, "agent");
            xb_add(&bar[XB_XGEN(bx)], 1u);
            asm volatile("s_waitcnt vmcnt(0)" ::: "memory");
        } else {
            XB_SPIN(xb_ld(&bar[XB_XGEN(bx)]) == gen, bar);
            __builtin_amdgcn_fence(__ATOMIC_ACQUIRE, "agent");
            asm volatile("s_waitcnt vmcnt(0)" ::: "memory");
        }
    }
    __syncthreads();
}

struct Args { const void* in[34]; float* out; unsigned char* ws; int ph_lo, ph_hi, li, pad; };
struct Frame {
    unsigned char* lds;
    LAS unsigned char* ldsl;
    int tid, lane, wave, G, bid;
    float* out;
    unsigned char* ws;
};
__device__ __forceinline__ float wave_sum(float v) {
#pragma unroll
    for (int o = 1; o < 64; o <<= 1) v += __shfl_xor(v, o);
    return v;
}
__device__ __forceinline__ float wave_max(float v) {
#pragma unroll
    for (int o = 1; o < 64; o <<= 1) v = fmaxf(v, __shfl_xor(v, o));
    return v;
}
__device__ __forceinline__ float gelu_exact(float x) { return 0.5f * x * (1.0f + erff(x * 0.70710678118654752f)); }

__device__ __forceinline__ const void* ldarg(int byte_off) {
    const void* p; auto k = __builtin_amdgcn_kernarg_segment_ptr();
    asm volatile("s_load_dwordx2 %0, %1, %2\n\ts_waitcnt lgkmcnt(0)" : "=s"(p) : "s"(k), "i"(byte_off) : "memory");
    return p;
}
#define IN_F(i) ((const float*)ldarg((i) * 8))
#define IN_I(i) ((const int*)ldarg((i) * 8))
#define WSF(off) ((float*)(F.ws + (off)))


typedef float nt_f4 __attribute__((ext_vector_type(4)));
__device__ __forceinline__ float4 ntld4(const float* p) { const nt_f4 v = __builtin_nontemporal_load((const GAS nt_f4*)p); return make_float4(v[0], v[1], v[2], v[3]); }
__device__ __forceinline__ void ntst4(float* p, float4 v) { const nt_f4 w = {v.x, v.y, v.z, v.w}; __builtin_nontemporal_store(w, (GAS nt_f4*)p); }
typedef unsigned short bf16;
typedef unsigned v4u __attribute__((ext_vector_type(4)));
__device__ __forceinline__ unsigned f2bf(float f) { unsigned u = __builtin_bit_cast(unsigned, f); return (u + 0x7fffu + ((u >> 16) & 1u)) >> 16; }
__device__ __forceinline__ unsigned pk2(float lo, float hi) { return f2bf(lo) | (f2bf(hi) << 16); }
__device__ __forceinline__ float bf2f(unsigned short b) { return __uint_as_float((unsigned)b << 16); }
#define WSB(off) ((bf16*)(F.ws + (off)))
#define LDS_WAIT() asm volatile("s_waitcnt lgkmcnt(0)" ::: "memory")

__device__ __forceinline__ void norm_2rows_to_bf16(const float* xrow, const float* g, bf16* orow, int lane) {
    float4 v[16]; float s0 = 0.f, s1 = 0.f;
#pragma unroll
    for (int j = 0; j < 16; ++j) v[j] = ntld4(xrow + (j >> 3) * DM + 256 * (j & 7) + 4 * lane);
#pragma unroll
    for (int j = 0; j < 8; ++j) { s0 += v[j].x * v[j].x + v[j].y * v[j].y + v[j].z * v[j].z + v[j].w * v[j].w; s1 += v[8 + j].x * v[8 + j].x + v[8 + j].y * v[8 + j].y + v[8 + j].z * v[8 + j].z + v[8 + j].w * v[8 + j].w; }
    s0 = wave_sum(s0); s1 = wave_sum(s1);
    const float r0 = 1.0f / sqrtf(s0 / (float)DM + EPS), r1 = 1.0f / sqrtf(s1 / (float)DM + EPS);
#pragma unroll
    for (int j = 0; j < 8; ++j) { const float4 g4 = *(const float4*)(g + 256 * j + 4 * lane);
        *(unsigned long long*)(orow + 256 * j + 4 * lane) = (unsigned long long)pk2(v[j].x * r0 * g4.x, v[j].y * r0 * g4.y) | ((unsigned long long)pk2(v[j].z * r0 * g4.z, v[j].w * r0 * g4.w) << 32);
        *(unsigned long long*)(orow + DM + 256 * j + 4 * lane) = (unsigned long long)pk2(v[8 + j].x * r1 * g4.x, v[8 + j].y * r1 * g4.y) | ((unsigned long long)pk2(v[8 + j].z * r1 * g4.z, v[8 + j].w * r1 * g4.w) << 32); }
}
__device__ __forceinline__ void norm4_load(const float* xrow, int lane, float4 (&v)[32]) {
#pragma unroll
    for (int j = 0; j < 32; ++j) v[j] = ntld4(xrow + (j >> 3) * DM + 256 * (j & 7) + 4 * lane);
}
__device__ __forceinline__ void norm4_finish(const float4 (&v)[32], const float* g, bf16* orow, int lane) {
    float s[4] = {0.f, 0.f, 0.f, 0.f};
#pragma unroll
    for (int j = 0; j < 32; ++j) s[j >> 3] += v[j].x * v[j].x + v[j].y * v[j].y + v[j].z * v[j].z + v[j].w * v[j].w;
    float r[4];
#pragma unroll
    for (int q = 0; q < 4; ++q) { s[q] = wave_sum(s[q]); r[q] = 1.0f / sqrtf(s[q] / (float)DM + EPS); }
#pragma unroll
    for (int j = 0; j < 8; ++j) { const float4 g4 = *(const float4*)(g + 256 * j + 4 * lane);
#pragma unroll
        for (int q = 0; q < 4; ++q) { const float4 w = v[8 * q + j]; const float rq = r[q];
            *(unsigned long long*)(orow + q * DM + 256 * j + 4 * lane) = (unsigned long long)pk2(w.x * rq * g4.x, w.y * rq * g4.y) | ((unsigned long long)pk2(w.z * rq * g4.z, w.w * rq * g4.w) << 32); } }
}
__device__ __forceinline__ void p0_transpose_item(const float* W, int K, int N, bf16* WT, int row_off, LAS float* scr, int item, int lane, const float* gain = nullptr, int goff = 0) {
    const int nblk = N / 32, kb = item / nblk, nb = item % nblk, k0 = 64 * kb, n0 = 32 * nb;
    float4 v[8];
#pragma unroll
    for (int i = 0; i < 8; ++i) v[i] = ntld4(W + (size_t)(k0 + 8 * i + (lane >> 3)) * N + n0 + 4 * (lane & 7));
#pragma unroll
    for (int i = 0; i < 8; ++i) { const int kk = 8 * i + (lane >> 3); const float gk = (gain && k0 + kk >= goff) ? gain[k0 + kk - goff] : 1.0f; LAS float* d = scr + kk * 33 + 4 * (lane & 7);
        d[0] = v[i].x * gk; d[1] = v[i].y * gk; d[2] = v[i].z * gk; d[3] = v[i].w * gk; }
    LDS_WAIT(); asm volatile("" ::: "memory");
    const int c = lane & 7;
#pragma unroll
    for (int j = 0; j < 4; ++j) { const int n = (lane >> 3) + 8 * j; const LAS float* s = scr + (8 * c) * 33 + n;
        v4u o; o.x = pk2(s[0 * 33], s[1 * 33]); o.y = pk2(s[2 * 33], s[3 * 33]); o.z = pk2(s[4 * 33], s[5 * 33]); o.w = pk2(s[6 * 33], s[7 * 33]);
        *(GAS v4u*)(WT + (size_t)(row_off + n0 + n) * K + k0 + 8 * c) = o; }
    LDS_WAIT(); asm volatile("" ::: "memory");
}
namespace pg8 {
#define PG8_LAS __attribute__((address_space(3)))
typedef unsigned short bf16_t;
typedef short bf16x8 __attribute__((ext_vector_type(8)));
typedef float f32x4 __attribute__((ext_vector_type(4)));
typedef unsigned u32x4 __attribute__((ext_vector_type(4)));
constexpr int BM = 256, BK = 64, HALF = 128, HTB = HALF * BK * 2  , STAGE_BYTES = 8 * HTB, NXCD = 8, WGM = 8;

__host__ __device__ __forceinline__ int lds_byte(int r, int c) { const int st = (r >> 4) * 2 + (c >> 5), rr = r & 15, cc = c & 31, ob = rr * 64 + cc * 2; return st * 1024 + (ob ^ (((ob >> 9) & 1) << 5)); }
__host__ __device__ __forceinline__ void stage_rc(int b, int& R, int& C) { const int st = b / 1024, sb = b % 1024, swz = sb ^ (((sb >> 9) & 1) << 5); R = (st >> 1) * 16 + swz / 64; C = (st & 1) * 32 + (swz % 64) / 2; }
__host__ __device__ __forceinline__ int perm32(int rho) { const int n = rho >> 4, i = rho & 15; return 8 * (i >> 2) + 4 * n + (i & 3); }

struct Unit { int pm, pn, bz; };
struct Gemm { const bf16_t* A; const bf16_t* Bt; int M, N, K; int lda, ldb; long sA, sB; int nb; };

struct StaticOrder {
    int nM, nN, nwg, G, c;
    int nb, per; __host__ __device__ void init(int M, int N, int G_, int c_, int nb_ = 1) { nM = M / BM; nN = N / BM; nb = nb_; per = nM * nN; nwg = per * nb; G = G_; c = c_; }
    __host__ __device__ bool next(int i, Unit& u) const {
        const long L = (long)i * G + c; if (L >= nwg) return false;
        int wgid = (int)L; { const int q = nwg / NXCD, r = nwg % NXCD, xcd = wgid % NXCD, off = wgid / NXCD; wgid = (xcd < r ? xcd * (q + 1) : r * (q + 1) + (xcd - r) * q) + off; }
        u.bz = wgid / per; wgid -= u.bz * per; const int nig = WGM * nN, gid = wgid / nig, fm = gid * WGM, gsz = (nM - fm) < WGM ? (nM - fm) : WGM;
        u.pm = fm + ((wgid % nig) % gsz); u.pn = (wgid % nig) / gsz; return true;
    }
    __device__ __forceinline__ void a_ready(const Unit&) const {}
    __device__ __forceinline__ void done(const Unit&) const {}
    template <class G_> __device__ __forceinline__ long offA(const Unit& u, const G_& g) const { return (long)u.bz * g.sA; }
    template <class G_> __device__ __forceinline__ long offB(const Unit& u, const G_& g) const { return (long)u.bz * g.sB; }
};

__device__ __forceinline__ unsigned cvt_pk_bf16(float lo, float hi) { unsigned r; asm volatile("v_cvt_pk_bf16_f32 %0, %1, %2" : "=v"(r) : "v"(lo), "v"(hi)); return r; }
typedef float f32x2 __attribute__((ext_vector_type(2)));
__device__ __forceinline__ f32x2 gelu_pk(f32x2 v) {
    const f32x2 av = __builtin_elementwise_abs(v), d = av * 0.2316418882f + 1.0f;
    f32x2 t; t.x = __builtin_amdgcn_rcpf(d.x); t.y = __builtin_amdgcn_rcpf(d.y);
    f32x2 q = t * 0.5307027145f + (-0.7265760135f); q = q * t + 0.7107068705f; q = q * t + (-0.142248368f); q = q * t + 0.127414796f; q = q * t;
    const f32x2 s = (v * v) * (-0.72134752044f);
    f32x2 e; e.x = __builtin_amdgcn_exp2f(s.x); e.y = __builtin_amdgcn_exp2f(s.y);
    const f32x2 m = v * (q * e), r = v - m;
    f32x2 o; o.x = v.x < 0.f ? m.x : r.x; o.y = v.y < 0.f ? m.y : r.y; return o;
}

template <int ACT  > struct EpiBf16 {
    static constexpr bool PERM = true, AFTER_DRAIN = false; static_assert(ACT == 0 || ACT == 1, "EpiBf16: ACT is 0 (none) or 1 (gelu_pk)");
    bf16_t* O; int ldc; const float* bias; int split_cols; size_t split_stride; float scale0;
    __device__ __forceinline__ void operator()(const f32x4 (&acc)[2][2][4][2], const Unit& u, int wr, int wc, int fr, int fq) const {
        const int row0 = u.pm * BM + wr * 64 + fr; int colt = u.pn * BM; bf16_t* base = O;
        float sc = 1.f; if (split_cols) { const int t = colt / split_cols; base += (size_t)t * split_stride; colt -= t * split_cols; if (t == 0) sc = scale0; }
        const int col0 = colt + wc * 32 + 8 * fq, bcol0 = u.pn * BM + wc * 32 + 8 * fq;
        f32x4 bv[2][2];
#pragma unroll
        for (int bj = 0; bj < 2; ++bj)
#pragma unroll
            for (int n = 0; n < 2; ++n) bv[bj][n] = bias ? *(const f32x4*)(bias + bcol0 + bj * HALF + 4 * n) : (f32x4){0.f, 0.f, 0.f, 0.f};
#pragma unroll
        for (int ai = 0; ai < 2; ++ai)
#pragma unroll
            for (int m = 0; m < 4; ++m) { bf16_t* rowp = base + (size_t)(row0 + ai * HALF + m * 16) * ldc + col0;
#pragma unroll
                for (int bj = 0; bj < 2; ++bj) { f32x4 v0 = acc[ai][bj][m][0] + bv[bj][0], v1 = acc[ai][bj][m][1] + bv[bj][1];
                    if (ACT == 1) { f32x2 a = gelu_pk((f32x2){v0[0], v0[1]}), b = gelu_pk((f32x2){v0[2], v0[3]}), c = gelu_pk((f32x2){v1[0], v1[1]}), d = gelu_pk((f32x2){v1[2], v1[3]});
                        v0 = (f32x4){a.x, a.y, b.x, b.y}; v1 = (f32x4){c.x, c.y, d.x, d.y}; }
                    v0 = v0 * sc; v1 = v1 * sc; u32x4 w; w.x = cvt_pk_bf16(v0[0], v0[1]); w.y = cvt_pk_bf16(v0[2], v0[3]); w.z = cvt_pk_bf16(v1[0], v1[1]); w.w = cvt_pk_bf16(v1[2], v1[3]);
                    *(u32x4*)(rowp + bj * HALF) = w; } }
    }
};
template <class T, class = void> struct MidK { static constexpr bool v = false; };
template <class T> struct MidK<T, decltype((void)T::MIDK)> { static constexpr bool v = T::MIDK; };
template <class Epi, class Sched, bool ALIGN_EPI = false, bool SP2 = false>
__device__ __forceinline__ void gemm_phase(PG8_LAS unsigned char* lds, const Gemm g, const Sched& S, const Epi& E) {
    const int tid = threadIdx.x, wid = __builtin_amdgcn_readfirstlane(tid >> 6), lane = tid & 63, wr = wid >> 2, wc = wid & 3, fr = lane & 15, fq = lane >> 4;
    const int K = g.K, nt = K / BK;
    unsigned voffA[2], voffB[2];
#pragma unroll
    for (int i = 0; i < 2; ++i) { int R, C; stage_rc(tid * 16 + i * 8192, R, C); const int Rb = Epi::PERM ? ((R & ~31) + perm32(R & 31)) : R;
        voffA[i] = (unsigned)(R * g.lda + C) * 2u; voffB[i] = (unsigned)(Rb * g.ldb + C) * 2u; }
    const size_t kstep = (size_t)(BK * 2);
    const size_t hstepA = (size_t)HALF * g.lda * 2, hstepB = (size_t)HALF * g.ldb * 2;
    const size_t tstepA = 2 * hstepA, tstepB = 2 * hstepB;
    const unsigned ldsw = (unsigned)wid * 1024u;
    const int aoff = lds_byte(wr * 64 + fr, fq * 8), boff = lds_byte(wc * 32 + fr, fq * 8);
#define PG8_SA(b, h) (((b) * 2 + (h)) * HTB)
#define PG8_SB(b, h) ((4 + (b) * 2 + (h)) * HTB)
#define PG8_STAGE(bufoff, gbase, voff) do { _Pragma("unroll") for (int _i = 0; _i < 2; ++_i) \
        __builtin_amdgcn_global_load_lds((const unsigned*)((const char*)(gbase) + (voff)[_i]), (PG8_LAS unsigned*)(lds + (bufoff) + ldsw + _i * 8192), 16, 0, 0); } while (0)
#define PG8_LDA(dst, b, h) do { _Pragma("unroll") for (int m = 0; m < 4; ++m) _Pragma("unroll") for (int k = 0; k < 2; ++k) dst[m][k] = *(const PG8_LAS bf16x8*)(lds + PG8_SA(b, h) + aoff + m * 2048 + k * 1024); } while (0)
#define PG8_LDB(dst, b, h) do { _Pragma("unroll") for (int n = 0; n < 2; ++n) _Pragma("unroll") for (int k = 0; k < 2; ++k) dst[n][k] = *(const PG8_LAS bf16x8*)(lds + PG8_SB(b, h) + boff + n * 2048 + k * 1024); } while (0)
#define PG8_MMA(ai, bj, At, Bt) do { __builtin_amdgcn_s_setprio(1); _Pragma("unroll") for (int m = 0; m < 4; ++m) _Pragma("unroll") for (int n = 0; n < 2; ++n) _Pragma("unroll") for (int k = 0; k < 2; ++k) \
        acc[ai][bj][m][n] = __builtin_amdgcn_mfma_f32_16x16x32_bf16(Bt[n][k], At[m][k], acc[ai][bj][m][n], 0, 0, 0); __builtin_amdgcn_s_setprio(0); } while (0)
#define PG8_WAIT_V(n) asm volatile("s_waitcnt vmcnt(" #n ")" ::: "memory")
#define PG8_WAIT_L(n) asm volatile("s_waitcnt lgkmcnt(" #n ")" ::: "memory")
#define PG8_BAR __builtin_amdgcn_s_barrier()
#define PG8_SCHED __builtin_amdgcn_sched_barrier(0)
    Unit cur, nxt; int ui = 0;
    if (!S.next(0, cur)) return;
    f32x4 acc[2][2][4][2];
#pragma unroll
    for (int a = 0; a < 2; ++a)
#pragma unroll
        for (int b = 0; b < 2; ++b)
#pragma unroll
            for (int m = 0; m < 4; ++m)
#pragma unroll
                for (int n = 0; n < 2; ++n) acc[a][b][m][n] = (f32x4){0.f, 0.f, 0.f, 0.f};
    bf16x8 At[4][2], B0[2][2], B1[2][2];
    const char* cA = (const char*)g.A + (size_t)S.offA(cur, g) * 2 + (size_t)cur.pm * tstepA; const char* cB = (const char*)g.Bt + (size_t)S.offB(cur, g) * 2 + (size_t)cur.pn * tstepB;
    S.a_ready(cur);
    if constexpr (SP2) {
        PG8_STAGE(PG8_SB(0, 0), cB, voffB); PG8_STAGE(PG8_SB(0, 1), cB + hstepB, voffB); PG8_STAGE(PG8_SA(0, 0), cA, voffA); PG8_STAGE(PG8_SA(0, 1), cA + hstepA, voffA);
        if (wr == 1) PG8_BAR;
        PG8_WAIT_V(2); PG8_BAR;
        PG8_STAGE(PG8_SB(1, 0), cB + kstep, voffB); PG8_STAGE(PG8_SA(1, 0), cA + kstep, voffA); PG8_STAGE(PG8_SB(1, 1), cB + hstepB + kstep, voffB);
        PG8_WAIT_V(6); PG8_BAR;
    } else {
        PG8_STAGE(PG8_SB(0, 0), cB, voffB); PG8_STAGE(PG8_SA(0, 0), cA, voffA); PG8_STAGE(PG8_SB(0, 1), cB + hstepB, voffB); PG8_STAGE(PG8_SA(0, 1), cA + hstepA, voffA);
        if (wr == 1) PG8_BAR;
        PG8_WAIT_V(4); PG8_BAR;
        PG8_STAGE(PG8_SB(1, 0), cB + kstep, voffB); PG8_STAGE(PG8_SA(1, 0), cA + kstep, voffA); PG8_STAGE(PG8_SB(1, 1), cB + hstepB + kstep, voffB);
        PG8_WAIT_V(6); PG8_BAR;
    }
    for (;;) {
        const bool has_next = S.next(ui + 1, nxt);
        const char* nA = has_next ? (const char*)g.A + (size_t)S.offA(nxt, g) * 2 + (size_t)nxt.pm * tstepA : cA; const char* nB = has_next ? (const char*)g.Bt + (size_t)S.offB(nxt, g) * 2 + (size_t)nxt.pn * tstepB : cB;
        for (int t = 0; t < nt; t += 2) {
            if constexpr (MidK<Epi>::v) { if (t == E.midk_t) E.midk(acc, cur, wr, wc, fr, fq); }
            const bool last = (t == nt - 2);
            const char* a1 = cA + (size_t)(t + 1) * kstep;
            const char* a2 = last ? nA : cA + (size_t)(t + 2) * kstep; const char* b2 = last ? nB : cB + (size_t)(t + 2) * kstep;
            const char* a3 = a2 + kstep; const char* b3 = b2 + kstep;
            if (last && has_next) S.a_ready(nxt);
            if constexpr (SP2) {
            PG8_LDB(B0, 0, 0); PG8_LDB(B1, 0, 1); PG8_SCHED; PG8_LDA(At, 0, 0); PG8_STAGE(PG8_SA(1, 1), a1 + hstepA, voffA);
            PG8_WAIT_V(8); PG8_WAIT_L(0); PG8_BAR; PG8_MMA(0, 0, At, B0); PG8_MMA(0, 1, At, B1); PG8_BAR; PG8_SCHED;
            PG8_LDA(At, 0, 1); PG8_STAGE(PG8_SB(0, 0), b2, voffB); PG8_STAGE(PG8_SB(0, 1), b2 + hstepB, voffB); PG8_STAGE(PG8_SA(0, 0), a2, voffA);
            PG8_WAIT_V(8); PG8_WAIT_L(0); PG8_BAR; PG8_MMA(1, 0, At, B0); PG8_MMA(1, 1, At, B1); PG8_BAR; PG8_SCHED;
            PG8_LDB(B0, 1, 0); PG8_LDB(B1, 1, 1); PG8_SCHED; PG8_LDA(At, 1, 0); PG8_STAGE(PG8_SA(0, 1), a2 + hstepA, voffA);
            PG8_WAIT_V(8); PG8_WAIT_L(0); PG8_BAR; PG8_MMA(0, 0, At, B0); PG8_MMA(0, 1, At, B1); PG8_BAR; PG8_SCHED;
            PG8_LDA(At, 1, 1); PG8_STAGE(PG8_SB(1, 0), b3, voffB); PG8_STAGE(PG8_SB(1, 1), b3 + hstepB, voffB); PG8_STAGE(PG8_SA(1, 0), a3, voffA);
            PG8_WAIT_V(8); PG8_WAIT_L(0); PG8_BAR; PG8_MMA(1, 0, At, B0); PG8_MMA(1, 1, At, B1); PG8_BAR; PG8_SCHED;
            } else {
            PG8_LDB(B0, 0, 0); PG8_SCHED; PG8_LDA(At, 0, 0); PG8_STAGE(PG8_SA(1, 1), a1 + hstepA, voffA);
            PG8_WAIT_L(8); PG8_BAR; PG8_WAIT_L(0); PG8_MMA(0, 0, At, B0); PG8_BAR; PG8_SCHED;
            PG8_LDB(B1, 0, 1); PG8_STAGE(PG8_SB(0, 0), b2, voffB);
            PG8_BAR; PG8_WAIT_L(0); PG8_MMA(0, 1, At, B1); PG8_BAR;
            PG8_LDA(At, 0, 1); PG8_STAGE(PG8_SA(0, 0), a2, voffA);
            PG8_BAR; PG8_WAIT_L(0); PG8_MMA(1, 0, At, B0); PG8_BAR; PG8_SCHED;
            PG8_STAGE(PG8_SB(0, 1), b2 + hstepB, voffB);
            PG8_WAIT_V(6); PG8_BAR; PG8_MMA(1, 1, At, B1); PG8_BAR;
            PG8_LDB(B0, 1, 0); PG8_SCHED; PG8_LDA(At, 1, 0); PG8_STAGE(PG8_SA(0, 1), a2 + hstepA, voffA);
            PG8_WAIT_L(8); PG8_BAR; PG8_WAIT_L(0); PG8_MMA(0, 0, At, B0); PG8_BAR; PG8_SCHED;
            PG8_LDB(B1, 1, 1); PG8_STAGE(PG8_SB(1, 0), b3, voffB);
            PG8_BAR; PG8_WAIT_L(0); PG8_MMA(0, 1, At, B1); PG8_BAR;
            PG8_LDA(At, 1, 1); PG8_STAGE(PG8_SA(1, 0), a3, voffA);
            PG8_BAR; PG8_WAIT_L(0); PG8_MMA(1, 0, At, B0); PG8_BAR; PG8_SCHED;
            PG8_STAGE(PG8_SB(1, 1), b3 + hstepB, voffB);
            PG8_WAIT_V(6); PG8_BAR; PG8_MMA(1, 1, At, B1); PG8_BAR;
            }
        }
        if constexpr (ALIGN_EPI) { if (wr == 0) PG8_BAR; }
        if constexpr (!Epi::AFTER_DRAIN) { E(acc, cur, wr, wc, fr, fq); S.done(cur); }
        if (!has_next) break;
#pragma unroll
        for (int a = 0; a < 2; ++a)
#pragma unroll
            for (int b = 0; b < 2; ++b)
#pragma unroll
                for (int m = 0; m < 4; ++m)
#pragma unroll
                    for (int n = 0; n < 2; ++n) acc[a][b][m][n] = (f32x4){0.f, 0.f, 0.f, 0.f};
        cur = nxt; cA = nA; cB = nB; ++ui;
        if constexpr (ALIGN_EPI) { if (wr == 1) PG8_BAR; }
    }
    PG8_WAIT_V(0);
    if constexpr (!ALIGN_EPI) { if (wr == 0) PG8_BAR; }
    PG8_BAR;
    if constexpr (Epi::AFTER_DRAIN) { E.fused(acc, cur, wr, wc, fr, fq, lds, wid, lane); S.done(cur); }
#undef PG8_SA
#undef PG8_SB
#undef PG8_STAGE
#undef PG8_LDA
#undef PG8_LDB
#undef PG8_MMA
#undef PG8_WAIT_V
#undef PG8_WAIT_L
#undef PG8_BAR
#undef PG8_SCHED
}
}

namespace pg8 {
struct EpiF32 {
    static constexpr bool PERM = false, AFTER_DRAIN = false;
    float* C; int ldc; const float* resid; long sC;
    __device__ __forceinline__ void operator()(const f32x4 (&acc)[2][2][4][2], const Unit& u, int wr, int wc, int fr, int fq) const {
        const int row0 = u.pm * BM + wr * 64 + fr, col0 = u.pn * BM + wc * 32 + 4 * fq;
        float* base = C + (size_t)u.bz * sC;
#pragma unroll
        for (int ai = 0; ai < 2; ++ai)
#pragma unroll
            for (int m = 0; m < 4; ++m) { const size_t ro = (size_t)(row0 + ai * HALF + m * 16) * ldc;
#pragma unroll
                for (int bj = 0; bj < 2; ++bj)
#pragma unroll
                    for (int n = 0; n < 2; ++n) { const size_t o = ro + col0 + bj * HALF + n * 16; f32x4 v = acc[ai][bj][m][n];
                        if (resid) v += *(const f32x4*)(resid + o);
                        *(f32x4*)(base + o) = v; } }
    }
};


template <bool RF32> struct EpiResidB {
    static constexpr bool PERM = true, AFTER_DRAIN = false;
    const void* resid; bf16_t* HB; float* ssq; int ldc;
    __device__ __forceinline__ void operator()(const f32x4 (&acc)[2][2][4][2], const Unit& u, int wr, int wc, int fr, int fq) const {
        const int row0 = u.pm * BM + wr * 64 + fr, col0 = u.pn * BM + wc * 32 + 8 * fq;
#pragma unroll
        for (int ai = 0; ai < 2; ++ai)
#pragma unroll
            for (int m = 0; m < 4; ++m) { const int r = row0 + ai * HALF + m * 16; const size_t ro = (size_t)r * ldc + col0; float ss = 0.f;
#pragma unroll
                for (int bj = 0; bj < 2; ++bj) { const size_t o = ro + bj * HALF; f32x4 v0 = acc[ai][bj][m][0], v1 = acc[ai][bj][m][1];
                    if (RF32) { v0 += *(const f32x4*)((const float*)resid + o); v1 += *(const f32x4*)((const float*)resid + o + 4); }
                    else { const u32x4 rb = *(const u32x4*)((const bf16_t*)resid + o);
                        v0[0] += __uint_as_float(rb.x << 16); v0[1] += __uint_as_float(rb.x & 0xffff0000u); v0[2] += __uint_as_float(rb.y << 16); v0[3] += __uint_as_float(rb.y & 0xffff0000u);
                        v1[0] += __uint_as_float(rb.z << 16); v1[1] += __uint_as_float(rb.z & 0xffff0000u); v1[2] += __uint_as_float(rb.w << 16); v1[3] += __uint_as_float(rb.w & 0xffff0000u); }
                    ss += (v0[0] * v0[0] + v0[1] * v0[1]) + (v0[2] * v0[2] + v0[3] * v0[3]) + (v1[0] * v1[0] + v1[1] * v1[1]) + (v1[2] * v1[2] + v1[3] * v1[3]);
                    u32x4 w; w.x = cvt_pk_bf16(v0[0], v0[1]); w.y = cvt_pk_bf16(v0[2], v0[3]); w.z = cvt_pk_bf16(v1[0], v1[1]); w.w = cvt_pk_bf16(v1[2], v1[3]);
                    *(u32x4*)(HB + o) = w; }
                ss += __shfl_xor(ss, 16); ss += __shfl_xor(ss, 32);
                if (fq == 0) atomicAdd(ssq + r, ss); }
    }
};

struct EpiWout {
    static constexpr bool PERM = true, AFTER_DRAIN = false, MIDK = true;
    const float* resid; bf16_t* HB; float* ssq; int ldc; const float* ssq_ssm; int midk_t;
    __device__ __forceinline__ void midk(f32x4 (&acc)[2][2][4][2], const Unit& u, int wr, int wc, int fr, int fq) const {
        const int row0 = u.pm * BM + wr * 64 + fr;
#pragma unroll
        for (int ai = 0; ai < 2; ++ai)
#pragma unroll
            for (int m = 0; m < 4; ++m) { const float ir = sqrtf(ssq_ssm[row0 + ai * HALF + m * 16] * (1.0f / 1024.0f) + 1e-6f);
#pragma unroll
                for (int bj = 0; bj < 2; ++bj) { acc[ai][bj][m][0] *= ir; acc[ai][bj][m][1] *= ir; } }
    }
    __device__ __forceinline__ void operator()(const f32x4 (&acc)[2][2][4][2], const Unit& u, int wr, int wc, int fr, int fq) const {
        const int row0 = u.pm * BM + wr * 64 + fr, col0 = u.pn * BM + wc * 32 + 8 * fq;
#pragma unroll
        for (int ai = 0; ai < 2; ++ai)
#pragma unroll
            for (int m = 0; m < 4; ++m) { const int r = row0 + ai * HALF + m * 16; const size_t ro = (size_t)r * ldc + col0; float ss = 0.f;
                const float rs = 1.0f / sqrtf(ssq_ssm[r] * (1.0f / 1024.0f) + 1e-6f);
#pragma unroll
                for (int bj = 0; bj < 2; ++bj) { const size_t o = ro + bj * HALF;
                    const f32x4 v0 = acc[ai][bj][m][0] * rs + *(const f32x4*)(resid + o), v1 = acc[ai][bj][m][1] * rs + *(const f32x4*)(resid + o + 4);
                    ss += (v0[0] * v0[0] + v0[1] * v0[1]) + (v0[2] * v0[2] + v0[3] * v0[3]) + (v1[0] * v1[0] + v1[1] * v1[1]) + (v1[2] * v1[2] + v1[3] * v1[3]);
                    u32x4 w; w.x = cvt_pk_bf16(v0[0], v0[1]); w.y = cvt_pk_bf16(v0[2], v0[3]); w.z = cvt_pk_bf16(v1[0], v1[1]); w.w = cvt_pk_bf16(v1[2], v1[3]);
                    *(u32x4*)(HB + o) = w; }
                ss += __shfl_xor(ss, 16); ss += __shfl_xor(ss, 32);
                if (fq == 0) atomicAdd(ssq + r, ss); }
    }
};
struct EpiRowBf16 {
    static constexpr bool PERM = true, AFTER_DRAIN = false;
    bf16_t* O; int ldc; const float* ssq; float scale;
    __device__ __forceinline__ void operator()(const f32x4 (&acc)[2][2][4][2], const Unit& u, int wr, int wc, int fr, int fq) const {
        const int row0 = u.pm * BM + wr * 64 + fr, col0 = u.pn * BM + wc * 32 + 8 * fq;
#pragma unroll
        for (int ai = 0; ai < 2; ++ai)
#pragma unroll
            for (int m = 0; m < 4; ++m) { const int r = row0 + ai * HALF + m * 16; const float sc = scale / sqrtf(ssq[r] * (1.0f / 2048.0f) + 1e-6f); bf16_t* rowp = O + (size_t)r * ldc + col0;
#pragma unroll
                for (int bj = 0; bj < 2; ++bj) { const f32x4 v0 = acc[ai][bj][m][0] * sc, v1 = acc[ai][bj][m][1] * sc;
                    u32x4 w; w.x = cvt_pk_bf16(v0[0], v0[1]); w.y = cvt_pk_bf16(v0[2], v0[3]); w.z = cvt_pk_bf16(v1[0], v1[1]); w.w = cvt_pk_bf16(v1[2], v1[3]);
                    *(u32x4*)(rowp + bj * HALF) = w; } }
    }
};
struct EpiSl {
    static constexpr bool PERM = false, AFTER_DRAIN = false;
    float* Sl;
    __device__ __forceinline__ void operator()(const f32x4 (&acc)[2][2][4][2], const Unit& u, int wr, int wc, int fr, int fq) const {
        const int row0 = u.pm * BM + wr * 64 + fr, col0 = wc * 32 + 4 * fq;
        float* base = Sl + (size_t)u.bz * 512 * 128;
#pragma unroll
        for (int ai = 0; ai < 2; ++ai)
#pragma unroll
            for (int m = 0; m < 4; ++m) { float* rowp = base + (size_t)(row0 + ai * HALF + m * 16) * 128 + col0;
#pragma unroll
                for (int n = 0; n < 2; ++n) *(f32x4*)(rowp + n * 16) = acc[ai][0][m][n]; }
    }
};
struct EpiS5 {
    static constexpr bool PERM = true, AFTER_DRAIN = false;
    bf16_t* Gb;
    __device__ __forceinline__ void operator()(const f32x4 (&acc)[2][2][4][2], const Unit& u, int wr, int wc, int fr, int fq) const {
        const int row0 = u.pm * BM + wr * 64 + fr, col0 = u.pn * BM + wc * 32 + 8 * fq;
#pragma unroll
        for (int ai = 0; ai < 2; ++ai)
#pragma unroll
            for (int m = 0; m < 4; ++m) { const int cb = row0 + ai * HALF + m * 16;
#pragma unroll
                for (int bj = 0; bj < 2; ++bj) { const int n0 = col0 + bj * HALF; const int tau = n0 >> 4, h0 = n0 & 15;
                    const f32x4 v0 = acc[ai][bj][m][0], v1 = acc[ai][bj][m][1];
                    const f32x2 a = gelu_pk((f32x2){v0[0], v0[1]}), b = gelu_pk((f32x2){v0[2], v0[3]}), c = gelu_pk((f32x2){v1[0], v1[1]}), d = gelu_pk((f32x2){v1[2], v1[3]});
                    u32x4 w; w.x = cvt_pk_bf16(a.x, a.y); w.y = cvt_pk_bf16(b.x, b.y); w.z = cvt_pk_bf16(c.x, c.y); w.w = cvt_pk_bf16(d.x, d.y);
                    *(u32x4*)(Gb + ((size_t)cb * 32 + tau) * 1024 + 16 * u.bz + h0) = w; } }
    }
};

struct EpiXkv {
    static constexpr bool PERM = false, AFTER_DRAIN = false;
    bf16_t* KP; bf16_t* VT2;
    __device__ __forceinline__ void operator()(const f32x4 (&acc)[2][2][4][2], const Unit& u, int wr, int wc, int fr, int fq) const {
        const int row0 = u.pm * BM + wr * 64 + fr, col0 = u.pn * BM + wc * 32 + 4 * fq;
#pragma unroll
        for (int ai = 0; ai < 2; ++ai)
#pragma unroll
            for (int m = 0; m < 4; ++m) { const int r = row0 + ai * HALF + m * 16; const int b = r >> 8, mm = r & 255;
#pragma unroll
                for (int bj = 0; bj < 2; ++bj)
#pragma unroll
                    for (int n = 0; n < 2; ++n) { const int c = col0 + bj * HALF + n * 16; const f32x4 v = acc[ai][bj][m][n];
                        if (c < 512) { const int hd = c >> 7, d = c & 127; bf16_t* p = KP + ((size_t)(b * 4 + hd) * 256 + mm) * 256;
                            *(unsigned long long*)(p + (hd & 1) * 128 + d) = (unsigned long long)cvt_pk_bf16(v[0], v[1]) | ((unsigned long long)cvt_pk_bf16(v[2], v[3]) << 32);
                            *(unsigned long long*)(p + ((hd & 1) ^ 1) * 128 + d) = 0ull; }
                        else { const int c2 = c - 512, hd = c2 >> 7, d = c2 & 127; bf16_t* p = VT2 + ((size_t)(b * 2 + (hd >> 1)) * 256 + (hd & 1) * 128 + d) * 512;
                            const unsigned w01 = cvt_pk_bf16(v[0], v[1]), w23 = cvt_pk_bf16(v[2], v[3]);
                            const int k1 = (hd & 1) * 256 + mm, k0 = ((hd & 1) ^ 1) * 256 + mm;
                            p[k1] = (bf16_t)(w01 & 0xffffu); p[512 + k1] = (bf16_t)(w01 >> 16); p[1024 + k1] = (bf16_t)(w23 & 0xffffu); p[1536 + k1] = (bf16_t)(w23 >> 16);
                            p[k0] = 0; p[512 + k0] = 0; p[1024 + k0] = 0; p[1536 + k0] = 0; } } }
    }
};
struct EpiXs {
    static constexpr bool PERM = true, AFTER_DRAIN = true;
    bf16_t* XP; float* Lsum;
    __device__ __forceinline__ void fused(f32x4 (&acc)[2][2][4][2], const Unit& u, int wr, int wc, int fr, int fq, PG8_LAS unsigned char* lds, int wid, int lane) const {
        PG8_LAS float* Mx = (PG8_LAS float*)lds;
        const int b = u.bz >> 2, hd = u.bz & 3;
#pragma unroll
        for (int ai = 0; ai < 2; ++ai)
#pragma unroll
            for (int m = 0; m < 4; ++m) { float mx = -INFINITY;
#pragma unroll
                for (int bj = 0; bj < 2; ++bj)
#pragma unroll
                    for (int n = 0; n < 2; ++n) { const f32x4 v = acc[ai][bj][m][n]; mx = fmaxf(mx, fmaxf(fmaxf(v[0], v[1]), fmaxf(v[2], v[3]))); }
                mx = fmaxf(mx, __shfl_xor(mx, 16)); mx = fmaxf(mx, __shfl_xor(mx, 32));
                if (fq == 0) Mx[(ai * HALF + wr * 64 + m * 16 + fr) * 4 + wc] = mx; }
        asm volatile("s_waitcnt lgkmcnt(0)" ::: "memory"); __builtin_amdgcn_s_barrier(); asm volatile("" ::: "memory");
#pragma unroll
        for (int ai = 0; ai < 2; ++ai)
#pragma unroll
            for (int m = 0; m < 4; ++m) { const int rl = ai * HALF + wr * 64 + m * 16 + fr; const f32x4 mv = *(const PG8_LAS f32x4*)(Mx + rl * 4);
                const float mx = fmaxf(fmaxf(mv[0], mv[1]), fmaxf(mv[2], mv[3])); float ss = 0.f;
                const size_t t = (size_t)b * 2048 + u.pm * BM + rl; bf16_t* rowp = XP + t * 1024 + hd * 256 + wc * 32 + 8 * fq;
#pragma unroll
                for (int bj = 0; bj < 2; ++bj) { f32x4 p0, p1;
#pragma unroll
                    for (int e = 0; e < 4; ++e) { p0[e] = __expf(acc[ai][bj][m][0][e] - mx); p1[e] = __expf(acc[ai][bj][m][1][e] - mx); }
                    ss += (p0[0] + p0[1]) + (p0[2] + p0[3]) + (p1[0] + p1[1]) + (p1[2] + p1[3]);
                    u32x4 w; w.x = cvt_pk_bf16(p0[0], p0[1]); w.y = cvt_pk_bf16(p0[2], p0[3]); w.z = cvt_pk_bf16(p1[0], p1[1]); w.w = cvt_pk_bf16(p1[2], p1[3]);
                    *(u32x4*)(rowp + bj * HALF) = w; }
                ss += __shfl_xor(ss, 16); ss += __shfl_xor(ss, 32);
                if (fq == 0) atomicAdd(Lsum + t * 4 + hd, ss); }
    }
};
struct EpiXo {
    static constexpr bool PERM = true, AFTER_DRAIN = false;
    bf16_t* XO; const float* Lsum;
    __device__ __forceinline__ void operator()(const f32x4 (&acc)[2][2][4][2], const Unit& u, int wr, int wc, int fr, int fq) const {
        const int b = u.bz >> 2, pair = (u.bz >> 1) & 1, kh = u.bz & 1;
#pragma unroll
        for (int ai = 0; ai < 2; ++ai)
#pragma unroll
            for (int m = 0; m < 4; ++m) { const size_t t = (size_t)b * 2048 + u.pm * BM + ai * HALF + wr * 64 + m * 16 + fr; bf16_t* rowp = XO + t * 512 + pair * 256 + wc * 32 + 8 * fq;
                { const float il = 1.0f / Lsum[t * 4 + pair * 2 + kh]; const f32x4 v0 = (kh ? acc[ai][1][m][0] : acc[ai][0][m][0]) * il, v1 = (kh ? acc[ai][1][m][1] : acc[ai][0][m][1]) * il;
                    u32x4 w; w.x = cvt_pk_bf16(v0[0], v0[1]); w.y = cvt_pk_bf16(v0[2], v0[3]); w.z = cvt_pk_bf16(v1[0], v1[1]); w.w = cvt_pk_bf16(v1[2], v1[3]);
                    *(u32x4*)(rowp + kh * HALF) = w; } }
    }
};
struct XsOrder {
    int G, c, sel;
    __device__ __forceinline__ bool next(int i, Unit& u) const { if (i > 0) return false; const int L = sel * G + c; if (L >= 256) return false; u.pm = L & 7; u.pn = 0; u.bz = L >> 3; return true; }
    __device__ __forceinline__ void a_ready(const Unit&) const {}
    __device__ __forceinline__ void done(const Unit&) const {}
    template <class G_> __device__ __forceinline__ long offA(const Unit& u, const G_&) const { return (long)(u.bz >> 2) * 2048 * 512 + ((u.bz & 3) >> 1) * 256; }
    template <class G_> __device__ __forceinline__ long offB(const Unit& u, const G_&) const { return (long)u.bz * 256 * 256; }
};
struct XoOrder {
    int G, c;
    __device__ __forceinline__ bool next(int i, Unit& u) const { const int L = i * G + c; if (L >= 256) return false; u.pm = L & 7; u.pn = 0; u.bz = L >> 3; return true; }
    __device__ __forceinline__ void a_ready(const Unit&) const {}
    __device__ __forceinline__ void done(const Unit&) const {}
    template <class G_> __device__ __forceinline__ long offA(const Unit& u, const G_&) const { return (long)(u.bz >> 2) * 2048 * 1024 + (u.bz & 3) * 256; }
    template <class G_> __device__ __forceinline__ long offB(const Unit& u, const G_&) const { return (long)(u.bz >> 1) * 256 * 512 + (u.bz & 1) * 256; }
};
struct EpiGlu {
    static constexpr bool PERM = false, AFTER_DRAIN = false;
    const bf16_t* G; const float* bias; bf16_t* CAT; float* ssq;
    __device__ __forceinline__ void operator()(const f32x4 (&acc)[2][2][4][2], const Unit& u, int wr, int wc, int fr, int fq) const {
        const int row0 = u.pm * BM + wr * 64 + fr, col0 = u.pn * BM + wc * 32 + 4 * fq;
#pragma unroll
        for (int ai = 0; ai < 2; ++ai)
#pragma unroll
            for (int m = 0; m < 4; ++m) { const int r = row0 + ai * HALF + m * 16; float ss = 0.f;
#pragma unroll
                for (int bj = 0; bj < 2; ++bj)
#pragma unroll
                    for (int n = 0; n < 2; ++n) { const int c = col0 + bj * HALF + n * 16; const f32x4 z = acc[ai][bj][m][n] + *(const f32x4*)(bias + c); const unsigned long long gb = *(const unsigned long long*)(G + (size_t)r * 1024 + c);
                        f32x4 gv; gv[0] = __uint_as_float((unsigned)gb << 16); gv[1] = __uint_as_float((unsigned)gb & 0xffff0000u); gv[2] = __uint_as_float((unsigned)(gb >> 32) << 16); gv[3] = __uint_as_float((unsigned)(gb >> 32) & 0xffff0000u);
                        f32x4 o; o[0] = gv[0] / (1.0f + __expf(-z[0])); o[1] = gv[1] / (1.0f + __expf(-z[1])); o[2] = gv[2] / (1.0f + __expf(-z[2])); o[3] = gv[3] / (1.0f + __expf(-z[3]));
                        ss += o[0] * o[0] + o[1] * o[1] + o[2] * o[2] + o[3] * o[3];
                        const unsigned long long w = (unsigned long long)cvt_pk_bf16(o[0], o[1]) | ((unsigned long long)cvt_pk_bf16(o[2], o[3]) << 32);
                        *(unsigned long long*)(CAT + (size_t)r * 2048 + 1024 + c) = w; }
                ss += __shfl_xor(ss, 16); ss += __shfl_xor(ss, 32);
                if (fq == 0) atomicAdd(ssq + r, ss); }
    }
};
struct EpiWin {
    static constexpr bool PERM = true, AFTER_DRAIN = false;
    bf16_t* QKV; size_t sec_stride; bf16_t* UC; const float* rope; float qscale;
    __device__ __forceinline__ void operator()(const f32x4 (&acc)[2][2][4][2], const Unit& u, int wr, int wc, int fr, int fq) const {
        const int row0 = u.pm * BM + wr * 64 + fr;
        const int sec = u.pn >> 2;
        const int col0 = (u.pn & 3) * BM + wc * 32 + 8 * fq;
        if (sec == 3) {
#pragma unroll
            for (int ai = 0; ai < 2; ++ai)
#pragma unroll
                for (int m = 0; m < 4; ++m) { const int r = row0 + ai * HALF + m * 16; const int cb = r >> 5, sg = r & 31;
#pragma unroll
                    for (int bj = 0; bj < 2; ++bj) { const int col = col0 + bj * HALF; const int g = col >> 4, h0 = col & 15;
                        const f32x4 v0 = acc[ai][bj][m][0], v1 = acc[ai][bj][m][1];
                        u32x4 w; w.x = cvt_pk_bf16(v0[0], v0[1]); w.y = cvt_pk_bf16(v0[2], v0[3]); w.z = cvt_pk_bf16(v1[0], v1[1]); w.w = cvt_pk_bf16(v1[2], v1[3]);
                        *(u32x4*)(UC + ((size_t)g * 512 + cb) * 640 + sg * 16 + h0) = w; } }
            return;
        }
        bf16_t* base = QKV + (size_t)sec * sec_stride;
        const float sc = sec == 0 ? qscale : 1.0f;
        const bool rot = (sec < 2) && ((wc & 1) == 0);
        const float sgn = (fq & 1) ? 1.0f : -1.0f;
        const bool mine = fq < 2;
#pragma unroll
        for (int ai = 0; ai < 2; ++ai)
#pragma unroll
            for (int m = 0; m < 4; ++m) { const int r = row0 + ai * HALF + m * 16; bf16_t* rowp = base + (size_t)r * 1024 + col0;
                f32x4 cs[4];
                if (rot) {
#pragma unroll
                    for (int q = 0; q < 4; ++q) cs[q] = *(const f32x4*)(rope + (size_t)r * 16 + 4 * q);
                }
#pragma unroll
                for (int bj = 0; bj < 2; ++bj) { f32x4 v0 = acc[ai][bj][m][0], v1 = acc[ai][bj][m][1];
                    if (rot) {
                        f32x4 p0, p1;
#pragma unroll
                        for (int e = 0; e < 4; ++e) { p0[e] = __shfl_xor(v0[e], 16); p1[e] = __shfl_xor(v1[e], 16); }
                        if (mine) {
#pragma unroll
                            for (int e = 0; e < 4; ++e) {
                                const float c0 = cs[e >> 1][(e & 1) * 2], s0 = cs[e >> 1][(e & 1) * 2 + 1];
                                const float c1 = cs[2 + (e >> 1)][(e & 1) * 2], s1 = cs[2 + (e >> 1)][(e & 1) * 2 + 1];
                                v0[e] = v0[e] * c0 + sgn * p0[e] * s0; v1[e] = v1[e] * c1 + sgn * p1[e] * s1; }
                        }
                    }
                    v0 = v0 * sc; v1 = v1 * sc; u32x4 w; w.x = cvt_pk_bf16(v0[0], v0[1]); w.y = cvt_pk_bf16(v0[2], v0[3]); w.z = cvt_pk_bf16(v1[0], v1[1]); w.w = cvt_pk_bf16(v1[2], v1[3]);
                    *(u32x4*)(rowp + bj * HALF) = w; } }
    }
};
}
#define GEMM_RUN(EPI, ALIGN, g, S, E) pg8::gemm_phase<EPI, pg8::StaticOrder, ALIGN, true>(F.ldsl, g, S, E)
namespace attn_body {
using bf16=__hip_bfloat16;
using bf16x8=__attribute__((ext_vector_type(8)))short;
using s16x4=__attribute__((ext_vector_type(4)))short;
using f32x16=__attribute__((ext_vector_type(16)))float;
using u32x4=__attribute__((ext_vector_type(4)))unsigned;
constexpr int BATCH=8,NHEAD=16,SEQ=2048,D=64,DM=NHEAD*D;
constexpr int NW=8,QBLK=32,QB=QBLK*NW,KVBLK=64,NQB=SEQ/QB;
constexpr int ATTN_PITCH=DM, ATTN_UNIT_ROWS=QB;
__device__ __forceinline__ int crow(int r,int hi){return (r&3)+8*(r>>2)+4*hi;}
#define SBAR() __builtin_amdgcn_sched_barrier(0)
__device__ __forceinline__ void cmask(f32x16&p0,f32x16&p1,int jb,int qrel,int hi){
  asm volatile("":"+v"(qrel),"+v"(hi));
  const float NEG=-INFINITY; int kb=64*jb+4*hi;
  #pragma unroll
  for(int r=0;r<16;++r){int kv=kb+(r&3)+8*(r>>2); if(kv>qrel)p0[r]=NEG; if(kv+32>qrel)p1[r]=NEG;}
}

constexpr int NSLOT=3, SLOTB=8192;
constexpr int LDS_K=0, LDS_V=NSLOT*SLOTB, LDS_WS=2*NSLOT*SLOTB, LDS_OST=LDS_WS+NW*64*4, LDS_BYTES=LDS_OST+NW*4096, LDS_X=LDS_BYTES, LDS_SSQ=LDS_X+NW*4096;
constexpr float C2=0.125f*1.4426950408889634f;
__device__ __forceinline__ void glds16(const void*gsrc,unsigned lds_dst){unsigned keep;
  asm volatile("s_mov_b32 %0, m0\n\ts_mov_b32 m0, %2\n\ts_nop 0\n\tglobal_load_lds_dwordx4 %1, off\n\ts_mov_b32 m0, %0":"=&s"(keep):"v"(gsrc),"s"(lds_dst):"memory");}
__device__ __forceinline__ float max3f(float a,float b,float c){float r;asm("v_max3_f32 %0, %1, %2, %3":"=v"(r):"v"(a),"v"(b),"v"(c));return r;}
__device__ __forceinline__ float max2f(float a,float b){float r;asm("v_max_f32_e32 %0, %1, %2":"=v"(r):"v"(a),"v"(b));return r;}
__device__ __forceinline__ float fadd_s(float a,float b){float r;asm("v_add_f32_e32 %0, %1, %2":"=v"(r):"v"(a),"v"(b));return r;}
__device__ __forceinline__ float fsub_s(float a,float b){float r;asm("v_sub_f32_e32 %0, %1, %2":"=v"(r):"v"(a),"v"(b));return r;}
typedef float f32x2_t __attribute__((ext_vector_type(2))); typedef __bf16 bf16x2_t __attribute__((ext_vector_type(2)));
__device__ __forceinline__ unsigned cvtpk_s(float lo,float hi){f32x2_t v={lo,hi};bf16x2_t b=__builtin_convertvector(v,bf16x2_t);return __builtin_bit_cast(unsigned,b);}
#define WAIT_BAR(N) asm volatile("s_waitcnt vmcnt(" #N ") lgkmcnt(0)\n\ts_barrier":::"memory")

__device__ __forceinline__ void qkt(f32x16&p0,f32x16&p1,const char*Kslot,const bf16x8*qr,int r32,int hi){ const f32x16 zc=f32x16{};
  const char*kb=Kslot+hi*1024+r32*16;
  #pragma unroll
  for(int d0=0;d0<4;++d0){
    const bf16x8 b0=*reinterpret_cast<const bf16x8*>(kb+d0*2048);
    const bf16x8 b1=*reinterpret_cast<const bf16x8*>(kb+d0*2048+512);
    if(d0==0){p0=__builtin_amdgcn_mfma_f32_32x32x16_bf16(b0,qr[0],zc,0,0,0);p1=__builtin_amdgcn_mfma_f32_32x32x16_bf16(b1,qr[0],zc,0,0,0);}
    else{p0=__builtin_amdgcn_mfma_f32_32x32x16_bf16(b0,qr[d0],p0,0,0,0);p1=__builtin_amdgcn_mfma_f32_32x32x16_bf16(b1,qr[d0],p1,0,0,0);}}
}
typedef __attribute__((address_space(3))) const char* lds_cptr;
typedef short v4i16_t __attribute__((ext_vector_type(4)));
__device__ __forceinline__ void kload8(bf16x8*kf,lds_cptr kp){
  kf[0]=*(const __attribute__((address_space(3))) bf16x8*)(kp);      kf[1]=*(const __attribute__((address_space(3))) bf16x8*)(kp+512);
  kf[2]=*(const __attribute__((address_space(3))) bf16x8*)(kp+2048); kf[3]=*(const __attribute__((address_space(3))) bf16x8*)(kp+2560);
  kf[4]=*(const __attribute__((address_space(3))) bf16x8*)(kp+4096); kf[5]=*(const __attribute__((address_space(3))) bf16x8*)(kp+4608);
  kf[6]=*(const __attribute__((address_space(3))) bf16x8*)(kp+6144); kf[7]=*(const __attribute__((address_space(3))) bf16x8*)(kp+6656);
}
__device__ __forceinline__ void kload2(bf16x8*kf,lds_cptr kp,int j){ kf[2*j]=*(const __attribute__((address_space(3))) bf16x8*)(kp+j*2048); kf[2*j+1]=*(const __attribute__((address_space(3))) bf16x8*)(kp+j*2048+512); }
__device__ __forceinline__ s16x4 vtr(lds_cptr p){ return __builtin_bit_cast(s16x4,__builtin_amdgcn_ds_read_tr16_b64_v4i16((__attribute__((address_space(3))) v4i16_t*)p)); }
__device__ __forceinline__ float rowmax(const f32x16&p0,const f32x16&p1){
  float a=max3f(p0[0],p0[1],p1[0]),b=max3f(p0[2],p0[3],p1[1]);a=max3f(a,p1[2],p1[3]);
  #pragma unroll
  for(int r=4;r<16;r+=4){a=max3f(a,p0[r],p0[r+1]);b=max3f(b,p0[r+2],p0[r+3]);a=max3f(a,p1[r],p1[r+1]);b=max3f(b,p1[r+2],p1[r+3]);}
  const float m=max2f(a,b);
  auto rr=__builtin_amdgcn_permlane32_swap(__float_as_uint(m),__float_as_uint(m),false,false);
  return max2f(__uint_as_float(rr[0]),__uint_as_float(rr[1]));
}
__device__ __forceinline__ void pv(f32x16*o,int vb,bf16x8 pa0,bf16x8 pa1,bf16x8 pa2,bf16x8 pa3){
  #pragma unroll
  for(int d0=0;d0<2;++d0){s16x4 lo[4],hi[4];
    #pragma unroll
    for(int ks=0;ks<4;++ks){
      asm volatile("ds_read_b64_tr_b16 %0,%1 offset:%c2":"=&v"(lo[ks]):"v"(vb),"i"(d0*4096+ks*1024):"memory");
      asm volatile("ds_read_b64_tr_b16 %0,%1 offset:%c2":"=&v"(hi[ks]):"v"(vb),"i"(d0*4096+ks*1024+512):"memory");}
    asm volatile("s_waitcnt lgkmcnt(0)":::"memory");SBAR();
    #define PK(k) (bf16x8){lo[k][0],lo[k][1],lo[k][2],lo[k][3],hi[k][0],hi[k][1],hi[k][2],hi[k][3]}
    o[d0]=__builtin_amdgcn_mfma_f32_32x32x16_bf16(pa0,PK(0),o[d0],0,0,0);
    o[d0]=__builtin_amdgcn_mfma_f32_32x32x16_bf16(pa1,PK(1),o[d0],0,0,0);
    o[d0]=__builtin_amdgcn_mfma_f32_32x32x16_bf16(pa2,PK(2),o[d0],0,0,0);
    o[d0]=__builtin_amdgcn_mfma_f32_32x32x16_bf16(pa3,PK(3),o[d0],0,0,0);
    #undef PK
  }
}

#ifndef ATTN_STORE16
#define ATTN_STORE16(p,v) (*(u32x4*)(p)=(v))
#endif
template<int THRL> __device__ __forceinline__ void attn_unit(int b,int h,int hv,int qb,const bf16*Q,const bf16*__restrict__ K,const bf16*__restrict__ V,bf16*CATp,const int mode,const float lam,const float*hgp,char*shm){
  const int tid=threadIdx.x,lane=tid&63,r32=lane&31,hi=lane>>5; const int wid=__builtin_amdgcn_readfirstlane(tid>>6);
  const long rowbase=(long)b*SEQ; const int q0=qb*QB;
  const bf16*Qw=Q+(rowbase+q0+wid*QBLK)*DM+h*D;
  const bf16*Kh=K+rowbase*DM+h*D,*Vh=V+rowbase*DM+hv*D;
  const unsigned lds0=(unsigned)(uintptr_t)shm;
  float*wsf=(float*)(shm+LDS_WS)+wid*64;
  const bf16*ksrc=Kh+(long)lane*DM+wid*8;
  const bf16*vsrc=Vh+(long)(16*(wid&3)+(lane>>2))*DM+(wid>>2)*32+(lane&3)*8;
  const unsigned kdst=lds0+LDS_K+wid*1024, vdst=lds0+LDS_V+wid*1024;
  #define DMA_K(t,slot) glds16(ksrc+(long)(t)*KVBLK*DM,(unsigned)__builtin_amdgcn_readfirstlane(kdst+(slot)))
  #define DMA_V(t,slot) glds16(vsrc+(long)(t)*KVBLK*DM,(unsigned)__builtin_amdgcn_readfirstlane(vdst+(slot)))
  const int vb0=(int)(lds0+LDS_V)+((lane>>4)&1)*32+(lane&3)*8+(4*hi+((lane&15)>>2))*64;
  const char*Kbase=shm+LDS_K; bf16x8 kf[8];
  const lds_cptr shm3=(lds_cptr)shm; const lds_cptr kp0=shm3+LDS_K+hi*1024+r32*16; const lds_cptr vp0=shm3+LDS_V+((lane>>4)&1)*32+(lane&3)*8+(4*hi+((lane&15)>>2))*64;
  const int NT=(q0+QB)/KVBLK;
  DMA_K(0,0);DMA_V(0,0);DMA_K(1,SLOTB);
  bf16x8 qr[4];
  #pragma unroll
  for(int d0=0;d0<4;++d0)qr[d0]=*reinterpret_cast<const bf16x8*>(&Qw[(long)r32*DM+d0*16+hi*8]);
  float mhat=0.f,l_reg=0.f;f32x16 o[2];o[0]=f32x16{};o[1]=f32x16{};
  const int qrel=wid*QBLK+r32;
  #define CMASK(P0,P1,t) do{int jb_=(t)-(NT-4); if(jb_>=0)cmask(P0,P1,jb_,qrel,hi);}while(0)
  bool resc=false;
  #define START(P0,P1) do{ const float rm=rowmax(P0,P1); resc=false; mhat=rm; \
    _Pragma("unroll") for(int r=0;r<16;++r)P0[r]=__builtin_amdgcn_exp2f(fsub_s(P0[r],mhat)); }while(0)
  #define RESC() do{ if(resc){ asm volatile("s_waitcnt lgkmcnt(0)":::"memory"); \
      _Pragma("unroll") for(int d_=0;d_<2;++d_) _Pragma("unroll") for(int r=0;r<16;++r)o[d_][r]*=wsf[crow(r,hi)]; } }while(0)
  f32x16 pA0,pA1,pB0,pB1;
  int sl_prev=0,sl_cur=0,sl_next=SLOTB;
  #define ROT() do{sl_prev=sl_cur;sl_cur=sl_next;sl_next=(sl_next==(NSLOT-1)*SLOTB)?0:sl_next+SLOTB;}while(0)
  DMA_K(2,2*SLOTB);
  WAIT_BAR(3);
  qkt(pA0,pA1,Kbase,qr,r32,hi);asm volatile("s_nop 15\n\ts_nop 7":"+v"(pA0),"+v"(pA1));CMASK(pA0,pA1,0);
  START(pA0,pA1);
  _Pragma("unroll") for(int r=0;r<16;++r)pA1[r]=__builtin_amdgcn_exp2f(fsub_s(pA1[r],mhat));
  WAIT_BAR(0);
  DMA_K(3,0);DMA_V(1,SLOTB);
  ROT();
  kload8(kf,kp0+sl_cur);
  WAIT_BAR(2);
  s16x4 vlo[8],vhi[8]; u32x4 pw0,pw1,pw2,pw3;
  #define PKW(P,B) cvtpk_s(P[B],P[B+1])
  #define PAF(k) __builtin_bit_cast(bf16x8,pw##k)
  #define VFR(i) (bf16x8){vlo[i][0],vlo[i][1],vlo[i][2],vlo[i][3],vhi[i][0],vhi[i][1],vhi[i][2],vhi[i][3]}
  #define PIN(x) asm volatile("":"+v"(x))
  #define MX3(a,b,c) __builtin_fmaxf(__builtin_fmaxf((a),(b)),(c))
  #define GAPA(MF,A0,A1,A2,A3,W0,W1,PW) do{ MF; sacc+=A0; sacc+=A1; sacc+=A2; sacc+=A3; PIN(sacc); W0; W1; PIN(PW); SBAR(); }while(0)
  #define EX(v) __builtin_amdgcn_exp2f((v)-mhat)
  #define GAPB(MF,X,B) do{ MF; X[B]=EX(X[B]); X[B+1]=EX(X[B+1]); X[B+2]=EX(X[B+2]); X[B+3]=EX(X[B+3]); PIN(X); SBAR(); }while(0)
  #define VRD(i) do{ vlo[i]=vtr(vp_+(((i)>>2)*4096+((i)&3)*1024)); vhi[i]=vtr(vp_+(((i)>>2)*4096+((i)&3)*1024+512)); }while(0)
  #define KRD(G,j) do{ if(G){ kload2(kf,kp0+sl_next,j); SBAR(); } }while(0)
  #define STEP(C0,C1,P0,P1,t,GK,GV,GL) do{ SBAR(); const f32x16 zc_=f32x16{}; \
    const lds_cptr vp_=vp0+sl_prev; \
    VRD(0); SBAR(); float sacc=(P0[0]+P0[1]); \
    GAPA(C0=__builtin_amdgcn_mfma_f32_32x32x16_bf16(kf[0],qr[0],zc_,0,0,0), P0[2],P0[3],P0[4],P0[5],     pw0[0]=PKW(P0,0), pw0[1]=PKW(P0,2), pw0); \
    VRD(4); SBAR(); GAPA(C1=__builtin_amdgcn_mfma_f32_32x32x16_bf16(kf[1],qr[0],zc_,0,0,0), P0[6],P0[7],P0[8],P0[9],     pw0[2]=PKW(P0,4), pw0[3]=PKW(P0,6), pw0); \
    VRD(1); SBAR(); GAPA(C0=__builtin_amdgcn_mfma_f32_32x32x16_bf16(kf[2],qr[1],C0,0,0,0),   P0[10],P0[11],P0[12],P0[13], pw1[0]=PKW(P0,8), pw1[1]=PKW(P0,10), pw1); \
    VRD(5); SBAR(); GAPA(C1=__builtin_amdgcn_mfma_f32_32x32x16_bf16(kf[3],qr[1],C1,0,0,0),   P0[14],P0[15],P1[0],P1[1],   pw1[2]=PKW(P0,12),pw1[3]=PKW(P0,14), pw1); \
    VRD(2); SBAR(); GAPA(C0=__builtin_amdgcn_mfma_f32_32x32x16_bf16(kf[4],qr[2],C0,0,0,0),   P1[2],P1[3],P1[4],P1[5],     pw2[0]=PKW(P1,0), pw2[1]=PKW(P1,2), pw2); \
    VRD(6); SBAR(); GAPA(C1=__builtin_amdgcn_mfma_f32_32x32x16_bf16(kf[5],qr[2],C1,0,0,0),   P1[6],P1[7],P1[8],P1[9],     pw2[2]=PKW(P1,4), pw2[3]=PKW(P1,6), pw2); \
    VRD(3); SBAR(); GAPA(C0=__builtin_amdgcn_mfma_f32_32x32x16_bf16(kf[6],qr[3],C0,0,0,0),   P1[10],P1[11],P1[12],P1[13], pw3[0]=PKW(P1,8), pw3[1]=PKW(P1,10), pw3); \
    VRD(7); SBAR(); GAPA(C1=__builtin_amdgcn_mfma_f32_32x32x16_bf16(kf[7],qr[3],C1,0,0,0),   P1[14],P1[15],0.f,0.f,       pw3[2]=PKW(P1,12),pw3[3]=PKW(P1,14), pw3); \
    l_reg+=sacc; \
    if(GK){DMA_K((t)+3,sl_cur);} if(GV){DMA_V((t)+1,sl_next);} \
    CMASK(C0,C1,t); \
    { float a=MX3(C0[0],C0[1],C1[0]),b=MX3(C0[2],C0[3],C1[1]); a=MX3(a,C1[2],C1[3]); \
      _Pragma("unroll") for(int r=4;r<16;r+=4){a=MX3(a,C0[r],C0[r+1]);b=MX3(b,C0[r+2],C0[r+3]);a=MX3(a,C1[r],C1[r+1]);b=MX3(b,C1[r+2],C1[r+3]);} \
      float rm=__builtin_fmaxf(a,b); { auto rr=__builtin_amdgcn_permlane32_swap(__float_as_uint(rm),__float_as_uint(rm),false,false); rm=__builtin_fmaxf(__uint_as_float(rr[0]),__uint_as_float(rr[1])); } \
      resc=false; \
      rm-=mhat; \
      if(__builtin_expect(__any(rm>(float)THRL),0)){ const float dl=__builtin_fmaxf(rm,0.f); mhat+=dl; \
        const float f=__builtin_amdgcn_exp2f(-dl); l_reg*=f; if(hi==0)wsf[r32]=f; resc=true; } } \
    SBAR(); \
    GAPB(o[0]=__builtin_amdgcn_mfma_f32_32x32x16_bf16(PAF(0),VFR(0),o[0],0,0,0), C0,0); \
    GAPB(o[1]=__builtin_amdgcn_mfma_f32_32x32x16_bf16(PAF(0),VFR(4),o[1],0,0,0), C0,4); \
    KRD(GL,0); GAPB(o[0]=__builtin_amdgcn_mfma_f32_32x32x16_bf16(PAF(1),VFR(1),o[0],0,0,0), C0,8); \
    KRD(GL,1); GAPB(o[1]=__builtin_amdgcn_mfma_f32_32x32x16_bf16(PAF(1),VFR(5),o[1],0,0,0), C0,12); \
    KRD(GL,2); GAPB(o[0]=__builtin_amdgcn_mfma_f32_32x32x16_bf16(PAF(2),VFR(2),o[0],0,0,0), C1,0); \
    KRD(GL,3); GAPB(o[1]=__builtin_amdgcn_mfma_f32_32x32x16_bf16(PAF(2),VFR(6),o[1],0,0,0), C1,4); \
    GAPB(o[0]=__builtin_amdgcn_mfma_f32_32x32x16_bf16(PAF(3),VFR(3),o[0],0,0,0), C1,8); \
    GAPB(o[1]=__builtin_amdgcn_mfma_f32_32x32x16_bf16(PAF(3),VFR(7),o[1],0,0,0), C1,12); \
    }while(0)
  int t=1;
  #undef CMASK
  #define CMASK(P0,P1,t) do{}while(0)
  for(;t+5<NT;t+=2){
    STEP(pB0,pB1,pA0,pA1,t,true,true,true);     WAIT_BAR(2); RESC(); ROT();
    STEP(pA0,pA1,pB0,pB1,t+1,true,true,true);   WAIT_BAR(2); RESC(); ROT();
  }
  #undef CMASK
  #define CMASK(P0,P1,t) do{int jb_=(t)-(NT-4); if(jb_>=0)cmask(P0,P1,jb_,qrel,hi);}while(0)
  #define ENDW(tt) do{ if((tt)+3<NT){WAIT_BAR(2);} else if((tt)+2<NT){WAIT_BAR(1);} else {WAIT_BAR(0);} }while(0)
  for(;t+1<NT;t+=2){
    STEP(pB0,pB1,pA0,pA1,t,(t+3<NT),(t+1<NT),(t+1<NT));       ENDW(t);   RESC(); ROT();
    STEP(pA0,pA1,pB0,pB1,t+1,(t+4<NT),(t+2<NT),(t+2<NT));     ENDW(t+1); RESC(); ROT();
  }
  STEP(pB0,pB1,pA0,pA1,NT-1,false,false,false); RESC();
  { float sacc=pB0[0]+pB0[1]; _Pragma("unroll") for(int r=2;r<16;++r)sacc+=pB0[r]; _Pragma("unroll") for(int r=0;r<16;++r)sacc+=pB1[r]; l_reg+=sacc;
    pw0=(u32x4){PKW(pB0,0),PKW(pB0,2),PKW(pB0,4),PKW(pB0,6)};pw1=(u32x4){PKW(pB0,8),PKW(pB0,10),PKW(pB0,12),PKW(pB0,14)};pw2=(u32x4){PKW(pB1,0),PKW(pB1,2),PKW(pB1,4),PKW(pB1,6)};pw3=(u32x4){PKW(pB1,8),PKW(pB1,10),PKW(pB1,12),PKW(pB1,14)};
    SBAR(); pv(o,vb0+sl_cur,PAF(0),PAF(1),PAF(2),PAF(3)); }
  #undef PKW
  #undef PAF
  #undef VFR
  #undef PIN
  #undef MX3
  #undef GAPA
  #undef GAPB
  #undef EX
  #undef VRD
  #undef KRD
  #undef STEP
  #undef ENDW
  {auto rr=__builtin_amdgcn_permlane32_swap(__float_as_uint(l_reg),__float_as_uint(l_reg),false,false);l_reg=__uint_as_float(rr[0])+__uint_as_float(rr[1]);}
  if(hi==0)wsf[32+r32]=l_reg;asm volatile("s_waitcnt lgkmcnt(0)":::"memory");
  float rli[16];
  #pragma unroll
  for(int r=0;r<16;++r)rli[r]=__builtin_amdgcn_rcpf(wsf[32+crow(r,hi)]);
  { bf16*stg=(bf16*)(shm+LDS_OST)+wid*2048;
    bf16*xst=(bf16*)(shm+LDS_X)+wid*2048; float*ssq=(float*)(shm+LDS_SSQ)+wid*32;
    bf16*cur=(mode&2)?stg:xst;
    if((mode&1)==0){
      #pragma unroll
      for(int r=0;r<16;++r){const int orow=crow(r,hi);
        #pragma unroll
        for(int d0=0;d0<2;++d0)cur[orow*64+d0*32+r32]=__float2bfloat16(o[d0][r]*rli[r]);}
    } else {
      #pragma unroll
      for(int r=0;r<16;++r){const int orow=crow(r,hi);
        #pragma unroll
        for(int d0=0;d0<2;++d0){const int pos=orow*64+d0*32+r32; const float dd=__bfloat162float(cur[pos])-lam*(o[d0][r]*rli[r]); cur[pos]=__float2bfloat16(dd);}}
      asm volatile("s_waitcnt lgkmcnt(0)":::"memory");
      const long trow=rowbase+q0+wid*QBLK;
      #pragma unroll
      for(int i=0;i<4;++i){const int row=i*8+(lane>>3),ch=lane&7; const u32x4 vb=*(const u32x4*)(cur+row*64+ch*8);
        float fb[8];
        #pragma unroll
        for(int e=0;e<4;++e){fb[2*e]=__uint_as_float(vb[e]<<16);fb[2*e+1]=__uint_as_float(vb[e]&0xffff0000u);}
        float ss=0.f;
        #pragma unroll
        for(int e=0;e<8;++e)ss+=fb[e]*fb[e];
        ss+=__shfl_xor(ss,1);ss+=__shfl_xor(ss,2);ss+=__shfl_xor(ss,4);
        if(mode==1){ if(ch==0)ssq[row]=ss; }
        else{
          const u32x4 va=*(const u32x4*)(xst+row*64+ch*8);
          const float rr=(1.0f-LAM_INIT)/sqrtf((ssq[row]+ss)/128.0f+EPS);
          const float4 ga0=*(const float4*)(hgp+ch*8),ga1=*(const float4*)(hgp+ch*8+4),gb0=*(const float4*)(hgp+64+ch*8),gb1=*(const float4*)(hgp+64+ch*8+4);
          const float ga[8]={ga0.x,ga0.y,ga0.z,ga0.w,ga1.x,ga1.y,ga1.z,ga1.w},gb[8]={gb0.x,gb0.y,gb0.z,gb0.w,gb1.x,gb1.y,gb1.z,gb1.w};
          u32x4 oa,ob;
          #pragma unroll
          for(int e=0;e<4;++e){
            oa[e]=cvtpk_s(__uint_as_float(va[e]<<16)*rr*ga[2*e],__uint_as_float(va[e]&0xffff0000u)*rr*ga[2*e+1]);
            ob[e]=cvtpk_s(fb[2*e]*rr*gb[2*e],fb[2*e+1]*rr*gb[2*e+1]);}
          bf16*cp=CATp+(trow+row)*2048+(hv>>1)*128+ch*8;
          ATTN_STORE16(cp,oa); ATTN_STORE16(cp+64,ob);
        }
      }
    }
  }
  asm volatile("s_waitcnt lgkmcnt(0)\n\ts_barrier":::"memory");
  #undef DMA_K
  #undef DMA_V
  #undef CMASK
  #undef START
  #undef RESC
  #undef ROT
}
constexpr int ATTN_LDS_BYTES=LDS_BYTES+NW*4096+NW*128;
struct AttnTensors { const bf16* Q; const bf16* K; const bf16* V; bf16* CAT; float lam; const float* hg; };
template<int THRL=8> __device__ __forceinline__ void attn_phase(char*lds,const AttnTensors&T,int vcu,int G){
  for(int item=vcu;item<BATCH*8*4;item+=G){
    const int b=item>>5,h=(item>>2)&7,j=item&3;
    for(int q2=0;q2<2;++q2){ const int qb=q2?j:NQB-1-j;
      for(int mode=0;mode<4;++mode) attn_unit<THRL>(b,2*h+(mode&1),2*h+(mode>>1),qb,T.Q,T.K,T.V,T.CAT,mode,T.lam,T.hg,lds); }
  }
}
#undef SBAR
#undef WAIT_BAR
}

__device__ __forceinline__ void p_s5_stepA(const Frame& F, const Args& A);
__device__ __forceinline__ void p3_attn(const Frame& F, const Args& A) {
    const attn_body::AttnTensors AT{(const attn_body::bf16*)WSB(WS_QB), (const attn_body::bf16*)WSB(WS_KB), (const attn_body::bf16*)WSB(WS_VB), (attn_body::bf16*)WSB(WS_B), *WSF(WS_LAM), IN_F(9)};
    const int vcu = (F.G % 8 == 0) ? (F.bid % 8) * (F.G / 8) + F.bid / 8 : F.bid;
    p_s5_stepA(F, A);
    attn_body::attn_phase<8>((char*)F.lds, AT, vcu, F.G);
}
__device__ __forceinline__ void p0_s5_setup(const Frame& F, const Args& A) {
    LAS float* Apr = (LAS float*)F.ldsl;
    LAS float* Api = Apr + 33 * 64;
    LAS float* Bbr = Api + 33 * 64;
    LAS float* Bbi = Bbr + 1024;
    LAS float* Cr = Bbi + 1024;
    LAS float* Ci = Cr + 1024;
    LAS float* Kk = Ci + 1024;
    const float* a_re = IN_F(10); const float* a_im = IN_F(11); const float* log_dt = IN_F(12);
    const float* b_re = IN_F(13); const float* b_im = IN_F(14); const float* c_re = IN_F(15); const float* c_im = IN_F(16); const float* dsk = IN_F(17);
    bf16* BtC = WSB(WS_BTC); bf16* BtA = WSB(WS_BTA); float* AL = WSF(WS_AL);
    const int tid = F.tid;
    const float* xin = IN_F(0); const float* g3 = IN_F(3); bf16* XN = WSB(WS_B);
    const int gw4 = 4 * (F.bid * NWAVES + F.wave), step4 = 4 * F.G * NWAVES; int nbat = 0;
#define S5_BAR() asm volatile("s_waitcnt lgkmcnt(0)\n\ts_barrier" ::: "memory")
    for (int item = F.bid; item < SG * 4; item += F.G) {
        const int g = item >> 2, hq = item & 3; const bool first = item == F.bid;
        S5_BAR();
        const float dtf = expf(log_dt[g]); const double dt = (double)dtf;
        for (int e = tid; e < 33 * 64; e += NTHR) {
            const int k = e >> 6, p = e & 63;
            const float lre = a_re[g * SP + p], lim = a_im[g * SP + p];
            const float mag = expf(lre * dtf * (float)k), af = lim * dtf * (float)k;
            Apr[e] = mag * cosf(af); Api[e] = mag * sinf(af);
        }
        for (int e = tid; e < 1024; e += NTHR) {
            const int p = e >> 4, h = e & 15;
            const double lre = a_re[g * SP + p], lim = a_im[g * SP + p];
            const double mag = exp(lre * dt), ang = lim * dt;
            const double rev = ang * 0.15915494309189533577, frr = rev - floor(rev);
            const float af = (float)(frr * 6.283185307179586477);
            const double ar = mag * (double)cosf(af), ai = mag * (double)sinf(af);
            const double den = lre * lre + lim * lim;
            const double fre = ((ar - 1.0) * lre + ai * lim) / den, fim = (ai * lre - (ar - 1.0) * lim) / den;
            const double br = b_re[(g * SP + p) * 16 + h], bi = b_im[(g * SP + p) * 16 + h];
            Bbr[e] = (float)(fre * br - fim * bi); Bbi[e] = (float)(fre * bi + fim * br);
            Cr[h * 64 + p] = c_re[(g * 16 + h) * SP + p]; Ci[h * 64 + p] = c_im[(g * 16 + h) * SP + p];
        }
        S5_BAR();
        float4 pv[32]; const int r0 = gw4 + nbat * step4; const bool has0 = first && r0 < T;
        if (has0) { norm4_load(xin + (size_t)r0 * DM, F.lane, pv); ++nbat; }
        if (hq == 0 && tid < 64) { AL[(g * 64 + tid) * 2] = Apr[32 * 64 + tid]; AL[(g * 64 + tid) * 2 + 1] = Api[32 * 64 + tid]; }
        if (tid < 128) {
            const int k = tid >> 2, hl = tid & 3, h = 4 * hq + hl;
            float acc[16];
#pragma unroll
            for (int q = 0; q < 16; ++q) acc[q] = 0.f;
            for (int p = 0; p < 64; ++p) {
                const float cr = Cr[h * 64 + p], ci = Ci[h * 64 + p], ar = Apr[k * 64 + p], ai = Api[k * 64 + p];
                const float gr = cr * ar - ci * ai, gi = cr * ai + ci * ar;
#pragma unroll
                for (int q = 0; q < 16; ++q) acc[q] += gr * Bbr[p * 16 + q] - gi * Bbi[p * 16 + q];
            }
#pragma unroll
            for (int q = 0; q < 16; ++q) Kk[tid * 16 + q] = acc[q];
        }
        S5_BAR();
        const float dk0 = dsk[g * 16 + 4 * hq], dk1 = dsk[g * 16 + 4 * hq + 1], dk2 = dsk[g * 16 + 4 * hq + 2], dk3 = dsk[g * 16 + 4 * hq + 3];
        if (has0) norm4_finish(pv, g3, XN + (size_t)r0 * DM, F.lane);
        const int r1 = gw4 + nbat * step4; const bool has1 = first && r1 < T;
        if (has1) { norm4_load(xin + (size_t)r1 * DM, F.lane, pv); ++nbat; }
        asm volatile("" ::: "memory");
        for (int e = tid; e < 128 * 80; e += NTHR) {
            const int rr = e / 80, k0 = (e - rr * 80) * 8; const int tau = rr >> 2, hl = rr & 3, h = 4 * hq + hl;
            float v[8];
            if (k0 < 512) { const int sg = k0 >> 4, hp0 = k0 & 15;
#pragma unroll
                for (int q = 0; q < 8; ++q) { float x = 0.f; if (sg <= tau) { x = Kk[(((tau - sg) << 2) + hl) * 16 + hp0 + q]; if (sg == tau && hp0 + q == h) x += (hl == 0 ? dk0 : hl == 1 ? dk1 : hl == 2 ? dk2 : dk3); } v[q] = x; } }
            else { const int kp = k0 - 512, ri = kp >> 6, p0 = kp & 63;
#pragma unroll
                for (int q = 0; q < 8; ++q) { const int p = p0 + q; const float ar = Apr[(tau + 1) * 64 + p], ai = Api[(tau + 1) * 64 + p];
                    const float gr = Cr[h * 64 + p] * ar - Ci[h * 64 + p] * ai, gi = Cr[h * 64 + p] * ai + Ci[h * 64 + p] * ar; v[q] = ri ? -gi : gr; } }
            v4u o; o.x = pk2(v[0], v[1]); o.y = pk2(v[2], v[3]); o.z = pk2(v[4], v[5]); o.w = pk2(v[6], v[7]);
            *(v4u*)(BtC + ((size_t)g * 512 + tau * 16 + h) * 640 + k0) = o;
        }
        for (int e = tid; e < 32 * 64; e += NTHR) {
            const int rr = e >> 6, k0 = (e & 63) * 8; const int ri = rr >> 4, p = 16 * hq + (rr & 15), sg = k0 >> 4, hp0 = k0 & 15;
            const float ar = Apr[(31 - sg) * 64 + p], ai = Api[(31 - sg) * 64 + p];
            float v[8];
#pragma unroll
            for (int q = 0; q < 8; ++q) { const float br = Bbr[p * 16 + hp0 + q], bi = Bbi[p * 16 + hp0 + q]; v[q] = ri ? (ar * bi + ai * br) : (ar * br - ai * bi); }
            v4u o; o.x = pk2(v[0], v[1]); o.y = pk2(v[2], v[3]); o.z = pk2(v[4], v[5]); o.w = pk2(v[6], v[7]);
            *(v4u*)(BtA + ((size_t)g * 256 + ri * 64 + p) * 512 + k0) = o;
        }
        if (has1) norm4_finish(pv, g3, XN + (size_t)r1 * DM, F.lane);
    }
    {
        float4 pv[32];
        for (int r = gw4 + nbat * step4; r < T; r += step4) { norm4_load(xin + (size_t)r * DM, F.lane, pv); norm4_finish(pv, g3, XN + (size_t)r * DM, F.lane); }
    }
#undef S5_BAR
    __syncthreads();
}
__device__ __forceinline__ void p_s5_stepA(const Frame& F, const Args& A) {
    pg8::Gemm g{WSB(WS_UCAT), WSB(WS_BTA), NCH, 256, 512, UCK, 512, (long)NCH * UCK, (long)256 * 512, SG}; pg8::StaticOrder S; S.init(NCH, 256, F.G, F.bid, SG);
    pg8::EpiSl E{WSF(WS_SL)}; GEMM_RUN(pg8::EpiSl, true, g, S, E);
}
__device__ __forceinline__ void p4_s5_scan(const Frame& F, const Args& A) {
    const float* Sl = WSF(WS_SL); const float* AL = WSF(WS_AL); bf16* UC = WSB(WS_UCAT);
    if (F.wave >= 4) return;
    pg8::StaticOrder S; S.init(NCH, 512, F.G, F.bid, SG); pg8::Unit u;
    for (int i = 0; S.next(i, u); ++i) {
        const int p = F.lane, b = u.pm * 4 + F.wave, g = u.bz;
        const float ar = AL[(g * 64 + p) * 2], ai = AL[(g * 64 + p) * 2 + 1];
        const size_t row0 = (size_t)g * NCH + b * 64;
        float lr[64], li[64];
#pragma unroll
        for (int c = 0; c < 64; ++c) { lr[c] = Sl[(row0 + c) * 128 + p]; li[c] = Sl[(row0 + c) * 128 + 64 + p]; }
        asm volatile("" ::: "memory");
        float sr = 0.f, si = 0.f;
#pragma unroll
        for (int c = 0; c < 64; ++c) {
            bf16* up = UC + (row0 + c) * UCK + 512;
            up[p] = (bf16)f2bf(sr); up[64 + p] = (bf16)f2bf(si);
            const float nr = ar * sr - ai * si + lr[c], ni = ar * si + ai * sr + li[c];
            sr = nr; si = ni;
        }
    }
}
__device__ __forceinline__ void p5_s5_out(const Frame& F, const Args& A) {
    pg8::Gemm g{WSB(WS_UCAT), WSB(WS_BTC), NCH, 512, UCK, UCK, UCK, (long)NCH * UCK, (long)512 * UCK, SG}; pg8::StaticOrder S; S.init(NCH, 512, F.G, F.bid, SG);
    pg8::EpiS5 E{WSB(WS_GB)}; GEMM_RUN(pg8::EpiS5, true, g, S, E);
}
__device__ __forceinline__ void p10_xscores(const Frame& F, const Args& A) {
    for (int sel = 0; sel * F.G + F.bid < 256; ++sel) {
        pg8::Gemm g{WSB(WS_XQB), WSB(WS_KP), 2048, 256, 256, XW, 256, 0, 0, 1}; pg8::XsOrder S{F.G, F.bid, sel};
        pg8::EpiXs E{WSB(WS_XP), WSF(WS_LSUM)};
        pg8::gemm_phase<pg8::EpiXs, pg8::XsOrder, false, true>(F.ldsl, g, S, E);
        __syncthreads();
    }
}
__device__ __forceinline__ void p10_xpv(const Frame& F, const Args& A) {
    pg8::Gemm g{WSB(WS_XP), WSB(WS_VT2), 2048, 256, 256, 1024, 512, 0, 0, 1}; pg8::XoOrder S{F.G, F.bid};
    pg8::EpiXo E{WSB(WS_XO), WSF(WS_LSUM)};
    pg8::gemm_phase<pg8::EpiXo, pg8::XoOrder, true, true>(F.ldsl, g, S, E);
}
__device__ __forceinline__ unsigned f2key(float f) { const unsigned u = __float_as_uint(f); return (u & 0x80000000u) ? ~u : (u | 0x80000000u); }
__device__ __forceinline__ float key2f(unsigned k) { const unsigned u = (k & 0x80000000u) ? (k ^ 0x80000000u) : ~k; return __uint_as_float(u); }
#define INS16(L, xk) do { unsigned x_ = (xk); _Pragma("unroll") for (int s_ = 0; s_ < 16; ++s_) { const unsigned hi_ = L[s_] > x_ ? L[s_] : x_; x_ = L[s_] > x_ ? x_ : L[s_]; L[s_] = hi_; } } while (0)
#define CE_DESC(a_, b_) do { const unsigned hi_ = (a_) > (b_) ? (a_) : (b_), lo_ = (a_) > (b_) ? (b_) : (a_); (a_) = hi_; (b_) = lo_; } while (0)
__device__ __forceinline__ void sort16_desc(unsigned (&v)[16]) {
#pragma unroll
    for (int k = 2; k <= 16; k <<= 1)
#pragma unroll
        for (int j = k >> 1; j > 0; j >>= 1)
#pragma unroll
            for (int i = 0; i < 16; ++i) { const int l = i ^ j; if (l > i) { if ((i & k) == 0) CE_DESC(v[i], v[l]); else CE_DESC(v[l], v[i]); } }
}
__device__ __forceinline__ void merge16_desc(unsigned (&a)[16], const unsigned (&b)[16]) {
#pragma unroll
    for (int i = 0; i < 16; ++i) a[i] = a[i] > b[15 - i] ? a[i] : b[15 - i];
#pragma unroll
    for (int j = 8; j > 0; j >>= 1)
#pragma unroll
        for (int i = 0; i < 16; ++i) { const int l = i ^ j; if (l > i) CE_DESC(a[i], a[l]); }
}
__device__ __forceinline__ void top16_of_128(const float* sp, unsigned (&L)[16]) {
#pragma unroll 1
    for (int c = 0; c < 8; ++c) {
        unsigned ch[16];
#pragma unroll
        for (int i = 0; i < 16; ++i) ch[i] = (f2key(sp[(size_t)(c * 16 + i) * T]) & ~127u) | (unsigned)(127 - (c * 16 + i));
        sort16_desc(ch);
        if (c == 0) {
#pragma unroll
            for (int i = 0; i < 16; ++i) L[i] = ch[i];
        } else merge16_desc(L, ch);
    }
}
namespace pg8 {
struct TkOrder {
    int G, c, sel;
    __device__ __forceinline__ bool next(int i, Unit& u) const { if (i > 0) return false; const int L = sel * G + c; if (L >= PH * (T / BM)) return false; u.pm = 0; u.pn = L & (T / BM - 1); u.bz = L / (T / BM); return true; }
    __device__ __forceinline__ void a_ready(const Unit&) const {}
    __device__ __forceinline__ void done(const Unit&) const {}
    template <class G_> __device__ __forceinline__ long offA(const Unit& u, const G_& g) const { return (long)u.bz * g.sA; }
    template <class G_> __device__ __forceinline__ long offB(const Unit& u, const G_& g) const { return (long)u.bz * g.sB; }
};
struct EpiTopk {
    static constexpr bool PERM = false, AFTER_DRAIN = true;
    static constexpr int PITCH = 260;
    unsigned short* IDX; float* GATE;
    __device__ __forceinline__ void stage(const f32x4 (&acc)[2][2][4][2], int ai, int wr, int wc, int fr, int fq, PG8_LAS float* SCL) const {
#pragma unroll
        for (int m = 0; m < 4; ++m)
#pragma unroll
            for (int bj = 0; bj < 2; ++bj)
#pragma unroll
                for (int n = 0; n < 2; ++n) *(PG8_LAS f32x4*)(SCL + (wr * 64 + m * 16 + fr) * PITCH + bj * HALF + wc * 32 + n * 16 + 4 * fq) = acc[ai][bj][m][n];
    }
    static __device__ __forceinline__ unsigned blend(unsigned m, unsigned a, unsigned b) { return (a & m) | (b & ~m); }
    static __device__ __forceinline__ unsigned swap1(unsigned v) { return (unsigned)__builtin_amdgcn_update_dpp(0, (int)v, 0xB1, 0xF, 0xF, true); }
    __device__ __forceinline__ void top16(const PG8_LAS float* sp, int nb, unsigned (&L)[16]) const {
#pragma unroll 1
        for (int c = 0; c < 4; ++c) {
            unsigned ch[16];
#pragma unroll
            for (int i = 0; i < 16; ++i) ch[i] = (f2key(sp[(c * 16 + i) * PITCH]) & ~127u) | (unsigned)(nb - (c * 16 + i));
            sort16_desc(ch);
            if (c == 0) {
#pragma unroll
                for (int i = 0; i < 16; ++i) L[i] = ch[i];
            } else merge16_desc(L, ch);
        }
        unsigned P[16];
#pragma unroll
        for (int i = 0; i < 16; ++i) P[i] = swap1(L[i]);
        merge16_desc(L, P);
    }
    __device__ __forceinline__ void fused(f32x4 (&acc)[2][2][4][2], const Unit& u, int wr, int wc, int fr, int fq, PG8_LAS unsigned char* lds, int wid, int lane) const {
        PG8_LAS float* SCL = (PG8_LAS float*)lds;
        int ln = lane; asm volatile("" : "+v"(ln));
        const int tl = wid * 32 + (ln >> 1), kh = ln & 1; const unsigned km = 0u - (unsigned)kh;
        PG8_LAS unsigned char* li = lds + PK * PITCH * 4 + tl * 32;
        const PG8_LAS float* col = SCL + tl;
        float t1[16], t2[16];
        stage(acc, 0, wr, wc, fr, fq, SCL);
        asm volatile("s_waitcnt lgkmcnt(0)" ::: "memory"); __builtin_amdgcn_s_barrier(); asm volatile("" ::: "memory");
        { unsigned L1[16]; top16(col + kh * 64 * PITCH, 127 - kh * 64, L1);
#pragma unroll
          for (int s = 0; s < 16; ++s) { const int i1 = 127 - (int)(L1[s] & 127u); if (kh == 0) li[s] = (unsigned char)i1; t1[s] = col[i1 * PITCH]; } }
        asm volatile("s_waitcnt lgkmcnt(0)" ::: "memory"); __builtin_amdgcn_s_barrier(); asm volatile("" ::: "memory");
        stage(acc, 1, wr, wc, fr, fq, SCL);
        asm volatile("s_waitcnt lgkmcnt(0)" ::: "memory"); __builtin_amdgcn_s_barrier(); asm volatile("" ::: "memory");
        { unsigned L2[16]; top16(col + kh * 64 * PITCH, 127 - kh * 64, L2);
#pragma unroll
          for (int s = 0; s < 16; ++s) { const int i2 = 127 - (int)(L2[s] & 127u); if (kh == 0) li[16 + s] = (unsigned char)i2; t2[s] = col[i2 * PITCH]; } }
        unsigned Lc[16], c1[16];
        {
            int n = 0;
#pragma unroll
            for (int a = 0; a < 16; ++a)
#pragma unroll
                for (int m = 0; m < 8; ++m)
                    if ((a + 1) * (2 * m + 1) <= 16) {
                        const bool odd_ok = (a + 1) * (2 * m + 2) <= 16;
                        const float tb = __uint_as_float(blend(km, __float_as_uint(t2[(2 * m + 1) & 15]), __float_as_uint(t2[2 * m])));
                        unsigned k = (f2key(t1[a] + tb) & ~255u) | (unsigned)((255 - (a * 16 + 2 * m)) - kh);
                        if (!odd_ok) k = kh ? 0u : k;
                        if (n < 16) Lc[n] = k; else c1[n - 16] = k; ++n; }
            c1[14] = 0u; c1[15] = 0u;
        }
        sort16_desc(Lc); sort16_desc(c1); merge16_desc(Lc, c1);
        {
            unsigned P[16];
#pragma unroll
            for (int i = 0; i < 16; ++i) P[i] = swap1(Lc[i]);
            merge16_desc(Lc, P);
        }
        float ts[16]; const float mx = key2f(Lc[0] & ~255u); float sum = 0.f;
#pragma unroll
        for (int s = 0; s < 16; ++s) { ts[s] = expf(key2f(Lc[s] & ~255u) - mx); sum += ts[s]; }
        const float inv = 1.0f / sum;
        const size_t ob = (size_t)(u.pn * BM + tl) * 128 + u.bz * 16 + kh * 8;
        asm volatile("s_waitcnt lgkmcnt(0)" ::: "memory");
#pragma unroll
        for (int s = 0; s < 8; ++s) {
            const unsigned key = blend(km, Lc[8 + s], Lc[s]); const float tv = __uint_as_float(blend(km, __float_as_uint(ts[8 + s]), __float_as_uint(ts[s])));
            const int flat = 255 - (int)(key & 255u); const int a = flat >> 4, b = flat & 15;
            const int e1 = li[a], e2 = li[16 + b];
            IDX[ob + s] = (unsigned short)(e1 * PK + e2);
            GATE[ob + s] = tv * inv;
        }
    }
};
}

struct PeerCtx { int xr, nx, nloc, rank; };
__device__ __forceinline__ PeerCtx peer_ctx(const Frame& F, volatile LAS unsigned* MISC) {
    if (F.tid == 0) {
        unsigned* barw = (unsigned*)(F.ws + WS_CTL) + CW_BAR; const unsigned x = MISC[11];
        unsigned nx = 0, xr = 0, nloc = 1;
        for (unsigned j = 0; j < 16; ++j) { const unsigned c = xb_ld(&barw[XB_XCNT(j)]); if (c) { ++nx; if (j < x) ++xr; } if (j == x) nloc = c ? c : 1u; }
        MISC[12] = xr; MISC[13] = nx ? nx : 1u; MISC[14] = nloc;
    }
    __syncthreads();
    PeerCtx c; c.xr = (int)MISC[12]; c.nx = (int)MISC[13]; c.nloc = (int)MISC[14]; c.rank = (int)MISC[10];
    return c;
}
typedef __bf16 bf16x2 __attribute__((ext_vector_type(2)));
__device__ __forceinline__ float dot2_bf16(unsigned w, unsigned x, float acc) { return __builtin_amdgcn_fdot2_f32_bf16(__builtin_bit_cast(bf16x2, w), __builtin_bit_cast(bf16x2, x), acc, false); }
__device__ __forceinline__ float dot8(const v4u& r, const v4u& x) { float a = dot2_bf16(r.x, x.x, 0.f); a = dot2_bf16(r.y, x.y, a); a = dot2_bf16(r.z, x.z, a); return dot2_bf16(r.w, x.w, a); }
__device__ __forceinline__ float xl1(float x) { return __uint_as_float((unsigned)__builtin_amdgcn_update_dpp(0, (int)__float_as_uint(x), 0xB1, 0xF, 0xF, true)); }
__device__ __forceinline__ float xl2(float x) { return __uint_as_float((unsigned)__builtin_amdgcn_update_dpp(0, (int)__float_as_uint(x), 0x4E, 0xF, 0xF, true)); }
__device__ __forceinline__ float xl4(float x) { const int v = (int)__float_as_uint(x); int r = __builtin_amdgcn_update_dpp(0, v, 0x104, 0xF, 0x5, false); r = __builtin_amdgcn_update_dpp(r, v, 0x114, 0xF, 0xA, false); return __uint_as_float((unsigned)r); }
__device__ __forceinline__ float xl8(float x) { return __uint_as_float((unsigned)__builtin_amdgcn_update_dpp(0, (int)__float_as_uint(x), 0x128, 0xF, 0xF, true)); }
__device__ __forceinline__ float sum16x(float a, float b) { const auto r = __builtin_amdgcn_permlane16_swap(__float_as_uint(a), __float_as_uint(b), false, false); return __uint_as_float(r[0]) + __uint_as_float(r[1]); }
__device__ __forceinline__ float sum32x(float a, float b) { const auto r = __builtin_amdgcn_permlane32_swap(__float_as_uint(a), __float_as_uint(b), false, false); return __uint_as_float(r[0]) + __uint_as_float(r[1]); }
__device__ __forceinline__ float wave_sum_valu(float x) {
    x += xl1(x); x += xl2(x);
    x += __uint_as_float((unsigned)__builtin_amdgcn_update_dpp(0, (int)__float_as_uint(x), 0x141, 0xF, 0xF, true));
    x += __uint_as_float((unsigned)__builtin_amdgcn_update_dpp(0, (int)__float_as_uint(x), 0x140, 0xF, 0xF, true));
    x = sum16x(x, x); return sum32x(x, x);
}
#define RED8J(v0, v1, v2, v3, v4, v5, v6, v7, B2, B1, B0, out) do { \
    const float a0_ = ((B2) ? v4 : v0) + xl4((B2) ? v0 : v4), a1_ = ((B2) ? v5 : v1) + xl4((B2) ? v1 : v5); \
    const float a2_ = ((B2) ? v6 : v2) + xl4((B2) ? v2 : v6), a3_ = ((B2) ? v7 : v3) + xl4((B2) ? v3 : v7); \
    const float c0_ = ((B1) ? a2_ : a0_) + xl2((B1) ? a0_ : a2_), c1_ = ((B1) ? a3_ : a1_) + xl2((B1) ? a1_ : a3_); \
    out = ((B0) ? c1_ : c0_) + xl1((B0) ? c0_ : c1_); } while (0)
__device__ __forceinline__ int xi1(int x) { return __builtin_amdgcn_update_dpp(0, x, 0xB1, 0xF, 0xF, true); }
__device__ __forceinline__ int xi2(int x) { return __builtin_amdgcn_update_dpp(0, x, 0x4E, 0xF, 0xF, true); }
__device__ __forceinline__ int xi4(int x) { int r = __builtin_amdgcn_update_dpp(0, x, 0x104, 0xF, 0x5, false); return __builtin_amdgcn_update_dpp(r, x, 0x114, 0xF, 0xA, false); }
#define RED8JI(v0, v1, v2, v3, v4, v5, v6, v7, B2, B1, B0, out) do { \
    const int a0_ = ((B2) ? v4 : v0) + xi4((B2) ? v0 : v4), a1_ = ((B2) ? v5 : v1) + xi4((B2) ? v1 : v5); \
    const int a2_ = ((B2) ? v6 : v2) + xi4((B2) ? v2 : v6), a3_ = ((B2) ? v7 : v3) + xi4((B2) ? v3 : v7); \
    const int c0_ = ((B1) ? a2_ : a0_) + xi2((B1) ? a0_ : a2_), c1_ = ((B1) ? a3_ : a1_) + xi2((B1) ? a1_ : a3_); \
    out = ((B0) ? c1_ : c0_) + xi1((B0) ? c0_ : c1_); } while (0)
#define RED8G(v0, v1, v2, v3, v4, v5, v6, v7, B0, out) do { \
    const float a0_ = sum32x(v0, v4), a1_ = sum32x(v1, v5), a2_ = sum32x(v2, v6), a3_ = sum32x(v3, v7); \
    const float c0_ = sum16x(a0_, a2_), c1_ = sum16x(a1_, a3_); \
    out = ((B0) ? c1_ : c0_) + xl8((B0) ? c0_ : c1_); } while (0)
#define RED8(v0, v1, v2, v3, v4, v5, v6, v7, B2, B1, B0, X2, X1, X0, out) do { \
    const float a0_ = ((B2) ? v4 : v0) + __shfl_xor((B2) ? v0 : v4, X2), a1_ = ((B2) ? v5 : v1) + __shfl_xor((B2) ? v1 : v5, X2); \
    const float a2_ = ((B2) ? v6 : v2) + __shfl_xor((B2) ? v2 : v6, X2), a3_ = ((B2) ? v7 : v3) + __shfl_xor((B2) ? v3 : v7, X2); \
    const float c0_ = ((B1) ? a2_ : a0_) + __shfl_xor((B1) ? a0_ : a2_, X1), c1_ = ((B1) ? a3_ : a1_) + __shfl_xor((B1) ? a1_ : a3_, X1); \
    out = ((B0) ? c1_ : c0_) + __shfl_xor((B0) ? c0_ : c1_, X0); } while (0)
typedef float f32x2 __attribute__((ext_vector_type(2)));
struct PTok { unsigned ix[8]; v4u xa, xb; float oa, ob; };
#define PK_IDX(TK, k) (((k) & 1) ? (TK.ix[(k) >> 1] >> 16) : (TK.ix[(k) >> 1] & 0xffffu))
#define LD_IDX16(TK, ip_) do { _Pragma("unroll") for (int q_ = 0; q_ < 2; ++q_) { const int4 v_ = (ip_)[q_]; TK.ix[4 * q_] = (unsigned)v_.x; TK.ix[4 * q_ + 1] = (unsigned)v_.y; TK.ix[4 * q_ + 2] = (unsigned)v_.z; TK.ix[4 * q_ + 3] = (unsigned)v_.w; } } while (0)
__device__ __forceinline__ float dot16_fp8(const v4u& r, const f32x2 (&X)[8]) {
    f32x2 a = {0.f, 0.f};
#pragma unroll
    for (int q = 0; q < 4; ++q) { const f32x2 lo = __builtin_amdgcn_cvt_pk_f32_fp8((int)r[q], false), hi = __builtin_amdgcn_cvt_pk_f32_fp8((int)r[q], true);
        a = lo * X[2 * q] + a; a = hi * X[2 * q + 1] + a; }
    return a.x + a.y;
}
__device__ __forceinline__ void p17_peer_u(const Frame& F, const Args& A, volatile LAS unsigned* MISC) {
    const PeerCtx cx = peer_ctx(F, MISC);
    const unsigned char* UB = F.ws + WS_UB; const bf16* HB = WSB(WS_B); const unsigned short* IDX = (const unsigned short*)(F.ws + WS_IDX); float* PACT = WSF(WS_PACT) + (size_t)cx.xr * T * 128;
    const int lane = F.lane, j = lane & 7, g = lane >> 3;
    const bool b2 = lane & 4, b1 = lane & 2, b0 = lane & 1;
    const int NI = (T / 8 - cx.rank + cx.nloc - 1) / cx.nloc;
#define U_TOK(i_) (((cx.rank + (i_) * cx.nloc) * 8) + F.wave)
    for (int p = 0; cx.xr + cx.nx * p < NSL; ++p) {
        const int s = cx.xr + cx.nx * p;
        const __amdgpu_buffer_rsrc_t rs = __builtin_amdgcn_make_buffer_rsrc((void*)(UB + (size_t)s * (PK * PK) * SLW), 0, PK * PK * SLW, 0x00020000);
#define U_LOAD(TK, t_) do { const int4* ip_ = (const int4*)(IDX + (size_t)(t_) * 128 + 16 * g); LD_IDX16(TK, ip_); \
        TK.xa = *(const v4u*)(HB + (size_t)(t_) * DM + s * SLW + j * 16); TK.xb = *(const v4u*)(HB + (size_t)(t_) * DM + s * SLW + j * 16 + 8); \
        TK.oa = 0.f; TK.ob = 0.f; if (p != 0) { const float2 pp_ = *(const float2*)(PACT + (size_t)(t_) * 128 + 16 * g + 2 * j); TK.oa = pp_.x; TK.ob = pp_.y; } } while (0)
#define U_GATHER(R, TK) do { _Pragma("unroll") for (int k = 0; k < 16; ++k) R[k] = __builtin_amdgcn_raw_buffer_load_b128(rs, ((unsigned)PK_IDX(TK, k) << 7) + (unsigned)(j * 16), 0, 0); } while (0)
#define U_COMPUTE(R, XA_, XB_, OA, OB, t_) do { \
          \
        float xf_[16]; _Pragma("unroll") for (int q = 0; q < 4; ++q) { xf_[2 * q] = __uint_as_float(XA_[q] << 16); xf_[2 * q + 1] = __uint_as_float(XA_[q] & 0xffff0000u); xf_[8 + 2 * q] = __uint_as_float(XB_[q] << 16); xf_[8 + 2 * q + 1] = __uint_as_float(XB_[q] & 0xffff0000u); } \
        float am_ = 0.f; _Pragma("unroll") for (int q = 0; q < 16; ++q) am_ = fmaxf(am_, fabsf(xf_[q])); \
        am_ = fmaxf(am_, xl1(am_)); am_ = fmaxf(am_, xl2(am_)); am_ = fmaxf(am_, xl4(am_)); \
        const float qs_ = am_ > 1e-30f ? 127.0f / am_ : 0.0f, XS_ = am_ * (1.0f / 127.0f); \
        unsigned XA[4]; _Pragma("unroll") for (int d = 0; d < 4; ++d) { const int a0 = (int)__builtin_rintf(xf_[4 * d] * qs_), a1 = (int)__builtin_rintf(xf_[4 * d + 1] * qs_), a2 = (int)__builtin_rintf(xf_[4 * d + 2] * qs_), a3 = (int)__builtin_rintf(xf_[4 * d + 3] * qs_); \
            XA[d] = (unsigned)(a0 & 255) | ((unsigned)(a1 & 255) << 8) | ((unsigned)(a2 & 255) << 16) | ((unsigned)a3 << 24); } \
        int v[16]; _Pragma("unroll") for (int k = 0; k < 16; ++k) { int a_ = __builtin_amdgcn_sdot4((int)R[k][0], (int)XA[0], 0, false); a_ = __builtin_amdgcn_sdot4((int)R[k][1], (int)XA[1], a_, false); \
            a_ = __builtin_amdgcn_sdot4((int)R[k][2], (int)XA[2], a_, false); v[k] = __builtin_amdgcn_sdot4((int)R[k][3], (int)XA[3], a_, false); } \
        int ie_, io_; \
        RED8JI(v[0], v[2], v[4], v[6], v[8], v[10], v[12], v[14], b2, b1, b0, ie_); \
        RED8JI(v[1], v[3], v[5], v[7], v[9], v[11], v[13], v[15], b2, b1, b0, io_); \
        *(float2*)(PACT + (size_t)(t_) * 128 + 16 * g + 2 * j) = make_float2(OA + (float)ie_ * XS_, OB + (float)io_ * XS_); } while (0)
        PTok TA, TB; v4u RA[16], RB[16];
        if (NI > 0) U_LOAD(TA, U_TOK(0));
        if (NI > 1) U_LOAD(TB, U_TOK(1));
        if (NI > 0) U_GATHER(RA, TA);
        for (int i = 0; i < NI; i += 2) {
            { const v4u xa = TA.xa, xb = TA.xb; const float oa = TA.oa, ob = TA.ob;
              if (i + 2 < NI) U_LOAD(TA, U_TOK(i + 2));
              if (i + 1 < NI) U_GATHER(RB, TB);
              U_COMPUTE(RA, xa, xb, oa, ob, U_TOK(i)); }
            if (i + 1 < NI) {
                const v4u xa = TB.xa, xb = TB.xb; const float oa = TB.oa, ob = TB.ob;
                if (i + 3 < NI) U_LOAD(TB, U_TOK(i + 3));
                if (i + 2 < NI) U_GATHER(RA, TA);
                U_COMPUTE(RB, xa, xb, oa, ob, U_TOK(i + 1));
            }
        }
    }
#undef U_LOAD
#undef U_GATHER
#undef U_COMPUTE
#undef U_TOK
}
__device__ __forceinline__ void p18_peer_w(const Frame& F, const Args& A, volatile LAS unsigned* MISC) {
    const PeerCtx cx = peer_ctx(F, MISC);
    const float* PACT = WSF(WS_PACT); const float* GATE = WSF(WS_GATE); unsigned short* W = (unsigned short*)(F.ws + WS_PW);            const unsigned short* IDX = (const unsigned short*)(F.ws + WS_IDX);
    const float* iu = WSF(WS_ISCU); const float* iv = WSF(WS_ISCV); const float* ssq2 = WSF(WS_SSQ2);
    const size_t gt = (size_t)F.bid * NTHR + F.tid, NGT = (size_t)F.G * NTHR;
    for (size_t i = gt * 4; i < (size_t)T * 128; i += NGT * 4) {
        float4 a = make_float4(0.f, 0.f, 0.f, 0.f);
        for (int q0 = 0; q0 < cx.nx; q0 += 8) {
            float4 pa[8];
#pragma unroll
            for (int j = 0; j < 8; ++j) pa[j] = (q0 + j < cx.nx) ? *(const float4*)(PACT + (size_t)(q0 + j) * T * 128 + i) : make_float4(0.f, 0.f, 0.f, 0.f);
#pragma unroll
            for (int j = 0; j < 8; ++j) { a.x += pa[j].x; a.y += pa[j].y; a.z += pa[j].z; a.w += pa[j].w; }
        }
        const uint2 e2_ = *(const uint2*)(IDX + i); const int4 e = make_int4((int)(e2_.x & 0xffffu), (int)(e2_.x >> 16), (int)(e2_.y & 0xffffu), (int)(e2_.y >> 16)); const float4 gt4 = *(const float4*)(GATE + i);
        const float rs = 1.0f / sqrtf(ssq2[i >> 7] * (1.0f / 2048.0f) + EPS);
        float4 w;
        w.x = gt4.x * gelu_exact(a.x * iu[e.x] * rs) * iv[e.x]; w.y = gt4.y * gelu_exact(a.y * iu[e.y] * rs) * iv[e.y];
        w.z = gt4.z * gelu_exact(a.z * iu[e.z] * rs) * iv[e.z]; w.w = gt4.w * gelu_exact(a.w * iu[e.w] * rs) * iv[e.w];
        *(uint2*)(W + i) = make_uint2(pk2(w.x, w.y), pk2(w.z, w.w));
    }
}
struct VTok { unsigned ix[8]; unsigned w[8]; float h0, h1; };
__device__ __forceinline__ void p19_peer_v(const Frame& F, const Args& A, volatile LAS unsigned* MISC) {
    const PeerCtx cx = peer_ctx(F, MISC);
    const unsigned char* VT = F.ws + WS_VT;
    const __amdgpu_buffer_rsrc_t rsI = __builtin_amdgcn_make_buffer_rsrc((void*)(F.ws + WS_IDX), 0, T * 128 * 2, 0x00020000);
    const __amdgpu_buffer_rsrc_t rsW = __builtin_amdgcn_make_buffer_rsrc((void*)(F.ws + WS_PW), 0, T * 128 * 2, 0x00020000);
    const __amdgpu_buffer_rsrc_t rsHB = __builtin_amdgcn_make_buffer_rsrc((void*)(F.ws + WS_B), 0, T * DM * 2, 0x00020000);
    const int lane = F.lane, j = lane & 7, g = lane >> 3;
    const bool b5 = lane & 32, b4 = lane & 16, b3 = lane & 8;
    const int NI = (T / 8 - cx.rank + cx.nloc - 1) / cx.nloc;
#define U_TOK(i_) (((cx.rank + (i_) * cx.nloc) * 8) + F.wave)
    for (int p = 0; cx.xr + cx.nx * p < NSL; ++p) {
        const int s = cx.xr + cx.nx * p;
        const __amdgpu_buffer_rsrc_t rs = __builtin_amdgcn_make_buffer_rsrc((void*)(VT + (size_t)s * (PK * PK) * SLW), 0, PK * PK * SLW, 0x00020000);
        const unsigned hoff = (unsigned)(s * SLW + 16 * j + 2 * g) * 2u;
#define V_LOAD(TK, t_) do { const unsigned io_ = ((unsigned)(t_) * 128u + 16u * g) * 2u; \
        _Pragma("unroll") for (int q_ = 0; q_ < 2; ++q_) { const v4u v_ = __builtin_amdgcn_raw_buffer_load_b128(rsI, io_ + 16u * q_, 0, 0); TK.ix[4 * q_] = v_[0]; TK.ix[4 * q_ + 1] = v_[1]; TK.ix[4 * q_ + 2] = v_[2]; TK.ix[4 * q_ + 3] = v_[3]; } \
        _Pragma("unroll") for (int q_ = 0; q_ < 2; ++q_) { const v4u v_ = __builtin_amdgcn_raw_buffer_load_b128(rsW, io_ + 16u * q_, 0, 0); TK.w[4 * q_] = v_[0]; TK.w[4 * q_ + 1] = v_[1]; TK.w[4 * q_ + 2] = v_[2]; TK.w[4 * q_ + 3] = v_[3]; } \
        const unsigned hb_ = (unsigned)(t_) * (DM * 2u) + hoff; const unsigned hw_ = (unsigned)__builtin_amdgcn_raw_buffer_load_b32(rsHB, hb_, 0, 0); TK.h0 = __uint_as_float(hw_ << 16); TK.h1 = __uint_as_float(hw_ & 0xffff0000u); } while (0)
#define V_GATHER(R, TK) do { _Pragma("unroll") for (int k = 0; k < 16; ++k) R[k] = __builtin_amdgcn_raw_buffer_load_b128(rs, ((unsigned)PK_IDX(TK, k) << 7) + (unsigned)(j * 16), 0, 0); } while (0)
#define V_COMPUTE(R, WQ, H0, H1, t_) do { f32x2 acc[8]; _Pragma("unroll") for (int q = 0; q < 8; ++q) acc[q] = (f32x2){0.f, 0.f}; \
        _Pragma("unroll") for (int k = 0; k < 16; ++k) { const unsigned wd_ = WQ[k >> 1]; const float wk_ = __uint_as_float((k & 1) ? (wd_ & 0xffff0000u) : (wd_ << 16)); const f32x2 w2 = (f32x2){wk_, wk_}; \
            _Pragma("unroll") for (int q = 0; q < 4; ++q) { const f32x2 lo = __builtin_amdgcn_cvt_pk_f32_fp8((int)R[k][q], false), hi = __builtin_amdgcn_cvt_pk_f32_fp8((int)R[k][q], true); \
                acc[2 * q] = lo * w2 + acc[2 * q]; acc[2 * q + 1] = hi * w2 + acc[2 * q + 1]; } } \
        float f0_, f1_; \
        RED8G(acc[0].x, acc[1].x, acc[2].x, acc[3].x, acc[4].x, acc[5].x, acc[6].x, acc[7].x, b3, f0_); \
        RED8G(acc[0].y, acc[1].y, acc[2].y, acc[3].y, acc[4].y, acc[5].y, acc[6].y, acc[7].y, b3, f1_); \
        const unsigned hb2_ = (unsigned)(t_) * (DM * 2u) + hoff; const float n0_ = H0 + f0_, n1_ = H1 + f1_; \
        __builtin_amdgcn_raw_buffer_store_b32(pg8::cvt_pk_bf16(n0_, n1_), rsHB, hb2_, 0, 0); \
        } while (0)
        VTok TA, TB; v4u RA[16], RB[16];
        if (NI > 0) V_LOAD(TA, U_TOK(0));
        if (NI > 1) V_LOAD(TB, U_TOK(1));
        if (NI > 0) V_GATHER(RA, TA);
        for (int i = 0; i < NI; i += 2) {
            { const float h0 = TA.h0, h1 = TA.h1; unsigned wv[8];
              _Pragma("unroll") for (int q = 0; q < 8; ++q) wv[q] = TA.w[q];
              if (i + 2 < NI) V_LOAD(TA, U_TOK(i + 2));
              if (i + 1 < NI) V_GATHER(RB, TB);
              V_COMPUTE(RA, wv, h0, h1, U_TOK(i)); }
            if (i + 1 < NI) {
                const float h0 = TB.h0, h1 = TB.h1; unsigned wv[8];
                _Pragma("unroll") for (int q = 0; q < 8; ++q) wv[q] = TB.w[q];
                if (i + 3 < NI) V_LOAD(TB, U_TOK(i + 3));
                if (i + 2 < NI) V_GATHER(RA, TA);
                V_COMPUTE(RB, wv, h0, h1, U_TOK(i + 1));
            }
        }
    }
#undef V_LOAD
#undef V_GATHER
#undef V_COMPUTE
#undef U_TOK
}
__device__ __forceinline__ void p20_final(const Frame& F, const Args& A) {
    float* O = F.out; const bf16* HB = WSB(WS_B); const float* fg = IN_F(33);
    const int gw = F.bid * NWAVES + F.wave, NGW = F.G * NWAVES, lane = F.lane;
    for (int t = gw; t < T; t += NGW) {
        v4u h[4]; float sq = 0.f;
#pragma unroll
        for (int q = 0; q < 4; ++q) h[q] = *(const v4u*)(HB + (size_t)t * DM + 512 * q + 8 * lane);
#pragma unroll
        for (int q = 0; q < 4; ++q)
#pragma unroll
            for (int e = 0; e < 4; ++e) { const float a = __uint_as_float(h[q][e] << 16), b = __uint_as_float(h[q][e] & 0xffff0000u); sq += a * a + b * b; }
        sq = wave_sum_valu(sq);
        const float r = 1.0f / sqrtf(sq / (float)DM + EPS);
#pragma unroll
        for (int q = 0; q < 4; ++q) { const int c = 512 * q + 8 * lane;
            const float4 g0 = *(const float4*)(fg + c), g1 = *(const float4*)(fg + c + 4);
            ntst4(O + (size_t)t * DM + c, make_float4(__uint_as_float(h[q].x << 16) * r * g0.x, __uint_as_float(h[q].x & 0xffff0000u) * r * g0.y, __uint_as_float(h[q].y << 16) * r * g0.z, __uint_as_float(h[q].y & 0xffff0000u) * r * g0.w));
            ntst4(O + (size_t)t * DM + c + 4, make_float4(__uint_as_float(h[q].z << 16) * r * g1.x, __uint_as_float(h[q].z & 0xffff0000u) * r * g1.y, __uint_as_float(h[q].w << 16) * r * g1.z, __uint_as_float(h[q].w & 0xffff0000u) * r * g1.w)); }
    }
}
__device__ __forceinline__ void p0_prep(const Frame& F, const Args& A) {
    const int gw = F.bid * NWAVES + F.wave, NGW = F.G * NWAVES, lane = F.lane;
    LAS float* scr = (LAS float*)(F.ldsl + F.wave * 16384);
    constexpr int I_IN = 32 * 128, I_GLU = 16 * 32, I_OUT = 32 * 64, I_XQ = 32 * 16, I_XKV = 32 * 32, I_XO = 8 * 64, I_PQ = 32 * 64;
    constexpr int NITEMS = I_IN + I_GLU + I_OUT + I_XQ + I_XKV + I_XO + I_PQ;
    for (int it = gw; it < NITEMS; it += NGW) {
        int r = it;
        if (r < I_IN) { p0_transpose_item(IN_F(4), DM, INC, WSB(WS_WIN), 0, scr, r, lane); continue; } r -= I_IN;
        if (r < I_GLU) { p0_transpose_item(IN_F(18), SSMW, SSMW, WSB(WS_WGLU), 0, scr, r, lane); continue; } r -= I_GLU;
        if (r < I_OUT) { p0_transpose_item(IN_F(21), DM, DM, WSB(WS_WOUT), 0, scr, r, lane, IN_F(20), 1024); continue; } r -= I_OUT;
        if (r < I_XQ) { p0_transpose_item(IN_F(24), DM, XW, WSB(WS_WXQ), 0, scr, r, lane, IN_F(22)); continue; } r -= I_XQ;
        if (r < I_XKV) { p0_transpose_item(IN_F(25), DM, 2 * XW, WSB(WS_WXKV), 0, scr, r, lane); continue; } r -= I_XKV;
        if (r < I_XO) { p0_transpose_item(IN_F(26), XW, DM, WSB(WS_WXO), 0, scr, r, lane); continue; } r -= I_XO;
        p0_transpose_item(IN_F(28), DM, PH * PQD, WSB(WS_WPQ), 0, scr, r, lane, IN_F(27));
    }
    const float* x = IN_F(0); const float* mem = IN_F(1);
    { const float* g3 = IN_F(3); bf16* XN = WSB(WS_B);
      (void)x; (void)g3; (void)XN; }
    { const float* g23 = IN_F(23); bf16* MN = WSB(WS_MN);
      for (int r = 2 * gw; r < BATCH * NMEM; r += 2 * NGW) { norm_2rows_to_bf16(mem + (size_t)r * DM, g23, MN + (size_t)r * DM, lane); } }
    const int* pos = IN_I(2); float* rope = WSF(WS_ROPE);
    const int gt = F.bid * NTHR + F.tid, NGT = F.G * NTHR;
    for (int e = gt; e < T * 8; e += NGT) {
        const int t = e >> 3, i = e & 7;
        const float freq = expf(-(float)i * (13.122363377404328f / 8.0f));
        const float a = (float)pos[t] * freq;
        rope[e * 2 + 0] = cosf(a); rope[e * 2 + 1] = sinf(a);
    }
    if (gt == 0) {
        const float* q1 = IN_F(5); const float* k1 = IN_F(6); const float* q2 = IN_F(7); const float* k2 = IN_F(8);
        float s1 = 0.f, s2 = 0.f;
        for (int i = 0; i < 64; ++i) { s1 += q1[i] * k1[i]; s2 += q2[i] * k2[i]; }
        *WSF(WS_LAM) = expf(s1) - expf(s2) + LAM_INIT;
    }
    bf16* KD = WSB(WS_KD); const float* k1 = IN_F(29); const float* k2 = IN_F(30);
    for (int e = gt; e < PH * 256 * 256; e += NGT) {
        const int kk = e & 255, nn = (e >> 8) & 255, h = e >> 16;
        float v = 0.f;
        if ((kk >> 7) == (nn >> 7)) { const float* ks = (nn >> 7) ? k2 : k1; v = ks[((size_t)h * PK + (nn & 127)) * 128 + (kk & 127)]; }
        KD[e] = (bf16)f2bf(v);
    }
}
__device__ __forceinline__ void p1_win(const Frame& F, const Args& A) {
    { pg8::Gemm g{WSB(WS_B), WSB(WS_WIN), T, INC, DM, DM, DM, 0, 0, 1}; pg8::StaticOrder S; S.init(T, INC, F.G, F.bid); pg8::EpiWin E{WSB(WS_QB), (size_t)(WS_KB - WS_QB) / 2, WSB(WS_UCAT), WSF(WS_ROPE), attn_body::C2}; GEMM_RUN(pg8::EpiWin, true, g, S, E); }
}
__device__ __forceinline__ void p5_glu(const Frame& F, const Args& A) {
    pg8::Gemm g{WSB(WS_GB), WSB(WS_WGLU), T, SSMW, SSMW, SSMW, SSMW, 0, 0, 1}; pg8::StaticOrder S; S.init(T, SSMW, F.G, F.bid);
    pg8::EpiGlu E{WSB(WS_GB), IN_F(19), WSB(WS_B), WSF(WS_SSQ)}; GEMM_RUN(pg8::EpiGlu, true, g, S, E);
}

__device__ __forceinline__ void p5_tables(const Frame& F, const Args& A) {
    unsigned char* UB = F.ws + WS_UB; unsigned char* VT = F.ws + WS_VT;
    const float* Uin = IN_F(31); const float* Vin = IN_F(32); const float* gfn = IN_F(27); float* iscu = WSF(WS_ISCU); float* iscv = WSF(WS_ISCV);
    const int gw = F.bid * NWAVES + F.wave, NGW = F.G * NWAVES, lane = F.lane;
    for (int it = 2 * gw; it < 2 * PK * PK; it += 2 * NGW) {
        const int tb = it >= PK * PK, e = tb ? it - PK * PK : it;
        const float* src = (tb ? Vin : Uin) + (size_t)e * DM; unsigned char* dst = tb ? VT : UB; float* isc = tb ? iscv : iscu;
        float4 v[16]; float am0 = 0.f, am1 = 0.f;
#pragma unroll
        for (int q = 0; q < 16; ++q) v[q] = ntld4(src + (q >> 3) * DM + 256 * (q & 7) + 4 * lane);
        if (!tb) {
#pragma unroll
            for (int q = 0; q < 8; ++q) { const float4 g4 = *(const float4*)(gfn + 256 * q + 4 * lane);
                v[q].x *= g4.x; v[q].y *= g4.y; v[q].z *= g4.z; v[q].w *= g4.w; v[8 + q].x *= g4.x; v[8 + q].y *= g4.y; v[8 + q].z *= g4.z; v[8 + q].w *= g4.w; }
        }
#pragma unroll
        for (int q = 0; q < 8; ++q) { am0 = fmaxf(am0, fmaxf(fmaxf(fabsf(v[q].x), fabsf(v[q].y)), fmaxf(fabsf(v[q].z), fabsf(v[q].w))));
                                      am1 = fmaxf(am1, fmaxf(fmaxf(fabsf(v[8 + q].x), fabsf(v[8 + q].y)), fmaxf(fabsf(v[8 + q].z), fabsf(v[8 + q].w)))); }
        am0 = wave_max(am0); am1 = wave_max(am1);
        float sc0 = 1.0f, sc1 = 1.0f;
        if (tb) { if (am0 > 1e-30f) sc0 = __uint_as_float(__float_as_uint(448.0f / am0) & 0x7f800000u);
                  if (am1 > 1e-30f) sc1 = __uint_as_float(__float_as_uint(448.0f / am1) & 0x7f800000u); }
        else    { if (am0 > 1e-30f) sc0 = 127.0f / am0; if (am1 > 1e-30f) sc1 = 127.0f / am1; }
        if (lane == 0) { isc[e] = 1.0f / sc0; isc[e + 1] = 1.0f / sc1; }
#pragma unroll
        for (int q = 0; q < 16; ++q) {
            const float sc = q < 8 ? sc0 : sc1; int w = 0;
            if (tb) { w = __builtin_amdgcn_cvt_pk_fp8_f32(v[q].x * sc, v[q].y * sc, w, false);
                      w = __builtin_amdgcn_cvt_pk_fp8_f32(v[q].z * sc, v[q].w * sc, w, true); }
            else { const int q0 = (int)__builtin_rintf(v[q].x * sc), q1 = (int)__builtin_rintf(v[q].y * sc), q2 = (int)__builtin_rintf(v[q].z * sc), q3 = (int)__builtin_rintf(v[q].w * sc);
                   w = (int)((unsigned)(q0 & 255) | ((unsigned)(q1 & 255) << 8) | ((unsigned)(q2 & 255) << 16) | ((unsigned)q3 << 24)); }
            const int c = 256 * (q & 7) + 4 * lane;
            *(int*)(dst + ((size_t)(c >> 7) * (PK * PK) + e + (q >> 3)) * SLW + (c & 127)) = w;
        }
    }
}
__device__ __forceinline__ void p7_wout(const Frame& F, const Args& A) {
    pg8::Gemm g{WSB(WS_B), WSB(WS_WOUT), T, DM, DM, DM, DM, 0, 0, 1}; pg8::StaticOrder S; S.init(T, DM, F.G, F.bid);
    pg8::EpiWout E{IN_F(0), WSB(WS_HB2), WSF(WS_SSQ1), DM, WSF(WS_SSQ), 16}; GEMM_RUN(pg8::EpiWout, true, g, S, E);
}
__device__ __forceinline__ void p9_xq(const Frame& F, const Args& A) {
    pg8::Gemm g{WSB(WS_HB2), WSB(WS_WXQ), T, XW, DM, DM, DM, 0, 0, 1}; pg8::StaticOrder S; S.init(T, XW, F.G, F.bid);
    pg8::EpiRowBf16 E{WSB(WS_XQB), XW, WSF(WS_SSQ1), 0.08838834764831845f}; GEMM_RUN(pg8::EpiRowBf16, true, g, S, E);
    { pg8::Gemm g2{WSB(WS_MN), WSB(WS_WXKV), BATCH * NMEM, 2 * XW, DM, DM, DM, 0, 0, 1}; pg8::StaticOrder S2; S2.init(BATCH * NMEM, 2 * XW, F.G, F.G - 1 - F.bid); pg8::EpiXkv E2{WSB(WS_KP), WSB(WS_VT2)}; GEMM_RUN(pg8::EpiXkv, true, g2, S2, E2); }
}
__device__ __forceinline__ void p11_xo(const Frame& F, const Args& A) {
    pg8::Gemm g{WSB(WS_XO), WSB(WS_WXO), T, DM, XW, XW, XW, 0, 0, 1}; pg8::StaticOrder S; S.init(T, DM, F.G, F.bid);
    pg8::EpiResidB<false> E{WSB(WS_HB2), WSB(WS_B), WSF(WS_SSQ2), DM}; GEMM_RUN(pg8::EpiResidB<false>, true, g, S, E);
}
__device__ __forceinline__ void p13_pq(const Frame& F, const Args& A) {
    pg8::Gemm g{WSB(WS_B), WSB(WS_WPQ), T, PH * PQD, DM, DM, DM, 0, 0, 1}; pg8::StaticOrder S; S.init(T, PH * PQD, F.G, F.bid);
    pg8::EpiRowBf16 E{WSB(WS_PQ), PH * PQD, WSF(WS_SSQ2), 1.0f}; GEMM_RUN(pg8::EpiRowBf16, true, g, S, E);
}
__device__ __forceinline__ void p14_scores(const Frame& F, const Args& A) {
    for (int sel = 0; sel * F.G + F.bid < PH * (T / 256); ++sel) {
        pg8::Gemm g{WSB(WS_KD), WSB(WS_PQ), 256, T, 256, 256, PH * PQD, 65536, 256, PH}; pg8::TkOrder S{F.G, F.bid, sel};
        pg8::EpiTopk E{(unsigned short*)(F.ws + WS_IDX), WSF(WS_GATE)};
        pg8::gemm_phase<pg8::EpiTopk, pg8::TkOrder, false, true>(F.ldsl, g, S, E);
        __syncthreads();
    }
}

constexpr int NPHASE = 15;
__global__ void __launch_bounds__(NTHR, 2) mk_fwd(Args args) {
    extern __shared__ __attribute__((aligned(16))) unsigned char lds[];
#define MKFRAME() Frame F; { int t_ = threadIdx.x; asm volatile("" : "+v"(t_)); F.lds = lds; F.ldsl = (LAS unsigned char*)lds; F.tid = t_; F.lane = t_ & 63; F.wave = __builtin_amdgcn_readfirstlane(t_ >> 6); \
    F.G = gridDim.x; F.bid = blockIdx.x; F.ws = args.ws; F.out = args.out; }
    volatile LAS unsigned* MISC = (volatile LAS unsigned*)((LAS unsigned char*)lds + MISC_OFF);
    if (threadIdx.x < 32) MISC[threadIdx.x] = 0u;
    __syncthreads();
    (void)xcd_barrier_post((unsigned*)(args.ws + WS_CTL) + CW_BAR, MISC + 8);
    if (threadIdx.x == 0) { const unsigned x = xb_xcc_id(); MISC[11] = x; MISC[10] = xb_add((unsigned*)(args.ws + WS_CTL) + CW_TICKET + 64 * x, 1u); }
    const int lo = args.ph_lo, hi = args.ph_hi;
#define IN(k) (lo <= (k) && (k) < hi)
#define SEAM(k) do { if (IN(k) && IN((k) + 1)) { XcdBarrier b_; b_.bar = (unsigned*)(args.ws + WS_CTL) + CW_BAR; b_.x = 0; b_.st = MISC + 8; xcd_barrier(b_); } } while (0)
    if (IN(0)) { MKFRAME(); p0_prep(F, args); __syncthreads(); p0_s5_setup(F, args); }  SEAM(0);
    if (IN(1)) { MKFRAME(); p1_win(F, args); }             SEAM(1);
    if (IN(2)) { MKFRAME(); p3_attn(F, args); }            SEAM(2);
    if (IN(3)) { MKFRAME(); p4_s5_scan(F, args); }
    { int g3_ = __builtin_amdgcn_readfirstlane(IN(3) ? 1 : 0); asm volatile("s_waitcnt vmcnt(0)" : "+s"(g3_) :: "memory"); __syncthreads(); if (g3_) { MKFRAME(); p5_s5_out(F, args); } }   SEAM(3);
    if (IN(4)) { MKFRAME(); p5_glu(F, args); p5_tables(F, args); }  SEAM(4);
    if (IN(5)) { MKFRAME(); p7_wout(F, args); }            SEAM(5);
    if (IN(6)) { MKFRAME(); p9_xq(F, args); }              SEAM(6);
    if (IN(7)) { MKFRAME(); p10_xscores(F, args); }
    { int g8_ = __builtin_amdgcn_readfirstlane(IN(7) ? 1 : 0); asm volatile("s_waitcnt vmcnt(0)" : "+s"(g8_) :: "memory"); __syncthreads(); if (g8_) { MKFRAME(); p10_xpv(F, args); } }   SEAM(7);
    if (IN(8)) { MKFRAME(); p11_xo(F, args); }            SEAM(8);
    if (IN(9)) { MKFRAME(); p13_pq(F, args); }            SEAM(9);
    if (IN(10)) { MKFRAME(); p14_scores(F, args); }        SEAM(10);
    if (IN(11)) { MKFRAME(); p17_peer_u(F, args, MISC); }  SEAM(11);
    if (IN(12)) { MKFRAME(); p18_peer_w(F, args, MISC); }  SEAM(12);
    if (IN(13)) { MKFRAME(); p19_peer_v(F, args, MISC); }  SEAM(13);
    if (IN(14)) { MKFRAME(); p20_final(F, args); }
#undef IN
#undef SEAM
}
extern "C" void kernel_launch(void* const* d_in, const int* in_sizes, int n_in, void* d_out, int out_size, void* d_ws, size_t ws_size, hipStream_t stream) {
    static int grid = 0;
    if (grid == 0) {
        if (n_in != 34 || out_size != T * DM || ws_size < WS_END) { fprintf(stderr, "kernel_launch: unexpected shapes n_in %d out %d ws %zu\n", n_in, out_size, ws_size); grid = -1; return; }
        int dev = 0, cus = 0;
        if (hipGetDevice(&dev) != hipSuccess || hipDeviceGetAttribute(&cus, hipDeviceAttributeMultiprocessorCount, dev) != hipSuccess) { grid = -1; return; }
        if (hipFuncSetAttribute((const void*)mk_fwd, hipFuncAttributeMaxDynamicSharedMemorySize, LDS_BYTES) != hipSuccess) { fprintf(stderr, "kernel_launch: hipFuncSetAttribute failed\n"); grid = -1; return; }
        int per_cu = 0;
        (void)hipOccupancyMaxActiveBlocksPerMultiprocessor(&per_cu, (const void*)mk_fwd, NTHR, LDS_BYTES);
        (void)hipGetLastError();
        grid = cus;
    }
    if (grid < 0) return;
    (void)hipMemsetAsync((char*)d_ws + WS_CTL, 0, CTL_ZERO_BYTES, stream);
    Args a{};
    for (int i = 0; i < 34; ++i) a.in[i] = d_in[i];
    a.out = (float*)d_out; a.ws = (unsigned char*)d_ws;
    a.ph_lo = 0; a.ph_hi = NPHASE; a.li = 0;
    hipLaunchKernelGGL(mk_fwd, dim3(grid), dim3(NTHR), LDS_BYTES, stream, a);
}
```
